# Optimizing an MI355X kernel written in HIP

```python
import math
import jax, jax.numpy as jnp
from jax import lax
import numpy as np

D_MODEL = 1024
BATCH = 16
SEQ = 2048
DEPTH = 4

HEAD_DIM = 64
N_MIXERS = 4
GROUP_WIDTH = D_MODEL // N_MIXERS
GROUP_HEADS = GROUP_WIDTH // HEAD_DIM
CHUNK = 128
POOL_WINDOWS = (2, 4, 8, 16)
POOL_GROUPS = len(POOL_WINDOWS)
POOL_GROUP_DIM = GROUP_WIDTH // POOL_GROUPS
WINDOW = 128
SWA_Q_HEADS = GROUP_HEADS
SWA_KV_HEADS = 2
SWA_GROUP = SWA_Q_HEADS // SWA_KV_HEADS
SB_HEADS = GROUP_HEADS
SB_BLOCK = 128
N_BUCKETS = 32
MAX_DISTANCE = 128
D_FF = ((8 * D_MODEL // 3 + 255) // 256) * 256
EPS = 1e-6

IN_SIZES = (GROUP_WIDTH, GROUP_WIDTH, GROUP_WIDTH,
            GROUP_WIDTH, SWA_KV_HEADS * HEAD_DIM, SWA_KV_HEADS * HEAD_DIM,
            GROUP_WIDTH, GROUP_WIDTH, GROUP_WIDTH)
D_IN = sum(IN_SIZES)

kernel_name = "hybrid_parallel_headgroup_trunk"


def _split_points():
    pts, acc = [], 0
    for s in IN_SIZES[:-1]:
        acc += s
        pts.append(acc)
    return pts


def _rmsnorm(x, g):
    xf = x.astype(jnp.float32)
    y = xf * lax.rsqrt(jnp.mean(xf * xf, axis=-1, keepdims=True) + EPS)
    return (y * g.astype(jnp.float32)).astype(x.dtype)


def _layernorm_noaffine(x):
    xf = x.astype(jnp.float32)
    mu = jnp.mean(xf, axis=-1, keepdims=True)
    xc = xf - mu
    y = xc * lax.rsqrt(jnp.mean(xc * xc, axis=-1, keepdims=True) + EPS)
    return y.astype(x.dtype)


def _chunked_sgu(u, v, w_s, b_s):
    B, S, _ = u.shape
    nc = S // CHUNK
    u = jax.nn.gelu(u)
    v = _layernorm_noaffine(jax.nn.gelu(v).reshape(B, nc, CHUNK, GROUP_HEADS, HEAD_DIM))
    causal = jnp.tril(jnp.ones((CHUNK, CHUNK), w_s.dtype))
    w = w_s * causal[None]
    mix = jnp.einsum('hts,bnshd->bnthd', w, v) + b_s.T[None, None, :, :, None]
    return u * mix.reshape(B, S, GROUP_WIDTH)


def _multiscale_pool(p, w_pool, scale):
    B, S, _ = p.shape
    pg = p.reshape(B, S, POOL_GROUPS, POOL_GROUP_DIM)
    csum = jnp.cumsum(pg.astype(jnp.float32), axis=1)
    csum = jnp.pad(csum, ((0, 0), (1, 0), (0, 0), (0, 0)))
    t = jnp.arange(S)[:, None]
    win = jnp.array(POOL_WINDOWS, jnp.int32)[None, :]
    start = jnp.maximum(t + 1 - win, 0)
    gidx = jnp.arange(POOL_GROUPS)[None, :]
    window_sum = csum[:, 1:] - csum[:, start, gidx]
    count = (t + 1 - start).astype(jnp.float32)
    pooled = window_sum / count[None, :, :, None]
    y = pooled.astype(p.dtype) - pg
    y = jnp.einsum('bsgc,gcd->bsgd', y, w_pool)
    return y.reshape(B, S, GROUP_WIDTH) * scale


def _t5_bucket(dist):
    max_exact = N_BUCKETS // 2
    df = jnp.maximum(dist, 1).astype(jnp.float32)
    large = max_exact + (jnp.log(df / max_exact) / math.log(MAX_DISTANCE / max_exact)
                         * (N_BUCKETS - max_exact)).astype(jnp.int32)
    large = jnp.minimum(large, N_BUCKETS - 1)
    return jnp.where(dist < max_exact, dist, large)


def _swa_sink_attention(q, k, v, sinks, rel_bias):
    B, S, _ = q.shape
    nb = S // WINDOW
    qb = q.reshape(B, nb, WINDOW, SWA_KV_HEADS, SWA_GROUP, HEAD_DIM)
    kb = k.reshape(B, nb, WINDOW, SWA_KV_HEADS, HEAD_DIM)
    vb = v.reshape(B, nb, WINDOW, SWA_KV_HEADS, HEAD_DIM)
    pad = ((0, 0), (1, 0), (0, 0), (0, 0), (0, 0))
    k2 = jnp.concatenate([jnp.pad(kb, pad)[:, :-1], kb], axis=2)
    v2 = jnp.concatenate([jnp.pad(vb, pad)[:, :-1], vb], axis=2)
    logits = jnp.einsum('bnqhgd,bnkhd->bnhgqk', qb, k2,
                        preferred_element_type=jnp.float32) * (HEAD_DIM ** -0.5)
    dist = (jnp.arange(WINDOW)[:, None] + WINDOW) - jnp.arange(2 * WINDOW)[None, :]
    in_window = (dist >= 0) & (dist < WINDOW)
    bias = rel_bias.astype(jnp.float32)[_t5_bucket(jnp.clip(dist, 0, WINDOW - 1))]
    bias = bias.transpose(2, 0, 1).reshape(SWA_KV_HEADS, SWA_GROUP, WINDOW, 2 * WINDOW)
    not_pad = (jnp.arange(nb)[:, None] > 0) | (jnp.arange(2 * WINDOW)[None, :] >= WINDOW)
    mask = in_window[None] & not_pad[:, None, :]
    logits = jnp.where(mask[None, :, None, None], logits + bias, -1e30)
    sink = jnp.broadcast_to(sinks.astype(jnp.float32).reshape(SWA_KV_HEADS, SWA_GROUP, 1, 1),
                            logits.shape[:-1] + (1,))
    probs = jax.nn.softmax(jnp.concatenate([logits, sink], axis=-1), axis=-1)[..., :-1]
    out = jnp.einsum('bnhgqk,bnkhd->bnqhgd', probs.astype(v.dtype), v2)
    return out.reshape(B, S, GROUP_WIDTH)


def _stick_breaking_attention(q, k, v):
    B, S, _ = q.shape
    nb = S // SB_BLOCK
    kh = k.reshape(B, S, SB_HEADS, HEAD_DIM)
    vh = v.reshape(B, S, SB_HEADS, HEAD_DIM)
    qb = q.reshape(B, nb, SB_BLOCK, SB_HEADS, HEAD_DIM).transpose(1, 0, 2, 3, 4)
    key_pos = jnp.arange(S)
    scale = HEAD_DIM ** -0.5

    def block(args):
        qblk, n = args
        z = jnp.einsum('bqhd,bkhd->bhqk', qblk, kh,
                       preferred_element_type=jnp.float32) * scale
        q_pos = n * SB_BLOCK + jnp.arange(SB_BLOCK)
        causal = key_pos[None, :] < q_pos[:, None]
        log_1m = jnp.where(causal, jax.nn.log_sigmoid(-z), 0.0)
        tail = lax.cumsum(log_1m, axis=3, reverse=True) - log_1m
        w = jnp.where(causal, jnp.exp(jax.nn.log_sigmoid(z) + tail), 0.0)
        return jnp.einsum('bhqk,bkhd->bqhd', w.astype(v.dtype), vh)

    out = lax.map(block, (qb, jnp.arange(nb)))
    return out.transpose(1, 0, 2, 3, 4).reshape(B, S, GROUP_WIDTH)


def setup_inputs(seed: int = 0) -> dict:
    key = jax.random.key(seed)
    ks = jax.random.split(key, 16)
    f32 = jnp.float32
    nrm = lambda k, shape, s: jax.random.normal(k, shape, f32) * s
    return {
        "x": jax.random.normal(ks[0], (BATCH, SEQ, D_MODEL), f32),
        "w_in": nrm(ks[1], (DEPTH, D_MODEL, D_IN), D_MODEL ** -0.5),
        "w_out": nrm(ks[2], (DEPTH, D_MODEL, D_MODEL), D_MODEL ** -0.5),
        "sgu_w": nrm(ks[3], (DEPTH, GROUP_HEADS, CHUNK, CHUNK), CHUNK ** -0.5),
        "sgu_b": 1.0 + nrm(ks[4], (DEPTH, GROUP_HEADS, CHUNK), 0.02),
        "pool_w": nrm(ks[5], (DEPTH, POOL_GROUPS, POOL_GROUP_DIM, POOL_GROUP_DIM), POOL_GROUP_DIM ** -0.5),
        "pool_scale": 1.0 + nrm(ks[6], (DEPTH, GROUP_WIDTH), 0.02),
        "swa_sinks": nrm(ks[7], (DEPTH, SWA_Q_HEADS), 1.0),
        "rel_bias": nrm(ks[8], (N_BUCKETS, SWA_Q_HEADS), 0.5),
        "mix_out_gain": 1.0 + nrm(ks[9], (DEPTH, D_MODEL), 0.02),
        "norm_mix": 1.0 + nrm(ks[10], (DEPTH, D_MODEL), 0.02),
        "norm_ffn": 1.0 + nrm(ks[11], (DEPTH, D_MODEL), 0.02),
        "w_gate_up": nrm(ks[12], (DEPTH, D_MODEL, 2 * D_FF), D_MODEL ** -0.5),
        "w_down": nrm(ks[13], (DEPTH, D_FF, D_MODEL), D_FF ** -0.5),
        "norm_final": 1.0 + nrm(ks[14], (D_MODEL,), 0.02),
    }


def reference(x, w_in, w_out, sgu_w, sgu_b, pool_w, pool_scale, swa_sinks, rel_bias,
              mix_out_gain, norm_mix, norm_ffn, w_gate_up, w_down, norm_final):
    B, S, _ = x.shape
    splits = _split_points()
    for l in range(DEPTH):
        h = _rmsnorm(x, norm_mix[l])
        proj = h @ w_in[l]
        a_u, a_v, b_in, c_q, c_k, c_v, d_q, d_k, d_v = jnp.split(proj, splits, axis=-1)
        y_a = _chunked_sgu(a_u, a_v, sgu_w[l], sgu_b[l])
        y_b = _multiscale_pool(b_in, pool_w[l], pool_scale[l])
        y_c = _swa_sink_attention(c_q, c_k, c_v, swa_sinks[l], rel_bias)
        y_d = _stick_breaking_attention(d_q, d_k, d_v)
        ycat = jnp.stack([y_a, y_b, y_c, y_d], axis=2)
        ycat = _rmsnorm(ycat, mix_out_gain[l].reshape(N_MIXERS, GROUP_WIDTH))
        x = x + ycat.reshape(B, S, D_MODEL) @ w_out[l]
        h = _rmsnorm(x, norm_ffn[l])
        gate, up = jnp.split(h @ w_gate_up[l], 2, axis=-1)
        x = x + (jax.nn.silu(gate) * up) @ w_down[l]
    return _rmsnorm(x, norm_final)
```

```cpp
#include <hip/hip_runtime.h>
#include <hip/hip_cooperative_groups.h>
#include <cstdio>
#include <cstdint>
namespace cg = cooperative_groups;
namespace pg8 {
#define PG8_LAS __attribute__((address_space(3)))
typedef unsigned short bf16_t;
typedef short bf16x8 __attribute__((ext_vector_type(8)));
typedef float f32x4 __attribute__((ext_vector_type(4)));
typedef unsigned u32x4 __attribute__((ext_vector_type(4)));
constexpr int BM = 256, BK = 64, HALF = 128, HTB = HALF * BK * 2  , STAGE_BYTES = 8 * HTB, NXCD = 8, WGM = 8;

__host__ __device__ __forceinline__ int lds_byte(int r, int c) { const int st = (r >> 4) * 2 + (c >> 5), rr = r & 15, cc = c & 31, ob = rr * 64 + cc * 2; return st * 1024 + (ob ^ (((ob >> 9) & 1) << 5)); }
__host__ __device__ __forceinline__ void stage_rc(int b, int& R, int& C) { const int st = b / 1024, sb = b % 1024, swz = sb ^ (((sb >> 9) & 1) << 5); R = (st >> 1) * 16 + swz / 64; C = (st & 1) * 32 + (swz % 64) / 2; }
__host__ __device__ __forceinline__ int perm32(int rho) { const int n = rho >> 4, i = rho & 15; return 8 * (i >> 2) + 4 * n + (i & 3); }

struct Unit { int pm, pn; };
struct Gemm { const bf16_t* A; const bf16_t* Bt; int M, N, K; };

struct StaticOrder {
    int nM, nN, nwg, G, c;
    __host__ __device__ void init(int M, int N, int G_, int c_) { nM = M / BM; nN = N / BM; nwg = nM * nN; G = G_; c = c_; }
    __host__ __device__ bool next(int i, Unit& u) const {
        const long L = (long)i * G + c; if (L >= nwg) return false;
        int wgid = (int)L; { const int q = nwg / NXCD, r = nwg % NXCD, xcd = wgid % NXCD, off = wgid / NXCD; wgid = (xcd < r ? xcd * (q + 1) : r * (q + 1) + (xcd - r) * q) + off; }
        const int nig = WGM * nN, gid = wgid / nig, fm = gid * WGM, gsz = (nM - fm) < WGM ? (nM - fm) : WGM;
        u.pm = fm + ((wgid % nig) % gsz); u.pn = (wgid % nig) / gsz; return true;
    }
    __device__ __forceinline__ void a_ready(const Unit&) const {}
    __device__ __forceinline__ void done(const Unit&) const {}
};

__device__ __forceinline__ unsigned cvt_pk_bf16(float lo, float hi) { unsigned r; asm volatile("v_cvt_pk_bf16_f32 %0, %1, %2" : "=v"(r) : "v"(lo), "v"(hi)); return r; }
typedef float f32x2 __attribute__((ext_vector_type(2)));
template <class Epi, class Sched, bool ALIGN_EPI = false, bool SP2 = false>
__device__ __forceinline__ void gemm_phase(PG8_LAS unsigned char* lds, const Gemm g, const Sched& S, const Epi& E, const int opq) {
    const int tid = threadIdx.x + opq, wid = __builtin_amdgcn_readfirstlane(tid >> 6), lane = tid & 63, wr = wid >> 2, wc = wid & 3, fr = lane & 15, fq = lane >> 4;
    const int K = g.K, nt = K / BK;
    unsigned voffA[2], voffB[2];
#pragma unroll
    for (int i = 0; i < 2; ++i) { int R, C; stage_rc(tid * 16 + i * 8192, R, C); const int Rb = Epi::PERM ? ((R & ~31) + perm32(R & 31)) : R;
        voffA[i] = (unsigned)(R * K + C) * 2u; voffB[i] = (unsigned)(Rb * K + C) * 2u; }
    const size_t kstep = (size_t)(BK * 2);
    const size_t hstep = (size_t)HALF * K * 2;
    const size_t tstep = 2 * hstep;
    const unsigned ldsw = (unsigned)wid * 1024u;
    const int aoff = lds_byte(wr * 64 + fr, fq * 8), boff = lds_byte(wc * 32 + fr, fq * 8);
#define PG8_SA(b, h) (((b) * 2 + (h)) * HTB)
#define PG8_SB(b, h) ((4 + (b) * 2 + (h)) * HTB)
#define PG8_STAGE(bufoff, gbase, voff) do { _Pragma("unroll") for (int _i = 0; _i < 2; ++_i) \
        __builtin_amdgcn_global_load_lds((const unsigned*)((const char*)(gbase) + (voff)[_i]), (PG8_LAS unsigned*)(lds + (bufoff) + ldsw + _i * 8192), 16, 0, 0); } while (0)
#define PG8_LDA(dst, b, h) do { _Pragma("unroll") for (int m = 0; m < 4; ++m) _Pragma("unroll") for (int k = 0; k < 2; ++k) dst[m][k] = *(const PG8_LAS bf16x8*)(lds + PG8_SA(b, h) + aoff + m * 2048 + k * 1024); } while (0)
#define PG8_LDB(dst, b, h) do { _Pragma("unroll") for (int n = 0; n < 2; ++n) _Pragma("unroll") for (int k = 0; k < 2; ++k) dst[n][k] = *(const PG8_LAS bf16x8*)(lds + PG8_SB(b, h) + boff + n * 2048 + k * 1024); } while (0)
#define PG8_MMA(ai, bj, At, Bt) do { __builtin_amdgcn_s_setprio(1); _Pragma("unroll") for (int m = 0; m < 4; ++m) _Pragma("unroll") for (int n = 0; n < 2; ++n) _Pragma("unroll") for (int k = 0; k < 2; ++k) \
        acc[ai][bj][m][n] = __builtin_amdgcn_mfma_f32_16x16x32_bf16(Bt[n][k], At[m][k], acc[ai][bj][m][n], 0, 0, 0); __builtin_amdgcn_s_setprio(0); } while (0)
#define PG8_WAIT_V(n) asm volatile("s_waitcnt vmcnt(" #n ")" ::: "memory")
#define PG8_WAIT_L(n) asm volatile("s_waitcnt lgkmcnt(" #n ")" ::: "memory")
#define PG8_BAR __builtin_amdgcn_s_barrier()
#define PG8_SCHED __builtin_amdgcn_sched_barrier(0)
    Unit cur, nxt; int ui = 0;
    if (!S.next(0, cur)) return;
    f32x4 acc[2][2][4][2];
#pragma unroll
    for (int a = 0; a < 2; ++a)
#pragma unroll
        for (int b = 0; b < 2; ++b)
#pragma unroll
            for (int m = 0; m < 4; ++m)
#pragma unroll
                for (int n = 0; n < 2; ++n) acc[a][b][m][n] = (f32x4){0.f, 0.f, 0.f, 0.f};
    bf16x8 At[4][2], B0[2][2], B1[2][2];
    const char* cA = (const char*)g.A + (size_t)cur.pm * tstep; const char* cB = (const char*)g.Bt + (size_t)cur.pn * tstep;
    S.a_ready(cur);
    if constexpr (SP2) {
        PG8_STAGE(PG8_SB(0, 0), cB, voffB); PG8_STAGE(PG8_SB(0, 1), cB + hstep, voffB); PG8_STAGE(PG8_SA(0, 0), cA, voffA); PG8_STAGE(PG8_SA(0, 1), cA + hstep, voffA);
        if (wr == 1) PG8_BAR;
        PG8_WAIT_V(2); PG8_BAR;
        PG8_STAGE(PG8_SB(1, 0), cB + kstep, voffB); PG8_STAGE(PG8_SA(1, 0), cA + kstep, voffA); PG8_STAGE(PG8_SB(1, 1), cB + hstep + kstep, voffB);
        PG8_WAIT_V(6); PG8_BAR;
    } else {
        PG8_STAGE(PG8_SB(0, 0), cB, voffB); PG8_STAGE(PG8_SA(0, 0), cA, voffA); PG8_STAGE(PG8_SB(0, 1), cB + hstep, voffB); PG8_STAGE(PG8_SA(0, 1), cA + hstep, voffA);
        if (wr == 1) PG8_BAR;
        PG8_WAIT_V(4); PG8_BAR;
        PG8_STAGE(PG8_SB(1, 0), cB + kstep, voffB); PG8_STAGE(PG8_SA(1, 0), cA + kstep, voffA); PG8_STAGE(PG8_SB(1, 1), cB + hstep + kstep, voffB);
        PG8_WAIT_V(6); PG8_BAR;
    }
    for (;;) {
        const bool has_next = S.next(ui + 1, nxt);
        const char* nA = has_next ? (const char*)g.A + (size_t)nxt.pm * tstep : cA; const char* nB = has_next ? (const char*)g.Bt + (size_t)nxt.pn * tstep : cB;
        for (int t = 0; t < nt; t += 2) {
            const bool last = (t == nt - 2);
            const char* a1 = cA + (size_t)(t + 1) * kstep;
            const char* a2 = last ? nA : cA + (size_t)(t + 2) * kstep; const char* b2 = last ? nB : cB + (size_t)(t + 2) * kstep;
            const char* a3 = a2 + kstep; const char* b3 = b2 + kstep;
            if (last && has_next) S.a_ready(nxt);
            if constexpr (SP2) {
            PG8_LDB(B0, 0, 0); PG8_LDB(B1, 0, 1); PG8_SCHED; PG8_LDA(At, 0, 0); PG8_STAGE(PG8_SA(1, 1), a1 + hstep, voffA);
            PG8_WAIT_V(8); PG8_WAIT_L(0); PG8_BAR; PG8_MMA(0, 0, At, B0); PG8_MMA(0, 1, At, B1); PG8_BAR; PG8_SCHED;
            PG8_LDA(At, 0, 1); PG8_STAGE(PG8_SB(0, 0), b2, voffB); PG8_STAGE(PG8_SB(0, 1), b2 + hstep, voffB); PG8_STAGE(PG8_SA(0, 0), a2, voffA);
            PG8_WAIT_V(8); PG8_WAIT_L(0); PG8_BAR; PG8_MMA(1, 0, At, B0); PG8_MMA(1, 1, At, B1); PG8_BAR; PG8_SCHED;
            PG8_LDB(B0, 1, 0); PG8_LDB(B1, 1, 1); PG8_SCHED; PG8_LDA(At, 1, 0); PG8_STAGE(PG8_SA(0, 1), a2 + hstep, voffA);
            PG8_WAIT_V(8); PG8_WAIT_L(0); PG8_BAR; PG8_MMA(0, 0, At, B0); PG8_MMA(0, 1, At, B1); PG8_BAR; PG8_SCHED;
            PG8_LDA(At, 1, 1); PG8_STAGE(PG8_SB(1, 0), b3, voffB); PG8_STAGE(PG8_SB(1, 1), b3 + hstep, voffB); PG8_STAGE(PG8_SA(1, 0), a3, voffA);
            PG8_WAIT_V(8); PG8_WAIT_L(0); PG8_BAR; PG8_MMA(1, 0, At, B0); PG8_MMA(1, 1, At, B1); PG8_BAR; PG8_SCHED;
            } else {
            PG8_LDB(B0, 0, 0); PG8_SCHED; PG8_LDA(At, 0, 0); PG8_STAGE(PG8_SA(1, 1), a1 + hstep, voffA);
            PG8_WAIT_L(8); PG8_BAR; PG8_WAIT_L(0); PG8_MMA(0, 0, At, B0); PG8_BAR; PG8_SCHED;
            PG8_LDB(B1, 0, 1); PG8_STAGE(PG8_SB(0, 0), b2, voffB);
            PG8_BAR; PG8_WAIT_L(0); PG8_MMA(0, 1, At, B1); PG8_BAR;
            PG8_LDA(At, 0, 1); PG8_STAGE(PG8_SA(0, 0), a2, voffA);
            PG8_BAR; PG8_WAIT_L(0); PG8_MMA(1, 0, At, B0); PG8_BAR; PG8_SCHED;
            PG8_STAGE(PG8_SB(0, 1), b2 + hstep, voffB);
            PG8_WAIT_V(6); PG8_BAR; PG8_MMA(1, 1, At, B1); PG8_BAR;
            PG8_LDB(B0, 1, 0); PG8_SCHED; PG8_LDA(At, 1, 0); PG8_STAGE(PG8_SA(0, 1), a2 + hstep, voffA);
            PG8_WAIT_L(8); PG8_BAR; PG8_WAIT_L(0); PG8_MMA(0, 0, At, B0); PG8_BAR; PG8_SCHED;
            PG8_LDB(B1, 1, 1); PG8_STAGE(PG8_SB(1, 0), b3, voffB);
            PG8_BAR; PG8_WAIT_L(0); PG8_MMA(0, 1, At, B1); PG8_BAR;
            PG8_LDA(At, 1, 1); PG8_STAGE(PG8_SA(1, 0), a3, voffA);
            PG8_BAR; PG8_WAIT_L(0); PG8_MMA(1, 0, At, B0); PG8_BAR; PG8_SCHED;
            PG8_STAGE(PG8_SB(1, 1), b3 + hstep, voffB);
            PG8_WAIT_V(6); PG8_BAR; PG8_MMA(1, 1, At, B1); PG8_BAR;
            }
        }
        if constexpr (ALIGN_EPI) { if (wr == 0) PG8_BAR; }
        if constexpr (!Epi::AFTER_DRAIN) { E(acc, cur, wr, wc, fr, fq); S.done(cur); }
        if (!has_next) break;
#pragma unroll
        for (int a = 0; a < 2; ++a)
#pragma unroll
            for (int b = 0; b < 2; ++b)
#pragma unroll
                for (int m = 0; m < 4; ++m)
#pragma unroll
                    for (int n = 0; n < 2; ++n) acc[a][b][m][n] = (f32x4){0.f, 0.f, 0.f, 0.f};
        cur = nxt; cA = nA; cB = nB; ++ui;
        if constexpr (ALIGN_EPI) { if (wr == 1) PG8_BAR; }
    }
    PG8_WAIT_V(0);
    if constexpr (!ALIGN_EPI) { if (wr == 0) PG8_BAR; }
    PG8_BAR;
    if constexpr (Epi::AFTER_DRAIN) { E.fused(acc, cur, wr, wc, fr, fq, lds, wid, lane); S.done(cur); }
#undef PG8_SA
#undef PG8_SB
#undef PG8_STAGE
#undef PG8_LDA
#undef PG8_LDB
#undef PG8_MMA
#undef PG8_WAIT_V
#undef PG8_WAIT_L
#undef PG8_BAR
#undef PG8_SCHED
}
}

constexpr int NB = 16, SEQ = 2048, DM = 1024, DEPTH = 4, DIN = 2048, DFF = 2816, M = NB * SEQ;
constexpr float EPS = 1e-6f;
constexpr size_t MiB = 1u << 20;
constexpr size_t WS_WIN = 0, WS_WOUT = 16 * MiB, WS_WGU = 24 * MiB, WS_WDN = 68 * MiB, WS_SGUW = 90 * MiB, WS_PWT = 90 * MiB + 512 * 1024,
                 WS_SS = 91 * MiB, WS_XB = 96 * MiB, WS_PROJ = 160 * MiB, WS_YCAT = 288 * MiB, WS_HID = 160 * MiB, WS_END = 352 * MiB;
constexpr int LDS_BYTES = 160 * 1024;
constexpr int NTHR = 512;

#define LAS __attribute__((address_space(3)))
typedef unsigned short bf16_t;
typedef short bf16x8 __attribute__((ext_vector_type(8)));
typedef float f32x4 __attribute__((ext_vector_type(4)));
typedef float f32x2 __attribute__((ext_vector_type(2)));
typedef unsigned u32x4 __attribute__((ext_vector_type(4)));
typedef unsigned u32x2 __attribute__((ext_vector_type(2)));
typedef __bf16 bf16x2_t __attribute__((ext_vector_type(2)));

__device__ __forceinline__ unsigned pk2(float lo, float hi) { f32x2 v = {lo, hi}; bf16x2_t b = __builtin_convertvector(v, bf16x2_t); return __builtin_bit_cast(unsigned, b); }
__device__ __forceinline__ bf16_t f2bf(float f) { return (bf16_t)(pk2(f, 0.f) & 0xffffu); }
__device__ __forceinline__ float bflo(unsigned w) { return __uint_as_float(w << 16); }
__device__ __forceinline__ float bfhi(unsigned w) { return __uint_as_float(w & 0xffff0000u); }
#define MFMA16(a, b, c) __builtin_amdgcn_mfma_f32_16x16x32_bf16((a), (b), (c), 0, 0, 0)
#define CFENCE() asm volatile("" ::: "memory")
#define LDSWAIT() asm volatile("s_waitcnt lgkmcnt(0)" ::: "memory")
__device__ __forceinline__ float fexp(float x) { return __builtin_amdgcn_exp2f(x * 1.4426950408889634f); }
__device__ __forceinline__ float gelu_tanh(float x) {
    const float u2 = 1.5957691216057308f * x * (1.0f + 0.044715f * x * x);
    return x * __builtin_amdgcn_rcpf(1.0f + fexp(-u2));
}
__device__ __forceinline__ float rstd_of(const float* ss, int row) {
    const f32x4* p = (const f32x4*)(ss + (size_t)row * 16); const f32x4 a = p[0], b = p[1], c = p[2], d = p[3];
    const f32x4 s = (a + b) + (c + d); return rsqrtf(((s.x + s.y) + (s.z + s.w)) * (1.0f / 1024.0f) + EPS);
}

namespace pg8 {
struct EpiIn {
    static constexpr bool PERM = true, AFTER_DRAIN = false;
    bf16_t* O; const float* ss;
    __device__ __forceinline__ void operator()(const f32x4 (&acc)[2][2][4][2], const Unit& u, int wr, int wc, int fr, int fq) const {
        const int row0 = u.pm * BM + wr * 64 + fr, col0 = u.pn * BM + wc * 32 + 8 * fq; const bool act = u.pn < 2;
#pragma unroll
        for (int ai = 0; ai < 2; ++ai)
#pragma unroll
            for (int m = 0; m < 4; ++m) { const int row = row0 + ai * HALF + m * 16; const float rs = rstd_of(ss, row); bf16_t* rowp = O + (size_t)row * DIN + col0;
#pragma unroll
                for (int bj = 0; bj < 2; ++bj) { f32x4 v0 = acc[ai][bj][m][0] * rs, v1 = acc[ai][bj][m][1] * rs;
                    if (act) { v0 = (f32x4){gelu_tanh(v0[0]), gelu_tanh(v0[1]), gelu_tanh(v0[2]), gelu_tanh(v0[3])}; v1 = (f32x4){gelu_tanh(v1[0]), gelu_tanh(v1[1]), gelu_tanh(v1[2]), gelu_tanh(v1[3])}; }
                    u32x4 w; w.x = pk2(v0[0], v0[1]); w.y = pk2(v0[2], v0[3]); w.z = pk2(v1[0], v1[1]); w.w = pk2(v1[2], v1[3]);
                    *(u32x4*)(rowp + bj * HALF) = w; }
                if (m & 1) CFENCE(); }
    }
};
struct EpiGU {
    static constexpr bool PERM = true, AFTER_DRAIN = false;
    bf16_t* O; const float* ss;
    __device__ __forceinline__ void operator()(const f32x4 (&acc)[2][2][4][2], const Unit& u, int wr, int wc, int fr, int fq) const {
        const int row0 = u.pm * BM + wr * 64 + fr, col0 = u.pn * HALF + wc * 32 + 8 * fq;
#pragma unroll
        for (int ai = 0; ai < 2; ++ai)
#pragma unroll
            for (int m = 0; m < 4; ++m) { const int row = row0 + ai * HALF + m * 16; const float rs = rstd_of(ss, row); bf16_t* rowp = O + (size_t)row * DFF + col0;
                float h[8];
#pragma unroll
                for (int n = 0; n < 2; ++n)
#pragma unroll
                    for (int e = 0; e < 4; ++e) { const float g = acc[ai][0][m][n][e] * rs, up = acc[ai][1][m][n][e] * rs; h[n * 4 + e] = g * up * __builtin_amdgcn_rcpf(1.0f + fexp(-g)); }
                u32x4 w; w.x = pk2(h[0], h[1]); w.y = pk2(h[2], h[3]); w.z = pk2(h[4], h[5]); w.w = pk2(h[6], h[7]);
                *(u32x4*)rowp = w;
                if (m & 1) CFENCE(); }
    }
};
struct EpiRes {
    static constexpr bool PERM = false, AFTER_DRAIN = false;
    const float* xin; float* xout; bf16_t* xb; float* ss;
    __device__ __forceinline__ void operator()(const f32x4 (&acc)[2][2][4][2], const Unit& u, int wr, int wc, int fr, int fq) const {
        const int row0 = u.pm * BM + wr * 64 + fr, col0 = u.pn * BM + wc * 32 + 4 * fq;
#pragma unroll
        for (int ai = 0; ai < 2; ++ai)
#pragma unroll
            for (int m = 0; m < 4; ++m) { const int row = row0 + ai * HALF + m * 16; const size_t off = (size_t)row * DM + col0; float q = 0.f;
#pragma unroll
                for (int bj = 0; bj < 2; ++bj)
#pragma unroll
                    for (int n = 0; n < 2; ++n) { const f32x4 xo = *(const f32x4*)(xin + off + bj * HALF + n * 16); const f32x4 v = xo + acc[ai][bj][m][n];
                        *(f32x4*)(xout + off + bj * HALF + n * 16) = v; q += (v[0] * v[0] + v[1] * v[1]) + (v[2] * v[2] + v[3] * v[3]);
                        u32x2 w; w.x = pk2(v[0], v[1]); w.y = pk2(v[2], v[3]); *(u32x2*)(xb + off + bj * HALF + n * 16) = w; }
                q += __shfl_xor(q, 16); q += __shfl_xor(q, 32);
                if (fq == 0) ss[(size_t)row * 16 + u.pn * 4 + wc] = q;
                CFENCE(); }
    }
};
}

__device__ __forceinline__ void transpose_item(const float* W, int K, int N, bf16_t* WT, const float* gain, int mode, LAS float* scr, int item, int lane) {
    const int nblk = N / 32, kb = item / nblk, nb = item % nblk, k0 = 64 * kb, n0 = 32 * nb;
#pragma unroll 8
    for (int i = 0; i < 32; ++i) { const int kk = 2 * i + (lane >> 5); const float g = gain ? gain[k0 + kk] : 1.0f; scr[kk * 33 + (lane & 31)] = W[(size_t)(k0 + kk) * N + n0 + (lane & 31)] * g; }
    LDSWAIT();
    const int c = lane & 7;
#pragma unroll
    for (int j = 0; j < 4; ++j) { const int n = (lane >> 3) + 8 * j, gn = n0 + n; const LAS float* s = scr + (8 * c) * 33 + n;
        float cs = 1.0f; int row = gn;
        if (mode == 1) { if ((gn >= 768 && gn < 1024) || (gn >= 1280 && gn < 1536)) cs = 0.125f; }
        if (mode == 2) { const int jj = gn < DFF ? gn : gn - DFF; row = 256 * (jj >> 7) + (jj & 127) + (gn < DFF ? 0 : 128); }
        u32x4 o; o.x = pk2(s[0 * 33] * cs, s[1 * 33] * cs); o.y = pk2(s[2 * 33] * cs, s[3 * 33] * cs); o.z = pk2(s[4 * 33] * cs, s[5 * 33] * cs); o.w = pk2(s[6 * 33] * cs, s[7 * 33] * cs);
        *(u32x4*)(WT + (size_t)row * K + k0 + 8 * c) = o; }
    LDSWAIT();
}
__device__ __forceinline__ float wave_sum(float v) {
#pragma unroll
    for (int o = 1; o < 64; o <<= 1) v += __shfl_xor(v, o);
    return v;
}

struct Params {
    const float *x, *w_in, *w_out, *sgu_w, *sgu_b, *pool_w, *pool_scale, *swa_sinks, *rel_bias, *mix_out_gain, *norm_mix, *norm_ffn, *w_gate_up, *w_down, *norm_final;
    float* out; unsigned char* ws;
};


__device__ __forceinline__ void st4(bf16_t* p, const f32x4 y) { u32x2 o; o.x = pk2(y[0], y[1]); o.y = pk2(y[2], y[3]); *(u32x2*)p = o; }
__device__ __forceinline__ void rescale4(bf16_t* p, float rs) {
    const unsigned long long v = __hip_atomic_load((unsigned long long*)p, __ATOMIC_RELAXED, __HIP_MEMORY_SCOPE_AGENT); const unsigned lo = (unsigned)v, hi = (unsigned)(v >> 32);
    u32x2 o; o.x = pk2(bflo(lo) * rs, bfhi(lo) * rs); o.y = pk2(bflo(hi) * rs, bfhi(hi) * rs); *(u32x2*)p = o;
}
#define VMWAIT() asm volatile("s_waitcnt vmcnt(0)" ::: "memory")
__device__ __forceinline__ float ssq4(const f32x4 y) { return (y[0] * y[0] + y[1] * y[1]) + (y[2] * y[2] + y[3] * y[3]); }

__device__ __forceinline__ void mixer_A(LAS unsigned char* L, const bf16_t* proj, const bf16_t* sguw, const float* sgub, bf16_t* ycat, int b, int ch, int tid, int lane, int w) {
    constexpr int VTS = 136;
    LAS bf16_t* VT = (LAS bf16_t*)L;
    const size_t row0 = (size_t)b * SEQ + ch * 128;
    {
        const int tok = tid >> 2, h = tid & 3;
        const bf16_t* src = proj + (row0 + tok) * DIN + 256 + h * 64;
        float v[64]; float s = 0.f;
#pragma unroll
        for (int i = 0; i < 8; ++i) { const u32x4 t = *(const u32x4*)(src + 8 * i);
            v[8 * i + 0] = bflo(t.x); v[8 * i + 1] = bfhi(t.x); v[8 * i + 2] = bflo(t.y); v[8 * i + 3] = bfhi(t.y); v[8 * i + 4] = bflo(t.z); v[8 * i + 5] = bfhi(t.z); v[8 * i + 6] = bflo(t.w); v[8 * i + 7] = bfhi(t.w); }
#pragma unroll
        for (int i = 0; i < 64; ++i) s += v[i];
        const float mean = s * (1.0f / 64.0f); float s2 = 0.f;
#pragma unroll
        for (int i = 0; i < 64; ++i) { v[i] -= mean; s2 += v[i] * v[i]; }
        const float rstd = rsqrtf(s2 * (1.0f / 64.0f) + EPS);
        LAS bf16_t* dst = VT + (h * 64) * VTS + tok;
#pragma unroll
        for (int i = 0; i < 64; ++i) dst[i * VTS] = f2bf(v[i] * rstd);
    }
    __syncthreads();
    const int c = lane & 15, q = lane >> 4, wv = tid >> 6;
    const int nks = (w >> 1) + 1;
    const size_t trow = row0 + 16 * wv + c; float ssq = 0.f;
    bf16_t* yrow = ycat + trow * DM + 0 + 4 * q;
    const bf16_t* urow = proj + trow * DIN + 4 * q;
    const LAS bf16_t* vbase = VT + c * VTS + 8 * q;
    const bf16_t* wbase = sguw + (size_t)(16 * wv + c) * 128 + 8 * q;
#pragma unroll 1
    for (int h = 0; h < 4; ++h) {
        f32x4 acc[4];
#pragma unroll
        for (int n = 0; n < 4; ++n) acc[n] = (f32x4){0.f, 0.f, 0.f, 0.f};
#pragma unroll
        for (int ks = 0; ks < 4; ++ks) if (ks < nks) {
            const bf16x8 bfrag = *(const bf16x8*)(wbase + h * 128 * 128 + 32 * ks);
#pragma unroll
            for (int n = 0; n < 4; ++n) { const bf16x8 a = *(const LAS bf16x8*)(vbase + (h * 64 + 16 * n) * VTS + 32 * ks); acc[n] = MFMA16(a, bfrag, acc[n]); }
        }
        const float bias = sgub[h * 128 + 16 * wv + c];
#pragma unroll
        for (int n = 0; n < 4; ++n) { const u32x2 uu = *(const u32x2*)(urow + h * 64 + 16 * n);
            f32x4 y; y[0] = bflo(uu.x) * (acc[n][0] + bias); y[1] = bfhi(uu.x) * (acc[n][1] + bias); y[2] = bflo(uu.y) * (acc[n][2] + bias); y[3] = bfhi(uu.y) * (acc[n][3] + bias);
            ssq += ssq4(y); st4(yrow + h * 64 + 16 * n, y); }
    }
    ssq += __shfl_xor(ssq, 16); ssq += __shfl_xor(ssq, 32);
    const float rs = rsqrtf(ssq * (1.0f / 256.0f) + EPS);
    VMWAIT();
#pragma unroll 4
    for (int i = 0; i < 16; ++i) rescale4(yrow + 16 * i, rs);
}

__device__ __forceinline__ void mixer_B(LAS unsigned char* L, const bf16_t* proj, const bf16_t* pwt, const float* pscale, bf16_t* ycat, int b, int ch, int tid, int lane, int w) {
    constexpr int YS = 264;
    LAS bf16_t* Y = (LAS bf16_t*)L;
    const size_t row0 = (size_t)b * SEQ + ch * 128;
    {
        const int tok = tid >> 2, g = tid & 3; const int win = 2 << g; const int tseq = ch * 128 + tok; const int cnt = (tseq + 1 < win) ? (tseq + 1) : win;
        const float inv = 1.0f / (float)cnt;
#pragma unroll 1
        for (int hf = 0; hf < 2; ++hf) {
            const bf16_t* src = proj + (row0 + tok) * DIN + 512 + g * 64 + hf * 32;
            float p0[32], s[32];
#pragma unroll
            for (int i = 0; i < 4; ++i) { const u32x4 t = *(const u32x4*)(src + 8 * i);
                p0[8 * i + 0] = bflo(t.x); p0[8 * i + 1] = bfhi(t.x); p0[8 * i + 2] = bflo(t.y); p0[8 * i + 3] = bfhi(t.y); p0[8 * i + 4] = bflo(t.z); p0[8 * i + 5] = bfhi(t.z); p0[8 * i + 6] = bflo(t.w); p0[8 * i + 7] = bfhi(t.w); }
#pragma unroll
            for (int i = 0; i < 32; ++i) s[i] = p0[i];
#pragma unroll 1
            for (int j = 1; j < cnt; ++j) { const bf16_t* sj = src - (size_t)j * DIN;
#pragma unroll
                for (int i = 0; i < 4; ++i) { const u32x4 t = *(const u32x4*)(sj + 8 * i);
                    s[8 * i + 0] += bflo(t.x); s[8 * i + 1] += bfhi(t.x); s[8 * i + 2] += bflo(t.y); s[8 * i + 3] += bfhi(t.y); s[8 * i + 4] += bflo(t.z); s[8 * i + 5] += bfhi(t.z); s[8 * i + 6] += bflo(t.w); s[8 * i + 7] += bfhi(t.w); } }
#pragma unroll
            for (int i = 0; i < 4; ++i) { u32x4 o; o.x = pk2(s[8 * i + 0] * inv - p0[8 * i + 0], s[8 * i + 1] * inv - p0[8 * i + 1]); o.y = pk2(s[8 * i + 2] * inv - p0[8 * i + 2], s[8 * i + 3] * inv - p0[8 * i + 3]);
                o.z = pk2(s[8 * i + 4] * inv - p0[8 * i + 4], s[8 * i + 5] * inv - p0[8 * i + 5]); o.w = pk2(s[8 * i + 6] * inv - p0[8 * i + 6], s[8 * i + 7] * inv - p0[8 * i + 7]);
                *(LAS u32x4*)(Y + tok * YS + g * 64 + hf * 32 + 8 * i) = o; }
        }
    }
    __syncthreads();
    const int c = lane & 15, q = lane >> 4, wv = tid >> 6;
    const size_t trow = row0 + 16 * wv + c; float ssq = 0.f;
    bf16_t* yrow = ycat + trow * DM + 256 + 4 * q;
    const LAS bf16_t* ybase = Y + (16 * wv + c) * YS + 8 * q;
    const bf16_t* pbase = pwt + (size_t)c * 64 + 8 * q;
#pragma unroll 1
    for (int g = 0; g < 4; ++g) {
        f32x4 acc[4];
#pragma unroll
        for (int n = 0; n < 4; ++n) acc[n] = (f32x4){0.f, 0.f, 0.f, 0.f};
#pragma unroll
        for (int ks = 0; ks < 2; ++ks) { const bf16x8 bfrag = *(const LAS bf16x8*)(ybase + g * 64 + 32 * ks);
#pragma unroll
            for (int n = 0; n < 4; ++n) { const bf16x8 a = *(const bf16x8*)(pbase + (g * 64 + 16 * n) * 64 + 32 * ks); acc[n] = MFMA16(a, bfrag, acc[n]); } }
#pragma unroll
        for (int n = 0; n < 4; ++n) { const f32x4 sc = *(const f32x4*)(pscale + g * 64 + 16 * n + 4 * q); const f32x4 y = acc[n] * sc; ssq += ssq4(y); st4(yrow + g * 64 + 16 * n, y); }
    }
    ssq += __shfl_xor(ssq, 16); ssq += __shfl_xor(ssq, 32);
    const float rs = rsqrtf(ssq * (1.0f / 256.0f) + EPS);
    VMWAIT();
#pragma unroll 4
    for (int i = 0; i < 16; ++i) rescale4(yrow + 16 * i, rs);
}

__device__ __forceinline__ void mixer_C(LAS unsigned char* L, const bf16_t* proj, const float* sinks, const float* rel_bias, bf16_t* ycat, int b, int qb, int tid, int lane, int w) {
    constexpr int KS = 72, VS = 280, SS = 164;
    const int wv = tid >> 6;
    LAS bf16_t* KL = (LAS bf16_t*)L;
    LAS bf16_t* VT = (LAS bf16_t*)(L + 36864);
    LAS float* S = (LAS float*)(L + 72704) + wv * 16 * SS;
    LAS float* BT = (LAS float*)(L + 156672);
    const size_t row0 = (size_t)b * SEQ + qb * 128;
    {
        const int j = tid >> 7, dist = tid & 127; int bucket = dist;
        if (dist >= 16) { const int lg = 16 + (int)(__logf((float)dist * (1.0f / 16.0f)) / 2.0794415416798357f * 16.0f); bucket = lg < 31 ? lg : 31; }
        BT[j * 128 + dist] = rel_bias[bucket * 4 + j];
    }
    const int c = lane & 15, q = lane >> 4;
    const size_t trow = row0 + 16 * wv + c; float ssq = 0.f;
    bf16_t* yrow = ycat + trow * DM + 512 + 4 * q;
    const LAS bf16_t* kbase = KL + (16 * wv + c) * KS + 8 * q;
    const LAS bf16_t* vbase = VT + c * VS + 16 * wv + 8 * q;
    LAS float* swr = S + c * SS + 4 * q;
    const LAS bf16_t* wrd = (const LAS bf16_t*)(S + c * SS) + 8 * q;
    const int row = lane >> 2, seg = lane & 3;
    LAS float* srd = S + row * SS + 40 * seg;
#pragma unroll 1
    for (int kvh = 0; kvh < 2; ++kvh) {
        __syncthreads();
        {
            const int key = tid >> 1, half = tid & 1; const bool okk = (qb > 0) || (key >= 128);
            const bf16_t* ksrc = proj + (row0 - 128 + key) * DIN + 1024 + kvh * 64 + half * 32;
            const bf16_t* vsrc = ksrc + 128;
            LAS bf16_t* vdst = VT + (half * 32) * VS + key;
#pragma unroll
            for (int i = 0; i < 4; ++i) { u32x4 kk = {0u, 0u, 0u, 0u}, vv = {0u, 0u, 0u, 0u};
                if (okk) { kk = *(const u32x4*)(ksrc + 8 * i); vv = *(const u32x4*)(vsrc + 8 * i); }
                *(LAS u32x4*)(KL + key * KS + half * 32 + 8 * i) = kk;
                vdst[(8 * i + 0) * VS] = (bf16_t)(vv.x & 0xffffu); vdst[(8 * i + 1) * VS] = (bf16_t)(vv.x >> 16); vdst[(8 * i + 2) * VS] = (bf16_t)(vv.y & 0xffffu); vdst[(8 * i + 3) * VS] = (bf16_t)(vv.y >> 16);
                vdst[(8 * i + 4) * VS] = (bf16_t)(vv.z & 0xffffu); vdst[(8 * i + 5) * VS] = (bf16_t)(vv.z >> 16); vdst[(8 * i + 6) * VS] = (bf16_t)(vv.w & 0xffffu); vdst[(8 * i + 7) * VS] = (bf16_t)(vv.w >> 16); }
            if (tid < 64) {
#pragma unroll
                for (int i = 0; i < 3; ++i) *(LAS u32x4*)(VT + tid * VS + 256 + 8 * i) = (u32x4){0u, 0u, 0u, 0u}; }
        }
        __syncthreads();
#pragma unroll 1
        for (int g = 0; g < 2; ++g) { const int j = 2 * kvh + g;
            bf16x8 qf[2];
#pragma unroll
            for (int ks = 0; ks < 2; ++ks) qf[ks] = *(const bf16x8*)(proj + trow * DIN + 768 + j * 64 + 32 * ks + 8 * q);
#pragma unroll
            for (int kti = 0; kti < 9; ++kti) { f32x4 s = {0.f, 0.f, 0.f, 0.f};
#pragma unroll
                for (int ks = 0; ks < 2; ++ks) { const bf16x8 a = *(const LAS bf16x8*)(kbase + 16 * kti * KS + 32 * ks); s = MFMA16(a, qf[ks], s); }
                *(LAS f32x4*)(swr + 16 * kti) = s; }
            LDSWAIT();
            { const float sink = sinks[j]; const LAS float* bt = BT + j * 128;
                int zz; asm volatile("v_mov_b32 %0, 0" : "=v"(zz));
                const int rowz = row + zz; const int klo = (qb > 0) ? (rowz + 1) : max(rowz + 1, 128 - 16 * w), khi = rowz + 128;
                float lg[40]; float mx = sink;
#pragma unroll
                for (int i4 = 0; i4 < 10; ++i4) { const f32x4 sv = *(const LAS f32x4*)(srd + 4 * i4);
#pragma unroll
                    for (int e = 0; e < 4; ++e) { const int kl = 40 * seg + 4 * i4 + e; const int dist = 128 + rowz - kl; const bool valid = (unsigned)(kl - klo) <= (unsigned)(khi - klo);
                        const int dcl = dist & 127; const float bb = bt[dcl];
                        const float v = valid ? (sv[e] + bb) : -1e30f; lg[4 * i4 + e] = v; mx = fmaxf(mx, v); } }
                mx = fmaxf(mx, __shfl_xor(mx, 1)); mx = fmaxf(mx, __shfl_xor(mx, 2));
                float sum = 0.f;
#pragma unroll
                for (int i = 0; i < 40; ++i) { const float p = (lg[i] > -1e29f) ? fexp(lg[i] - mx) : 0.f; lg[i] = p; sum += p; }
                sum += __shfl_xor(sum, 1); sum += __shfl_xor(sum, 2);
                const float inv = 1.0f / (sum + fexp(sink - mx));
                LDSWAIT();
                LAS bf16_t* Wr = (LAS bf16_t*)(S + row * SS) + 40 * seg;
#pragma unroll
                for (int i8 = 0; i8 < 5; ++i8) { u32x4 o; o.x = pk2(lg[8 * i8 + 0] * inv, lg[8 * i8 + 1] * inv); o.y = pk2(lg[8 * i8 + 2] * inv, lg[8 * i8 + 3] * inv); o.z = pk2(lg[8 * i8 + 4] * inv, lg[8 * i8 + 5] * inv); o.w = pk2(lg[8 * i8 + 6] * inv, lg[8 * i8 + 7] * inv);
                    *(LAS u32x4*)(Wr + 8 * i8) = o; }
            }
            LDSWAIT();
            f32x4 acc[4];
#pragma unroll
            for (int n = 0; n < 4; ++n) acc[n] = (f32x4){0.f, 0.f, 0.f, 0.f};
#pragma unroll
            for (int ks = 0; ks < 5; ++ks) { const bf16x8 bfrag = *(const LAS bf16x8*)(wrd + 32 * ks);
#pragma unroll
                for (int n = 0; n < 4; ++n) { const bf16x8 a = *(const LAS bf16x8*)(vbase + 16 * n * VS + 32 * ks); acc[n] = MFMA16(a, bfrag, acc[n]); } }
            LDSWAIT();
#pragma unroll
            for (int n = 0; n < 4; ++n) { ssq += ssq4(acc[n]); st4(yrow + j * 64 + 16 * n, acc[n]); }
        }
    }
    ssq += __shfl_xor(ssq, 16); ssq += __shfl_xor(ssq, 32);
    const float rs = rsqrtf(ssq * (1.0f / 256.0f) + EPS);
    VMWAIT();
#pragma unroll 4
    for (int i = 0; i < 16; ++i) rescale4(yrow + 16 * i, rs);
}

__device__ __forceinline__ void mixer_D(LAS unsigned char* L, const bf16_t* proj, bf16_t* ycat, int b, int qb64, int tid, int lane, int w) {
    constexpr int KS = 264, VS = 72, SS = 68, WS = 72;
    const int wv = tid >> 6;
    LAS bf16_t* KL = (LAS bf16_t*)L;
    LAS bf16_t* VT = (LAS bf16_t*)(L + 33792);
    LAS float* S = (LAS float*)(L + 70656) + wv * 16 * SS;
    LAS bf16_t* Wl = (LAS bf16_t*)(L + 105472) + wv * 16 * WS;
    LAS float* RED = (LAS float*)(L + 123904);
    const int rg = wv & 3, hp = wv >> 2, c = lane & 15, q = lane >> 4;
    const size_t seq0 = (size_t)b * SEQ; const size_t trow = seq0 + qb64 * 64 + 16 * rg + c;
    bf16x8 qf[2][2];
#pragma unroll
    for (int hh = 0; hh < 2; ++hh)
#pragma unroll
        for (int ks = 0; ks < 2; ++ks) qf[hh][ks] = *(const bf16x8*)(proj + trow * DIN + 1280 + (2 * hp + hh) * 64 + 32 * ks + 8 * q);
    f32x4 acc[2][4];
#pragma unroll
    for (int hh = 0; hh < 2; ++hh)
#pragma unroll
        for (int n = 0; n < 4; ++n) acc[hh][n] = (f32x4){0.f, 0.f, 0.f, 0.f};
    float carry[2] = {0.f, 0.f};
    const int srow = lane >> 2, seg = lane & 3, qloc = 16 * rg + srow;
    const LAS bf16_t* kbase = KL + c * KS + hp * 128 + 8 * q;
    const LAS bf16_t* vbase = VT + (hp * 128 + c) * VS + 8 * q;
    LAS float* swr = S + c * SS + 4 * q;
    const LAS float* srd = S + srow * SS + 16 * seg;
    LAS bf16_t* wwr = Wl + srow * WS + 16 * seg;
    const LAS bf16_t* wrd = Wl + c * WS + 8 * q;
    const int skey = tid >> 3, spart = tid & 7;
    const bf16_t* ksrc0 = proj + (seq0 + skey) * DIN + 1536 + spart * 32;
    LAS bf16_t* kdst = KL + skey * KS + spart * 32;
    LAS bf16_t* vdst = VT + (spart * 32) * VS + skey;
#pragma unroll 1
    for (int kt = qb64; kt >= 0; --kt) {
        __syncthreads();
        {
            const bf16_t* ksrc = ksrc0 + (size_t)kt * 64 * DIN;
            const bf16_t* vsrc = ksrc + 256;
#pragma unroll
            for (int i = 0; i < 4; ++i) { const u32x4 kk = *(const u32x4*)(ksrc + 8 * i), vv = *(const u32x4*)(vsrc + 8 * i);
                *(LAS u32x4*)(kdst + 8 * i) = kk;
                vdst[(8 * i + 0) * VS] = (bf16_t)(vv.x & 0xffffu); vdst[(8 * i + 1) * VS] = (bf16_t)(vv.x >> 16); vdst[(8 * i + 2) * VS] = (bf16_t)(vv.y & 0xffffu); vdst[(8 * i + 3) * VS] = (bf16_t)(vv.y >> 16);
                vdst[(8 * i + 4) * VS] = (bf16_t)(vv.z & 0xffffu); vdst[(8 * i + 5) * VS] = (bf16_t)(vv.z >> 16); vdst[(8 * i + 6) * VS] = (bf16_t)(vv.w & 0xffffu); vdst[(8 * i + 7) * VS] = (bf16_t)(vv.w >> 16); }
        }
        __syncthreads();
        const bool diag = (kt == qb64);
#pragma unroll
        for (int hh = 0; hh < 2; ++hh) {
#pragma unroll
            for (int kti = 0; kti < 4; ++kti) { f32x4 s = {0.f, 0.f, 0.f, 0.f};
#pragma unroll
                for (int ks = 0; ks < 2; ++ks) { const bf16x8 a = *(const LAS bf16x8*)(kbase + 16 * kti * KS + hh * 64 + 32 * ks); s = MFMA16(a, qf[hh][ks], s); }
                *(LAS f32x4*)(swr + 16 * kti) = s; }
            LDSWAIT();
            {
                float z[16], cs[16];
#pragma unroll
                for (int i4 = 0; i4 < 4; ++i4) { const f32x4 sv = *(const LAS f32x4*)(srd + 4 * i4); z[4 * i4 + 0] = sv[0]; z[4 * i4 + 1] = sv[1]; z[4 * i4 + 2] = sv[2]; z[4 * i4 + 3] = sv[3]; }
                float run = 0.f;
#pragma unroll
                for (int i = 15; i >= 0; --i) { const bool valid = !diag || (16 * seg + i < qloc);
                    const float zz = z[i]; const float e = fexp(-fabsf(zz)); const float sp = fmaxf(zz, 0.f) + __logf(1.0f + e);
                    run += valid ? sp : 0.f; cs[i] = run; }
                const int lb = lane & ~3;
                const float t0 = __shfl(run, lb + 0), t1 = __shfl(run, lb + 1), t2 = __shfl(run, lb + 2), t3 = __shfl(run, lb + 3);
                const float off = carry[hh] + (seg < 1 ? t1 : 0.f) + (seg < 2 ? t2 : 0.f) + (seg < 3 ? t3 : 0.f);
                carry[hh] += (t0 + t1) + (t2 + t3);
                float wvv[16];
#pragma unroll
                for (int i = 0; i < 16; ++i) { const bool valid = !diag || (16 * seg + i < qloc); wvv[i] = valid ? fexp(z[i] - (off + cs[i])) : 0.f; }
                u32x4 o0, o1; o0.x = pk2(wvv[0], wvv[1]); o0.y = pk2(wvv[2], wvv[3]); o0.z = pk2(wvv[4], wvv[5]); o0.w = pk2(wvv[6], wvv[7]); o1.x = pk2(wvv[8], wvv[9]); o1.y = pk2(wvv[10], wvv[11]); o1.z = pk2(wvv[12], wvv[13]); o1.w = pk2(wvv[14], wvv[15]);
                *(LAS u32x4*)(wwr) = o0; *(LAS u32x4*)(wwr + 8) = o1;
            }
            LDSWAIT();
#pragma unroll
            for (int ks = 0; ks < 2; ++ks) { const bf16x8 bfrag = *(const LAS bf16x8*)(wrd + 32 * ks);
#pragma unroll
                for (int n = 0; n < 4; ++n) { const bf16x8 a = *(const LAS bf16x8*)(vbase + (hh * 64 + 16 * n) * VS + 32 * ks); acc[hh][n] = MFMA16(a, bfrag, acc[hh][n]); } }
            LDSWAIT();
        }
    }
    float ssq = 0.f;
#pragma unroll
    for (int hh = 0; hh < 2; ++hh)
#pragma unroll
        for (int n = 0; n < 4; ++n) ssq += ssq4(acc[hh][n]);
    ssq += __shfl_xor(ssq, 16); ssq += __shfl_xor(ssq, 32);
    __syncthreads();
    if (q == 0) RED[(16 * rg + c) * 2 + hp] = ssq;
    __syncthreads();
    const float tot = RED[(16 * rg + c) * 2 + 0] + RED[(16 * rg + c) * 2 + 1];
    const float rs = rsqrtf(tot * (1.0f / 256.0f) + EPS);
    bf16_t* yrow = ycat + trow * DM + 768 + hp * 128 + 4 * q;
#pragma unroll
    for (int hh = 0; hh < 2; ++hh)
#pragma unroll
        for (int n = 0; n < 4; ++n) st4(yrow + hh * 64 + 16 * n, acc[hh][n] * rs);
}

__global__ void __launch_bounds__(NTHR, 2) fwd_megakernel(Params p) {
    extern __shared__ __attribute__((aligned(16))) unsigned char lds[];
    cg::grid_group grid = cg::this_grid();
    LAS unsigned char* L = (LAS unsigned char*)lds;
    const int tid = threadIdx.x, lane = tid & 63, wave = __builtin_amdgcn_readfirstlane(tid >> 6);
    const int G = gridDim.x, bx = blockIdx.x;
    unsigned char* ws = p.ws;
    bf16_t* Win_t = (bf16_t*)(ws + WS_WIN); bf16_t* Wout_t = (bf16_t*)(ws + WS_WOUT); bf16_t* Wgu_t = (bf16_t*)(ws + WS_WGU); bf16_t* Wdn_t = (bf16_t*)(ws + WS_WDN);
    bf16_t* SGUW = (bf16_t*)(ws + WS_SGUW); bf16_t* PWT = (bf16_t*)(ws + WS_PWT); float* SSQ = (float*)(ws + WS_SS);
    bf16_t* XB = (bf16_t*)(ws + WS_XB); bf16_t* PROJ = (bf16_t*)(ws + WS_PROJ); bf16_t* YCAT = (bf16_t*)(ws + WS_YCAT); bf16_t* HID = (bf16_t*)(ws + WS_HID);

    {
        LAS float* scr = (LAS float*)(L + wave * 16384);
        const int gw = bx * 8 + wave, NGW = G * 8;
        constexpr int I_IN = (DM / 64) * (DIN / 32), I_OUT = (DM / 64) * (DM / 32), I_GU = (DM / 64) * (2 * DFF / 32), I_DN = (DFF / 64) * (DM / 32), I_L = I_IN + I_OUT + I_GU + I_DN;
        for (int it = gw; it < DEPTH * I_L; it += NGW) {
            const int l = it / I_L; int r = it % I_L;
            if (r < I_IN) { transpose_item(p.w_in + (size_t)l * DM * DIN, DM, DIN, Win_t + (size_t)l * DIN * DM, p.norm_mix + l * DM, 1, scr, r, lane); continue; } r -= I_IN;
            if (r < I_OUT) { transpose_item(p.w_out + (size_t)l * DM * DM, DM, DM, Wout_t + (size_t)l * DM * DM, p.mix_out_gain + l * DM, 0, scr, r, lane); continue; } r -= I_OUT;
            if (r < I_GU) { transpose_item(p.w_gate_up + (size_t)l * DM * 2 * DFF, DM, 2 * DFF, Wgu_t + (size_t)l * 2 * DFF * DM, p.norm_ffn + l * DM, 2, scr, r, lane); continue; } r -= I_GU;
            transpose_item(p.w_down + (size_t)l * DFF * DM, DFF, DM, Wdn_t + (size_t)l * DM * DFF, nullptr, 0, scr, r, lane);
        }
        for (int m = gw; m < M; m += NGW) {
            const f32x4* xr = (const f32x4*)(p.x + (size_t)m * DM) + lane; u32x2* o8 = (u32x2*)(XB + (size_t)m * DM) + lane; float s = 0.f;
#pragma unroll
            for (int j = 0; j < 4; ++j) { const f32x4 v = xr[64 * j]; s += (v.x * v.x + v.y * v.y) + (v.z * v.z + v.w * v.w); u32x2 o; o.x = pk2(v.x, v.y); o.y = pk2(v.z, v.w); o8[64 * j] = o; }
            s = wave_sum(s);
            if (lane < 16) SSQ[(size_t)m * 16 + lane] = (lane == 0) ? s : 0.f;
        }
        const int gt = bx * NTHR + tid, NGT = G * NTHR;
        for (int e = gt; e < DEPTH * 4 * 128 * 128 / 8; e += NGT) { const int s0 = (e & 15) * 8, t = (e >> 4) & 127; const float* src = p.sgu_w + (size_t)e * 8;
            const f32x4 a = *(const f32x4*)src, bq = *(const f32x4*)(src + 4); float v[8] = {a.x, a.y, a.z, a.w, bq.x, bq.y, bq.z, bq.w};
#pragma unroll
            for (int i = 0; i < 8; ++i) v[i] = (s0 + i <= t) ? v[i] : 0.f;
            u32x4 o; o.x = pk2(v[0], v[1]); o.y = pk2(v[2], v[3]); o.z = pk2(v[4], v[5]); o.w = pk2(v[6], v[7]); *(u32x4*)(SGUW + (size_t)e * 8) = o; }
        for (int e = gt; e < DEPTH * 4 * 64 * 64; e += NGT) { const int cc = e & 63, d = (e >> 6) & 63, lg = e >> 12; PWT[e] = f2bf(p.pool_w[((size_t)lg * 64 + cc) * 64 + d]); }
    }
    grid.sync();

    for (int l = 0; l < DEPTH; ++l) {
#ifndef NO_P1
        { int zk; asm volatile("s_mov_b32 %0, 0" : "=s"(zk)); pg8::Gemm g{XB, Win_t + (size_t)l * DIN * DM, M, DIN, DM + zk}; pg8::StaticOrder S; S.init(M, DIN, G + zk, bx); pg8::EpiIn E{PROJ, SSQ};
          pg8::gemm_phase<pg8::EpiIn, pg8::StaticOrder, true, true>(L, g, S, E, zk); }
#endif
        grid.sync();
        for (int u = bx; u < 256; u += G) { const int b = u >> 4, ch = u & 15;
            __syncthreads();
#ifndef NO_A
            { int zt; asm volatile("v_mov_b32 %0, 0" : "=v"(zt)); const int t2 = tid + zt; mixer_A(L, PROJ, SGUW + (size_t)l * 4 * 128 * 128, p.sgu_b + l * 4 * 128, YCAT, b, ch, t2, t2 & 63, __builtin_amdgcn_readfirstlane(t2 >> 6)); }
#endif
            __syncthreads();
#ifndef NO_B
            { int zt; asm volatile("v_mov_b32 %0, 0" : "=v"(zt)); const int t2 = tid + zt; mixer_B(L, PROJ, PWT + (size_t)l * 4 * 64 * 64, p.pool_scale + l * 256, YCAT, b, ch, t2, t2 & 63, __builtin_amdgcn_readfirstlane(t2 >> 6)); }
#endif
            __syncthreads();
#ifndef NO_C
            { int zt; asm volatile("v_mov_b32 %0, 0" : "=v"(zt)); const int t2 = tid + zt; mixer_C(L, PROJ, p.swa_sinks + l * 4, p.rel_bias, YCAT, b, ch, t2, t2 & 63, __builtin_amdgcn_readfirstlane(t2 >> 6)); }
#endif
            __syncthreads();
#ifndef NO_D
#pragma unroll 1
            for (int hf = 0; hf < 2; ++hf) { int zt; asm volatile("v_mov_b32 %0, 0" : "=v"(zt)); const int t2 = tid + zt; mixer_D(L, PROJ, YCAT, b, hf ? 31 - ch : ch, t2, t2 & 63, __builtin_amdgcn_readfirstlane(t2 >> 6)); __syncthreads(); }
#endif
        }
        grid.sync();
#ifndef NO_P3
        { int zk; asm volatile("s_mov_b32 %0, 0" : "=s"(zk)); pg8::Gemm g{YCAT, Wout_t + (size_t)l * DM * DM, M, DM, DM + zk}; pg8::StaticOrder S; S.init(M, DM, G + zk, bx); pg8::EpiRes E{l == 0 ? p.x : p.out, p.out, XB, SSQ};
          pg8::gemm_phase<pg8::EpiRes, pg8::StaticOrder, true, true>(L, g, S, E, zk); }
#endif
        grid.sync();
#ifndef NO_P4
        { int zk; asm volatile("s_mov_b32 %0, 0" : "=s"(zk)); pg8::Gemm g{XB, Wgu_t + (size_t)l * 2 * DFF * DM, M, 2 * DFF, DM + zk}; pg8::StaticOrder S; S.init(M, 2 * DFF, G + zk, bx); pg8::EpiGU E{HID, SSQ};
          pg8::gemm_phase<pg8::EpiGU, pg8::StaticOrder, true, true>(L, g, S, E, zk); }
#endif
        grid.sync();
#ifndef NO_P5
        { int zk; asm volatile("s_mov_b32 %0, 0" : "=s"(zk)); pg8::Gemm g{HID, Wdn_t + (size_t)l * DM * DFF, M, DM, DFF + zk}; pg8::StaticOrder S; S.init(M, DM, G + zk, bx); pg8::EpiRes E{p.out, p.out, XB, SSQ};
          pg8::gemm_phase<pg8::EpiRes, pg8::StaticOrder, true, true>(L, g, S, E, zk); }
#endif
        grid.sync();
    }
    {
        const int gw = bx * 8 + wave, NGW = G * 8;
        for (int m = gw; m < M; m += NGW) { const float rs = rstd_of(SSQ, m); f32x4* xr = (f32x4*)(p.out + (size_t)m * DM) + lane; const f32x4* gr = (const f32x4*)p.norm_final + lane;
#pragma unroll
            for (int j = 0; j < 4; ++j) { const f32x4 v = xr[64 * j], gg = gr[64 * j]; xr[64 * j] = v * rs * gg; } }
    }
}

extern "C" void kernel_launch(void* const* d_in, const int* in_sizes, int n_in, void* d_out, int out_size, void* d_ws, size_t ws_size, hipStream_t stream) {
    static int grid_blocks = 0;
    if (grid_blocks == 0) {
        if (n_in != 15 || in_sizes[0] != M * DM || out_size != M * DM || ws_size < WS_END) { fprintf(stderr, "kernel_launch: unexpected shapes (n_in %d, in0 %d, out %d, ws %zu)\n", n_in, n_in > 0 ? in_sizes[0] : -1, out_size, ws_size); grid_blocks = -1; return; }
        int dev = 0, cus = 0, per_cu = 0;
        hipGetDevice(&dev); hipDeviceGetAttribute(&cus, hipDeviceAttributeMultiprocessorCount, dev);
        if (hipFuncSetAttribute((const void*)fwd_megakernel, hipFuncAttributeMaxDynamicSharedMemorySize, LDS_BYTES) != hipSuccess) { fprintf(stderr, "kernel_launch: hipFuncSetAttribute failed\n"); }
        if (hipOccupancyMaxActiveBlocksPerMultiprocessor(&per_cu, (const void*)fwd_megakernel, NTHR, LDS_BYTES) != hipSuccess || per_cu < 1) { fprintf(stderr, "kernel_launch: occupancy query says %d\n", per_cu); per_cu = 1; }
        (void)hipGetLastError();
        grid_blocks = cus * 1;
        if (grid_blocks <= 0) grid_blocks = 256;
    }
    if (grid_blocks < 0) return;
    Params p{};
    p.x = (const float*)d_in[0]; p.w_in = (const float*)d_in[1]; p.w_out = (const float*)d_in[2]; p.sgu_w = (const float*)d_in[3]; p.sgu_b = (const float*)d_in[4];
    p.pool_w = (const float*)d_in[5]; p.pool_scale = (const float*)d_in[6]; p.swa_sinks = (const float*)d_in[7]; p.rel_bias = (const float*)d_in[8]; p.mix_out_gain = (const float*)d_in[9];
    p.norm_mix = (const float*)d_in[10]; p.norm_ffn = (const float*)d_in[11]; p.w_gate_up = (const float*)d_in[12]; p.w_down = (const float*)d_in[13]; p.norm_final = (const float*)d_in[14];
    p.out = (float*)d_out; p.ws = (unsigned char*)d_ws;
    void* args[] = {&p};
    hipError_t e = hipLaunchCooperativeKernel((const void*)fwd_megakernel, dim3(grid_blocks), dim3(NTHR), args, LDS_BYTES, stream);
    if (e != hipSuccess) fprintf(stderr, "cooperative launch failed: %s (grid %d)\n", hipGetErrorString(e), grid_blocks);
}
```

```cpp
#include <hip/hip_runtime.h>
#include <hip/hip_cooperative_groups.h>
#include <cstdio>
#include <cstdint>
namespace cg = cooperative_groups;
namespace pg8 {
#define PG8_LAS __attribute__((address_space(3)))
typedef unsigned short bf16_t;
typedef short bf16x8 __attribute__((ext_vector_type(8)));
typedef float f32x4 __attribute__((ext_vector_type(4)));
typedef unsigned u32x4 __attribute__((ext_vector_type(4)));
constexpr int BM = 256, BK = 64, HALF = 128, HTB = HALF * BK * 2  , STAGE_BYTES = 8 * HTB, NXCD = 8, WGM = 8;

__host__ __device__ __forceinline__ int lds_byte(int r, int c) { const int st = (r >> 4) * 2 + (c >> 5), rr = r & 15, cc = c & 31, ob = rr * 64 + cc * 2; return st * 1024 + (ob ^ (((ob >> 9) & 1) << 5)); }
__host__ __device__ __forceinline__ void stage_rc(int b, int& R, int& C) { const int st = b / 1024, sb = b % 1024, swz = sb ^ (((sb >> 9) & 1) << 5); R = (st >> 1) * 16 + swz / 64; C = (st & 1) * 32 + (swz % 64) / 2; }
__host__ __device__ __forceinline__ int perm32(int rho) { const int n = rho >> 4, i = rho & 15; return 8 * (i >> 2) + 4 * n + (i & 3); }

struct Unit { int pm, pn; };
struct Gemm { const bf16_t* A; const bf16_t* Bt; int M, N, K; };

struct StaticOrder {
    int nM, nN, nwg, G, c;
    __host__ __device__ void init(int M, int N, int G_, int c_) { nM = M / BM; nN = N / BM; nwg = nM * nN; G = G_; c = c_; }
    __host__ __device__ bool next(int i, Unit& u) const {
        const long L = (long)i * G + c; if (L >= nwg) return false;
        int wgid = (int)L; { const int q = nwg / NXCD, r = nwg % NXCD, xcd = wgid % NXCD, off = wgid / NXCD; wgid = (xcd < r ? xcd * (q + 1) : r * (q + 1) + (xcd - r) * q) + off; }
        const int nig = WGM * nN, gid = wgid / nig, fm = gid * WGM, gsz = (nM - fm) < WGM ? (nM - fm) : WGM;
        u.pm = fm + ((wgid % nig) % gsz); u.pn = (wgid % nig) / gsz; return true;
    }
    __device__ __forceinline__ void a_ready(const Unit&) const {}
    __device__ __forceinline__ void done(const Unit&) const {}
};

__device__ __forceinline__ unsigned cvt_pk_bf16(float lo, float hi) { unsigned r; asm volatile("v_cvt_pk_bf16_f32 %0, %1, %2" : "=v"(r) : "v"(lo), "v"(hi)); return r; }
typedef float f32x2 __attribute__((ext_vector_type(2)));
template <class Epi, class Sched, bool ALIGN_EPI = false, bool SP2 = false>
__device__ __forceinline__ void gemm_phase(PG8_LAS unsigned char* lds, const Gemm g, const Sched& S, const Epi& E, const int opq) {
    const int tid = threadIdx.x + opq, wid = __builtin_amdgcn_readfirstlane(tid >> 6), lane = tid & 63, wr = wid >> 2, wc = wid & 3, fr = lane & 15, fq = lane >> 4;
    const int K = g.K, nt = K / BK;
    unsigned voffA[2], voffB[2];
#pragma unroll
    for (int i = 0; i < 2; ++i) { int R, C; stage_rc(tid * 16 + i * 8192, R, C); const int Rb = Epi::PERM ? ((R & ~31) + perm32(R & 31)) : R;
        voffA[i] = (unsigned)(R * K + C) * 2u; voffB[i] = (unsigned)(Rb * K + C) * 2u; }
    const size_t kstep = (size_t)(BK * 2);
    const size_t hstep = (size_t)HALF * K * 2;
    const size_t tstep = 2 * hstep;
    const unsigned ldsw = (unsigned)wid * 1024u;
    const int aoff = lds_byte(wr * 64 + fr, fq * 8), boff = lds_byte(wc * 32 + fr, fq * 8);
#define PG8_SA(b, h) (((b) * 2 + (h)) * HTB)
#define PG8_SB(b, h) ((4 + (b) * 2 + (h)) * HTB)
#define PG8_STAGE(bufoff, gbase, voff) do { _Pragma("unroll") for (int _i = 0; _i < 2; ++_i) \
        __builtin_amdgcn_global_load_lds((const unsigned*)((const char*)(gbase) + (voff)[_i]), (PG8_LAS unsigned*)(lds + (bufoff) + ldsw + _i * 8192), 16, 0, 0); } while (0)
#define PG8_LDA(dst, b, h) do { _Pragma("unroll") for (int m = 0; m < 4; ++m) _Pragma("unroll") for (int k = 0; k < 2; ++k) dst[m][k] = *(const PG8_LAS bf16x8*)(lds + PG8_SA(b, h) + aoff + m * 2048 + k * 1024); } while (0)
#define PG8_LDB(dst, b, h) do { _Pragma("unroll") for (int n = 0; n < 2; ++n) _Pragma("unroll") for (int k = 0; k < 2; ++k) dst[n][k] = *(const PG8_LAS bf16x8*)(lds + PG8_SB(b, h) + boff + n * 2048 + k * 1024); } while (0)
#define PG8_MMA(ai, bj, At, Bt) do { __builtin_amdgcn_s_setprio(1); _Pragma("unroll") for (int m = 0; m < 4; ++m) _Pragma("unroll") for (int n = 0; n < 2; ++n) _Pragma("unroll") for (int k = 0; k < 2; ++k) \
        acc[ai][bj][m][n] = __builtin_amdgcn_mfma_f32_16x16x32_bf16(Bt[n][k], At[m][k], acc[ai][bj][m][n], 0, 0, 0); __builtin_amdgcn_s_setprio(0); } while (0)
#define PG8_WAIT_V(n) asm volatile("s_waitcnt vmcnt(" #n ")" ::: "memory")
#define PG8_WAIT_L(n) asm volatile("s_waitcnt lgkmcnt(" #n ")" ::: "memory")
#define PG8_BAR __builtin_amdgcn_s_barrier()
#define PG8_SCHED __builtin_amdgcn_sched_barrier(0)
    Unit cur, nxt; int ui = 0;
    if (!S.next(0, cur)) return;
    f32x4 acc[2][2][4][2];
#pragma unroll
    for (int a = 0; a < 2; ++a)
#pragma unroll
        for (int b = 0; b < 2; ++b)
#pragma unroll
            for (int m = 0; m < 4; ++m)
#pragma unroll
                for (int n = 0; n < 2; ++n) acc[a][b][m][n] = (f32x4){0.f, 0.f, 0.f, 0.f};
    bf16x8 At[4][2], B0[2][2], B1[2][2];
    const char* cA = (const char*)g.A + (size_t)cur.pm * tstep; const char* cB = (const char*)g.Bt + (size_t)cur.pn * tstep;
    S.a_ready(cur);
    if constexpr (SP2) {
        PG8_STAGE(PG8_SB(0, 0), cB, voffB); PG8_STAGE(PG8_SB(0, 1), cB + hstep, voffB); PG8_STAGE(PG8_SA(0, 0), cA, voffA); PG8_STAGE(PG8_SA(0, 1), cA + hstep, voffA);
        if (wr == 1) PG8_BAR;
        PG8_WAIT_V(2); PG8_BAR;
        PG8_STAGE(PG8_SB(1, 0), cB + kstep, voffB); PG8_STAGE(PG8_SA(1, 0), cA + kstep, voffA); PG8_STAGE(PG8_SB(1, 1), cB + hstep + kstep, voffB);
        PG8_WAIT_V(6); PG8_BAR;
    } else {
        PG8_STAGE(PG8_SB(0, 0), cB, voffB); PG8_STAGE(PG8_SA(0, 0), cA, voffA); PG8_STAGE(PG8_SB(0, 1), cB + hstep, voffB); PG8_STAGE(PG8_SA(0, 1), cA + hstep, voffA);
        if (wr == 1) PG8_BAR;
        PG8_WAIT_V(4); PG8_BAR;
        PG8_STAGE(PG8_SB(1, 0), cB + kstep, voffB); PG8_STAGE(PG8_SA(1, 0), cA + kstep, voffA); PG8_STAGE(PG8_SB(1, 1), cB + hstep + kstep, voffB);
        PG8_WAIT_V(6); PG8_BAR;
    }
    for (;;) {
        const bool has_next = S.next(ui + 1, nxt);
        const char* nA = has_next ? (const char*)g.A + (size_t)nxt.pm * tstep : cA; const char* nB = has_next ? (const char*)g.Bt + (size_t)nxt.pn * tstep : cB;
        for (int t = 0; t < nt; t += 2) {
            const bool last = (t == nt - 2);
            const char* a1 = cA + (size_t)(t + 1) * kstep;
            const char* a2 = last ? nA : cA + (size_t)(t + 2) * kstep; const char* b2 = last ? nB : cB + (size_t)(t + 2) * kstep;
            const char* a3 = a2 + kstep; const char* b3 = b2 + kstep;
            if (last && has_next) S.a_ready(nxt);
            if constexpr (SP2) {
            PG8_LDB(B0, 0, 0); PG8_LDB(B1, 0, 1); PG8_SCHED; PG8_LDA(At, 0, 0); PG8_STAGE(PG8_SA(1, 1), a1 + hstep, voffA);
            PG8_WAIT_V(8); PG8_WAIT_L(0); PG8_BAR; PG8_MMA(0, 0, At, B0); PG8_MMA(0, 1, At, B1); PG8_BAR; PG8_SCHED;
            PG8_LDA(At, 0, 1); PG8_STAGE(PG8_SB(0, 0), b2, voffB); PG8_STAGE(PG8_SB(0, 1), b2 + hstep, voffB); PG8_STAGE(PG8_SA(0, 0), a2, voffA);
            PG8_WAIT_V(8); PG8_WAIT_L(0); PG8_BAR; PG8_MMA(1, 0, At, B0); PG8_MMA(1, 1, At, B1); PG8_BAR; PG8_SCHED;
            PG8_LDB(B0, 1, 0); PG8_LDB(B1, 1, 1); PG8_SCHED; PG8_LDA(At, 1, 0); PG8_STAGE(PG8_SA(0, 1), a2 + hstep, voffA);
            PG8_WAIT_V(8); PG8_WAIT_L(0); PG8_BAR; PG8_MMA(0, 0, At, B0); PG8_MMA(0, 1, At, B1); PG8_BAR; PG8_SCHED;
            PG8_LDA(At, 1, 1); PG8_STAGE(PG8_SB(1, 0), b3, voffB); PG8_STAGE(PG8_SB(1, 1), b3 + hstep, voffB); PG8_STAGE(PG8_SA(1, 0), a3, voffA);
            PG8_WAIT_V(8); PG8_WAIT_L(0); PG8_BAR; PG8_MMA(1, 0, At, B0); PG8_MMA(1, 1, At, B1); PG8_BAR; PG8_SCHED;
            } else {
            PG8_LDB(B0, 0, 0); PG8_SCHED; PG8_LDA(At, 0, 0); PG8_STAGE(PG8_SA(1, 1), a1 + hstep, voffA);
            PG8_WAIT_L(8); PG8_BAR; PG8_WAIT_L(0); PG8_MMA(0, 0, At, B0); PG8_BAR; PG8_SCHED;
            PG8_LDB(B1, 0, 1); PG8_STAGE(PG8_SB(0, 0), b2, voffB);
            PG8_BAR; PG8_WAIT_L(0); PG8_MMA(0, 1, At, B1); PG8_BAR;
            PG8_LDA(At, 0, 1); PG8_STAGE(PG8_SA(0, 0), a2, voffA);
            PG8_BAR; PG8_WAIT_L(0); PG8_MMA(1, 0, At, B0); PG8_BAR; PG8_SCHED;
            PG8_STAGE(PG8_SB(0, 1), b2 + hstep, voffB);
            PG8_WAIT_V(6); PG8_BAR; PG8_MMA(1, 1, At, B1); PG8_BAR;
            PG8_LDB(B0, 1, 0); PG8_SCHED; PG8_LDA(At, 1, 0); PG8_STAGE(PG8_SA(0, 1), a2 + hstep, voffA);
            PG8_WAIT_L(8); PG8_BAR; PG8_WAIT_L(0); PG8_MMA(0, 0, At, B0); PG8_BAR; PG8_SCHED;
            PG8_LDB(B1, 1, 1); PG8_STAGE(PG8_SB(1, 0), b3, voffB);
            PG8_BAR; PG8_WAIT_L(0); PG8_MMA(0, 1, At, B1); PG8_BAR;
            PG8_LDA(At, 1, 1); PG8_STAGE(PG8_SA(1, 0), a3, voffA);
            PG8_BAR; PG8_WAIT_L(0); PG8_MMA(1, 0, At, B0); PG8_BAR; PG8_SCHED;
            PG8_STAGE(PG8_SB(1, 1), b3 + hstep, voffB);
            PG8_WAIT_V(6); PG8_BAR; PG8_MMA(1, 1, At, B1); PG8_BAR;
            }
        }
        if constexpr (ALIGN_EPI) { if (wr == 0) PG8_BAR; }
        if constexpr (!Epi::AFTER_DRAIN) { E(acc, cur, wr, wc, fr, fq); S.done(cur); }
        if (!has_next) break;
#pragma unroll
        for (int a = 0; a < 2; ++a)
#pragma unroll
            for (int b = 0; b < 2; ++b)
#pragma unroll
                for (int m = 0; m < 4; ++m)
#pragma unroll
                    for (int n = 0; n < 2; ++n) acc[a][b][m][n] = (f32x4){0.f, 0.f, 0.f, 0.f};
        cur = nxt; cA = nA; cB = nB; ++ui;
        if constexpr (ALIGN_EPI) { if (wr == 1) PG8_BAR; }
    }
    PG8_WAIT_V(0);
    if constexpr (!ALIGN_EPI) { if (wr == 0) PG8_BAR; }
    PG8_BAR;
    if constexpr (Epi::AFTER_DRAIN) { E.fused(acc, cur, wr, wc, fr, fq, lds, wid, lane); S.done(cur); }
#undef PG8_SA
#undef PG8_SB
#undef PG8_STAGE
#undef PG8_LDA
#undef PG8_LDB
#undef PG8_MMA
#undef PG8_WAIT_V
#undef PG8_WAIT_L
#undef PG8_BAR
#undef PG8_SCHED
}
}

constexpr int NB = 16, SEQ = 2048, DM = 1024, DEPTH = 4, DIN = 2048, DFF = 2816, M = NB * SEQ;
constexpr float EPS = 1e-6f;
constexpr size_t MiB = 1u << 20;
constexpr size_t WS_WIN = 0, WS_WOUT = 16 * MiB, WS_WGU = 24 * MiB, WS_WDN = 68 * MiB, WS_SGUW = 90 * MiB, WS_PWT = 90 * MiB + 512 * 1024,
                 WS_SS = 91 * MiB, WS_XB = 96 * MiB, WS_PROJ = 160 * MiB, WS_YCAT = 288 * MiB, WS_HID = 160 * MiB, WS_END = 352 * MiB;
constexpr int LDS_BYTES = 160 * 1024;
constexpr int NTHR = 512;

#define LAS __attribute__((address_space(3)))
typedef unsigned short bf16_t;
typedef short bf16x8 __attribute__((ext_vector_type(8)));
typedef float f32x4 __attribute__((ext_vector_type(4)));
typedef float f32x2 __attribute__((ext_vector_type(2)));
typedef unsigned u32x4 __attribute__((ext_vector_type(4)));
typedef unsigned u32x2 __attribute__((ext_vector_type(2)));
typedef __bf16 bf16x2_t __attribute__((ext_vector_type(2)));

__device__ __forceinline__ unsigned pk2(float lo, float hi) { f32x2 v = {lo, hi}; bf16x2_t b = __builtin_convertvector(v, bf16x2_t); return __builtin_bit_cast(unsigned, b); }
__device__ __forceinline__ bf16_t f2bf(float f) { return (bf16_t)(pk2(f, 0.f) & 0xffffu); }
__device__ __forceinline__ float bflo(unsigned w) { return __uint_as_float(w << 16); }
__device__ __forceinline__ float bfhi(unsigned w) { return __uint_as_float(w & 0xffff0000u); }
#define MFMA16(a, b, c) __builtin_amdgcn_mfma_f32_16x16x32_bf16((a), (b), (c), 0, 0, 0)
#define CFENCE() asm volatile("" ::: "memory")
#define LDSWAIT() asm volatile("s_waitcnt lgkmcnt(0)" ::: "memory")
__device__ __forceinline__ float fexp(float x) { return __builtin_amdgcn_exp2f(x * 1.4426950408889634f); }
__device__ __forceinline__ float gelu_tanh(float x) {
    const float u2 = 1.5957691216057308f * x * (1.0f + 0.044715f * x * x);
    return x * __builtin_amdgcn_rcpf(1.0f + fexp(-u2));
}
__device__ __forceinline__ float rstd_of(const float* ss, int row) {
    const f32x4* p = (const f32x4*)(ss + (size_t)row * 16); const f32x4 a = p[0], b = p[1], c = p[2], d = p[3];
    const f32x4 s = (a + b) + (c + d); return rsqrtf(((s.x + s.y) + (s.z + s.w)) * (1.0f / 1024.0f) + EPS);
}

namespace pg8 {
struct EpiIn {
    static constexpr bool PERM = true, AFTER_DRAIN = false;
    bf16_t* O; const float* ss;
    __device__ __forceinline__ void operator()(const f32x4 (&acc)[2][2][4][2], const Unit& u, int wr, int wc, int fr, int fq) const {
        const int row0 = u.pm * BM + wr * 64 + fr, col0 = u.pn * BM + wc * 32 + 8 * fq; const bool act = u.pn < 2;
#pragma unroll
        for (int ai = 0; ai < 2; ++ai)
#pragma unroll
            for (int m = 0; m < 4; ++m) { const int row = row0 + ai * HALF + m * 16; const float rs = rstd_of(ss, row); bf16_t* rowp = O + (size_t)row * DIN + col0;
#pragma unroll
                for (int bj = 0; bj < 2; ++bj) { f32x4 v0 = acc[ai][bj][m][0] * rs, v1 = acc[ai][bj][m][1] * rs;
                    if (act) { v0 = (f32x4){gelu_tanh(v0[0]), gelu_tanh(v0[1]), gelu_tanh(v0[2]), gelu_tanh(v0[3])}; v1 = (f32x4){gelu_tanh(v1[0]), gelu_tanh(v1[1]), gelu_tanh(v1[2]), gelu_tanh(v1[3])}; }
                    u32x4 w; w.x = pk2(v0[0], v0[1]); w.y = pk2(v0[2], v0[3]); w.z = pk2(v1[0], v1[1]); w.w = pk2(v1[2], v1[3]);
                    *(u32x4*)(rowp + bj * HALF) = w; }
                if (m & 1) CFENCE(); }
    }
};
struct EpiGU {
    static constexpr bool PERM = true, AFTER_DRAIN = false;
    bf16_t* O; const float* ss;
    __device__ __forceinline__ void operator()(const f32x4 (&acc)[2][2][4][2], const Unit& u, int wr, int wc, int fr, int fq) const {
        const int row0 = u.pm * BM + wr * 64 + fr, col0 = u.pn * HALF + wc * 32 + 8 * fq;
#pragma unroll
        for (int ai = 0; ai < 2; ++ai)
#pragma unroll
            for (int m = 0; m < 4; ++m) { const int row = row0 + ai * HALF + m * 16; const float rs = rstd_of(ss, row); bf16_t* rowp = O + (size_t)row * DFF + col0;
                float h[8];
#pragma unroll
                for (int n = 0; n < 2; ++n)
#pragma unroll
                    for (int e = 0; e < 4; ++e) { const float g = acc[ai][0][m][n][e] * rs, up = acc[ai][1][m][n][e] * rs; h[n * 4 + e] = g * up * __builtin_amdgcn_rcpf(1.0f + fexp(-g)); }
                u32x4 w; w.x = pk2(h[0], h[1]); w.y = pk2(h[2], h[3]); w.z = pk2(h[4], h[5]); w.w = pk2(h[6], h[7]);
                *(u32x4*)rowp = w;
                if (m & 1) CFENCE(); }
    }
};
struct EpiRes {
    static constexpr bool PERM = false, AFTER_DRAIN = false;
    const float* xin; float* xout; bf16_t* xb; float* ss;
    __device__ __forceinline__ void operator()(const f32x4 (&acc)[2][2][4][2], const Unit& u, int wr, int wc, int fr, int fq) const {
        const int row0 = u.pm * BM + wr * 64 + fr, col0 = u.pn * BM + wc * 32 + 4 * fq;
#pragma unroll
        for (int ai = 0; ai < 2; ++ai)
#pragma unroll
            for (int m = 0; m < 4; ++m) { const int row = row0 + ai * HALF + m * 16; const size_t off = (size_t)row * DM + col0; float q = 0.f;
#pragma unroll
                for (int bj = 0; bj < 2; ++bj)
#pragma unroll
                    for (int n = 0; n < 2; ++n) { const f32x4 xo = *(const f32x4*)(xin + off + bj * HALF + n * 16); const f32x4 v = xo + acc[ai][bj][m][n];
                        *(f32x4*)(xout + off + bj * HALF + n * 16) = v; q += (v[0] * v[0] + v[1] * v[1]) + (v[2] * v[2] + v[3] * v[3]);
                        u32x2 w; w.x = pk2(v[0], v[1]); w.y = pk2(v[2], v[3]); *(u32x2*)(xb + off + bj * HALF + n * 16) = w; }
                q += __shfl_xor(q, 16); q += __shfl_xor(q, 32);
                if (fq == 0) ss[(size_t)row * 16 + u.pn * 4 + wc] = q;
                CFENCE(); }
    }
};
}

__device__ __forceinline__ void transpose_item(const float* W, int K, int N, bf16_t* WT, const float* gain, int mode, LAS float* scr, int item, int lane) {
    const int nblk = N / 32, kb = item / nblk, nb = item % nblk, k0 = 64 * kb, n0 = 32 * nb;
#pragma unroll 8
    for (int i = 0; i < 32; ++i) { const int kk = 2 * i + (lane >> 5); const float g = gain ? gain[k0 + kk] : 1.0f; scr[kk * 33 + (lane & 31)] = W[(size_t)(k0 + kk) * N + n0 + (lane & 31)] * g; }
    LDSWAIT();
    const int c = lane & 7;
#pragma unroll
    for (int j = 0; j < 4; ++j) { const int n = (lane >> 3) + 8 * j, gn = n0 + n; const LAS float* s = scr + (8 * c) * 33 + n;
        float cs = 1.0f; int row = gn;
        if (mode == 1) { if ((gn >= 768 && gn < 1024) || (gn >= 1280 && gn < 1536)) cs = 0.125f; }
        if (mode == 2) { const int jj = gn < DFF ? gn : gn - DFF; row = 256 * (jj >> 7) + (jj & 127) + (gn < DFF ? 0 : 128); }
        u32x4 o; o.x = pk2(s[0 * 33] * cs, s[1 * 33] * cs); o.y = pk2(s[2 * 33] * cs, s[3 * 33] * cs); o.z = pk2(s[4 * 33] * cs, s[5 * 33] * cs); o.w = pk2(s[6 * 33] * cs, s[7 * 33] * cs);
        *(u32x4*)(WT + (size_t)row * K + k0 + 8 * c) = o; }
    LDSWAIT();
}
__device__ __forceinline__ float wave_sum(float v) {
#pragma unroll
    for (int o = 1; o < 64; o <<= 1) v += __shfl_xor(v, o);
    return v;
}

struct Params {
    const float *x, *w_in, *w_out, *sgu_w, *sgu_b, *pool_w, *pool_scale, *swa_sinks, *rel_bias, *mix_out_gain, *norm_mix, *norm_ffn, *w_gate_up, *w_down, *norm_final;
    float* out; unsigned char* ws;
};


__device__ __forceinline__ void st4(bf16_t* p, const f32x4 y) { u32x2 o; o.x = pk2(y[0], y[1]); o.y = pk2(y[2], y[3]); *(u32x2*)p = o; }
__device__ __forceinline__ void rescale4(bf16_t* p, float rs) {
    const unsigned long long v = __hip_atomic_load((unsigned long long*)p, __ATOMIC_RELAXED, __HIP_MEMORY_SCOPE_AGENT); const unsigned lo = (unsigned)v, hi = (unsigned)(v >> 32);
    u32x2 o; o.x = pk2(bflo(lo) * rs, bfhi(lo) * rs); o.y = pk2(bflo(hi) * rs, bfhi(hi) * rs); *(u32x2*)p = o;
}
#define VMWAIT() asm volatile("s_waitcnt vmcnt(0)" ::: "memory")
__device__ __forceinline__ float ssq4(const f32x4 y) { return (y[0] * y[0] + y[1] * y[1]) + (y[2] * y[2] + y[3] * y[3]); }

__device__ __forceinline__ void mixer_A(LAS unsigned char* L, const bf16_t* proj, const bf16_t* sguw, const float* sgub, bf16_t* ycat, int b, int ch, int tid, int lane, int w) {
    constexpr int VTS = 136;
    LAS bf16_t* VT = (LAS bf16_t*)L;
    const size_t row0 = (size_t)b * SEQ + ch * 128;
    {
        const int tok = tid >> 2, h = tid & 3;
        const bf16_t* src = proj + (row0 + tok) * DIN + 256 + h * 64;
        float v[64]; float s = 0.f;
#pragma unroll
        for (int i = 0; i < 8; ++i) { const u32x4 t = *(const u32x4*)(src + 8 * i);
            v[8 * i + 0] = bflo(t.x); v[8 * i + 1] = bfhi(t.x); v[8 * i + 2] = bflo(t.y); v[8 * i + 3] = bfhi(t.y); v[8 * i + 4] = bflo(t.z); v[8 * i + 5] = bfhi(t.z); v[8 * i + 6] = bflo(t.w); v[8 * i + 7] = bfhi(t.w); }
#pragma unroll
        for (int i = 0; i < 64; ++i) s += v[i];
        const float mean = s * (1.0f / 64.0f); float s2 = 0.f;
#pragma unroll
        for (int i = 0; i < 64; ++i) { v[i] -= mean; s2 += v[i] * v[i]; }
        const float rstd = rsqrtf(s2 * (1.0f / 64.0f) + EPS);
        LAS bf16_t* dst = VT + (h * 64) * VTS + tok;
#pragma unroll
        for (int i = 0; i < 64; ++i) dst[i * VTS] = f2bf(v[i] * rstd);
    }
    __syncthreads();
    const int c = lane & 15, q = lane >> 4, wv = tid >> 6;
    const int nks = (w >> 1) + 1;
    const size_t trow = row0 + 16 * wv + c; float ssq = 0.f;
    bf16_t* yrow = ycat + trow * DM + 0 + 4 * q;
    const bf16_t* urow = proj + trow * DIN + 4 * q;
    const LAS bf16_t* vbase = VT + c * VTS + 8 * q;
    const bf16_t* wbase = sguw + (size_t)(16 * wv + c) * 128 + 8 * q;
#pragma unroll 1
    for (int h = 0; h < 4; ++h) {
        f32x4 acc[4];
#pragma unroll
        for (int n = 0; n < 4; ++n) acc[n] = (f32x4){0.f, 0.f, 0.f, 0.f};
#pragma unroll
        for (int ks = 0; ks < 4; ++ks) if (ks < nks) {
            const bf16x8 bfrag = *(const bf16x8*)(wbase + h * 128 * 128 + 32 * ks);
#pragma unroll
            for (int n = 0; n < 4; ++n) { const bf16x8 a = *(const LAS bf16x8*)(vbase + (h * 64 + 16 * n) * VTS + 32 * ks); acc[n] = MFMA16(a, bfrag, acc[n]); }
        }
        const float bias = sgub[h * 128 + 16 * wv + c];
#pragma unroll
        for (int n = 0; n < 4; ++n) { const u32x2 uu = *(const u32x2*)(urow + h * 64 + 16 * n);
            f32x4 y; y[0] = bflo(uu.x) * (acc[n][0] + bias); y[1] = bfhi(uu.x) * (acc[n][1] + bias); y[2] = bflo(uu.y) * (acc[n][2] + bias); y[3] = bfhi(uu.y) * (acc[n][3] + bias);
            ssq += ssq4(y); st4(yrow + h * 64 + 16 * n, y); }
    }
    ssq += __shfl_xor(ssq, 16); ssq += __shfl_xor(ssq, 32);
    const float rs = rsqrtf(ssq * (1.0f / 256.0f) + EPS);
    VMWAIT();
#pragma unroll 4
    for (int i = 0; i < 16; ++i) rescale4(yrow + 16 * i, rs);
}

__device__ __forceinline__ void mixer_B(LAS unsigned char* L, const bf16_t* proj, const bf16_t* pwt, const float* pscale, bf16_t* ycat, int b, int ch, int tid, int lane, int w) {
    constexpr int YS = 264;
    LAS bf16_t* Y = (LAS bf16_t*)L;
    const size_t row0 = (size_t)b * SEQ + ch * 128;
    {
        const int tok = tid >> 2, g = tid & 3; const int win = 2 << g; const int tseq = ch * 128 + tok; const int cnt = (tseq + 1 < win) ? (tseq + 1) : win;
        const float inv = 1.0f / (float)cnt;
#pragma unroll 1
        for (int hf = 0; hf < 2; ++hf) {
            const bf16_t* src = proj + (row0 + tok) * DIN + 512 + g * 64 + hf * 32;
            float p0[32], s[32];
#pragma unroll
            for (int i = 0; i < 4; ++i) { const u32x4 t = *(const u32x4*)(src + 8 * i);
                p0[8 * i + 0] = bflo(t.x); p0[8 * i + 1] = bfhi(t.x); p0[8 * i + 2] = bflo(t.y); p0[8 * i + 3] = bfhi(t.y); p0[8 * i + 4] = bflo(t.z); p0[8 * i + 5] = bfhi(t.z); p0[8 * i + 6] = bflo(t.w); p0[8 * i + 7] = bfhi(t.w); }
#pragma unroll
            for (int i = 0; i < 32; ++i) s[i] = p0[i];
#pragma unroll 1
            for (int j = 1; j < cnt; ++j) { const bf16_t* sj = src - (size_t)j * DIN;
#pragma unroll
                for (int i = 0; i < 4; ++i) { const u32x4 t = *(const u32x4*)(sj + 8 * i);
                    s[8 * i + 0] += bflo(t.x); s[8 * i + 1] += bfhi(t.x); s[8 * i + 2] += bflo(t.y); s[8 * i + 3] += bfhi(t.y); s[8 * i + 4] += bflo(t.z); s[8 * i + 5] += bfhi(t.z); s[8 * i + 6] += bflo(t.w); s[8 * i + 7] += bfhi(t.w); } }
#pragma unroll
            for (int i = 0; i < 4; ++i) { u32x4 o; o.x = pk2(s[8 * i + 0] * inv - p0[8 * i + 0], s[8 * i + 1] * inv - p0[8 * i + 1]); o.y = pk2(s[8 * i + 2] * inv - p0[8 * i + 2], s[8 * i + 3] * inv - p0[8 * i + 3]);
                o.z = pk2(s[8 * i + 4] * inv - p0[8 * i + 4], s[8 * i + 5] * inv - p0[8 * i + 5]); o.w = pk2(s[8 * i + 6] * inv - p0[8 * i + 6], s[8 * i + 7] * inv - p0[8 * i + 7]);
                *(LAS u32x4*)(Y + tok * YS + g * 64 + hf * 32 + 8 * i) = o; }
        }
    }
    __syncthreads();
    const int c = lane & 15, q = lane >> 4, wv = tid >> 6;
    const size_t trow = row0 + 16 * wv + c; float ssq = 0.f;
    bf16_t* yrow = ycat + trow * DM + 256 + 4 * q;
    const LAS bf16_t* ybase = Y + (16 * wv + c) * YS + 8 * q;
    const bf16_t* pbase = pwt + (size_t)c * 64 + 8 * q;
#pragma unroll 1
    for (int g = 0; g < 4; ++g) {
        f32x4 acc[4];
#pragma unroll
        for (int n = 0; n < 4; ++n) acc[n] = (f32x4){0.f, 0.f, 0.f, 0.f};
#pragma unroll
        for (int ks = 0; ks < 2; ++ks) { const bf16x8 bfrag = *(const LAS bf16x8*)(ybase + g * 64 + 32 * ks);
#pragma unroll
            for (int n = 0; n < 4; ++n) { const bf16x8 a = *(const bf16x8*)(pbase + (g * 64 + 16 * n) * 64 + 32 * ks); acc[n] = MFMA16(a, bfrag, acc[n]); } }
#pragma unroll
        for (int n = 0; n < 4; ++n) { const f32x4 sc = *(const f32x4*)(pscale + g * 64 + 16 * n + 4 * q); const f32x4 y = acc[n] * sc; ssq += ssq4(y); st4(yrow + g * 64 + 16 * n, y); }
    }
    ssq += __shfl_xor(ssq, 16); ssq += __shfl_xor(ssq, 32);
    const float rs = rsqrtf(ssq * (1.0f / 256.0f) + EPS);
    VMWAIT();
#pragma unroll 4
    for (int i = 0; i < 16; ++i) rescale4(yrow + 16 * i, rs);
}

__device__ __forceinline__ void mixer_C(LAS unsigned char* L, const bf16_t* proj, const float* sinks, const float* rel_bias, bf16_t* ycat, int b, int qb, int tid, int lane, int w) {
    constexpr int KS = 72, VS = 280, SS = 164;
    const int wv = tid >> 6;
    LAS bf16_t* KL = (LAS bf16_t*)L;
    LAS bf16_t* VT = (LAS bf16_t*)(L + 36864);
    LAS float* S = (LAS float*)(L + 72704) + wv * 16 * SS;
    LAS float* BT = (LAS float*)(L + 156672);
    const size_t row0 = (size_t)b * SEQ + qb * 128;
    {
        const int j = tid >> 7, dist = tid & 127; int bucket = dist;
        if (dist >= 16) { const int lg = 16 + (int)(__logf((float)dist * (1.0f / 16.0f)) / 2.0794415416798357f * 16.0f); bucket = lg < 31 ? lg : 31; }
        BT[j * 128 + dist] = rel_bias[bucket * 4 + j];
    }
    const int c = lane & 15, q = lane >> 4;
    const size_t trow = row0 + 16 * wv + c; float ssq = 0.f;
    bf16_t* yrow = ycat + trow * DM + 512 + 4 * q;
    const LAS bf16_t* kbase = KL + (16 * wv + c) * KS + 8 * q;
    const LAS bf16_t* vbase = VT + c * VS + 16 * wv + 8 * q;
    LAS float* swr = S + c * SS + 4 * q;
    const LAS bf16_t* wrd = (const LAS bf16_t*)(S + c * SS) + 8 * q;
    const int row = lane >> 2, seg = lane & 3;
    LAS float* srd = S + row * SS + 40 * seg;
#pragma unroll 1
    for (int kvh = 0; kvh < 2; ++kvh) {
        __syncthreads();
        {
            const int key = tid >> 1, half = tid & 1; const bool okk = (qb > 0) || (key >= 128);
            const bf16_t* ksrc = proj + (row0 - 128 + key) * DIN + 1024 + kvh * 64 + half * 32;
            const bf16_t* vsrc = ksrc + 128;
            LAS bf16_t* vdst = VT + (half * 32) * VS + key;
#pragma unroll
            for (int i = 0; i < 4; ++i) { u32x4 kk = {0u, 0u, 0u, 0u}, vv = {0u, 0u, 0u, 0u};
                if (okk) { kk = *(const u32x4*)(ksrc + 8 * i); vv = *(const u32x4*)(vsrc + 8 * i); }
                *(LAS u32x4*)(KL + key * KS + half * 32 + 8 * i) = kk;
                vdst[(8 * i + 0) * VS] = (bf16_t)(vv.x & 0xffffu); vdst[(8 * i + 1) * VS] = (bf16_t)(vv.x >> 16); vdst[(8 * i + 2) * VS] = (bf16_t)(vv.y & 0xffffu); vdst[(8 * i + 3) * VS] = (bf16_t)(vv.y >> 16);
                vdst[(8 * i + 4) * VS] = (bf16_t)(vv.z & 0xffffu); vdst[(8 * i + 5) * VS] = (bf16_t)(vv.z >> 16); vdst[(8 * i + 6) * VS] = (bf16_t)(vv.w & 0xffffu); vdst[(8 * i + 7) * VS] = (bf16_t)(vv.w >> 16); }
            if (tid < 64) {
#pragma unroll
                for (int i = 0; i < 3; ++i) *(LAS u32x4*)(VT + tid * VS + 256 + 8 * i) = (u32x4){0u, 0u, 0u, 0u}; }
        }
        __syncthreads();
#pragma unroll 1
        for (int g = 0; g < 2; ++g) { const int j = 2 * kvh + g;
            bf16x8 qf[2];
#pragma unroll
            for (int ks = 0; ks < 2; ++ks) qf[ks] = *(const bf16x8*)(proj + trow * DIN + 768 + j * 64 + 32 * ks + 8 * q);
#pragma unroll
            for (int kti = 0; kti < 9; ++kti) { f32x4 s = {0.f, 0.f, 0.f, 0.f};
#pragma unroll
                for (int ks = 0; ks < 2; ++ks) { const bf16x8 a = *(const LAS bf16x8*)(kbase + 16 * kti * KS + 32 * ks); s = MFMA16(a, qf[ks], s); }
                *(LAS f32x4*)(swr + 16 * kti) = s; }
            LDSWAIT();
            { const float sink = sinks[j]; const LAS float* bt = BT + j * 128;
                int zz; asm volatile("v_mov_b32 %0, 0" : "=v"(zz));
                const int rowz = row + zz; const int klo = (qb > 0) ? (rowz + 1) : max(rowz + 1, 128 - 16 * w), khi = rowz + 128;
                float lg[40]; float mx = sink;
#pragma unroll
                for (int i4 = 0; i4 < 10; ++i4) { const f32x4 sv = *(const LAS f32x4*)(srd + 4 * i4);
#pragma unroll
                    for (int e = 0; e < 4; ++e) { const int kl = 40 * seg + 4 * i4 + e; const int dist = 128 + rowz - kl; const bool valid = (unsigned)(kl - klo) <= (unsigned)(khi - klo);
                        const int dcl = dist & 127; const float bb = bt[dcl];
                        const float v = valid ? (sv[e] + bb) : -1e30f; lg[4 * i4 + e] = v; mx = fmaxf(mx, v); } }
                mx = fmaxf(mx, __shfl_xor(mx, 1)); mx = fmaxf(mx, __shfl_xor(mx, 2));
                float sum = 0.f;
#pragma unroll
                for (int i = 0; i < 40; ++i) { const float p = (lg[i] > -1e29f) ? fexp(lg[i] - mx) : 0.f; lg[i] = p; sum += p; }
                sum += __shfl_xor(sum, 1); sum += __shfl_xor(sum, 2);
                const float inv = 1.0f / (sum + fexp(sink - mx));
                LDSWAIT();
                LAS bf16_t* Wr = (LAS bf16_t*)(S + row * SS) + 40 * seg;
#pragma unroll
                for (int i8 = 0; i8 < 5; ++i8) { u32x4 o; o.x = pk2(lg[8 * i8 + 0] * inv, lg[8 * i8 + 1] * inv); o.y = pk2(lg[8 * i8 + 2] * inv, lg[8 * i8 + 3] * inv); o.z = pk2(lg[8 * i8 + 4] * inv, lg[8 * i8 + 5] * inv); o.w = pk2(lg[8 * i8 + 6] * inv, lg[8 * i8 + 7] * inv);
                    *(LAS u32x4*)(Wr + 8 * i8) = o; }
            }
            LDSWAIT();
            f32x4 acc[4];
#pragma unroll
            for (int n = 0; n < 4; ++n) acc[n] = (f32x4){0.f, 0.f, 0.f, 0.f};
#pragma unroll
            for (int ks = 0; ks < 5; ++ks) { const bf16x8 bfrag = *(const LAS bf16x8*)(wrd + 32 * ks);
#pragma unroll
                for (int n = 0; n < 4; ++n) { const bf16x8 a = *(const LAS bf16x8*)(vbase + 16 * n * VS + 32 * ks); acc[n] = MFMA16(a, bfrag, acc[n]); } }
            LDSWAIT();
#pragma unroll
            for (int n = 0; n < 4; ++n) { ssq += ssq4(acc[n]); st4(yrow + j * 64 + 16 * n, acc[n]); }
        }
    }
    ssq += __shfl_xor(ssq, 16); ssq += __shfl_xor(ssq, 32);
    const float rs = rsqrtf(ssq * (1.0f / 256.0f) + EPS);
    VMWAIT();
#pragma unroll 4
    for (int i = 0; i < 16; ++i) rescale4(yrow + 16 * i, rs);
}

__device__ __forceinline__ void mixer_D(LAS unsigned char* L, const bf16_t* proj, bf16_t* ycat, int b, int qb64, int tid, int lane, int w) {
    constexpr int KS = 264, VS = 72, SS = 68, WS = 72;
    const int wv = tid >> 6;
    LAS bf16_t* KL = (LAS bf16_t*)L;
    LAS bf16_t* VT = (LAS bf16_t*)(L + 33792);
    LAS float* S = (LAS float*)(L + 70656) + wv * 16 * SS;
    LAS bf16_t* Wl = (LAS bf16_t*)(L + 105472) + wv * 16 * WS;
    LAS float* RED = (LAS float*)(L + 123904);
    volatile LAS unsigned* FLG = (volatile LAS unsigned*)(L + 124416);
    const int rg = wv & 3, hp = wv >> 2, c = lane & 15, q = lane >> 4;
    const size_t seq0 = (size_t)b * SEQ; const size_t trow = seq0 + qb64 * 64 + 16 * rg + c;
    bf16x8 qf[2][2];
#pragma unroll
    for (int hh = 0; hh < 2; ++hh)
#pragma unroll
        for (int ks = 0; ks < 2; ++ks) qf[hh][ks] = *(const bf16x8*)(proj + trow * DIN + 1280 + (2 * hp + hh) * 64 + 32 * ks + 8 * q);
    f32x4 acc[2][4];
#pragma unroll
    for (int hh = 0; hh < 2; ++hh)
#pragma unroll
        for (int n = 0; n < 4; ++n) acc[hh][n] = (f32x4){0.f, 0.f, 0.f, 0.f};
    float carry[2] = {0.f, 0.f};
    const int srow = lane >> 2, seg = lane & 3, qloc = 16 * rg + srow;
    const LAS bf16_t* kbase = KL + c * KS + hp * 128 + 8 * q;
    const LAS bf16_t* vbase = VT + (hp * 128 + c) * VS + 8 * q;
    LAS float* swr = S + c * SS + 4 * q;
    const LAS float* srd = S + srow * SS + 16 * seg;
    LAS bf16_t* wwr = Wl + srow * WS + 16 * seg;
    const LAS bf16_t* wrd = Wl + c * WS + 8 * q;
    const int skey = tid >> 3, spart = tid & 7;
    const bf16_t* ksrc0 = proj + (seq0 + skey) * DIN + 1536 + spart * 32;
    LAS bf16_t* kdst = KL + skey * KS + spart * 32;
    LAS bf16_t* vdst = VT + (spart * 32) * VS + skey;
    if (tid < 2) FLG[tid] = 0u;
    int it = 0;
#pragma unroll 1
    for (int kt = qb64; kt >= 0; --kt, ++it) {
        __syncthreads();
        if (it > 0 && FLG[(it - 1) & 1] == 0u) break;
        {
            const bf16_t* ksrc = ksrc0 + (size_t)kt * 64 * DIN;
            const bf16_t* vsrc = ksrc + 256;
#pragma unroll
            for (int i = 0; i < 4; ++i) { const u32x4 kk = *(const u32x4*)(ksrc + 8 * i), vv = *(const u32x4*)(vsrc + 8 * i);
                *(LAS u32x4*)(kdst + 8 * i) = kk;
                vdst[(8 * i + 0) * VS] = (bf16_t)(vv.x & 0xffffu); vdst[(8 * i + 1) * VS] = (bf16_t)(vv.x >> 16); vdst[(8 * i + 2) * VS] = (bf16_t)(vv.y & 0xffffu); vdst[(8 * i + 3) * VS] = (bf16_t)(vv.y >> 16);
                vdst[(8 * i + 4) * VS] = (bf16_t)(vv.z & 0xffffu); vdst[(8 * i + 5) * VS] = (bf16_t)(vv.z >> 16); vdst[(8 * i + 6) * VS] = (bf16_t)(vv.w & 0xffffu); vdst[(8 * i + 7) * VS] = (bf16_t)(vv.w >> 16); }
        }
        __syncthreads();
        if (tid == 0) FLG[(it + 1) & 1] = 0u;
        const bool diag = (kt == qb64);
#pragma unroll
        for (int hh = 0; hh < 2; ++hh) {
#pragma unroll
            for (int kti = 0; kti < 4; ++kti) { f32x4 s = {0.f, 0.f, 0.f, 0.f};
#pragma unroll
                for (int ks = 0; ks < 2; ++ks) { const bf16x8 a = *(const LAS bf16x8*)(kbase + 16 * kti * KS + hh * 64 + 32 * ks); s = MFMA16(a, qf[hh][ks], s); }
                *(LAS f32x4*)(swr + 16 * kti) = s; }
            LDSWAIT();
            {
                float z[16], cs[16];
#pragma unroll
                for (int i4 = 0; i4 < 4; ++i4) { const f32x4 sv = *(const LAS f32x4*)(srd + 4 * i4); z[4 * i4 + 0] = sv[0]; z[4 * i4 + 1] = sv[1]; z[4 * i4 + 2] = sv[2]; z[4 * i4 + 3] = sv[3]; }
                float run = 0.f;
#pragma unroll
                for (int i = 15; i >= 0; --i) { const bool valid = !diag || (16 * seg + i < qloc);
                    const float zz = z[i]; const float e = fexp(-fabsf(zz)); const float sp = fmaxf(zz, 0.f) + __logf(1.0f + e);
                    run += valid ? sp : 0.f; cs[i] = run; }
                const int lb = lane & ~3;
                const float t0 = __shfl(run, lb + 0), t1 = __shfl(run, lb + 1), t2 = __shfl(run, lb + 2), t3 = __shfl(run, lb + 3);
                const float off = carry[hh] + (seg < 1 ? t1 : 0.f) + (seg < 2 ? t2 : 0.f) + (seg < 3 ? t3 : 0.f);
                carry[hh] += (t0 + t1) + (t2 + t3);
                float wvv[16];
#pragma unroll
                for (int i = 0; i < 16; ++i) { const bool valid = !diag || (16 * seg + i < qloc); wvv[i] = valid ? fexp(z[i] - (off + cs[i])) : 0.f; }
                u32x4 o0, o1; o0.x = pk2(wvv[0], wvv[1]); o0.y = pk2(wvv[2], wvv[3]); o0.z = pk2(wvv[4], wvv[5]); o0.w = pk2(wvv[6], wvv[7]); o1.x = pk2(wvv[8], wvv[9]); o1.y = pk2(wvv[10], wvv[11]); o1.z = pk2(wvv[12], wvv[13]); o1.w = pk2(wvv[14], wvv[15]);
                *(LAS u32x4*)(wwr) = o0; *(LAS u32x4*)(wwr + 8) = o1;
            }
            LDSWAIT();
#pragma unroll
            for (int ks = 0; ks < 2; ++ks) { const bf16x8 bfrag = *(const LAS bf16x8*)(wrd + 32 * ks);
#pragma unroll
                for (int n = 0; n < 4; ++n) { const bf16x8 a = *(const LAS bf16x8*)(vbase + (hh * 64 + 16 * n) * VS + 32 * ks); acc[hh][n] = MFMA16(a, bfrag, acc[hh][n]); } }
            LDSWAIT();
        }
        if (__builtin_amdgcn_ballot_w64(fminf(carry[0], carry[1]) < 32.0f) != 0ull) { if (lane == 0) FLG[it & 1] = 1u; }
    }
    float ssq = 0.f;
#pragma unroll
    for (int hh = 0; hh < 2; ++hh)
#pragma unroll
        for (int n = 0; n < 4; ++n) ssq += ssq4(acc[hh][n]);
    ssq += __shfl_xor(ssq, 16); ssq += __shfl_xor(ssq, 32);
    __syncthreads();
    if (q == 0) RED[(16 * rg + c) * 2 + hp] = ssq;
    __syncthreads();
    const float tot = RED[(16 * rg + c) * 2 + 0] + RED[(16 * rg + c) * 2 + 1];
    const float rs = rsqrtf(tot * (1.0f / 256.0f) + EPS);
    bf16_t* yrow = ycat + trow * DM + 768 + hp * 128 + 4 * q;
#pragma unroll
    for (int hh = 0; hh < 2; ++hh)
#pragma unroll
        for (int n = 0; n < 4; ++n) st4(yrow + hh * 64 + 16 * n, acc[hh][n] * rs);
}

__global__ void __launch_bounds__(NTHR, 2) fwd_megakernel(Params p) {
    extern __shared__ __attribute__((aligned(16))) unsigned char lds[];
    cg::grid_group grid = cg::this_grid();
    LAS unsigned char* L = (LAS unsigned char*)lds;
    const int tid = threadIdx.x, lane = tid & 63, wave = __builtin_amdgcn_readfirstlane(tid >> 6);
    const int G = gridDim.x, bx = blockIdx.x;
    unsigned char* ws = p.ws;
    bf16_t* Win_t = (bf16_t*)(ws + WS_WIN); bf16_t* Wout_t = (bf16_t*)(ws + WS_WOUT); bf16_t* Wgu_t = (bf16_t*)(ws + WS_WGU); bf16_t* Wdn_t = (bf16_t*)(ws + WS_WDN);
    bf16_t* SGUW = (bf16_t*)(ws + WS_SGUW); bf16_t* PWT = (bf16_t*)(ws + WS_PWT); float* SSQ = (float*)(ws + WS_SS);
    bf16_t* XB = (bf16_t*)(ws + WS_XB); bf16_t* PROJ = (bf16_t*)(ws + WS_PROJ); bf16_t* YCAT = (bf16_t*)(ws + WS_YCAT); bf16_t* HID = (bf16_t*)(ws + WS_HID);

    {
        LAS float* scr = (LAS float*)(L + wave * 16384);
        const int gw = bx * 8 + wave, NGW = G * 8;
        constexpr int I_IN = (DM / 64) * (DIN / 32), I_OUT = (DM / 64) * (DM / 32), I_GU = (DM / 64) * (2 * DFF / 32), I_DN = (DFF / 64) * (DM / 32), I_L = I_IN + I_OUT + I_GU + I_DN;
        for (int it = gw; it < DEPTH * I_L; it += NGW) {
            const int l = it / I_L; int r = it % I_L;
            if (r < I_IN) { transpose_item(p.w_in + (size_t)l * DM * DIN, DM, DIN, Win_t + (size_t)l * DIN * DM, p.norm_mix + l * DM, 1, scr, r, lane); continue; } r -= I_IN;
            if (r < I_OUT) { transpose_item(p.w_out + (size_t)l * DM * DM, DM, DM, Wout_t + (size_t)l * DM * DM, p.mix_out_gain + l * DM, 0, scr, r, lane); continue; } r -= I_OUT;
            if (r < I_GU) { transpose_item(p.w_gate_up + (size_t)l * DM * 2 * DFF, DM, 2 * DFF, Wgu_t + (size_t)l * 2 * DFF * DM, p.norm_ffn + l * DM, 2, scr, r, lane); continue; } r -= I_GU;
            transpose_item(p.w_down + (size_t)l * DFF * DM, DFF, DM, Wdn_t + (size_t)l * DM * DFF, nullptr, 0, scr, r, lane);
        }
        for (int m = gw; m < M; m += NGW) {
            const f32x4* xr = (const f32x4*)(p.x + (size_t)m * DM) + lane; u32x2* o8 = (u32x2*)(XB + (size_t)m * DM) + lane; float s = 0.f;
#pragma unroll
            for (int j = 0; j < 4; ++j) { const f32x4 v = xr[64 * j]; s += (v.x * v.x + v.y * v.y) + (v.z * v.z + v.w * v.w); u32x2 o; o.x = pk2(v.x, v.y); o.y = pk2(v.z, v.w); o8[64 * j] = o; }
            s = wave_sum(s);
            if (lane < 16) SSQ[(size_t)m * 16 + lane] = (lane == 0) ? s : 0.f;
        }
        const int gt = bx * NTHR + tid, NGT = G * NTHR;
        for (int e = gt; e < DEPTH * 4 * 128 * 128 / 8; e += NGT) { const int s0 = (e & 15) * 8, t = (e >> 4) & 127; const float* src = p.sgu_w + (size_t)e * 8;
            const f32x4 a = *(const f32x4*)src, bq = *(const f32x4*)(src + 4); float v[8] = {a.x, a.y, a.z, a.w, bq.x, bq.y, bq.z, bq.w};
#pragma unroll
            for (int i = 0; i < 8; ++i) v[i] = (s0 + i <= t) ? v[i] : 0.f;
            u32x4 o; o.x = pk2(v[0], v[1]); o.y = pk2(v[2], v[3]); o.z = pk2(v[4], v[5]); o.w = pk2(v[6], v[7]); *(u32x4*)(SGUW + (size_t)e * 8) = o; }
        for (int e = gt; e < DEPTH * 4 * 64 * 64; e += NGT) { const int cc = e & 63, d = (e >> 6) & 63, lg = e >> 12; PWT[e] = f2bf(p.pool_w[((size_t)lg * 64 + cc) * 64 + d]); }
    }
    grid.sync();

    for (int l = 0; l < DEPTH; ++l) {
#ifndef NO_P1
        { int zk; asm volatile("s_mov_b32 %0, 0" : "=s"(zk)); pg8::Gemm g{XB, Win_t + (size_t)l * DIN * DM, M, DIN, DM + zk}; pg8::StaticOrder S; S.init(M, DIN, G + zk, bx); pg8::EpiIn E{PROJ, SSQ};
          pg8::gemm_phase<pg8::EpiIn, pg8::StaticOrder, true, true>(L, g, S, E, zk); }
#endif
        grid.sync();
#ifndef REP_MIX
#define REP_MIX 1
#endif
#ifndef REP_D
#define REP_D 1
#endif
        for (int rep = 0; rep < REP_MIX; ++rep)
        for (int u = bx; u < 256; u += G) { const int b = u >> 4, ch = u & 15;
            __syncthreads();
#ifndef NO_A
            { int zt; asm volatile("v_mov_b32 %0, 0" : "=v"(zt)); const int t2 = tid + zt; mixer_A(L, PROJ, SGUW + (size_t)l * 4 * 128 * 128, p.sgu_b + l * 4 * 128, YCAT, b, ch, t2, t2 & 63, __builtin_amdgcn_readfirstlane(t2 >> 6)); }
#endif
            __syncthreads();
#ifndef NO_B
            { int zt; asm volatile("v_mov_b32 %0, 0" : "=v"(zt)); const int t2 = tid + zt; mixer_B(L, PROJ, PWT + (size_t)l * 4 * 64 * 64, p.pool_scale + l * 256, YCAT, b, ch, t2, t2 & 63, __builtin_amdgcn_readfirstlane(t2 >> 6)); }
#endif
            __syncthreads();
#ifndef NO_C
            { int zt; asm volatile("v_mov_b32 %0, 0" : "=v"(zt)); const int t2 = tid + zt; mixer_C(L, PROJ, p.swa_sinks + l * 4, p.rel_bias, YCAT, b, ch, t2, t2 & 63, __builtin_amdgcn_readfirstlane(t2 >> 6)); }
#endif
            __syncthreads();
#ifndef NO_D
#pragma unroll 1
            for (int hf = 0; hf < 2 * REP_D; ++hf) { int zt; asm volatile("v_mov_b32 %0, 0" : "=v"(zt)); const int t2 = tid + zt; mixer_D(L, PROJ, YCAT, b, (hf & 1) ? 31 - ch : ch, t2, t2 & 63, __builtin_amdgcn_readfirstlane(t2 >> 6)); __syncthreads(); }
#endif
        }
        grid.sync();
#ifndef NO_P3
        { int zk; asm volatile("s_mov_b32 %0, 0" : "=s"(zk)); pg8::Gemm g{YCAT, Wout_t + (size_t)l * DM * DM, M, DM, DM + zk}; pg8::StaticOrder S; S.init(M, DM, G + zk, bx); pg8::EpiRes E{l == 0 ? p.x : p.out, p.out, XB, SSQ};
          pg8::gemm_phase<pg8::EpiRes, pg8::StaticOrder, true, true>(L, g, S, E, zk); }
#endif
        grid.sync();
#ifndef NO_P4
        { int zk; asm volatile("s_mov_b32 %0, 0" : "=s"(zk)); pg8::Gemm g{XB, Wgu_t + (size_t)l * 2 * DFF * DM, M, 2 * DFF, DM + zk}; pg8::StaticOrder S; S.init(M, 2 * DFF, G + zk, bx); pg8::EpiGU E{HID, SSQ};
          pg8::gemm_phase<pg8::EpiGU, pg8::StaticOrder, true, true>(L, g, S, E, zk); }
#endif
        grid.sync();
#ifndef NO_P5
        { int zk; asm volatile("s_mov_b32 %0, 0" : "=s"(zk)); pg8::Gemm g{HID, Wdn_t + (size_t)l * DM * DFF, M, DM, DFF + zk}; pg8::StaticOrder S; S.init(M, DM, G + zk, bx); pg8::EpiRes E{p.out, p.out, XB, SSQ};
          pg8::gemm_phase<pg8::EpiRes, pg8::StaticOrder, true, true>(L, g, S, E, zk); }
#endif
        grid.sync();
    }
    {
        const int gw = bx * 8 + wave, NGW = G * 8;
        for (int m = gw; m < M; m += NGW) { const float rs = rstd_of(SSQ, m); f32x4* xr = (f32x4*)(p.out + (size_t)m * DM) + lane; const f32x4* gr = (const f32x4*)p.norm_final + lane;
#pragma unroll
            for (int j = 0; j < 4; ++j) { const f32x4 v = xr[64 * j], gg = gr[64 * j]; xr[64 * j] = v * rs * gg; } }
    }
}

extern "C" void kernel_launch(void* const* d_in, const int* in_sizes, int n_in, void* d_out, int out_size, void* d_ws, size_t ws_size, hipStream_t stream) {
    static int grid_blocks = 0;
    if (grid_blocks == 0) {
        if (n_in != 15 || in_sizes[0] != M * DM || out_size != M * DM || ws_size < WS_END) { fprintf(stderr, "kernel_launch: unexpected shapes (n_in %d, in0 %d, out %d, ws %zu)\n", n_in, n_in > 0 ? in_sizes[0] : -1, out_size, ws_size); grid_blocks = -1; return; }
        int dev = 0, cus = 0, per_cu = 0;
        hipGetDevice(&dev); hipDeviceGetAttribute(&cus, hipDeviceAttributeMultiprocessorCount, dev);
        if (hipFuncSetAttribute((const void*)fwd_megakernel, hipFuncAttributeMaxDynamicSharedMemorySize, LDS_BYTES) != hipSuccess) { fprintf(stderr, "kernel_launch: hipFuncSetAttribute failed\n"); }
        if (hipOccupancyMaxActiveBlocksPerMultiprocessor(&per_cu, (const void*)fwd_megakernel, NTHR, LDS_BYTES) != hipSuccess || per_cu < 1) { fprintf(stderr, "kernel_launch: occupancy query says %d\n", per_cu); per_cu = 1; }
        (void)hipGetLastError();
        grid_blocks = cus * 1;
        if (grid_blocks <= 0) grid_blocks = 256;
    }
    if (grid_blocks < 0) return;
    Params p{};
    p.x = (const float*)d_in[0]; p.w_in = (const float*)d_in[1]; p.w_out = (const float*)d_in[2]; p.sgu_w = (const float*)d_in[3]; p.sgu_b = (const float*)d_in[4];
    p.pool_w = (const float*)d_in[5]; p.pool_scale = (const float*)d_in[6]; p.swa_sinks = (const float*)d_in[7]; p.rel_bias = (const float*)d_in[8]; p.mix_out_gain = (const float*)d_in[9];
    p.norm_mix = (const float*)d_in[10]; p.norm_ffn = (const float*)d_in[11]; p.w_gate_up = (const float*)d_in[12]; p.w_down = (const float*)d_in[13]; p.norm_final = (const float*)d_in[14];
    p.out = (float*)d_out; p.ws = (unsigned char*)d_ws;
    void* args[] = {&p};
    hipError_t e = hipLaunchCooperativeKernel((const void*)fwd_megakernel, dim3(grid_blocks), dim3(NTHR), args, LDS_BYTES, stream);
    if (e != hipSuccess) fprintf(stderr, "cooperative launch failed: %s (grid %d)\n", hipGetErrorString(e), grid_blocks);
}
```

```cpp
#include <hip/hip_runtime.h>
#include <hip/hip_cooperative_groups.h>
#include <cstdio>
#include <cstdint>
namespace cg = cooperative_groups;
namespace pg8 {
#define PG8_LAS __attribute__((address_space(3)))
typedef unsigned short bf16_t;
typedef short bf16x8 __attribute__((ext_vector_type(8)));
typedef float f32x4 __attribute__((ext_vector_type(4)));
typedef unsigned u32x4 __attribute__((ext_vector_type(4)));
constexpr int BM = 256, BK = 64, HALF = 128, HTB = HALF * BK * 2  , STAGE_BYTES = 8 * HTB, NXCD = 8, WGM = 8;

__host__ __device__ __forceinline__ int lds_byte(int r, int c) { const int st = (r >> 4) * 2 + (c >> 5), rr = r & 15, cc = c & 31, ob = rr * 64 + cc * 2; return st * 1024 + (ob ^ (((ob >> 9) & 1) << 5)); }
__host__ __device__ __forceinline__ void stage_rc(int b, int& R, int& C) { const int st = b / 1024, sb = b % 1024, swz = sb ^ (((sb >> 9) & 1) << 5); R = (st >> 1) * 16 + swz / 64; C = (st & 1) * 32 + (swz % 64) / 2; }
__host__ __device__ __forceinline__ int perm32(int rho) { const int n = rho >> 4, i = rho & 15; return 8 * (i >> 2) + 4 * n + (i & 3); }

struct Unit { int pm, pn; };
struct Gemm { const bf16_t* A; const bf16_t* Bt; int M, N, K; };

struct StaticOrder {
    int nM, nN, nwg, G, c;
    __host__ __device__ void init(int M, int N, int G_, int c_) { nM = M / BM; nN = N / BM; nwg = nM * nN; G = G_; c = c_; }
    __host__ __device__ bool next(int i, Unit& u) const {
        const long L = (long)i * G + c; if (L >= nwg) return false;
        int wgid = (int)L; { const int q = nwg / NXCD, r = nwg % NXCD, xcd = wgid % NXCD, off = wgid / NXCD; wgid = (xcd < r ? xcd * (q + 1) : r * (q + 1) + (xcd - r) * q) + off; }
        const int nig = WGM * nN, gid = wgid / nig, fm = gid * WGM, gsz = (nM - fm) < WGM ? (nM - fm) : WGM;
        u.pm = fm + ((wgid % nig) % gsz); u.pn = (wgid % nig) / gsz; return true;
    }
    __device__ __forceinline__ void a_ready(const Unit&) const {}
    __device__ __forceinline__ void done(const Unit&) const {}
};

__device__ __forceinline__ unsigned cvt_pk_bf16(float lo, float hi) { unsigned r; asm volatile("v_cvt_pk_bf16_f32 %0, %1, %2" : "=v"(r) : "v"(lo), "v"(hi)); return r; }
typedef float f32x2 __attribute__((ext_vector_type(2)));
template <class Epi, class Sched, bool ALIGN_EPI = false, bool SP2 = false>
__device__ __forceinline__ void gemm_phase(PG8_LAS unsigned char* lds, const Gemm g, const Sched& S, const Epi& E, const int opq) {
    const int tid = threadIdx.x + opq, wid = __builtin_amdgcn_readfirstlane(tid >> 6), lane = tid & 63, wr = wid >> 2, wc = wid & 3, fr = lane & 15, fq = lane >> 4;
    const int K = g.K, nt = K / BK;
    unsigned voffA[2], voffB[2];
#pragma unroll
    for (int i = 0; i < 2; ++i) { int R, C; stage_rc(tid * 16 + i * 8192, R, C); const int Rb = Epi::PERM ? ((R & ~31) + perm32(R & 31)) : R;
        voffA[i] = (unsigned)(R * K + C) * 2u; voffB[i] = (unsigned)(Rb * K + C) * 2u; }
    const size_t kstep = (size_t)(BK * 2);
    const size_t hstep = (size_t)HALF * K * 2;
    const size_t tstep = 2 * hstep;
    const unsigned ldsw = (unsigned)wid * 1024u;
    const int aoff = lds_byte(wr * 64 + fr, fq * 8), boff = lds_byte(wc * 32 + fr, fq * 8);
#define PG8_SA(b, h) (((b) * 2 + (h)) * HTB)
#define PG8_SB(b, h) ((4 + (b) * 2 + (h)) * HTB)
#define PG8_STAGE(bufoff, gbase, voff) do { _Pragma("unroll") for (int _i = 0; _i < 2; ++_i) \
        __builtin_amdgcn_global_load_lds((const unsigned*)((const char*)(gbase) + (voff)[_i]), (PG8_LAS unsigned*)(lds + (bufoff) + ldsw + _i * 8192), 16, 0, 0); } while (0)
#define PG8_LDA(dst, b, h) do { _Pragma("unroll") for (int m = 0; m < 4; ++m) _Pragma("unroll") for (int k = 0; k < 2; ++k) dst[m][k] = *(const PG8_LAS bf16x8*)(lds + PG8_SA(b, h) + aoff + m * 2048 + k * 1024); } while (0)
#define PG8_LDB(dst, b, h) do { _Pragma("unroll") for (int n = 0; n < 2; ++n) _Pragma("unroll") for (int k = 0; k < 2; ++k) dst[n][k] = *(const PG8_LAS bf16x8*)(lds + PG8_SB(b, h) + boff + n * 2048 + k * 1024); } while (0)
#define PG8_MMA(ai, bj, At, Bt) do { __builtin_amdgcn_s_setprio(1); _Pragma("unroll") for (int m = 0; m < 4; ++m) _Pragma("unroll") for (int n = 0; n < 2; ++n) _Pragma("unroll") for (int k = 0; k < 2; ++k) \
        acc[ai][bj][m][n] = __builtin_amdgcn_mfma_f32_16x16x32_bf16(Bt[n][k], At[m][k], acc[ai][bj][m][n], 0, 0, 0); __builtin_amdgcn_s_setprio(0); } while (0)
#define PG8_WAIT_V(n) asm volatile("s_waitcnt vmcnt(" #n ")" ::: "memory")
#define PG8_WAIT_L(n) asm volatile("s_waitcnt lgkmcnt(" #n ")" ::: "memory")
#define PG8_BAR __builtin_amdgcn_s_barrier()
#define PG8_SCHED __builtin_amdgcn_sched_barrier(0)
    Unit cur, nxt; int ui = 0;
    if (!S.next(0, cur)) return;
    f32x4 acc[2][2][4][2];
#pragma unroll
    for (int a = 0; a < 2; ++a)
#pragma unroll
        for (int b = 0; b < 2; ++b)
#pragma unroll
            for (int m = 0; m < 4; ++m)
#pragma unroll
                for (int n = 0; n < 2; ++n) acc[a][b][m][n] = (f32x4){0.f, 0.f, 0.f, 0.f};
    bf16x8 At[4][2], B0[2][2], B1[2][2];
    const char* cA = (const char*)g.A + (size_t)cur.pm * tstep; const char* cB = (const char*)g.Bt + (size_t)cur.pn * tstep;
    S.a_ready(cur);
    if constexpr (SP2) {
        PG8_STAGE(PG8_SB(0, 0), cB, voffB); PG8_STAGE(PG8_SB(0, 1), cB + hstep, voffB); PG8_STAGE(PG8_SA(0, 0), cA, voffA); PG8_STAGE(PG8_SA(0, 1), cA + hstep, voffA);
        if (wr == 1) PG8_BAR;
        PG8_WAIT_V(2); PG8_BAR;
        PG8_STAGE(PG8_SB(1, 0), cB + kstep, voffB); PG8_STAGE(PG8_SA(1, 0), cA + kstep, voffA); PG8_STAGE(PG8_SB(1, 1), cB + hstep + kstep, voffB);
        PG8_WAIT_V(6); PG8_BAR;
    } else {
        PG8_STAGE(PG8_SB(0, 0), cB, voffB); PG8_STAGE(PG8_SA(0, 0), cA, voffA); PG8_STAGE(PG8_SB(0, 1), cB + hstep, voffB); PG8_STAGE(PG8_SA(0, 1), cA + hstep, voffA);
        if (wr == 1) PG8_BAR;
        PG8_WAIT_V(4); PG8_BAR;
        PG8_STAGE(PG8_SB(1, 0), cB + kstep, voffB); PG8_STAGE(PG8_SA(1, 0), cA + kstep, voffA); PG8_STAGE(PG8_SB(1, 1), cB + hstep + kstep, voffB);
        PG8_WAIT_V(6); PG8_BAR;
    }
    for (;;) {
        const bool has_next = S.next(ui + 1, nxt);
        const char* nA = has_next ? (const char*)g.A + (size_t)nxt.pm * tstep : cA; const char* nB = has_next ? (const char*)g.Bt + (size_t)nxt.pn * tstep : cB;
        for (int t = 0; t < nt; t += 2) {
            const bool last = (t == nt - 2);
            const char* a1 = cA + (size_t)(t + 1) * kstep;
            const char* a2 = last ? nA : cA + (size_t)(t + 2) * kstep; const char* b2 = last ? nB : cB + (size_t)(t + 2) * kstep;
            const char* a3 = a2 + kstep; const char* b3 = b2 + kstep;
            if (last && has_next) S.a_ready(nxt);
            if constexpr (SP2) {
            PG8_LDB(B0, 0, 0); PG8_LDB(B1, 0, 1); PG8_SCHED; PG8_LDA(At, 0, 0); PG8_STAGE(PG8_SA(1, 1), a1 + hstep, voffA);
            PG8_WAIT_V(8); PG8_WAIT_L(0); PG8_BAR; PG8_MMA(0, 0, At, B0); PG8_MMA(0, 1, At, B1); PG8_BAR; PG8_SCHED;
            PG8_LDA(At, 0, 1); PG8_STAGE(PG8_SB(0, 0), b2, voffB); PG8_STAGE(PG8_SB(0, 1), b2 + hstep, voffB); PG8_STAGE(PG8_SA(0, 0), a2, voffA);
            PG8_WAIT_V(8); PG8_WAIT_L(0); PG8_BAR; PG8_MMA(1, 0, At, B0); PG8_MMA(1, 1, At, B1); PG8_BAR; PG8_SCHED;
            PG8_LDB(B0, 1, 0); PG8_LDB(B1, 1, 1); PG8_SCHED; PG8_LDA(At, 1, 0); PG8_STAGE(PG8_SA(0, 1), a2 + hstep, voffA);
            PG8_WAIT_V(8); PG8_WAIT_L(0); PG8_BAR; PG8_MMA(0, 0, At, B0); PG8_MMA(0, 1, At, B1); PG8_BAR; PG8_SCHED;
            PG8_LDA(At, 1, 1); PG8_STAGE(PG8_SB(1, 0), b3, voffB); PG8_STAGE(PG8_SB(1, 1), b3 + hstep, voffB); PG8_STAGE(PG8_SA(1, 0), a3, voffA);
            PG8_WAIT_V(8); PG8_WAIT_L(0); PG8_BAR; PG8_MMA(1, 0, At, B0); PG8_MMA(1, 1, At, B1); PG8_BAR; PG8_SCHED;
            } else {
            PG8_LDB(B0, 0, 0); PG8_SCHED; PG8_LDA(At, 0, 0); PG8_STAGE(PG8_SA(1, 1), a1 + hstep, voffA);
            PG8_WAIT_L(8); PG8_BAR; PG8_WAIT_L(0); PG8_MMA(0, 0, At, B0); PG8_BAR; PG8_SCHED;
            PG8_LDB(B1, 0, 1); PG8_STAGE(PG8_SB(0, 0), b2, voffB);
            PG8_BAR; PG8_WAIT_L(0); PG8_MMA(0, 1, At, B1); PG8_BAR;
            PG8_LDA(At, 0, 1); PG8_STAGE(PG8_SA(0, 0), a2, voffA);
            PG8_BAR; PG8_WAIT_L(0); PG8_MMA(1, 0, At, B0); PG8_BAR; PG8_SCHED;
            PG8_STAGE(PG8_SB(0, 1), b2 + hstep, voffB);
            PG8_WAIT_V(6); PG8_BAR; PG8_MMA(1, 1, At, B1); PG8_BAR;
            PG8_LDB(B0, 1, 0); PG8_SCHED; PG8_LDA(At, 1, 0); PG8_STAGE(PG8_SA(0, 1), a2 + hstep, voffA);
            PG8_WAIT_L(8); PG8_BAR; PG8_WAIT_L(0); PG8_MMA(0, 0, At, B0); PG8_BAR; PG8_SCHED;
            PG8_LDB(B1, 1, 1); PG8_STAGE(PG8_SB(1, 0), b3, voffB);
            PG8_BAR; PG8_WAIT_L(0); PG8_MMA(0, 1, At, B1); PG8_BAR;
            PG8_LDA(At, 1, 1); PG8_STAGE(PG8_SA(1, 0), a3, voffA);
            PG8_BAR; PG8_WAIT_L(0); PG8_MMA(1, 0, At, B0); PG8_BAR; PG8_SCHED;
            PG8_STAGE(PG8_SB(1, 1), b3 + hstep, voffB);
            PG8_WAIT_V(6); PG8_BAR; PG8_MMA(1, 1, At, B1); PG8_BAR;
            }
        }
        if constexpr (ALIGN_EPI) { if (wr == 0) PG8_BAR; }
        if constexpr (!Epi::AFTER_DRAIN) { E(acc, cur, wr, wc, fr, fq); S.done(cur); }
        if (!has_next) break;
#pragma unroll
        for (int a = 0; a < 2; ++a)
#pragma unroll
            for (int b = 0; b < 2; ++b)
#pragma unroll
                for (int m = 0; m < 4; ++m)
#pragma unroll
                    for (int n = 0; n < 2; ++n) acc[a][b][m][n] = (f32x4){0.f, 0.f, 0.f, 0.f};
        cur = nxt; cA = nA; cB = nB; ++ui;
        if constexpr (ALIGN_EPI) { if (wr == 1) PG8_BAR; }
    }
    PG8_WAIT_V(0);
    if constexpr (!ALIGN_EPI) { if (wr == 0) PG8_BAR; }
    PG8_BAR;
    if constexpr (Epi::AFTER_DRAIN) { E.fused(acc, cur, wr, wc, fr, fq, lds, wid, lane); S.done(cur); }
#undef PG8_SA
#undef PG8_SB
#undef PG8_STAGE
#undef PG8_LDA
#undef PG8_LDB
#undef PG8_MMA
#undef PG8_WAIT_V
#undef PG8_WAIT_L
#undef PG8_BAR
#undef PG8_SCHED
}
}

constexpr int NB = 16, SEQ = 2048, DM = 1024, DEPTH = 4, DIN = 2048, DFF = 2816, M = NB * SEQ;
constexpr float EPS = 1e-6f;
constexpr size_t MiB = 1u << 20;
constexpr size_t WS_WIN = 0, WS_WOUT = 16 * MiB, WS_WGU = 24 * MiB, WS_WDN = 68 * MiB, WS_SGUW = 90 * MiB, WS_PWT = 90 * MiB + 512 * 1024,
                 WS_SS = 91 * MiB, WS_BAR = 93 * MiB, WS_XB = 96 * MiB, WS_PROJ = 160 * MiB, WS_YCAT = 288 * MiB, WS_HID = 160 * MiB, WS_END = 352 * MiB;
constexpr int LDS_BYTES = 160 * 1024;
constexpr int NTHR = 512;

#define LAS __attribute__((address_space(3)))
typedef unsigned short bf16_t;
typedef short bf16x8 __attribute__((ext_vector_type(8)));
typedef float f32x4 __attribute__((ext_vector_type(4)));
typedef float f32x2 __attribute__((ext_vector_type(2)));
typedef unsigned u32x4 __attribute__((ext_vector_type(4)));
typedef unsigned u32x2 __attribute__((ext_vector_type(2)));
typedef __bf16 bf16x2_t __attribute__((ext_vector_type(2)));

__device__ __forceinline__ unsigned pk2(float lo, float hi) { f32x2 v = {lo, hi}; bf16x2_t b = __builtin_convertvector(v, bf16x2_t); return __builtin_bit_cast(unsigned, b); }
__device__ __forceinline__ bf16_t f2bf(float f) { return (bf16_t)(pk2(f, 0.f) & 0xffffu); }
__device__ __forceinline__ float bflo(unsigned w) { return __uint_as_float(w << 16); }
__device__ __forceinline__ float bfhi(unsigned w) { return __uint_as_float(w & 0xffff0000u); }
#define MFMA16(a, b, c) __builtin_amdgcn_mfma_f32_16x16x32_bf16((a), (b), (c), 0, 0, 0)
#define CFENCE() asm volatile("" ::: "memory")
#define LDSWAIT() asm volatile("s_waitcnt lgkmcnt(0)" ::: "memory")
__device__ __forceinline__ float fexp(float x) { return __builtin_amdgcn_exp2f(x * 1.4426950408889634f); }
__device__ __forceinline__ float gelu_tanh(float x) {
    const float u2 = 1.5957691216057308f * x * (1.0f + 0.044715f * x * x);
    return x * __builtin_amdgcn_rcpf(1.0f + fexp(-u2));
}
__device__ __forceinline__ float rstd_of(const float* ss, int row) {
    const f32x4* p = (const f32x4*)(ss + (size_t)row * 16); const f32x4 a = p[0], b = p[1], c = p[2], d = p[3];
    const f32x4 s = (a + b) + (c + d); return rsqrtf(((s.x + s.y) + (s.z + s.w)) * (1.0f / 1024.0f) + EPS);
}

namespace pg8 {
struct EpiIn {
    static constexpr bool PERM = true, AFTER_DRAIN = false;
    bf16_t* O; const float* ss;
    __device__ __forceinline__ void operator()(const f32x4 (&acc)[2][2][4][2], const Unit& u, int wr, int wc, int fr, int fq) const {
        const int row0 = u.pm * BM + wr * 64 + fr, col0 = u.pn * BM + wc * 32 + 8 * fq; const bool act = u.pn < 2;
#pragma unroll
        for (int ai = 0; ai < 2; ++ai)
#pragma unroll
            for (int m = 0; m < 4; ++m) { const int row = row0 + ai * HALF + m * 16; const float rs = rstd_of(ss, row); bf16_t* rowp = O + (size_t)row * DIN + col0;
#pragma unroll
                for (int bj = 0; bj < 2; ++bj) { f32x4 v0 = acc[ai][bj][m][0] * rs, v1 = acc[ai][bj][m][1] * rs;
                    if (act) { v0 = (f32x4){gelu_tanh(v0[0]), gelu_tanh(v0[1]), gelu_tanh(v0[2]), gelu_tanh(v0[3])}; v1 = (f32x4){gelu_tanh(v1[0]), gelu_tanh(v1[1]), gelu_tanh(v1[2]), gelu_tanh(v1[3])}; }
                    u32x4 w; w.x = pk2(v0[0], v0[1]); w.y = pk2(v0[2], v0[3]); w.z = pk2(v1[0], v1[1]); w.w = pk2(v1[2], v1[3]);
                    *(u32x4*)(rowp + bj * HALF) = w; }
                if (m & 1) CFENCE(); }
    }
};
struct EpiGU {
    static constexpr bool PERM = true, AFTER_DRAIN = false;
    bf16_t* O; const float* ss;
    __device__ __forceinline__ void operator()(const f32x4 (&acc)[2][2][4][2], const Unit& u, int wr, int wc, int fr, int fq) const {
        const int row0 = u.pm * BM + wr * 64 + fr, col0 = u.pn * HALF + wc * 32 + 8 * fq;
#pragma unroll
        for (int ai = 0; ai < 2; ++ai)
#pragma unroll
            for (int m = 0; m < 4; ++m) { const int row = row0 + ai * HALF + m * 16; const float rs = rstd_of(ss, row); bf16_t* rowp = O + (size_t)row * DFF + col0;
                float h[8];
#pragma unroll
                for (int n = 0; n < 2; ++n)
#pragma unroll
                    for (int e = 0; e < 4; ++e) { const float g = acc[ai][0][m][n][e] * rs, up = acc[ai][1][m][n][e] * rs; h[n * 4 + e] = g * up * __builtin_amdgcn_rcpf(1.0f + fexp(-g)); }
                u32x4 w; w.x = pk2(h[0], h[1]); w.y = pk2(h[2], h[3]); w.z = pk2(h[4], h[5]); w.w = pk2(h[6], h[7]);
                *(u32x4*)rowp = w;
                if (m & 1) CFENCE(); }
    }
};
struct EpiRes {
    static constexpr bool PERM = false, AFTER_DRAIN = false;
    const float* xin; float* xout; bf16_t* xb; float* ss;
    __device__ __forceinline__ void operator()(const f32x4 (&acc)[2][2][4][2], const Unit& u, int wr, int wc, int fr, int fq) const {
        const int row0 = u.pm * BM + wr * 64 + fr, col0 = u.pn * BM + wc * 32 + 4 * fq;
#pragma unroll
        for (int ai = 0; ai < 2; ++ai)
#pragma unroll
            for (int m = 0; m < 4; ++m) { const int row = row0 + ai * HALF + m * 16; const size_t off = (size_t)row * DM + col0; float q = 0.f;
#pragma unroll
                for (int bj = 0; bj < 2; ++bj)
#pragma unroll
                    for (int n = 0; n < 2; ++n) { const f32x4 xo = *(const f32x4*)(xin + off + bj * HALF + n * 16); const f32x4 v = xo + acc[ai][bj][m][n];
                        *(f32x4*)(xout + off + bj * HALF + n * 16) = v; q += (v[0] * v[0] + v[1] * v[1]) + (v[2] * v[2] + v[3] * v[3]);
                        u32x2 w; w.x = pk2(v[0], v[1]); w.y = pk2(v[2], v[3]); *(u32x2*)(xb + off + bj * HALF + n * 16) = w; }
                q += __shfl_xor(q, 16); q += __shfl_xor(q, 32);
                if (fq == 0) ss[(size_t)row * 16 + u.pn * 4 + wc] = q;
                CFENCE(); }
    }
};
}

__device__ __forceinline__ void transpose_item(const float* W, int K, int N, bf16_t* WT, const float* gain, int mode, LAS float* scr, int item, int lane) {
    const int nblk = N / 32, kb = item / nblk, nb = item % nblk, k0 = 64 * kb, n0 = 32 * nb;
#pragma unroll 8
    for (int i = 0; i < 32; ++i) { const int kk = 2 * i + (lane >> 5); const float g = gain ? gain[k0 + kk] : 1.0f; scr[kk * 33 + (lane & 31)] = W[(size_t)(k0 + kk) * N + n0 + (lane & 31)] * g; }
    LDSWAIT();
    const int c = lane & 7;
#pragma unroll
    for (int j = 0; j < 4; ++j) { const int n = (lane >> 3) + 8 * j, gn = n0 + n; const LAS float* s = scr + (8 * c) * 33 + n;
        float cs = 1.0f; int row = gn;
        if (mode == 1) { if ((gn >= 768 && gn < 1024) || (gn >= 1280 && gn < 1536)) cs = 0.125f; }
        if (mode == 2) { const int jj = gn < DFF ? gn : gn - DFF; row = 256 * (jj >> 7) + (jj & 127) + (gn < DFF ? 0 : 128); }
        u32x4 o; o.x = pk2(s[0 * 33] * cs, s[1 * 33] * cs); o.y = pk2(s[2 * 33] * cs, s[3 * 33] * cs); o.z = pk2(s[4 * 33] * cs, s[5 * 33] * cs); o.w = pk2(s[6 * 33] * cs, s[7 * 33] * cs);
        *(u32x4*)(WT + (size_t)row * K + k0 + 8 * c) = o; }
    LDSWAIT();
}
__device__ __forceinline__ float wave_sum(float v) {
#pragma unroll
    for (int o = 1; o < 64; o <<= 1) v += __shfl_xor(v, o);
    return v;
}

struct Params {
    const float *x, *w_in, *w_out, *sgu_w, *sgu_b, *pool_w, *pool_scale, *swa_sinks, *rel_bias, *mix_out_gain, *norm_mix, *norm_ffn, *w_gate_up, *w_down, *norm_final;
    float* out; unsigned char* ws;
};


__device__ __forceinline__ void st4(bf16_t* p, const f32x4 y) { u32x2 o; o.x = pk2(y[0], y[1]); o.y = pk2(y[2], y[3]); *(u32x2*)p = o; }
__device__ __forceinline__ void rescale4(bf16_t* p, float rs) {
    const unsigned long long v = __hip_atomic_load((unsigned long long*)p, __ATOMIC_RELAXED, __HIP_MEMORY_SCOPE_AGENT); const unsigned lo = (unsigned)v, hi = (unsigned)(v >> 32);
    u32x2 o; o.x = pk2(bflo(lo) * rs, bfhi(lo) * rs); o.y = pk2(bflo(hi) * rs, bfhi(hi) * rs); *(u32x2*)p = o;
}
#define VMWAIT() asm volatile("s_waitcnt vmcnt(0)" ::: "memory")
__device__ __forceinline__ float ssq4(const f32x4 y) { return (y[0] * y[0] + y[1] * y[1]) + (y[2] * y[2] + y[3] * y[3]); }

__device__ __forceinline__ void mixer_A(LAS unsigned char* L, const bf16_t* proj, const bf16_t* sguw, const float* sgub, bf16_t* ycat, int b, int ch, int tid, int lane, int w) {
    constexpr int VTS = 136;
    LAS bf16_t* VT = (LAS bf16_t*)L;
    const size_t row0 = (size_t)b * SEQ + ch * 128;
    {
        const int tok = tid >> 2, h = tid & 3;
        const bf16_t* src = proj + (row0 + tok) * DIN + 256 + h * 64;
        float v[64]; float s = 0.f;
#pragma unroll
        for (int i = 0; i < 8; ++i) { const u32x4 t = *(const u32x4*)(src + 8 * i);
            v[8 * i + 0] = bflo(t.x); v[8 * i + 1] = bfhi(t.x); v[8 * i + 2] = bflo(t.y); v[8 * i + 3] = bfhi(t.y); v[8 * i + 4] = bflo(t.z); v[8 * i + 5] = bfhi(t.z); v[8 * i + 6] = bflo(t.w); v[8 * i + 7] = bfhi(t.w); }
#pragma unroll
        for (int i = 0; i < 64; ++i) s += v[i];
        const float mean = s * (1.0f / 64.0f); float s2 = 0.f;
#pragma unroll
        for (int i = 0; i < 64; ++i) { v[i] -= mean; s2 += v[i] * v[i]; }
        const float rstd = rsqrtf(s2 * (1.0f / 64.0f) + EPS);
        LAS bf16_t* dst = VT + (h * 64) * VTS + tok;
#pragma unroll
        for (int i = 0; i < 64; ++i) dst[i * VTS] = f2bf(v[i] * rstd);
    }
    __syncthreads();
    const int c = lane & 15, q = lane >> 4, wv = tid >> 6;
    const int nks = (w >> 1) + 1;
    const size_t trow = row0 + 16 * wv + c; float ssq = 0.f;
    bf16_t* yrow = ycat + trow * DM + 0 + 4 * q;
    const bf16_t* urow = proj + trow * DIN + 4 * q;
    const LAS bf16_t* vbase = VT + c * VTS + 8 * q;
    const bf16_t* wbase = sguw + (size_t)(16 * wv + c) * 128 + 8 * q;
#pragma unroll 1
    for (int h = 0; h < 4; ++h) {
        f32x4 acc[4];
#pragma unroll
        for (int n = 0; n < 4; ++n) acc[n] = (f32x4){0.f, 0.f, 0.f, 0.f};
#pragma unroll
        for (int ks = 0; ks < 4; ++ks) if (ks < nks) {
            const bf16x8 bfrag = *(const bf16x8*)(wbase + h * 128 * 128 + 32 * ks);
#pragma unroll
            for (int n = 0; n < 4; ++n) { const bf16x8 a = *(const LAS bf16x8*)(vbase + (h * 64 + 16 * n) * VTS + 32 * ks); acc[n] = MFMA16(a, bfrag, acc[n]); }
        }
        const float bias = sgub[h * 128 + 16 * wv + c];
#pragma unroll
        for (int n = 0; n < 4; ++n) { const u32x2 uu = *(const u32x2*)(urow + h * 64 + 16 * n);
            f32x4 y; y[0] = bflo(uu.x) * (acc[n][0] + bias); y[1] = bfhi(uu.x) * (acc[n][1] + bias); y[2] = bflo(uu.y) * (acc[n][2] + bias); y[3] = bfhi(uu.y) * (acc[n][3] + bias);
            ssq += ssq4(y); st4(yrow + h * 64 + 16 * n, y); }
    }
    ssq += __shfl_xor(ssq, 16); ssq += __shfl_xor(ssq, 32);
    const float rs = rsqrtf(ssq * (1.0f / 256.0f) + EPS);
    VMWAIT();
#pragma unroll 4
    for (int i = 0; i < 16; ++i) rescale4(yrow + 16 * i, rs);
}

__device__ __forceinline__ void mixer_B(LAS unsigned char* L, const bf16_t* proj, const bf16_t* pwt, const float* pscale, bf16_t* ycat, int b, int ch, int tid, int lane, int w) {
    constexpr int YS = 264;
    LAS bf16_t* Y = (LAS bf16_t*)L;
    const size_t row0 = (size_t)b * SEQ + ch * 128;
    {
        const int tok = tid >> 2, g = tid & 3; const int win = 2 << g; const int tseq = ch * 128 + tok; const int cnt = (tseq + 1 < win) ? (tseq + 1) : win;
        const float inv = 1.0f / (float)cnt;
#pragma unroll 1
        for (int hf = 0; hf < 2; ++hf) {
            const bf16_t* src = proj + (row0 + tok) * DIN + 512 + g * 64 + hf * 32;
            float p0[32], s[32];
#pragma unroll
            for (int i = 0; i < 4; ++i) { const u32x4 t = *(const u32x4*)(src + 8 * i);
                p0[8 * i + 0] = bflo(t.x); p0[8 * i + 1] = bfhi(t.x); p0[8 * i + 2] = bflo(t.y); p0[8 * i + 3] = bfhi(t.y); p0[8 * i + 4] = bflo(t.z); p0[8 * i + 5] = bfhi(t.z); p0[8 * i + 6] = bflo(t.w); p0[8 * i + 7] = bfhi(t.w); }
#pragma unroll
            for (int i = 0; i < 32; ++i) s[i] = p0[i];
#pragma unroll 1
            for (int j = 1; j < cnt; ++j) { const bf16_t* sj = src - (size_t)j * DIN;
#pragma unroll
                for (int i = 0; i < 4; ++i) { const u32x4 t = *(const u32x4*)(sj + 8 * i);
                    s[8 * i + 0] += bflo(t.x); s[8 * i + 1] += bfhi(t.x); s[8 * i + 2] += bflo(t.y); s[8 * i + 3] += bfhi(t.y); s[8 * i + 4] += bflo(t.z); s[8 * i + 5] += bfhi(t.z); s[8 * i + 6] += bflo(t.w); s[8 * i + 7] += bfhi(t.w); } }
#pragma unroll
            for (int i = 0; i < 4; ++i) { u32x4 o; o.x = pk2(s[8 * i + 0] * inv - p0[8 * i + 0], s[8 * i + 1] * inv - p0[8 * i + 1]); o.y = pk2(s[8 * i + 2] * inv - p0[8 * i + 2], s[8 * i + 3] * inv - p0[8 * i + 3]);
                o.z = pk2(s[8 * i + 4] * inv - p0[8 * i + 4], s[8 * i + 5] * inv - p0[8 * i + 5]); o.w = pk2(s[8 * i + 6] * inv - p0[8 * i + 6], s[8 * i + 7] * inv - p0[8 * i + 7]);
                *(LAS u32x4*)(Y + tok * YS + g * 64 + hf * 32 + 8 * i) = o; }
        }
    }
    __syncthreads();
    const int c = lane & 15, q = lane >> 4, wv = tid >> 6;
    const size_t trow = row0 + 16 * wv + c; float ssq = 0.f;
    bf16_t* yrow = ycat + trow * DM + 256 + 4 * q;
    const LAS bf16_t* ybase = Y + (16 * wv + c) * YS + 8 * q;
    const bf16_t* pbase = pwt + (size_t)c * 64 + 8 * q;
#pragma unroll 1
    for (int g = 0; g < 4; ++g) {
        f32x4 acc[4];
#pragma unroll
        for (int n = 0; n < 4; ++n) acc[n] = (f32x4){0.f, 0.f, 0.f, 0.f};
#pragma unroll
        for (int ks = 0; ks < 2; ++ks) { const bf16x8 bfrag = *(const LAS bf16x8*)(ybase + g * 64 + 32 * ks);
#pragma unroll
            for (int n = 0; n < 4; ++n) { const bf16x8 a = *(const bf16x8*)(pbase + (g * 64 + 16 * n) * 64 + 32 * ks); acc[n] = MFMA16(a, bfrag, acc[n]); } }
#pragma unroll
        for (int n = 0; n < 4; ++n) { const f32x4 sc = *(const f32x4*)(pscale + g * 64 + 16 * n + 4 * q); const f32x4 y = acc[n] * sc; ssq += ssq4(y); st4(yrow + g * 64 + 16 * n, y); }
    }
    ssq += __shfl_xor(ssq, 16); ssq += __shfl_xor(ssq, 32);
    const float rs = rsqrtf(ssq * (1.0f / 256.0f) + EPS);
    VMWAIT();
#pragma unroll 4
    for (int i = 0; i < 16; ++i) rescale4(yrow + 16 * i, rs);
}

__device__ __forceinline__ void mixer_C(LAS unsigned char* L, const bf16_t* proj, const float* sinks, const float* rel_bias, bf16_t* ycat, int b, int qb, int tid, int lane, int w) {
    constexpr int KS = 72, VS = 280, SS = 164;
    const int wv = tid >> 6;
    LAS bf16_t* KL = (LAS bf16_t*)L;
    LAS bf16_t* VT = (LAS bf16_t*)(L + 36864);
    LAS float* S = (LAS float*)(L + 72704) + wv * 16 * SS;
    LAS float* BT = (LAS float*)(L + 156672);
    const size_t row0 = (size_t)b * SEQ + qb * 128;
    {
        const int j = tid >> 7, dist = tid & 127; int bucket = dist;
        if (dist >= 16) { const int lg = 16 + (int)(__logf((float)dist * (1.0f / 16.0f)) / 2.0794415416798357f * 16.0f); bucket = lg < 31 ? lg : 31; }
        BT[j * 128 + dist] = rel_bias[bucket * 4 + j];
    }
    const int c = lane & 15, q = lane >> 4;
    const size_t trow = row0 + 16 * wv + c; float ssq = 0.f;
    bf16_t* yrow = ycat + trow * DM + 512 + 4 * q;
    const LAS bf16_t* kbase = KL + (16 * wv + c) * KS + 8 * q;
    const LAS bf16_t* vbase = VT + c * VS + 16 * wv + 8 * q;
    LAS float* swr = S + c * SS + 4 * q;
    const LAS bf16_t* wrd = (const LAS bf16_t*)(S + c * SS) + 8 * q;
    const int row = lane >> 2, seg = lane & 3;
    LAS float* srd = S + row * SS + 40 * seg;
#pragma unroll 1
    for (int kvh = 0; kvh < 2; ++kvh) {
        __syncthreads();
        {
            const int key = tid >> 1, half = tid & 1; const bool okk = (qb > 0) || (key >= 128);
            const bf16_t* ksrc = proj + (row0 - 128 + key) * DIN + 1024 + kvh * 64 + half * 32;
            const bf16_t* vsrc = ksrc + 128;
            LAS bf16_t* vdst = VT + (half * 32) * VS + key;
#pragma unroll
            for (int i = 0; i < 4; ++i) { u32x4 kk = {0u, 0u, 0u, 0u}, vv = {0u, 0u, 0u, 0u};
                if (okk) { kk = *(const u32x4*)(ksrc + 8 * i); vv = *(const u32x4*)(vsrc + 8 * i); }
                *(LAS u32x4*)(KL + key * KS + half * 32 + 8 * i) = kk;
                vdst[(8 * i + 0) * VS] = (bf16_t)(vv.x & 0xffffu); vdst[(8 * i + 1) * VS] = (bf16_t)(vv.x >> 16); vdst[(8 * i + 2) * VS] = (bf16_t)(vv.y & 0xffffu); vdst[(8 * i + 3) * VS] = (bf16_t)(vv.y >> 16);
                vdst[(8 * i + 4) * VS] = (bf16_t)(vv.z & 0xffffu); vdst[(8 * i + 5) * VS] = (bf16_t)(vv.z >> 16); vdst[(8 * i + 6) * VS] = (bf16_t)(vv.w & 0xffffu); vdst[(8 * i + 7) * VS] = (bf16_t)(vv.w >> 16); }
            if (tid < 64) {
#pragma unroll
                for (int i = 0; i < 3; ++i) *(LAS u32x4*)(VT + tid * VS + 256 + 8 * i) = (u32x4){0u, 0u, 0u, 0u}; }
        }
        __syncthreads();
#pragma unroll 1
        for (int g = 0; g < 2; ++g) { const int j = 2 * kvh + g;
            bf16x8 qf[2];
#pragma unroll
            for (int ks = 0; ks < 2; ++ks) qf[ks] = *(const bf16x8*)(proj + trow * DIN + 768 + j * 64 + 32 * ks + 8 * q);
#pragma unroll
            for (int kti = 0; kti < 9; ++kti) { f32x4 s = {0.f, 0.f, 0.f, 0.f};
#pragma unroll
                for (int ks = 0; ks < 2; ++ks) { const bf16x8 a = *(const LAS bf16x8*)(kbase + 16 * kti * KS + 32 * ks); s = MFMA16(a, qf[ks], s); }
                *(LAS f32x4*)(swr + 16 * kti) = s; }
            LDSWAIT();
            { const float sink = sinks[j]; const LAS float* bt = BT + j * 128;
                int zz; asm volatile("v_mov_b32 %0, 0" : "=v"(zz));
                const int rowz = row + zz; const int klo = (qb > 0) ? (rowz + 1) : max(rowz + 1, 128 - 16 * w), khi = rowz + 128;
                float lg[40]; float mx = sink;
#pragma unroll
                for (int i4 = 0; i4 < 10; ++i4) { const f32x4 sv = *(const LAS f32x4*)(srd + 4 * i4);
#pragma unroll
                    for (int e = 0; e < 4; ++e) { const int kl = 40 * seg + 4 * i4 + e; const int dist = 128 + rowz - kl; const bool valid = (unsigned)(kl - klo) <= (unsigned)(khi - klo);
                        const int dcl = dist & 127; const float bb = bt[dcl];
                        const float v = valid ? (sv[e] + bb) : -1e30f; lg[4 * i4 + e] = v; mx = fmaxf(mx, v); } }
                mx = fmaxf(mx, __shfl_xor(mx, 1)); mx = fmaxf(mx, __shfl_xor(mx, 2));
                float sum = 0.f;
#pragma unroll
                for (int i = 0; i < 40; ++i) { const float p = (lg[i] > -1e29f) ? fexp(lg[i] - mx) : 0.f; lg[i] = p; sum += p; }
                sum += __shfl_xor(sum, 1); sum += __shfl_xor(sum, 2);
                const float inv = 1.0f / (sum + fexp(sink - mx));
                LDSWAIT();
                LAS bf16_t* Wr = (LAS bf16_t*)(S + row * SS) + 40 * seg;
#pragma unroll
                for (int i8 = 0; i8 < 5; ++i8) { u32x4 o; o.x = pk2(lg[8 * i8 + 0] * inv, lg[8 * i8 + 1] * inv); o.y = pk2(lg[8 * i8 + 2] * inv, lg[8 * i8 + 3] * inv); o.z = pk2(lg[8 * i8 + 4] * inv, lg[8 * i8 + 5] * inv); o.w = pk2(lg[8 * i8 + 6] * inv, lg[8 * i8 + 7] * inv);
                    *(LAS u32x4*)(Wr + 8 * i8) = o; }
            }
            LDSWAIT();
            f32x4 acc[4];
#pragma unroll
            for (int n = 0; n < 4; ++n) acc[n] = (f32x4){0.f, 0.f, 0.f, 0.f};
#pragma unroll
            for (int ks = 0; ks < 5; ++ks) { const bf16x8 bfrag = *(const LAS bf16x8*)(wrd + 32 * ks);
#pragma unroll
                for (int n = 0; n < 4; ++n) { const bf16x8 a = *(const LAS bf16x8*)(vbase + 16 * n * VS + 32 * ks); acc[n] = MFMA16(a, bfrag, acc[n]); } }
            LDSWAIT();
#pragma unroll
            for (int n = 0; n < 4; ++n) { ssq += ssq4(acc[n]); st4(yrow + j * 64 + 16 * n, acc[n]); }
        }
    }
    ssq += __shfl_xor(ssq, 16); ssq += __shfl_xor(ssq, 32);
    const float rs = rsqrtf(ssq * (1.0f / 256.0f) + EPS);
    VMWAIT();
#pragma unroll 4
    for (int i = 0; i < 16; ++i) rescale4(yrow + 16 * i, rs);
}

__device__ __forceinline__ void mixer_D(LAS unsigned char* L, const bf16_t* proj, bf16_t* ycat, int b, int qb64, int tid, int lane, int w) {
    constexpr int KS = 264, VS = 72, SS = 68, WS = 72;
    const int wv = tid >> 6;
    LAS bf16_t* KL = (LAS bf16_t*)L;
    LAS bf16_t* VT = (LAS bf16_t*)(L + 33792);
    LAS float* S = (LAS float*)(L + 70656) + wv * 16 * SS;
    LAS bf16_t* Wl = (LAS bf16_t*)(L + 105472) + wv * 16 * WS;
    LAS float* RED = (LAS float*)(L + 123904);
    volatile LAS unsigned* FLG = (volatile LAS unsigned*)(L + 124416);
    const int rg = wv & 3, hp = wv >> 2, c = lane & 15, q = lane >> 4;
    const size_t seq0 = (size_t)b * SEQ; const size_t trow = seq0 + qb64 * 64 + 16 * rg + c;
    bf16x8 qf[2][2];
#pragma unroll
    for (int hh = 0; hh < 2; ++hh)
#pragma unroll
        for (int ks = 0; ks < 2; ++ks) qf[hh][ks] = *(const bf16x8*)(proj + trow * DIN + 1280 + (2 * hp + hh) * 64 + 32 * ks + 8 * q);
    f32x4 acc[2][4];
#pragma unroll
    for (int hh = 0; hh < 2; ++hh)
#pragma unroll
        for (int n = 0; n < 4; ++n) acc[hh][n] = (f32x4){0.f, 0.f, 0.f, 0.f};
    float carry[2] = {0.f, 0.f};
    const int srow = lane >> 2, seg = lane & 3, qloc = 16 * rg + srow;
    const LAS bf16_t* kbase = KL + c * KS + hp * 128 + 8 * q;
    const LAS bf16_t* vbase = VT + (hp * 128 + c) * VS + 8 * q;
    LAS float* swr = S + c * SS + 4 * q;
    const LAS float* srd = S + srow * SS + 16 * seg;
    LAS bf16_t* wwr = Wl + srow * WS + 16 * seg;
    const LAS bf16_t* wrd = Wl + c * WS + 8 * q;
    const int skey = tid >> 3, spart = tid & 7;
    const bf16_t* ksrc0 = proj + (seq0 + skey) * DIN + 1536 + spart * 32;
    LAS bf16_t* kdst = KL + skey * KS + spart * 32;
    LAS bf16_t* vdst = VT + (spart * 32) * VS + skey;
    if (tid < 2) FLG[tid] = 0u;
    int it = 0;
#pragma unroll 1
    for (int kt = qb64; kt >= 0; --kt, ++it) {
        __syncthreads();
        if (it > 0 && FLG[(it - 1) & 1] == 0u) break;
        {
            const bf16_t* ksrc = ksrc0 + (size_t)kt * 64 * DIN;
            const bf16_t* vsrc = ksrc + 256;
#pragma unroll
            for (int i = 0; i < 4; ++i) { const u32x4 kk = *(const u32x4*)(ksrc + 8 * i), vv = *(const u32x4*)(vsrc + 8 * i);
                *(LAS u32x4*)(kdst + 8 * i) = kk;
                vdst[(8 * i + 0) * VS] = (bf16_t)(vv.x & 0xffffu); vdst[(8 * i + 1) * VS] = (bf16_t)(vv.x >> 16); vdst[(8 * i + 2) * VS] = (bf16_t)(vv.y & 0xffffu); vdst[(8 * i + 3) * VS] = (bf16_t)(vv.y >> 16);
                vdst[(8 * i + 4) * VS] = (bf16_t)(vv.z & 0xffffu); vdst[(8 * i + 5) * VS] = (bf16_t)(vv.z >> 16); vdst[(8 * i + 6) * VS] = (bf16_t)(vv.w & 0xffffu); vdst[(8 * i + 7) * VS] = (bf16_t)(vv.w >> 16); }
        }
        __syncthreads();
        if (tid == 0) FLG[(it + 1) & 1] = 0u;
        const bool diag = (kt == qb64);
#pragma unroll
        for (int hh = 0; hh < 2; ++hh) {
#pragma unroll
            for (int kti = 0; kti < 4; ++kti) { f32x4 s = {0.f, 0.f, 0.f, 0.f};
#pragma unroll
                for (int ks = 0; ks < 2; ++ks) { const bf16x8 a = *(const LAS bf16x8*)(kbase + 16 * kti * KS + hh * 64 + 32 * ks); s = MFMA16(a, qf[hh][ks], s); }
                *(LAS f32x4*)(swr + 16 * kti) = s; }
            LDSWAIT();
            {
                float z[16], cs[16];
#pragma unroll
                for (int i4 = 0; i4 < 4; ++i4) { const f32x4 sv = *(const LAS f32x4*)(srd + 4 * i4); z[4 * i4 + 0] = sv[0]; z[4 * i4 + 1] = sv[1]; z[4 * i4 + 2] = sv[2]; z[4 * i4 + 3] = sv[3]; }
                float run = 0.f;
#pragma unroll
                for (int i = 15; i >= 0; --i) { const bool valid = !diag || (16 * seg + i < qloc);
                    const float zz = z[i]; const float e = fexp(-fabsf(zz)); const float sp = fmaxf(zz, 0.f) + __logf(1.0f + e);
                    run += valid ? sp : 0.f; cs[i] = run; }
                const int lb = lane & ~3;
                const float t0 = __shfl(run, lb + 0), t1 = __shfl(run, lb + 1), t2 = __shfl(run, lb + 2), t3 = __shfl(run, lb + 3);
                const float off = carry[hh] + (seg < 1 ? t1 : 0.f) + (seg < 2 ? t2 : 0.f) + (seg < 3 ? t3 : 0.f);
                carry[hh] += (t0 + t1) + (t2 + t3);
                float wvv[16];
#pragma unroll
                for (int i = 0; i < 16; ++i) { const bool valid = !diag || (16 * seg + i < qloc); wvv[i] = valid ? fexp(z[i] - (off + cs[i])) : 0.f; }
                u32x4 o0, o1; o0.x = pk2(wvv[0], wvv[1]); o0.y = pk2(wvv[2], wvv[3]); o0.z = pk2(wvv[4], wvv[5]); o0.w = pk2(wvv[6], wvv[7]); o1.x = pk2(wvv[8], wvv[9]); o1.y = pk2(wvv[10], wvv[11]); o1.z = pk2(wvv[12], wvv[13]); o1.w = pk2(wvv[14], wvv[15]);
                *(LAS u32x4*)(wwr) = o0; *(LAS u32x4*)(wwr + 8) = o1;
            }
            LDSWAIT();
#pragma unroll
            for (int ks = 0; ks < 2; ++ks) { const bf16x8 bfrag = *(const LAS bf16x8*)(wrd + 32 * ks);
#pragma unroll
                for (int n = 0; n < 4; ++n) { const bf16x8 a = *(const LAS bf16x8*)(vbase + (hh * 64 + 16 * n) * VS + 32 * ks); acc[hh][n] = MFMA16(a, bfrag, acc[hh][n]); } }
            LDSWAIT();
        }
        if (__builtin_amdgcn_ballot_w64(fminf(carry[0], carry[1]) < 32.0f) != 0ull) { if (lane == 0) FLG[it & 1] = 1u; }
    }
    float ssq = 0.f;
#pragma unroll
    for (int hh = 0; hh < 2; ++hh)
#pragma unroll
        for (int n = 0; n < 4; ++n) ssq += ssq4(acc[hh][n]);
    ssq += __shfl_xor(ssq, 16); ssq += __shfl_xor(ssq, 32);
    __syncthreads();
    if (q == 0) RED[(16 * rg + c) * 2 + hp] = ssq;
    __syncthreads();
    const float tot = RED[(16 * rg + c) * 2 + 0] + RED[(16 * rg + c) * 2 + 1];
    const float rs = rsqrtf(tot * (1.0f / 256.0f) + EPS);
    bf16_t* yrow = ycat + trow * DM + 768 + hp * 128 + 4 * q;
#pragma unroll
    for (int hh = 0; hh < 2; ++hh)
#pragma unroll
        for (int n = 0; n < 4; ++n) st4(yrow + hh * 64 + 16 * n, acc[hh][n] * rs);
}

#define XB_TMO      128
#define XB_XCNT(j)  (256  + 64 * (j))
#define XB_XSUB(j)  (1280 + 64 * (j))
#define XB_XGEN(j)  (2304 + 64 * (j))
#define XB_TOP      3328
#define XB_TOPGEN   3392
#define XCD_BAR_WORDS 3456
#define XB_SPIN_CAP (1u << 18)

__device__ __forceinline__ unsigned xb_ld(unsigned* p)              { return __hip_atomic_load(p, __ATOMIC_RELAXED, __HIP_MEMORY_SCOPE_AGENT); }
__device__ __forceinline__ unsigned xb_add(unsigned* p, unsigned v) { return __hip_atomic_fetch_add(p, v, __ATOMIC_RELAXED, __HIP_MEMORY_SCOPE_AGENT); }
__device__ __forceinline__ unsigned xb_xcc_id() { return (unsigned)__builtin_amdgcn_s_getreg((3 << 11) | 20) & 0xFu; }
#define XB_SPIN(cond, bar) do { unsigned _sp = 0; while (cond) { __builtin_amdgcn_s_sleep(1); \
    if ((++_sp & 255u) == 0u) { if (xb_ld(&(bar)[XB_TMO])) break; if (_sp > XB_SPIN_CAP) { atomicAdd(&(bar)[XB_TMO], 1u); break; } } } } while (0)

struct XcdBarrier {
    unsigned* bar; unsigned x;
    volatile LAS unsigned* st;
};

__device__ __forceinline__ XcdBarrier xcd_barrier_post(unsigned* bar, volatile LAS unsigned* st) {
    XcdBarrier b; b.bar = bar; b.x = xb_xcc_id(); b.st = st;
    if (threadIdx.x == 0) (void)xb_add(&bar[XB_XCNT(b.x)], 1u);
    return b;
}
__device__ __forceinline__ void xcd_barrier_complete(unsigned* bar, unsigned x, unsigned& nloc, unsigned& nx) {
    const unsigned G = gridDim.x * gridDim.y * gridDim.z;
    unsigned sum, cnt, mine, sp = 0u;
    for (;;) {
        sum = 0u; cnt = 0u; mine = 0u;
#pragma unroll
        for (unsigned j = 0; j < 16; ++j) { const unsigned c = xb_ld(&bar[XB_XCNT(j)]); sum += c; cnt += (c > 0u) ? 1u : 0u; mine = (j == x) ? c : mine; }
        if (sum == G) break;
        __builtin_amdgcn_s_sleep(1);
        if ((++sp & 255u) == 0u) { if (xb_ld(&bar[XB_TMO])) break; if (sp > XB_SPIN_CAP) { atomicAdd(&bar[XB_TMO], 1u); break; } }
    }
    nloc = mine > 0u ? mine : 1u; nx = cnt > 0u ? cnt : 1u;
}

__device__ __forceinline__ void xcd_barrier(const XcdBarrier& b) {
    asm volatile("s_waitcnt vmcnt(0)" ::: "memory");
    __syncthreads();
    if (threadIdx.x == 0) {
        unsigned* bar = b.bar;
        __builtin_amdgcn_s_waitcnt(0);
        unsigned nloc = b.st[0], nx = b.st[1];
        if (nloc == 0u) { xcd_barrier_complete(bar, b.x, nloc, nx); b.st[0] = nloc; b.st[1] = nx; }
        const unsigned old = xb_add(&bar[XB_XSUB(b.x)], 1u);
        const unsigned gen = old / nloc;
        if (old + 1u == (gen + 1u) * nloc) {
            __builtin_amdgcn_fence(__ATOMIC_RELEASE, "agent");
            asm volatile("s_waitcnt vmcnt(0)" ::: "memory");
            const unsigned og = xb_add(&bar[XB_TOP], 1u);
            const unsigned tg = og / nx;
            if (og + 1u == (tg + 1u) * nx) xb_add(&bar[XB_TOPGEN], 1u);
            else XB_SPIN(xb_ld(&bar[XB_TOPGEN]) == tg, bar);
            __builtin_amdgcn_fence(__ATOMIC_ACQUIRE, "agent");
            xb_add(&bar[XB_XGEN(b.x)], 1u);
            asm volatile("s_waitcnt vmcnt(0)" ::: "memory");
        } else {
            XB_SPIN(xb_ld(&bar[XB_XGEN(b.x)]) == gen, bar);
            __builtin_amdgcn_fence(__ATOMIC_ACQUIRE, "agent");
            asm volatile("s_waitcnt vmcnt(0)" ::: "memory");
        }
    }
    __syncthreads();
}

#ifndef REP_SYNC
#define REP_SYNC 1
#endif
#define GSYNC() do { for (int _r = 0; _r < REP_SYNC; ++_r) xcd_barrier(xbar); } while (0)
__global__ void __launch_bounds__(NTHR, 2) fwd_megakernel(Params p) {
    extern __shared__ __attribute__((aligned(16))) unsigned char lds[];
    cg::grid_group grid = cg::this_grid();
    LAS unsigned char* L = (LAS unsigned char*)lds;
    const int tid = threadIdx.x, lane = tid & 63, wave = __builtin_amdgcn_readfirstlane(tid >> 6);
    const int G = gridDim.x, bx = blockIdx.x;
    unsigned char* ws = p.ws;
    bf16_t* Win_t = (bf16_t*)(ws + WS_WIN); bf16_t* Wout_t = (bf16_t*)(ws + WS_WOUT); bf16_t* Wgu_t = (bf16_t*)(ws + WS_WGU); bf16_t* Wdn_t = (bf16_t*)(ws + WS_WDN);
    bf16_t* SGUW = (bf16_t*)(ws + WS_SGUW); bf16_t* PWT = (bf16_t*)(ws + WS_PWT); float* SSQ = (float*)(ws + WS_SS);
    bf16_t* XB = (bf16_t*)(ws + WS_XB); bf16_t* PROJ = (bf16_t*)(ws + WS_PROJ); bf16_t* YCAT = (bf16_t*)(ws + WS_YCAT); bf16_t* HID = (bf16_t*)(ws + WS_HID);

    volatile LAS unsigned* xst = (volatile LAS unsigned*)(L + LDS_BYTES - 16);
    if (tid < 4) xst[tid] = 0u;
    unsigned* barw = (unsigned*)(ws + WS_BAR);
    if (bx == 0) for (int i = tid; i < XCD_BAR_WORDS; i += NTHR) __hip_atomic_store(barw + i, 0u, __ATOMIC_RELAXED, __HIP_MEMORY_SCOPE_AGENT);
    {
        LAS float* scr = (LAS float*)(L + wave * 16384);
        const int gw = bx * 8 + wave, NGW = G * 8;
        constexpr int I_IN = (DM / 64) * (DIN / 32), I_OUT = (DM / 64) * (DM / 32), I_GU = (DM / 64) * (2 * DFF / 32), I_DN = (DFF / 64) * (DM / 32), I_L = I_IN + I_OUT + I_GU + I_DN;
        for (int it = gw; it < DEPTH * I_L; it += NGW) {
            const int l = it / I_L; int r = it % I_L;
            if (r < I_IN) { transpose_item(p.w_in + (size_t)l * DM * DIN, DM, DIN, Win_t + (size_t)l * DIN * DM, p.norm_mix + l * DM, 1, scr, r, lane); continue; } r -= I_IN;
            if (r < I_OUT) { transpose_item(p.w_out + (size_t)l * DM * DM, DM, DM, Wout_t + (size_t)l * DM * DM, p.mix_out_gain + l * DM, 0, scr, r, lane); continue; } r -= I_OUT;
            if (r < I_GU) { transpose_item(p.w_gate_up + (size_t)l * DM * 2 * DFF, DM, 2 * DFF, Wgu_t + (size_t)l * 2 * DFF * DM, p.norm_ffn + l * DM, 2, scr, r, lane); continue; } r -= I_GU;
            transpose_item(p.w_down + (size_t)l * DFF * DM, DFF, DM, Wdn_t + (size_t)l * DM * DFF, nullptr, 0, scr, r, lane);
        }
        for (int m = gw; m < M; m += NGW) {
            const f32x4* xr = (const f32x4*)(p.x + (size_t)m * DM) + lane; u32x2* o8 = (u32x2*)(XB + (size_t)m * DM) + lane; float s = 0.f;
#pragma unroll
            for (int j = 0; j < 4; ++j) { const f32x4 v = xr[64 * j]; s += (v.x * v.x + v.y * v.y) + (v.z * v.z + v.w * v.w); u32x2 o; o.x = pk2(v.x, v.y); o.y = pk2(v.z, v.w); o8[64 * j] = o; }
            s = wave_sum(s);
            if (lane < 16) SSQ[(size_t)m * 16 + lane] = (lane == 0) ? s : 0.f;
        }
        const int gt = bx * NTHR + tid, NGT = G * NTHR;
        for (int e = gt; e < DEPTH * 4 * 128 * 128 / 8; e += NGT) { const int s0 = (e & 15) * 8, t = (e >> 4) & 127; const float* src = p.sgu_w + (size_t)e * 8;
            const f32x4 a = *(const f32x4*)src, bq = *(const f32x4*)(src + 4); float v[8] = {a.x, a.y, a.z, a.w, bq.x, bq.y, bq.z, bq.w};
#pragma unroll
            for (int i = 0; i < 8; ++i) v[i] = (s0 + i <= t) ? v[i] : 0.f;
            u32x4 o; o.x = pk2(v[0], v[1]); o.y = pk2(v[2], v[3]); o.z = pk2(v[4], v[5]); o.w = pk2(v[6], v[7]); *(u32x4*)(SGUW + (size_t)e * 8) = o; }
        for (int e = gt; e < DEPTH * 4 * 64 * 64; e += NGT) { const int cc = e & 63, d = (e >> 6) & 63, lg = e >> 12; PWT[e] = f2bf(p.pool_w[((size_t)lg * 64 + cc) * 64 + d]); }
    }
    grid.sync();
    const XcdBarrier xbar = xcd_barrier_post(barw, xst);

    for (int l = 0; l < DEPTH; ++l) {
#ifndef NO_P1
        { int zk; asm volatile("s_mov_b32 %0, 0" : "=s"(zk)); pg8::Gemm g{XB, Win_t + (size_t)l * DIN * DM, M, DIN, DM + zk}; pg8::StaticOrder S; S.init(M, DIN, G + zk, bx); pg8::EpiIn E{PROJ, SSQ};
          pg8::gemm_phase<pg8::EpiIn, pg8::StaticOrder, true, true>(L, g, S, E, zk); }
#endif
        GSYNC();
#ifndef REP_MIX
#define REP_MIX 1
#endif
#ifndef REP_D
#define REP_D 1
#endif
        for (int rep = 0; rep < REP_MIX; ++rep)
        for (int u = bx; u < 256; u += G) { const int b = u >> 4, ch = u & 15;
            __syncthreads();
#ifndef NO_A
            { int zt; asm volatile("v_mov_b32 %0, 0" : "=v"(zt)); const int t2 = tid + zt; mixer_A(L, PROJ, SGUW + (size_t)l * 4 * 128 * 128, p.sgu_b + l * 4 * 128, YCAT, b, ch, t2, t2 & 63, __builtin_amdgcn_readfirstlane(t2 >> 6)); }
#endif
            __syncthreads();
#ifndef NO_B
            { int zt; asm volatile("v_mov_b32 %0, 0" : "=v"(zt)); const int t2 = tid + zt; mixer_B(L, PROJ, PWT + (size_t)l * 4 * 64 * 64, p.pool_scale + l * 256, YCAT, b, ch, t2, t2 & 63, __builtin_amdgcn_readfirstlane(t2 >> 6)); }
#endif
            __syncthreads();
#ifndef NO_C
            { int zt; asm volatile("v_mov_b32 %0, 0" : "=v"(zt)); const int t2 = tid + zt; mixer_C(L, PROJ, p.swa_sinks + l * 4, p.rel_bias, YCAT, b, ch, t2, t2 & 63, __builtin_amdgcn_readfirstlane(t2 >> 6)); }
#endif
            __syncthreads();
#ifndef NO_D
#pragma unroll 1
            for (int hf = 0; hf < 2 * REP_D; ++hf) { int zt; asm volatile("v_mov_b32 %0, 0" : "=v"(zt)); const int t2 = tid + zt; mixer_D(L, PROJ, YCAT, b, (hf & 1) ? 31 - ch : ch, t2, t2 & 63, __builtin_amdgcn_readfirstlane(t2 >> 6)); __syncthreads(); }
#endif
        }
        GSYNC();
#ifndef NO_P3
        { int zk; asm volatile("s_mov_b32 %0, 0" : "=s"(zk)); pg8::Gemm g{YCAT, Wout_t + (size_t)l * DM * DM, M, DM, DM + zk}; pg8::StaticOrder S; S.init(M, DM, G + zk, bx); pg8::EpiRes E{l == 0 ? p.x : p.out, p.out, XB, SSQ};
          pg8::gemm_phase<pg8::EpiRes, pg8::StaticOrder, true, true>(L, g, S, E, zk); }
#endif
        GSYNC();
#ifndef NO_P4
        { int zk; asm volatile("s_mov_b32 %0, 0" : "=s"(zk)); pg8::Gemm g{XB, Wgu_t + (size_t)l * 2 * DFF * DM, M, 2 * DFF, DM + zk}; pg8::StaticOrder S; S.init(M, 2 * DFF, G + zk, bx); pg8::EpiGU E{HID, SSQ};
          pg8::gemm_phase<pg8::EpiGU, pg8::StaticOrder, true, true>(L, g, S, E, zk); }
#endif
        GSYNC();
#ifndef NO_P5
        { int zk; asm volatile("s_mov_b32 %0, 0" : "=s"(zk)); pg8::Gemm g{HID, Wdn_t + (size_t)l * DM * DFF, M, DM, DFF + zk}; pg8::StaticOrder S; S.init(M, DM, G + zk, bx); pg8::EpiRes E{p.out, p.out, XB, SSQ};
          pg8::gemm_phase<pg8::EpiRes, pg8::StaticOrder, true, true>(L, g, S, E, zk); }
#endif
        GSYNC();
    }
    {
        const int gw = bx * 8 + wave, NGW = G * 8;
        for (int m = gw; m < M; m += NGW) { const float rs = rstd_of(SSQ, m); f32x4* xr = (f32x4*)(p.out + (size_t)m * DM) + lane; const f32x4* gr = (const f32x4*)p.norm_final + lane;
#pragma unroll
            for (int j = 0; j < 4; ++j) { const f32x4 v = xr[64 * j], gg = gr[64 * j]; xr[64 * j] = v * rs * gg; } }
    }
}

extern "C" void kernel_launch(void* const* d_in, const int* in_sizes, int n_in, void* d_out, int out_size, void* d_ws, size_t ws_size, hipStream_t stream) {
    static int grid_blocks = 0;
    if (grid_blocks == 0) {
        if (n_in != 15 || in_sizes[0] != M * DM || out_size != M * DM || ws_size < WS_END) { fprintf(stderr, "kernel_launch: unexpected shapes (n_in %d, in0 %d, out %d, ws %zu)\n", n_in, n_in > 0 ? in_sizes[0] : -1, out_size, ws_size); grid_blocks = -1; return; }
        int dev = 0, cus = 0, per_cu = 0;
        hipGetDevice(&dev); hipDeviceGetAttribute(&cus, hipDeviceAttributeMultiprocessorCount, dev);
        if (hipFuncSetAttribute((const void*)fwd_megakernel, hipFuncAttributeMaxDynamicSharedMemorySize, LDS_BYTES) != hipSuccess) { fprintf(stderr, "kernel_launch: hipFuncSetAttribute failed\n"); }
        if (hipOccupancyMaxActiveBlocksPerMultiprocessor(&per_cu, (const void*)fwd_megakernel, NTHR, LDS_BYTES) != hipSuccess || per_cu < 1) { fprintf(stderr, "kernel_launch: occupancy query says %d\n", per_cu); per_cu = 1; }
        (void)hipGetLastError();
        grid_blocks = cus * 1;
        if (grid_blocks <= 0) grid_blocks = 256;
    }
    if (grid_blocks < 0) return;
    Params p{};
    p.x = (const float*)d_in[0]; p.w_in = (const float*)d_in[1]; p.w_out = (const float*)d_in[2]; p.sgu_w = (const float*)d_in[3]; p.sgu_b = (const float*)d_in[4];
    p.pool_w = (const float*)d_in[5]; p.pool_scale = (const float*)d_in[6]; p.swa_sinks = (const float*)d_in[7]; p.rel_bias = (const float*)d_in[8]; p.mix_out_gain = (const float*)d_in[9];
    p.norm_mix = (const float*)d_in[10]; p.norm_ffn = (const float*)d_in[11]; p.w_gate_up = (const float*)d_in[12]; p.w_down = (const float*)d_in[13]; p.norm_final = (const float*)d_in[14];
    p.out = (float*)d_out; p.ws = (unsigned char*)d_ws;
    void* args[] = {&p};
    hipError_t e = hipLaunchCooperativeKernel((const void*)fwd_megakernel, dim3(grid_blocks), dim3(NTHR), args, LDS_BYTES, stream);
    if (e != hipSuccess) fprintf(stderr, "cooperative launch failed: %s (grid %d)\n", hipGetErrorString(e), grid_blocks);
}
```

```cpp
#include <hip/hip_runtime.h>
#include <hip/hip_cooperative_groups.h>
#include <cstdio>
#include <cstdint>
namespace cg = cooperative_groups;
namespace pg8 {
#define PG8_LAS __attribute__((address_space(3)))
typedef unsigned short bf16_t;
typedef short bf16x8 __attribute__((ext_vector_type(8)));
typedef float f32x4 __attribute__((ext_vector_type(4)));
typedef unsigned u32x4 __attribute__((ext_vector_type(4)));
constexpr int BM = 256, BK = 64, HALF = 128, HTB = HALF * BK * 2  , STAGE_BYTES = 8 * HTB, NXCD = 8, WGM = 8;

__host__ __device__ __forceinline__ int lds_byte(int r, int c) { const int st = (r >> 4) * 2 + (c >> 5), rr = r & 15, cc = c & 31, ob = rr * 64 + cc * 2; return st * 1024 + (ob ^ (((ob >> 9) & 1) << 5)); }
__host__ __device__ __forceinline__ void stage_rc(int b, int& R, int& C) { const int st = b / 1024, sb = b % 1024, swz = sb ^ (((sb >> 9) & 1) << 5); R = (st >> 1) * 16 + swz / 64; C = (st & 1) * 32 + (swz % 64) / 2; }
__host__ __device__ __forceinline__ int perm32(int rho) { const int n = rho >> 4, i = rho & 15; return 8 * (i >> 2) + 4 * n + (i & 3); }

struct Unit { int pm, pn; };
struct Gemm { const bf16_t* A; const bf16_t* Bt; int M, N, K; };

struct StaticOrder {
    int nM, nN, nwg, G, c;
    __host__ __device__ void init(int M, int N, int G_, int c_) { nM = M / BM; nN = N / BM; nwg = nM * nN; G = G_; c = c_; }
    __host__ __device__ bool next(int i, Unit& u) const {
        const long L = (long)i * G + c; if (L >= nwg) return false;
        int wgid = (int)L; { const int q = nwg / NXCD, r = nwg % NXCD, xcd = wgid % NXCD, off = wgid / NXCD; wgid = (xcd < r ? xcd * (q + 1) : r * (q + 1) + (xcd - r) * q) + off; }
        const int nig = WGM * nN, gid = wgid / nig, fm = gid * WGM, gsz = (nM - fm) < WGM ? (nM - fm) : WGM;
        u.pm = fm + ((wgid % nig) % gsz); u.pn = (wgid % nig) / gsz; return true;
    }
    __device__ __forceinline__ void a_ready(const Unit&) const {}
    __device__ __forceinline__ void done(const Unit&) const {}
};

__device__ __forceinline__ unsigned cvt_pk_bf16(float lo, float hi) { unsigned r; asm volatile("v_cvt_pk_bf16_f32 %0, %1, %2" : "=v"(r) : "v"(lo), "v"(hi)); return r; }
typedef float f32x2 __attribute__((ext_vector_type(2)));
template <class Epi, class Sched, bool ALIGN_EPI = false, bool SP2 = false>
__device__ __forceinline__ void gemm_phase(PG8_LAS unsigned char* lds, const Gemm g, const Sched& S, const Epi& E, const int opq) {
    const int tid = threadIdx.x + opq, wid = __builtin_amdgcn_readfirstlane(tid >> 6), lane = tid & 63, wr = wid >> 2, wc = wid & 3, fr = lane & 15, fq = lane >> 4;
    const int K = g.K, nt = K / BK;
    unsigned voffA[2], voffB[2];
#pragma unroll
    for (int i = 0; i < 2; ++i) { int R, C; stage_rc(tid * 16 + i * 8192, R, C); const int Rb = Epi::PERM ? ((R & ~31) + perm32(R & 31)) : R;
        voffA[i] = (unsigned)(R * K + C) * 2u; voffB[i] = (unsigned)(Rb * K + C) * 2u; }
    const size_t kstep = (size_t)(BK * 2);
    const size_t hstep = (size_t)HALF * K * 2;
    const size_t tstep = 2 * hstep;
    const unsigned ldsw = (unsigned)wid * 1024u;
    const int aoff = lds_byte(wr * 64 + fr, fq * 8), boff = lds_byte(wc * 32 + fr, fq * 8);
#define PG8_SA(b, h) (((b) * 2 + (h)) * HTB)
#define PG8_SB(b, h) ((4 + (b) * 2 + (h)) * HTB)
#define PG8_STAGE(bufoff, gbase, voff) do { _Pragma("unroll") for (int _i = 0; _i < 2; ++_i) \
        __builtin_amdgcn_global_load_lds((const unsigned*)((const char*)(gbase) + (voff)[_i]), (PG8_LAS unsigned*)(lds + (bufoff) + ldsw + _i * 8192), 16, 0, 0); } while (0)
#define PG8_LDA(dst, b, h) do { _Pragma("unroll") for (int m = 0; m < 4; ++m) _Pragma("unroll") for (int k = 0; k < 2; ++k) dst[m][k] = *(const PG8_LAS bf16x8*)(lds + PG8_SA(b, h) + aoff + m * 2048 + k * 1024); } while (0)
#define PG8_LDB(dst, b, h) do { _Pragma("unroll") for (int n = 0; n < 2; ++n) _Pragma("unroll") for (int k = 0; k < 2; ++k) dst[n][k] = *(const PG8_LAS bf16x8*)(lds + PG8_SB(b, h) + boff + n * 2048 + k * 1024); } while (0)
#define PG8_MMA(ai, bj, At, Bt) do { __builtin_amdgcn_s_setprio(1); _Pragma("unroll") for (int m = 0; m < 4; ++m) _Pragma("unroll") for (int n = 0; n < 2; ++n) _Pragma("unroll") for (int k = 0; k < 2; ++k) \
        acc[ai][bj][m][n] = __builtin_amdgcn_mfma_f32_16x16x32_bf16(Bt[n][k], At[m][k], acc[ai][bj][m][n], 0, 0, 0); __builtin_amdgcn_s_setprio(0); } while (0)
#define PG8_WAIT_V(n) asm volatile("s_waitcnt vmcnt(" #n ")" ::: "memory")
#define PG8_WAIT_L(n) asm volatile("s_waitcnt lgkmcnt(" #n ")" ::: "memory")
#define PG8_BAR __builtin_amdgcn_s_barrier()
#define PG8_SCHED __builtin_amdgcn_sched_barrier(0)
    Unit cur, nxt; int ui = 0;
    if (!S.next(0, cur)) return;
    f32x4 acc[2][2][4][2];
#pragma unroll
    for (int a = 0; a < 2; ++a)
#pragma unroll
        for (int b = 0; b < 2; ++b)
#pragma unroll
            for (int m = 0; m < 4; ++m)
#pragma unroll
                for (int n = 0; n < 2; ++n) acc[a][b][m][n] = (f32x4){0.f, 0.f, 0.f, 0.f};
    bf16x8 At[4][2], B0[2][2], B1[2][2];
    const char* cA = (const char*)g.A + (size_t)cur.pm * tstep; const char* cB = (const char*)g.Bt + (size_t)cur.pn * tstep;
    S.a_ready(cur);
    if constexpr (SP2) {
        PG8_STAGE(PG8_SB(0, 0), cB, voffB); PG8_STAGE(PG8_SB(0, 1), cB + hstep, voffB); PG8_STAGE(PG8_SA(0, 0), cA, voffA); PG8_STAGE(PG8_SA(0, 1), cA + hstep, voffA);
        if (wr == 1) PG8_BAR;
        PG8_WAIT_V(2); PG8_BAR;
        PG8_STAGE(PG8_SB(1, 0), cB + kstep, voffB); PG8_STAGE(PG8_SA(1, 0), cA + kstep, voffA); PG8_STAGE(PG8_SB(1, 1), cB + hstep + kstep, voffB);
        PG8_WAIT_V(6); PG8_BAR;
    } else {
        PG8_STAGE(PG8_SB(0, 0), cB, voffB); PG8_STAGE(PG8_SA(0, 0), cA, voffA); PG8_STAGE(PG8_SB(0, 1), cB + hstep, voffB); PG8_STAGE(PG8_SA(0, 1), cA + hstep, voffA);
        if (wr == 1) PG8_BAR;
        PG8_WAIT_V(4); PG8_BAR;
        PG8_STAGE(PG8_SB(1, 0), cB + kstep, voffB); PG8_STAGE(PG8_SA(1, 0), cA + kstep, voffA); PG8_STAGE(PG8_SB(1, 1), cB + hstep + kstep, voffB);
        PG8_WAIT_V(6); PG8_BAR;
    }
    for (;;) {
        const bool has_next = S.next(ui + 1, nxt);
        const char* nA = has_next ? (const char*)g.A + (size_t)nxt.pm * tstep : cA; const char* nB = has_next ? (const char*)g.Bt + (size_t)nxt.pn * tstep : cB;
        for (int t = 0; t < nt; t += 2) {
            const bool last = (t == nt - 2);
            const char* a1 = cA + (size_t)(t + 1) * kstep;
            const char* a2 = last ? nA : cA + (size_t)(t + 2) * kstep; const char* b2 = last ? nB : cB + (size_t)(t + 2) * kstep;
            const char* a3 = a2 + kstep; const char* b3 = b2 + kstep;
            if (last && has_next) S.a_ready(nxt);
            if constexpr (SP2) {
            PG8_LDB(B0, 0, 0); PG8_LDB(B1, 0, 1); PG8_SCHED; PG8_LDA(At, 0, 0); PG8_STAGE(PG8_SA(1, 1), a1 + hstep, voffA);
            PG8_WAIT_V(8); PG8_WAIT_L(0); PG8_BAR; PG8_MMA(0, 0, At, B0); PG8_MMA(0, 1, At, B1); PG8_BAR; PG8_SCHED;
            PG8_LDA(At, 0, 1); PG8_STAGE(PG8_SB(0, 0), b2, voffB); PG8_STAGE(PG8_SB(0, 1), b2 + hstep, voffB); PG8_STAGE(PG8_SA(0, 0), a2, voffA);
            PG8_WAIT_V(8); PG8_WAIT_L(0); PG8_BAR; PG8_MMA(1, 0, At, B0); PG8_MMA(1, 1, At, B1); PG8_BAR; PG8_SCHED;
            PG8_LDB(B0, 1, 0); PG8_LDB(B1, 1, 1); PG8_SCHED; PG8_LDA(At, 1, 0); PG8_STAGE(PG8_SA(0, 1), a2 + hstep, voffA);
            PG8_WAIT_V(8); PG8_WAIT_L(0); PG8_BAR; PG8_MMA(0, 0, At, B0); PG8_MMA(0, 1, At, B1); PG8_BAR; PG8_SCHED;
            PG8_LDA(At, 1, 1); PG8_STAGE(PG8_SB(1, 0), b3, voffB); PG8_STAGE(PG8_SB(1, 1), b3 + hstep, voffB); PG8_STAGE(PG8_SA(1, 0), a3, voffA);
            PG8_WAIT_V(8); PG8_WAIT_L(0); PG8_BAR; PG8_MMA(1, 0, At, B0); PG8_MMA(1, 1, At, B1); PG8_BAR; PG8_SCHED;
            } else {
            PG8_LDB(B0, 0, 0); PG8_SCHED; PG8_LDA(At, 0, 0); PG8_STAGE(PG8_SA(1, 1), a1 + hstep, voffA);
            PG8_WAIT_L(8); PG8_BAR; PG8_WAIT_L(0); PG8_MMA(0, 0, At, B0); PG8_BAR; PG8_SCHED;
            PG8_LDB(B1, 0, 1); PG8_STAGE(PG8_SB(0, 0), b2, voffB);
            PG8_BAR; PG8_WAIT_L(0); PG8_MMA(0, 1, At, B1); PG8_BAR;
            PG8_LDA(At, 0, 1); PG8_STAGE(PG8_SA(0, 0), a2, voffA);
            PG8_BAR; PG8_WAIT_L(0); PG8_MMA(1, 0, At, B0); PG8_BAR; PG8_SCHED;
            PG8_STAGE(PG8_SB(0, 1), b2 + hstep, voffB);
            PG8_WAIT_V(6); PG8_BAR; PG8_MMA(1, 1, At, B1); PG8_BAR;
            PG8_LDB(B0, 1, 0); PG8_SCHED; PG8_LDA(At, 1, 0); PG8_STAGE(PG8_SA(0, 1), a2 + hstep, voffA);
            PG8_WAIT_L(8); PG8_BAR; PG8_WAIT_L(0); PG8_MMA(0, 0, At, B0); PG8_BAR; PG8_SCHED;
            PG8_LDB(B1, 1, 1); PG8_STAGE(PG8_SB(1, 0), b3, voffB);
            PG8_BAR; PG8_WAIT_L(0); PG8_MMA(0, 1, At, B1); PG8_BAR;
            PG8_LDA(At, 1, 1); PG8_STAGE(PG8_SA(1, 0), a3, voffA);
            PG8_BAR; PG8_WAIT_L(0); PG8_MMA(1, 0, At, B0); PG8_BAR; PG8_SCHED;
            PG8_STAGE(PG8_SB(1, 1), b3 + hstep, voffB);
            PG8_WAIT_V(6); PG8_BAR; PG8_MMA(1, 1, At, B1); PG8_BAR;
            }
        }
        if constexpr (ALIGN_EPI) { if (wr == 0) PG8_BAR; }
        if constexpr (!Epi::AFTER_DRAIN) { E(acc, cur, wr, wc, fr, fq); S.done(cur); }
        if (!has_next) break;
#pragma unroll
        for (int a = 0; a < 2; ++a)
#pragma unroll
            for (int b = 0; b < 2; ++b)
#pragma unroll
                for (int m = 0; m < 4; ++m)
#pragma unroll
                    for (int n = 0; n < 2; ++n) acc[a][b][m][n] = (f32x4){0.f, 0.f, 0.f, 0.f};
        cur = nxt; cA = nA; cB = nB; ++ui;
        if constexpr (ALIGN_EPI) { if (wr == 1) PG8_BAR; }
    }
    PG8_WAIT_V(0);
    if constexpr (!ALIGN_EPI) { if (wr == 0) PG8_BAR; }
    PG8_BAR;
    if constexpr (Epi::AFTER_DRAIN) { E.fused(acc, cur, wr, wc, fr, fq, lds, wid, lane); S.done(cur); }
#undef PG8_SA
#undef PG8_SB
#undef PG8_STAGE
#undef PG8_LDA
#undef PG8_LDB
#undef PG8_MMA
#undef PG8_WAIT_V
#undef PG8_WAIT_L
#undef PG8_BAR
#undef PG8_SCHED
}
}

constexpr int NB = 16, SEQ = 2048, DM = 1024, DEPTH = 4, DIN = 2048, DFF = 2816, M = NB * SEQ;
constexpr float EPS = 1e-6f;
constexpr size_t MiB = 1u << 20;
constexpr size_t WS_WIN = 0, WS_WOUT = 16 * MiB, WS_WGU = 24 * MiB, WS_WDN = 68 * MiB, WS_SGUW = 90 * MiB, WS_PWT = 90 * MiB + 512 * 1024,
                 WS_SS = 91 * MiB, WS_BAR = 93 * MiB, WS_XB = 96 * MiB, WS_PROJ = 160 * MiB, WS_YCAT = 288 * MiB, WS_HID = 160 * MiB, WS_END = 352 * MiB;
constexpr int LDS_BYTES = 160 * 1024;
constexpr int NTHR = 512;

#define LAS __attribute__((address_space(3)))
typedef unsigned short bf16_t;
typedef short bf16x8 __attribute__((ext_vector_type(8)));
typedef float f32x4 __attribute__((ext_vector_type(4)));
typedef float f32x2 __attribute__((ext_vector_type(2)));
typedef unsigned u32x4 __attribute__((ext_vector_type(4)));
typedef unsigned u32x2 __attribute__((ext_vector_type(2)));
typedef __bf16 bf16x2_t __attribute__((ext_vector_type(2)));

__device__ __forceinline__ unsigned pk2(float lo, float hi) { f32x2 v = {lo, hi}; bf16x2_t b = __builtin_convertvector(v, bf16x2_t); return __builtin_bit_cast(unsigned, b); }
__device__ __forceinline__ bf16_t f2bf(float f) { return (bf16_t)(pk2(f, 0.f) & 0xffffu); }
__device__ __forceinline__ float bflo(unsigned w) { return __uint_as_float(w << 16); }
__device__ __forceinline__ float bfhi(unsigned w) { return __uint_as_float(w & 0xffff0000u); }
#define MFMA16(a, b, c) __builtin_amdgcn_mfma_f32_16x16x32_bf16((a), (b), (c), 0, 0, 0)
#define CFENCE() asm volatile("" ::: "memory")
#define LDSWAIT() asm volatile("s_waitcnt lgkmcnt(0)" ::: "memory")
__device__ __forceinline__ float fexp(float x) { return __builtin_amdgcn_exp2f(x * 1.4426950408889634f); }
__device__ __forceinline__ float gelu_tanh(float x) {
    const float u2 = 1.5957691216057308f * x * (1.0f + 0.044715f * x * x);
    return x * __builtin_amdgcn_rcpf(1.0f + fexp(-u2));
}
__device__ __forceinline__ float rstd_of(const float* ss, int row) {
    const f32x4* p = (const f32x4*)(ss + (size_t)row * 16); const f32x4 a = p[0], b = p[1], c = p[2], d = p[3];
    const f32x4 s = (a + b) + (c + d); return rsqrtf(((s.x + s.y) + (s.z + s.w)) * (1.0f / 1024.0f) + EPS);
}

__device__ __forceinline__ float ssq4(const f32x4 y) { return (y[0] * y[0] + y[1] * y[1]) + (y[2] * y[2] + y[3] * y[3]); }

namespace pg8 {
struct EpiIn {
    static constexpr bool PERM = true, AFTER_DRAIN = false;
    bf16_t* O; const float* ss;
    __device__ __forceinline__ void operator()(const f32x4 (&acc)[2][2][4][2], const Unit& u, int wr, int wc, int fr, int fq) const {
        const int row0 = u.pm * BM + wr * 64 + fr, col0 = u.pn * BM + wc * 32 + 8 * fq; const bool act = u.pn < 2;
#pragma unroll
        for (int ai = 0; ai < 2; ++ai)
#pragma unroll
            for (int m = 0; m < 4; ++m) { const int row = row0 + ai * HALF + m * 16; const float rs = rstd_of(ss, row); bf16_t* rowp = O + (size_t)row * DIN + col0;
#pragma unroll
                for (int bj = 0; bj < 2; ++bj) { f32x4 v0 = acc[ai][bj][m][0] * rs, v1 = acc[ai][bj][m][1] * rs;
                    if (act) { v0 = (f32x4){gelu_tanh(v0[0]), gelu_tanh(v0[1]), gelu_tanh(v0[2]), gelu_tanh(v0[3])}; v1 = (f32x4){gelu_tanh(v1[0]), gelu_tanh(v1[1]), gelu_tanh(v1[2]), gelu_tanh(v1[3])}; }
                    u32x4 w; w.x = pk2(v0[0], v0[1]); w.y = pk2(v0[2], v0[3]); w.z = pk2(v1[0], v1[1]); w.w = pk2(v1[2], v1[3]);
                    *(u32x4*)(rowp + bj * HALF) = w; }
                if (m & 1) CFENCE(); }
    }
};
struct EpiGU {
    static constexpr bool PERM = true, AFTER_DRAIN = false;
    bf16_t* O; const float* ss;
    __device__ __forceinline__ void operator()(const f32x4 (&acc)[2][2][4][2], const Unit& u, int wr, int wc, int fr, int fq) const {
        const int row0 = u.pm * BM + wr * 64 + fr, col0 = u.pn * HALF + wc * 32 + 8 * fq;
#pragma unroll
        for (int ai = 0; ai < 2; ++ai)
#pragma unroll
            for (int m = 0; m < 4; ++m) { const int row = row0 + ai * HALF + m * 16; const float rs = rstd_of(ss, row); bf16_t* rowp = O + (size_t)row * DFF + col0;
                float h[8];
#pragma unroll
                for (int n = 0; n < 2; ++n)
#pragma unroll
                    for (int e = 0; e < 4; ++e) { const float g = acc[ai][0][m][n][e] * rs, up = acc[ai][1][m][n][e] * rs; h[n * 4 + e] = g * up * __builtin_amdgcn_rcpf(1.0f + fexp(-g)); }
                u32x4 w; w.x = pk2(h[0], h[1]); w.y = pk2(h[2], h[3]); w.z = pk2(h[4], h[5]); w.w = pk2(h[6], h[7]);
                *(u32x4*)rowp = w;
                if (m & 1) CFENCE(); }
    }
};
struct EpiRes {
    static constexpr bool PERM = true, AFTER_DRAIN = false;
    const float* xin32; float* xout32; bf16_t* xb; float* ss;
    __device__ __forceinline__ void operator()(const f32x4 (&acc)[2][2][4][2], const Unit& u, int wr, int wc, int fr, int fq) const {
        const int row0 = u.pm * BM + wr * 64 + fr, col0 = u.pn * BM + wc * 32 + 8 * fq;
#pragma unroll
        for (int ai = 0; ai < 2; ++ai)
#pragma unroll
            for (int m = 0; m < 4; ++m) { const int row = row0 + ai * HALF + m * 16; const size_t off = (size_t)row * DM + col0; float q = 0.f;
#pragma unroll
                for (int bj = 0; bj < 2; ++bj) { f32x4 r0, r1;
                    if (xin32) { r0 = *(const f32x4*)(xin32 + off + bj * HALF); r1 = *(const f32x4*)(xin32 + off + bj * HALF + 4); }
                    else { const u32x4 t = *(const u32x4*)(xb + off + bj * HALF); r0 = (f32x4){bflo(t.x), bfhi(t.x), bflo(t.y), bfhi(t.y)}; r1 = (f32x4){bflo(t.z), bfhi(t.z), bflo(t.w), bfhi(t.w)}; }
                    const f32x4 v0 = r0 + acc[ai][bj][m][0], v1 = r1 + acc[ai][bj][m][1];
                    q += ssq4(v0) + ssq4(v1);
                    if (xout32) { *(f32x4*)(xout32 + off + bj * HALF) = v0; *(f32x4*)(xout32 + off + bj * HALF + 4) = v1; }
                    else { u32x4 w; w.x = pk2(v0[0], v0[1]); w.y = pk2(v0[2], v0[3]); w.z = pk2(v1[0], v1[1]); w.w = pk2(v1[2], v1[3]); *(u32x4*)(xb + off + bj * HALF) = w; } }
                q += __shfl_xor(q, 16); q += __shfl_xor(q, 32);
                if (fq == 0) ss[(size_t)row * 16 + u.pn * 4 + wc] = q;
                if (m & 1) CFENCE(); }
    }
};
}

__device__ __forceinline__ void transpose_item(const float* W, int K, int N, bf16_t* WT, const float* gain, int mode, LAS float* scr, int item, int lane) {
    const int nblk = N / 32, kb = item / nblk, nb = item % nblk, k0 = 64 * kb, n0 = 32 * nb;
#pragma unroll 8
    for (int i = 0; i < 32; ++i) { const int kk = 2 * i + (lane >> 5); const float g = gain ? gain[k0 + kk] : 1.0f; scr[kk * 33 + (lane & 31)] = W[(size_t)(k0 + kk) * N + n0 + (lane & 31)] * g; }
    LDSWAIT();
    const int c = lane & 7;
#pragma unroll
    for (int j = 0; j < 4; ++j) { const int n = (lane >> 3) + 8 * j, gn = n0 + n; const LAS float* s = scr + (8 * c) * 33 + n;
        float cs = 1.0f; int row = gn;
        if (mode == 1) { if ((gn >= 768 && gn < 1024) || (gn >= 1280 && gn < 1536)) cs = 0.125f; }
        if (mode == 2) { const int jj = gn < DFF ? gn : gn - DFF; row = 256 * (jj >> 7) + (jj & 127) + (gn < DFF ? 0 : 128); }
        u32x4 o; o.x = pk2(s[0 * 33] * cs, s[1 * 33] * cs); o.y = pk2(s[2 * 33] * cs, s[3 * 33] * cs); o.z = pk2(s[4 * 33] * cs, s[5 * 33] * cs); o.w = pk2(s[6 * 33] * cs, s[7 * 33] * cs);
        *(u32x4*)(WT + (size_t)row * K + k0 + 8 * c) = o; }
    LDSWAIT();
}
__device__ __forceinline__ float wave_sum(float v) {
#pragma unroll
    for (int o = 1; o < 64; o <<= 1) v += __shfl_xor(v, o);
    return v;
}

struct Params {
    const float *x, *w_in, *w_out, *sgu_w, *sgu_b, *pool_w, *pool_scale, *swa_sinks, *rel_bias, *mix_out_gain, *norm_mix, *norm_ffn, *w_gate_up, *w_down, *norm_final;
    float* out; unsigned char* ws;
};


__device__ __forceinline__ void st4(bf16_t* p, const f32x4 y) { u32x2 o; o.x = pk2(y[0], y[1]); o.y = pk2(y[2], y[3]); *(u32x2*)p = o; }
__device__ __forceinline__ void rescale4(bf16_t* p, float rs) {
    const unsigned long long v = __hip_atomic_load((unsigned long long*)p, __ATOMIC_RELAXED, __HIP_MEMORY_SCOPE_AGENT); const unsigned lo = (unsigned)v, hi = (unsigned)(v >> 32);
    u32x2 o; o.x = pk2(bflo(lo) * rs, bfhi(lo) * rs); o.y = pk2(bflo(hi) * rs, bfhi(hi) * rs); *(u32x2*)p = o;
}
#define VMWAIT() asm volatile("s_waitcnt vmcnt(0)" ::: "memory")

__device__ __forceinline__ void mixer_A(LAS unsigned char* L, const bf16_t* proj, const bf16_t* sguw, const float* sgub, bf16_t* ycat, int b, int ch, int tid, int lane, int w) {
    constexpr int VTS = 136;
    LAS bf16_t* VT = (LAS bf16_t*)L;
    const size_t row0 = (size_t)b * SEQ + ch * 128;
    {
        const int tok = tid >> 2, h = tid & 3;
        const bf16_t* src = proj + (row0 + tok) * DIN + 256 + h * 64;
        float v[64]; float s = 0.f;
#pragma unroll
        for (int i = 0; i < 8; ++i) { const u32x4 t = *(const u32x4*)(src + 8 * i);
            v[8 * i + 0] = bflo(t.x); v[8 * i + 1] = bfhi(t.x); v[8 * i + 2] = bflo(t.y); v[8 * i + 3] = bfhi(t.y); v[8 * i + 4] = bflo(t.z); v[8 * i + 5] = bfhi(t.z); v[8 * i + 6] = bflo(t.w); v[8 * i + 7] = bfhi(t.w); }
#pragma unroll
        for (int i = 0; i < 64; ++i) s += v[i];
        const float mean = s * (1.0f / 64.0f); float s2 = 0.f;
#pragma unroll
        for (int i = 0; i < 64; ++i) { v[i] -= mean; s2 += v[i] * v[i]; }
        const float rstd = rsqrtf(s2 * (1.0f / 64.0f) + EPS);
        LAS bf16_t* dst = VT + (h * 64) * VTS + tok;
#pragma unroll
        for (int i = 0; i < 64; ++i) dst[i * VTS] = f2bf(v[i] * rstd);
    }
    __syncthreads();
    const int c = lane & 15, q = lane >> 4, wv = tid >> 6;
    const int nks = (w >> 1) + 1;
    const size_t trow = row0 + 16 * wv + c; float ssq = 0.f;
    bf16_t* yrow = ycat + trow * DM + 0 + 4 * q;
    const bf16_t* urow = proj + trow * DIN + 4 * q;
    const LAS bf16_t* vbase = VT + c * VTS + 8 * q;
    const bf16_t* wbase = sguw + (size_t)(16 * wv + c) * 128 + 8 * q;
#pragma unroll 1
    for (int h = 0; h < 4; ++h) {
        f32x4 acc[4];
#pragma unroll
        for (int n = 0; n < 4; ++n) acc[n] = (f32x4){0.f, 0.f, 0.f, 0.f};
#pragma unroll
        for (int ks = 0; ks < 4; ++ks) if (ks < nks) {
            const bf16x8 bfrag = *(const bf16x8*)(wbase + h * 128 * 128 + 32 * ks);
#pragma unroll
            for (int n = 0; n < 4; ++n) { const bf16x8 a = *(const LAS bf16x8*)(vbase + (h * 64 + 16 * n) * VTS + 32 * ks); acc[n] = MFMA16(a, bfrag, acc[n]); }
        }
        const float bias = sgub[h * 128 + 16 * wv + c];
#pragma unroll
        for (int n = 0; n < 4; ++n) { const u32x2 uu = *(const u32x2*)(urow + h * 64 + 16 * n);
            f32x4 y; y[0] = bflo(uu.x) * (acc[n][0] + bias); y[1] = bfhi(uu.x) * (acc[n][1] + bias); y[2] = bflo(uu.y) * (acc[n][2] + bias); y[3] = bfhi(uu.y) * (acc[n][3] + bias);
            ssq += ssq4(y); st4(yrow + h * 64 + 16 * n, y); }
    }
    ssq += __shfl_xor(ssq, 16); ssq += __shfl_xor(ssq, 32);
    const float rs = rsqrtf(ssq * (1.0f / 256.0f) + EPS);
    VMWAIT();
#pragma unroll 4
    for (int i = 0; i < 16; ++i) rescale4(yrow + 16 * i, rs);
}

__device__ __forceinline__ void mixer_B(LAS unsigned char* L, const bf16_t* proj, const bf16_t* pwt, const float* pscale, bf16_t* ycat, int b, int ch, int tid, int lane, int w) {
    constexpr int YS = 264;
    LAS bf16_t* Y = (LAS bf16_t*)L;
    const size_t row0 = (size_t)b * SEQ + ch * 128;
    {
        const int tok = tid >> 2, g = tid & 3; const int win = 2 << g; const int tseq = ch * 128 + tok; const int cnt = (tseq + 1 < win) ? (tseq + 1) : win;
        const float inv = 1.0f / (float)cnt;
#pragma unroll 1
        for (int hf = 0; hf < 2; ++hf) {
            const bf16_t* src = proj + (row0 + tok) * DIN + 512 + g * 64 + hf * 32;
            float p0[32], s[32];
#pragma unroll
            for (int i = 0; i < 4; ++i) { const u32x4 t = *(const u32x4*)(src + 8 * i);
                p0[8 * i + 0] = bflo(t.x); p0[8 * i + 1] = bfhi(t.x); p0[8 * i + 2] = bflo(t.y); p0[8 * i + 3] = bfhi(t.y); p0[8 * i + 4] = bflo(t.z); p0[8 * i + 5] = bfhi(t.z); p0[8 * i + 6] = bflo(t.w); p0[8 * i + 7] = bfhi(t.w); }
#pragma unroll
            for (int i = 0; i < 32; ++i) s[i] = p0[i];
#pragma unroll 1
            for (int j = 1; j < cnt; ++j) { const bf16_t* sj = src - (size_t)j * DIN;
#pragma unroll
                for (int i = 0; i < 4; ++i) { const u32x4 t = *(const u32x4*)(sj + 8 * i);
                    s[8 * i + 0] += bflo(t.x); s[8 * i + 1] += bfhi(t.x); s[8 * i + 2] += bflo(t.y); s[8 * i + 3] += bfhi(t.y); s[8 * i + 4] += bflo(t.z); s[8 * i + 5] += bfhi(t.z); s[8 * i + 6] += bflo(t.w); s[8 * i + 7] += bfhi(t.w); } }
#pragma unroll
            for (int i = 0; i < 4; ++i) { u32x4 o; o.x = pk2(s[8 * i + 0] * inv - p0[8 * i + 0], s[8 * i + 1] * inv - p0[8 * i + 1]); o.y = pk2(s[8 * i + 2] * inv - p0[8 * i + 2], s[8 * i + 3] * inv - p0[8 * i + 3]);
                o.z = pk2(s[8 * i + 4] * inv - p0[8 * i + 4], s[8 * i + 5] * inv - p0[8 * i + 5]); o.w = pk2(s[8 * i + 6] * inv - p0[8 * i + 6], s[8 * i + 7] * inv - p0[8 * i + 7]);
                *(LAS u32x4*)(Y + tok * YS + g * 64 + hf * 32 + 8 * i) = o; }
        }
    }
    __syncthreads();
    const int c = lane & 15, q = lane >> 4, wv = tid >> 6;
    const size_t trow = row0 + 16 * wv + c; float ssq = 0.f;
    bf16_t* yrow = ycat + trow * DM + 256 + 4 * q;
    const LAS bf16_t* ybase = Y + (16 * wv + c) * YS + 8 * q;
    const bf16_t* pbase = pwt + (size_t)c * 64 + 8 * q;
#pragma unroll 1
    for (int g = 0; g < 4; ++g) {
        f32x4 acc[4];
#pragma unroll
        for (int n = 0; n < 4; ++n) acc[n] = (f32x4){0.f, 0.f, 0.f, 0.f};
#pragma unroll
        for (int ks = 0; ks < 2; ++ks) { const bf16x8 bfrag = *(const LAS bf16x8*)(ybase + g * 64 + 32 * ks);
#pragma unroll
            for (int n = 0; n < 4; ++n) { const bf16x8 a = *(const bf16x8*)(pbase + (g * 64 + 16 * n) * 64 + 32 * ks); acc[n] = MFMA16(a, bfrag, acc[n]); } }
#pragma unroll
        for (int n = 0; n < 4; ++n) { const f32x4 sc = *(const f32x4*)(pscale + g * 64 + 16 * n + 4 * q); const f32x4 y = acc[n] * sc; ssq += ssq4(y); st4(yrow + g * 64 + 16 * n, y); }
    }
    ssq += __shfl_xor(ssq, 16); ssq += __shfl_xor(ssq, 32);
    const float rs = rsqrtf(ssq * (1.0f / 256.0f) + EPS);
    VMWAIT();
#pragma unroll 4
    for (int i = 0; i < 16; ++i) rescale4(yrow + 16 * i, rs);
}

__device__ __forceinline__ void mixer_C(LAS unsigned char* L, const bf16_t* proj, const float* sinks, const float* rel_bias, bf16_t* ycat, int b, int qb, int tid, int lane, int w) {
    constexpr int KS = 72, VS = 280, SS = 164;
    const int wv = tid >> 6;
    LAS bf16_t* KL = (LAS bf16_t*)L;
    LAS bf16_t* VT = (LAS bf16_t*)(L + 36864);
    LAS float* S = (LAS float*)(L + 72704) + wv * 16 * SS;
    LAS float* BT = (LAS float*)(L + 156672);
    const size_t row0 = (size_t)b * SEQ + qb * 128;
    {
        const int j = tid >> 7, dist = tid & 127; int bucket = dist;
        if (dist >= 16) { const int lg = 16 + (int)(__logf((float)dist * (1.0f / 16.0f)) / 2.0794415416798357f * 16.0f); bucket = lg < 31 ? lg : 31; }
        BT[j * 128 + dist] = rel_bias[bucket * 4 + j];
    }
    const int c = lane & 15, q = lane >> 4;
    const size_t trow = row0 + 16 * wv + c; float ssq = 0.f;
    bf16_t* yrow = ycat + trow * DM + 512 + 4 * q;
    const LAS bf16_t* kbase = KL + (16 * wv + c) * KS + 8 * q;
    const LAS bf16_t* vbase = VT + c * VS + 16 * wv + 8 * q;
    LAS float* swr = S + c * SS + 4 * q;
    const LAS bf16_t* wrd = (const LAS bf16_t*)(S + c * SS) + 8 * q;
    const int row = lane >> 2, seg = lane & 3;
    LAS float* srd = S + row * SS + 40 * seg;
#pragma unroll 1
    for (int kvh = 0; kvh < 2; ++kvh) {
        __syncthreads();
        {
            const int key = tid >> 1, half = tid & 1; const bool okk = (qb > 0) || (key >= 128);
            const bf16_t* ksrc = proj + (row0 - 128 + key) * DIN + 1024 + kvh * 64 + half * 32;
            const bf16_t* vsrc = ksrc + 128;
            LAS bf16_t* vdst = VT + (half * 32) * VS + key;
#pragma unroll
            for (int i = 0; i < 4; ++i) { u32x4 kk = {0u, 0u, 0u, 0u}, vv = {0u, 0u, 0u, 0u};
                if (okk) { kk = *(const u32x4*)(ksrc + 8 * i); vv = *(const u32x4*)(vsrc + 8 * i); }
                *(LAS u32x4*)(KL + key * KS + half * 32 + 8 * i) = kk;
                vdst[(8 * i + 0) * VS] = (bf16_t)(vv.x & 0xffffu); vdst[(8 * i + 1) * VS] = (bf16_t)(vv.x >> 16); vdst[(8 * i + 2) * VS] = (bf16_t)(vv.y & 0xffffu); vdst[(8 * i + 3) * VS] = (bf16_t)(vv.y >> 16);
                vdst[(8 * i + 4) * VS] = (bf16_t)(vv.z & 0xffffu); vdst[(8 * i + 5) * VS] = (bf16_t)(vv.z >> 16); vdst[(8 * i + 6) * VS] = (bf16_t)(vv.w & 0xffffu); vdst[(8 * i + 7) * VS] = (bf16_t)(vv.w >> 16); }
            if (tid < 64) {
#pragma unroll
                for (int i = 0; i < 3; ++i) *(LAS u32x4*)(VT + tid * VS + 256 + 8 * i) = (u32x4){0u, 0u, 0u, 0u}; }
        }
        __syncthreads();
#pragma unroll 1
        for (int g = 0; g < 2; ++g) { const int j = 2 * kvh + g;
            bf16x8 qf[2];
#pragma unroll
            for (int ks = 0; ks < 2; ++ks) qf[ks] = *(const bf16x8*)(proj + trow * DIN + 768 + j * 64 + 32 * ks + 8 * q);
#pragma unroll
            for (int kti = 0; kti < 9; ++kti) { f32x4 s = {0.f, 0.f, 0.f, 0.f};
#pragma unroll
                for (int ks = 0; ks < 2; ++ks) { const bf16x8 a = *(const LAS bf16x8*)(kbase + 16 * kti * KS + 32 * ks); s = MFMA16(a, qf[ks], s); }
                *(LAS f32x4*)(swr + 16 * kti) = s; }
            LDSWAIT();
            { const float sink = sinks[j]; const LAS float* bt = BT + j * 128;
                int zz; asm volatile("v_mov_b32 %0, 0" : "=v"(zz));
                const int rowz = row + zz; const int klo = (qb > 0) ? (rowz + 1) : max(rowz + 1, 128 - 16 * w), khi = rowz + 128;
                float lg[40]; float mx = sink;
#pragma unroll
                for (int i4 = 0; i4 < 10; ++i4) { const f32x4 sv = *(const LAS f32x4*)(srd + 4 * i4);
#pragma unroll
                    for (int e = 0; e < 4; ++e) { const int kl = 40 * seg + 4 * i4 + e; const int dist = 128 + rowz - kl; const bool valid = (unsigned)(kl - klo) <= (unsigned)(khi - klo);
                        const int dcl = dist & 127; const float bb = bt[dcl];
                        const float v = valid ? (sv[e] + bb) : -1e30f; lg[4 * i4 + e] = v; mx = fmaxf(mx, v); } }
                mx = fmaxf(mx, __shfl_xor(mx, 1)); mx = fmaxf(mx, __shfl_xor(mx, 2));
                float sum = 0.f;
#pragma unroll
                for (int i = 0; i < 40; ++i) { const float p = (lg[i] > -1e29f) ? fexp(lg[i] - mx) : 0.f; lg[i] = p; sum += p; }
                sum += __shfl_xor(sum, 1); sum += __shfl_xor(sum, 2);
                const float inv = 1.0f / (sum + fexp(sink - mx));
                LDSWAIT();
                LAS bf16_t* Wr = (LAS bf16_t*)(S + row * SS) + 40 * seg;
#pragma unroll
                for (int i8 = 0; i8 < 5; ++i8) { u32x4 o; o.x = pk2(lg[8 * i8 + 0] * inv, lg[8 * i8 + 1] * inv); o.y = pk2(lg[8 * i8 + 2] * inv, lg[8 * i8 + 3] * inv); o.z = pk2(lg[8 * i8 + 4] * inv, lg[8 * i8 + 5] * inv); o.w = pk2(lg[8 * i8 + 6] * inv, lg[8 * i8 + 7] * inv);
                    *(LAS u32x4*)(Wr + 8 * i8) = o; }
            }
            LDSWAIT();
            f32x4 acc[4];
#pragma unroll
            for (int n = 0; n < 4; ++n) acc[n] = (f32x4){0.f, 0.f, 0.f, 0.f};
#pragma unroll
            for (int ks = 0; ks < 5; ++ks) { const bf16x8 bfrag = *(const LAS bf16x8*)(wrd + 32 * ks);
#pragma unroll
                for (int n = 0; n < 4; ++n) { const bf16x8 a = *(const LAS bf16x8*)(vbase + 16 * n * VS + 32 * ks); acc[n] = MFMA16(a, bfrag, acc[n]); } }
            LDSWAIT();
#pragma unroll
            for (int n = 0; n < 4; ++n) { ssq += ssq4(acc[n]); st4(yrow + j * 64 + 16 * n, acc[n]); }
        }
    }
    ssq += __shfl_xor(ssq, 16); ssq += __shfl_xor(ssq, 32);
    const float rs = rsqrtf(ssq * (1.0f / 256.0f) + EPS);
    VMWAIT();
#pragma unroll 4
    for (int i = 0; i < 16; ++i) rescale4(yrow + 16 * i, rs);
}

__device__ __forceinline__ void mixer_D(LAS unsigned char* L, const bf16_t* proj, bf16_t* ycat, int b, int qb64, int tid, int lane, int w) {
    constexpr int KS = 264, VS = 72, SS = 68, WS = 72;
    const int wv = tid >> 6;
    LAS bf16_t* KL = (LAS bf16_t*)L;
    LAS bf16_t* VT = (LAS bf16_t*)(L + 33792);
    LAS float* S = (LAS float*)(L + 70656) + wv * 16 * SS;
    LAS bf16_t* Wl = (LAS bf16_t*)(L + 105472) + wv * 16 * WS;
    LAS float* RED = (LAS float*)(L + 123904);
    volatile LAS unsigned* FLG = (volatile LAS unsigned*)(L + 124416);
    const int rg = wv & 3, hp = wv >> 2, c = lane & 15, q = lane >> 4;
    const size_t seq0 = (size_t)b * SEQ; const size_t trow = seq0 + qb64 * 64 + 16 * rg + c;
    bf16x8 qf[2][2];
#pragma unroll
    for (int hh = 0; hh < 2; ++hh)
#pragma unroll
        for (int ks = 0; ks < 2; ++ks) qf[hh][ks] = *(const bf16x8*)(proj + trow * DIN + 1280 + (2 * hp + hh) * 64 + 32 * ks + 8 * q);
    f32x4 acc[2][4];
#pragma unroll
    for (int hh = 0; hh < 2; ++hh)
#pragma unroll
        for (int n = 0; n < 4; ++n) acc[hh][n] = (f32x4){0.f, 0.f, 0.f, 0.f};
    float carry[2] = {0.f, 0.f};
    const int srow = lane >> 2, seg = lane & 3, qloc = 16 * rg + srow;
    const LAS bf16_t* kbase = KL + c * KS + hp * 128 + 8 * q;
    const LAS bf16_t* vbase = VT + (hp * 128 + c) * VS + 8 * q;
    LAS float* swr = S + c * SS + 4 * q;
    const LAS float* srd = S + srow * SS + 16 * seg;
    LAS bf16_t* wwr = Wl + srow * WS + 16 * seg;
    const LAS bf16_t* wrd = Wl + c * WS + 8 * q;
    const int skey = tid >> 3, spart = tid & 7;
    const bf16_t* ksrc0 = proj + (seq0 + skey) * DIN + 1536 + spart * 32;
    LAS bf16_t* kdst = KL + skey * KS + spart * 32;
    LAS bf16_t* vdst = VT + (spart * 32) * VS + skey;
    if (tid < 2) FLG[tid] = 0u;
    int it = 0;
#pragma unroll 1
    for (int kt = qb64; kt >= 0; --kt, ++it) {
        __syncthreads();
        if (it > 0 && FLG[(it - 1) & 1] == 0u) break;
        {
            const bf16_t* ksrc = ksrc0 + (size_t)kt * 64 * DIN;
            const bf16_t* vsrc = ksrc + 256;
#pragma unroll
            for (int i = 0; i < 4; ++i) { const u32x4 kk = *(const u32x4*)(ksrc + 8 * i), vv = *(const u32x4*)(vsrc + 8 * i);
                *(LAS u32x4*)(kdst + 8 * i) = kk;
                vdst[(8 * i + 0) * VS] = (bf16_t)(vv.x & 0xffffu); vdst[(8 * i + 1) * VS] = (bf16_t)(vv.x >> 16); vdst[(8 * i + 2) * VS] = (bf16_t)(vv.y & 0xffffu); vdst[(8 * i + 3) * VS] = (bf16_t)(vv.y >> 16);
                vdst[(8 * i + 4) * VS] = (bf16_t)(vv.z & 0xffffu); vdst[(8 * i + 5) * VS] = (bf16_t)(vv.z >> 16); vdst[(8 * i + 6) * VS] = (bf16_t)(vv.w & 0xffffu); vdst[(8 * i + 7) * VS] = (bf16_t)(vv.w >> 16); }
        }
        __syncthreads();
        if (tid == 0) FLG[(it + 1) & 1] = 0u;
        const bool diag = (kt == qb64);
#pragma unroll
        for (int hh = 0; hh < 2; ++hh) {
#pragma unroll
            for (int kti = 0; kti < 4; ++kti) { f32x4 s = {0.f, 0.f, 0.f, 0.f};
#pragma unroll
                for (int ks = 0; ks < 2; ++ks) { const bf16x8 a = *(const LAS bf16x8*)(kbase + 16 * kti * KS + hh * 64 + 32 * ks); s = MFMA16(a, qf[hh][ks], s); }
                *(LAS f32x4*)(swr + 16 * kti) = s; }
            LDSWAIT();
            {
                float z[16], cs[16];
#pragma unroll
                for (int i4 = 0; i4 < 4; ++i4) { const f32x4 sv = *(const LAS f32x4*)(srd + 4 * i4); z[4 * i4 + 0] = sv[0]; z[4 * i4 + 1] = sv[1]; z[4 * i4 + 2] = sv[2]; z[4 * i4 + 3] = sv[3]; }
                float run = 0.f;
#pragma unroll
                for (int i = 15; i >= 0; --i) { const bool valid = !diag || (16 * seg + i < qloc);
                    const float zz = z[i]; const float e = fexp(-fabsf(zz)); const float sp = fmaxf(zz, 0.f) + __logf(1.0f + e);
                    run += valid ? sp : 0.f; cs[i] = run; }
                const int lb = lane & ~3;
                const float t0 = __shfl(run, lb + 0), t1 = __shfl(run, lb + 1), t2 = __shfl(run, lb + 2), t3 = __shfl(run, lb + 3);
                const float off = carry[hh] + (seg < 1 ? t1 : 0.f) + (seg < 2 ? t2 : 0.f) + (seg < 3 ? t3 : 0.f);
                carry[hh] += (t0 + t1) + (t2 + t3);
                float wvv[16];
#pragma unroll
                for (int i = 0; i < 16; ++i) { const bool valid = !diag || (16 * seg + i < qloc); wvv[i] = valid ? fexp(z[i] - (off + cs[i])) : 0.f; }
                u32x4 o0, o1; o0.x = pk2(wvv[0], wvv[1]); o0.y = pk2(wvv[2], wvv[3]); o0.z = pk2(wvv[4], wvv[5]); o0.w = pk2(wvv[6], wvv[7]); o1.x = pk2(wvv[8], wvv[9]); o1.y = pk2(wvv[10], wvv[11]); o1.z = pk2(wvv[12], wvv[13]); o1.w = pk2(wvv[14], wvv[15]);
                *(LAS u32x4*)(wwr) = o0; *(LAS u32x4*)(wwr + 8) = o1;
            }
            LDSWAIT();
#pragma unroll
            for (int ks = 0; ks < 2; ++ks) { const bf16x8 bfrag = *(const LAS bf16x8*)(wrd + 32 * ks);
#pragma unroll
                for (int n = 0; n < 4; ++n) { const bf16x8 a = *(const LAS bf16x8*)(vbase + (hh * 64 + 16 * n) * VS + 32 * ks); acc[hh][n] = MFMA16(a, bfrag, acc[hh][n]); } }
            LDSWAIT();
        }
        if (__builtin_amdgcn_ballot_w64(fminf(carry[0], carry[1]) < 32.0f) != 0ull) { if (lane == 0) FLG[it & 1] = 1u; }
    }
    float ssq = 0.f;
#pragma unroll
    for (int hh = 0; hh < 2; ++hh)
#pragma unroll
        for (int n = 0; n < 4; ++n) ssq += ssq4(acc[hh][n]);
    ssq += __shfl_xor(ssq, 16); ssq += __shfl_xor(ssq, 32);
    __syncthreads();
    if (q == 0) RED[(16 * rg + c) * 2 + hp] = ssq;
    __syncthreads();
    const float tot = RED[(16 * rg + c) * 2 + 0] + RED[(16 * rg + c) * 2 + 1];
    const float rs = rsqrtf(tot * (1.0f / 256.0f) + EPS);
    bf16_t* yrow = ycat + trow * DM + 768 + hp * 128 + 4 * q;
#pragma unroll
    for (int hh = 0; hh < 2; ++hh)
#pragma unroll
        for (int n = 0; n < 4; ++n) st4(yrow + hh * 64 + 16 * n, acc[hh][n] * rs);
}

#define XB_TMO      128
#define XB_XCNT(j)  (256  + 64 * (j))
#define XB_XSUB(j)  (1280 + 64 * (j))
#define XB_XGEN(j)  (2304 + 64 * (j))
#define XB_TOP      3328
#define XB_TOPGEN   3392
#define XCD_BAR_WORDS 3456
#define XB_SPIN_CAP (1u << 18)

__device__ __forceinline__ unsigned xb_ld(unsigned* p)              { return __hip_atomic_load(p, __ATOMIC_RELAXED, __HIP_MEMORY_SCOPE_AGENT); }
__device__ __forceinline__ unsigned xb_add(unsigned* p, unsigned v) { return __hip_atomic_fetch_add(p, v, __ATOMIC_RELAXED, __HIP_MEMORY_SCOPE_AGENT); }
__device__ __forceinline__ unsigned xb_xcc_id() { return (unsigned)__builtin_amdgcn_s_getreg((3 << 11) | 20) & 0xFu; }
#define XB_SPIN(cond, bar) do { unsigned _sp = 0; while (cond) { __builtin_amdgcn_s_sleep(1); \
    if ((++_sp & 255u) == 0u) { if (xb_ld(&(bar)[XB_TMO])) break; if (_sp > XB_SPIN_CAP) { atomicAdd(&(bar)[XB_TMO], 1u); break; } } } } while (0)

struct XcdBarrier {
    unsigned* bar; unsigned x;
    volatile LAS unsigned* st;
};

__device__ __forceinline__ XcdBarrier xcd_barrier_post(unsigned* bar, volatile LAS unsigned* st) {
    XcdBarrier b; b.bar = bar; b.x = xb_xcc_id(); b.st = st;
    if (threadIdx.x == 0) (void)xb_add(&bar[XB_XCNT(b.x)], 1u);
    return b;
}
__device__ __forceinline__ void xcd_barrier_complete(unsigned* bar, unsigned x, unsigned& nloc, unsigned& nx) {
    const unsigned G = gridDim.x * gridDim.y * gridDim.z;
    unsigned sum, cnt, mine, sp = 0u;
    for (;;) {
        sum = 0u; cnt = 0u; mine = 0u;
#pragma unroll
        for (unsigned j = 0; j < 16; ++j) { const unsigned c = xb_ld(&bar[XB_XCNT(j)]); sum += c; cnt += (c > 0u) ? 1u : 0u; mine = (j == x) ? c : mine; }
        if (sum == G) break;
        __builtin_amdgcn_s_sleep(1);
        if ((++sp & 255u) == 0u) { if (xb_ld(&bar[XB_TMO])) break; if (sp > XB_SPIN_CAP) { atomicAdd(&bar[XB_TMO], 1u); break; } }
    }
    nloc = mine > 0u ? mine : 1u; nx = cnt > 0u ? cnt : 1u;
}

__device__ __forceinline__ void xcd_barrier(const XcdBarrier& b) {
    asm volatile("s_waitcnt vmcnt(0)" ::: "memory");
    __syncthreads();
    if (threadIdx.x == 0) {
        unsigned* bar = b.bar;
        __builtin_amdgcn_s_waitcnt(0);
        unsigned nloc = b.st[0], nx = b.st[1];
        if (nloc == 0u) { xcd_barrier_complete(bar, b.x, nloc, nx); b.st[0] = nloc; b.st[1] = nx; }
        const unsigned old = xb_add(&bar[XB_XSUB(b.x)], 1u);
        const unsigned gen = old / nloc;
        if (old + 1u == (gen + 1u) * nloc) {
            __builtin_amdgcn_fence(__ATOMIC_RELEASE, "agent");
            asm volatile("s_waitcnt vmcnt(0)" ::: "memory");
            const unsigned og = xb_add(&bar[XB_TOP], 1u);
            const unsigned tg = og / nx;
            if (og + 1u == (tg + 1u) * nx) xb_add(&bar[XB_TOPGEN], 1u);
            else XB_SPIN(xb_ld(&bar[XB_TOPGEN]) == tg, bar);
            __builtin_amdgcn_fence(__ATOMIC_ACQUIRE, "agent");
            xb_add(&bar[XB_XGEN(b.x)], 1u);
            asm volatile("s_waitcnt vmcnt(0)" ::: "memory");
        } else {
            XB_SPIN(xb_ld(&bar[XB_XGEN(b.x)]) == gen, bar);
            __builtin_amdgcn_fence(__ATOMIC_ACQUIRE, "agent");
            asm volatile("s_waitcnt vmcnt(0)" ::: "memory");
        }
    }
    __syncthreads();
}

#ifndef REP_SYNC
#define REP_SYNC 1
#endif
#define GSYNC() do { for (int _r = 0; _r < REP_SYNC; ++_r) xcd_barrier(xbar); } while (0)
__global__ void __launch_bounds__(NTHR, 2) fwd_megakernel(Params p) {
    extern __shared__ __attribute__((aligned(16))) unsigned char lds[];
    cg::grid_group grid = cg::this_grid();
    LAS unsigned char* L = (LAS unsigned char*)lds;
    const int tid = threadIdx.x, lane = tid & 63, wave = __builtin_amdgcn_readfirstlane(tid >> 6);
    const int G = gridDim.x, bx = blockIdx.x;
    unsigned char* ws = p.ws;
    bf16_t* Win_t = (bf16_t*)(ws + WS_WIN); bf16_t* Wout_t = (bf16_t*)(ws + WS_WOUT); bf16_t* Wgu_t = (bf16_t*)(ws + WS_WGU); bf16_t* Wdn_t = (bf16_t*)(ws + WS_WDN);
    bf16_t* SGUW = (bf16_t*)(ws + WS_SGUW); bf16_t* PWT = (bf16_t*)(ws + WS_PWT); float* SSQ = (float*)(ws + WS_SS);
    bf16_t* XB = (bf16_t*)(ws + WS_XB); bf16_t* PROJ = (bf16_t*)(ws + WS_PROJ); bf16_t* YCAT = (bf16_t*)(ws + WS_YCAT); bf16_t* HID = (bf16_t*)(ws + WS_HID);

    volatile LAS unsigned* xst = (volatile LAS unsigned*)(L + LDS_BYTES - 16);
    if (tid < 4) xst[tid] = 0u;
    unsigned* barw = (unsigned*)(ws + WS_BAR);
    if (bx == 0) for (int i = tid; i < XCD_BAR_WORDS; i += NTHR) __hip_atomic_store(barw + i, 0u, __ATOMIC_RELAXED, __HIP_MEMORY_SCOPE_AGENT);
    {
        LAS float* scr = (LAS float*)(L + wave * 16384);
        const int gw = bx * 8 + wave, NGW = G * 8;
        constexpr int I_IN = (DM / 64) * (DIN / 32), I_OUT = (DM / 64) * (DM / 32), I_GU = (DM / 64) * (2 * DFF / 32), I_DN = (DFF / 64) * (DM / 32), I_L = I_IN + I_OUT + I_GU + I_DN;
        for (int it = gw; it < DEPTH * I_L; it += NGW) {
            const int l = it / I_L; int r = it % I_L;
            if (r < I_IN) { transpose_item(p.w_in + (size_t)l * DM * DIN, DM, DIN, Win_t + (size_t)l * DIN * DM, p.norm_mix + l * DM, 1, scr, r, lane); continue; } r -= I_IN;
            if (r < I_OUT) { transpose_item(p.w_out + (size_t)l * DM * DM, DM, DM, Wout_t + (size_t)l * DM * DM, p.mix_out_gain + l * DM, 0, scr, r, lane); continue; } r -= I_OUT;
            if (r < I_GU) { transpose_item(p.w_gate_up + (size_t)l * DM * 2 * DFF, DM, 2 * DFF, Wgu_t + (size_t)l * 2 * DFF * DM, p.norm_ffn + l * DM, 2, scr, r, lane); continue; } r -= I_GU;
            transpose_item(p.w_down + (size_t)l * DFF * DM, DFF, DM, Wdn_t + (size_t)l * DM * DFF, nullptr, 0, scr, r, lane);
        }
        for (int m = gw; m < M; m += NGW) {
            const f32x4* xr = (const f32x4*)(p.x + (size_t)m * DM) + lane; u32x2* o8 = (u32x2*)(XB + (size_t)m * DM) + lane; float s = 0.f;
#pragma unroll
            for (int j = 0; j < 4; ++j) { const f32x4 v = xr[64 * j]; s += (v.x * v.x + v.y * v.y) + (v.z * v.z + v.w * v.w); u32x2 o; o.x = pk2(v.x, v.y); o.y = pk2(v.z, v.w); o8[64 * j] = o; }
            s = wave_sum(s);
            if (lane < 16) SSQ[(size_t)m * 16 + lane] = (lane == 0) ? s : 0.f;
        }
        const int gt = bx * NTHR + tid, NGT = G * NTHR;
        for (int e = gt; e < DEPTH * 4 * 128 * 128 / 8; e += NGT) { const int s0 = (e & 15) * 8, t = (e >> 4) & 127; const float* src = p.sgu_w + (size_t)e * 8;
            const f32x4 a = *(const f32x4*)src, bq = *(const f32x4*)(src + 4); float v[8] = {a.x, a.y, a.z, a.w, bq.x, bq.y, bq.z, bq.w};
#pragma unroll
            for (int i = 0; i < 8; ++i) v[i] = (s0 + i <= t) ? v[i] : 0.f;
            u32x4 o; o.x = pk2(v[0], v[1]); o.y = pk2(v[2], v[3]); o.z = pk2(v[4], v[5]); o.w = pk2(v[6], v[7]); *(u32x4*)(SGUW + (size_t)e * 8) = o; }
        for (int e = gt; e < DEPTH * 4 * 64 * 64; e += NGT) { const int cc = e & 63, d = (e >> 6) & 63, lg = e >> 12; PWT[e] = f2bf(p.pool_w[((size_t)lg * 64 + cc) * 64 + d]); }
    }
    grid.sync();
    const XcdBarrier xbar = xcd_barrier_post(barw, xst);

    for (int l = 0; l < DEPTH; ++l) {
#ifndef REP_P1
#define REP_P1 1
#endif
#ifndef NO_P1
        for (int rep = 0; rep < REP_P1; ++rep) { int zk; asm volatile("s_mov_b32 %0, 0" : "=s"(zk)); pg8::Gemm g{XB, Win_t + (size_t)l * DIN * DM, M, DIN, DM + zk}; pg8::StaticOrder S; S.init(M, DIN, G + zk, bx); pg8::EpiIn E{PROJ, SSQ};
          pg8::gemm_phase<pg8::EpiIn, pg8::StaticOrder, true, true>(L, g, S, E, zk); }
#endif
        GSYNC();
#ifndef REP_MIX
#define REP_MIX 1
#endif
#ifndef REP_D
#define REP_D 1
#endif
        for (int rep = 0; rep < REP_MIX; ++rep)
        for (int u = bx; u < 256; u += G) { const int b = u >> 4, ch = u & 15;
            __syncthreads();
#ifndef NO_A
            { int zt; asm volatile("v_mov_b32 %0, 0" : "=v"(zt)); const int t2 = tid + zt; mixer_A(L, PROJ, SGUW + (size_t)l * 4 * 128 * 128, p.sgu_b + l * 4 * 128, YCAT, b, ch, t2, t2 & 63, __builtin_amdgcn_readfirstlane(t2 >> 6)); }
#endif
            __syncthreads();
#ifndef NO_B
            { int zt; asm volatile("v_mov_b32 %0, 0" : "=v"(zt)); const int t2 = tid + zt; mixer_B(L, PROJ, PWT + (size_t)l * 4 * 64 * 64, p.pool_scale + l * 256, YCAT, b, ch, t2, t2 & 63, __builtin_amdgcn_readfirstlane(t2 >> 6)); }
#endif
            __syncthreads();
#ifndef NO_C
            { int zt; asm volatile("v_mov_b32 %0, 0" : "=v"(zt)); const int t2 = tid + zt; mixer_C(L, PROJ, p.swa_sinks + l * 4, p.rel_bias, YCAT, b, ch, t2, t2 & 63, __builtin_amdgcn_readfirstlane(t2 >> 6)); }
#endif
            __syncthreads();
#ifndef NO_D
#pragma unroll 1
            for (int hf = 0; hf < 2 * REP_D; ++hf) { int zt; asm volatile("v_mov_b32 %0, 0" : "=v"(zt)); const int t2 = tid + zt; mixer_D(L, PROJ, YCAT, b, (hf & 1) ? 31 - ch : ch, t2, t2 & 63, __builtin_amdgcn_readfirstlane(t2 >> 6)); __syncthreads(); }
#endif
        }
        GSYNC();
#ifndef NO_P3
        { int zk; asm volatile("s_mov_b32 %0, 0" : "=s"(zk)); pg8::Gemm g{YCAT, Wout_t + (size_t)l * DM * DM, M, DM, DM + zk}; pg8::StaticOrder S; S.init(M, DM, G + zk, bx); pg8::EpiRes E{l == 0 ? p.x : nullptr, nullptr, XB, SSQ};
          pg8::gemm_phase<pg8::EpiRes, pg8::StaticOrder, true, true>(L, g, S, E, zk); }
#endif
        GSYNC();
#ifndef REP_P4
#define REP_P4 1
#endif
#ifndef NO_P4
        for (int rep = 0; rep < REP_P4; ++rep) { int zk; asm volatile("s_mov_b32 %0, 0" : "=s"(zk)); pg8::Gemm g{XB, Wgu_t + (size_t)l * 2 * DFF * DM, M, 2 * DFF, DM + zk}; pg8::StaticOrder S; S.init(M, 2 * DFF, G + zk, bx); pg8::EpiGU E{HID, SSQ};
          pg8::gemm_phase<pg8::EpiGU, pg8::StaticOrder, true, true>(L, g, S, E, zk); }
#endif
        GSYNC();
#ifndef NO_P5
        { int zk; asm volatile("s_mov_b32 %0, 0" : "=s"(zk)); pg8::Gemm g{HID, Wdn_t + (size_t)l * DM * DFF, M, DM, DFF + zk}; pg8::StaticOrder S; S.init(M, DM, G + zk, bx); pg8::EpiRes E{nullptr, l == DEPTH - 1 ? p.out : nullptr, XB, SSQ};
          pg8::gemm_phase<pg8::EpiRes, pg8::StaticOrder, true, true>(L, g, S, E, zk); }
#endif
        GSYNC();
    }
    {
        const int gw = bx * 8 + wave, NGW = G * 8;
        for (int m = gw; m < M; m += NGW) { const float rs = rstd_of(SSQ, m); f32x4* xr = (f32x4*)(p.out + (size_t)m * DM) + lane; const f32x4* gr = (const f32x4*)p.norm_final + lane;
#pragma unroll
            for (int j = 0; j < 4; ++j) { const f32x4 v = xr[64 * j], gg = gr[64 * j]; xr[64 * j] = v * rs * gg; } }
    }
}

extern "C" void kernel_launch(void* const* d_in, const int* in_sizes, int n_in, void* d_out, int out_size, void* d_ws, size_t ws_size, hipStream_t stream) {
    static int grid_blocks = 0;
    if (grid_blocks == 0) {
        if (n_in != 15 || in_sizes[0] != M * DM || out_size != M * DM || ws_size < WS_END) { fprintf(stderr, "kernel_launch: unexpected shapes (n_in %d, in0 %d, out %d, ws %zu)\n", n_in, n_in > 0 ? in_sizes[0] : -1, out_size, ws_size); grid_blocks = -1; return; }
        int dev = 0, cus = 0, per_cu = 0;
        hipGetDevice(&dev); hipDeviceGetAttribute(&cus, hipDeviceAttributeMultiprocessorCount, dev);
        if (hipFuncSetAttribute((const void*)fwd_megakernel, hipFuncAttributeMaxDynamicSharedMemorySize, LDS_BYTES) != hipSuccess) { fprintf(stderr, "kernel_launch: hipFuncSetAttribute failed\n"); }
        if (hipOccupancyMaxActiveBlocksPerMultiprocessor(&per_cu, (const void*)fwd_megakernel, NTHR, LDS_BYTES) != hipSuccess || per_cu < 1) { fprintf(stderr, "kernel_launch: occupancy query says %d\n", per_cu); per_cu = 1; }
        (void)hipGetLastError();
        grid_blocks = cus * 1;
        if (grid_blocks <= 0) grid_blocks = 256;
    }
    if (grid_blocks < 0) return;
    Params p{};
    p.x = (const float*)d_in[0]; p.w_in = (const float*)d_in[1]; p.w_out = (const float*)d_in[2]; p.sgu_w = (const float*)d_in[3]; p.sgu_b = (const float*)d_in[4];
    p.pool_w = (const float*)d_in[5]; p.pool_scale = (const float*)d_in[6]; p.swa_sinks = (const float*)d_in[7]; p.rel_bias = (const float*)d_in[8]; p.mix_out_gain = (const float*)d_in[9];
    p.norm_mix = (const float*)d_in[10]; p.norm_ffn = (const float*)d_in[11]; p.w_gate_up = (const float*)d_in[12]; p.w_down = (const float*)d_in[13]; p.norm_final = (const float*)d_in[14];
    p.out = (float*)d_out; p.ws = (unsigned char*)d_ws;
    void* args[] = {&p};
    hipError_t e = hipLaunchCooperativeKernel((const void*)fwd_megakernel, dim3(grid_blocks), dim3(NTHR), args, LDS_BYTES, stream);
    if (e != hipSuccess) fprintf(stderr, "cooperative launch failed: %s (grid %d)\n", hipGetErrorString(e), grid_blocks);
}
```

```cpp
#include <hip/hip_runtime.h>
#include <hip/hip_cooperative_groups.h>
#include <cstdio>
#include <cstdint>
namespace cg = cooperative_groups;
namespace pg8 {
#define PG8_LAS __attribute__((address_space(3)))
typedef unsigned short bf16_t;
typedef short bf16x8 __attribute__((ext_vector_type(8)));
typedef float f32x4 __attribute__((ext_vector_type(4)));
typedef unsigned u32x4 __attribute__((ext_vector_type(4)));
constexpr int BM = 256, BK = 64, HALF = 128, HTB = HALF * BK * 2  , STAGE_BYTES = 8 * HTB, NXCD = 8, WGM = 8;

__host__ __device__ __forceinline__ int lds_byte(int r, int c) { const int st = (r >> 4) * 2 + (c >> 5), rr = r & 15, cc = c & 31, ob = rr * 64 + cc * 2; return st * 1024 + (ob ^ (((ob >> 9) & 1) << 5)); }
__host__ __device__ __forceinline__ void stage_rc(int b, int& R, int& C) { const int st = b / 1024, sb = b % 1024, swz = sb ^ (((sb >> 9) & 1) << 5); R = (st >> 1) * 16 + swz / 64; C = (st & 1) * 32 + (swz % 64) / 2; }
__host__ __device__ __forceinline__ int perm32(int rho) { const int n = rho >> 4, i = rho & 15; return 8 * (i >> 2) + 4 * n + (i & 3); }

struct Unit { int pm, pn; };
struct Gemm { const bf16_t* A; const bf16_t* Bt; int M, N, K; };

struct StaticOrder {
    int nM, nN, nwg, G, c;
    __host__ __device__ void init(int M, int N, int G_, int c_) { nM = M / BM; nN = N / BM; nwg = nM * nN; G = G_; c = c_; }
    __host__ __device__ bool next(int i, Unit& u) const {
        const long L = (long)i * G + c; if (L >= nwg) return false;
        int wgid = (int)L; { const int q = nwg / NXCD, r = nwg % NXCD, xcd = wgid % NXCD, off = wgid / NXCD; wgid = (xcd < r ? xcd * (q + 1) : r * (q + 1) + (xcd - r) * q) + off; }
        const int nig = WGM * nN, gid = wgid / nig, fm = gid * WGM, gsz = (nM - fm) < WGM ? (nM - fm) : WGM;
        u.pm = fm + ((wgid % nig) % gsz); u.pn = (wgid % nig) / gsz; return true;
    }
    __device__ __forceinline__ void a_ready(const Unit&) const {}
    __device__ __forceinline__ void done(const Unit&) const {}
};

__device__ __forceinline__ unsigned cvt_pk_bf16(float lo, float hi) { unsigned r; asm volatile("v_cvt_pk_bf16_f32 %0, %1, %2" : "=v"(r) : "v"(lo), "v"(hi)); return r; }
typedef float f32x2 __attribute__((ext_vector_type(2)));
template <class Epi, class Sched, bool ALIGN_EPI = false, bool SP2 = false>
__device__ __forceinline__ void gemm_phase(PG8_LAS unsigned char* lds, const Gemm g, const Sched& S, const Epi& E, const int opq) {
    const int tid = threadIdx.x + opq, wid = __builtin_amdgcn_readfirstlane(tid >> 6), lane = tid & 63, wr = wid >> 2, wc = wid & 3, fr = lane & 15, fq = lane >> 4;
    const int K = g.K, nt = K / BK;
    unsigned voffA[2], voffB[2];
#pragma unroll
    for (int i = 0; i < 2; ++i) { int R, C; stage_rc(tid * 16 + i * 8192, R, C); const int Rb = Epi::PERM ? ((R & ~31) + perm32(R & 31)) : R;
        voffA[i] = (unsigned)(R * K + C) * 2u; voffB[i] = (unsigned)(Rb * K + C) * 2u; }
    const size_t kstep = (size_t)(BK * 2);
    const size_t hstep = (size_t)HALF * K * 2;
    const size_t tstep = 2 * hstep;
    const unsigned ldsw = (unsigned)wid * 1024u;
    const int aoff = lds_byte(wr * 64 + fr, fq * 8), boff = lds_byte(wc * 32 + fr, fq * 8);
#define PG8_SA(b, h) (((b) * 2 + (h)) * HTB)
#define PG8_SB(b, h) ((4 + (b) * 2 + (h)) * HTB)
#define PG8_STAGE(bufoff, gbase, voff) do { _Pragma("unroll") for (int _i = 0; _i < 2; ++_i) \
        __builtin_amdgcn_global_load_lds((const unsigned*)((const char*)(gbase) + (voff)[_i]), (PG8_LAS unsigned*)(lds + (bufoff) + ldsw + _i * 8192), 16, 0, 0); } while (0)
#define PG8_LDA(dst, b, h) do { _Pragma("unroll") for (int m = 0; m < 4; ++m) _Pragma("unroll") for (int k = 0; k < 2; ++k) dst[m][k] = *(const PG8_LAS bf16x8*)(lds + PG8_SA(b, h) + aoff + m * 2048 + k * 1024); } while (0)
#define PG8_LDB(dst, b, h) do { _Pragma("unroll") for (int n = 0; n < 2; ++n) _Pragma("unroll") for (int k = 0; k < 2; ++k) dst[n][k] = *(const PG8_LAS bf16x8*)(lds + PG8_SB(b, h) + boff + n * 2048 + k * 1024); } while (0)
#define PG8_MMA(ai, bj, At, Bt) do { __builtin_amdgcn_s_setprio(1); _Pragma("unroll") for (int m = 0; m < 4; ++m) _Pragma("unroll") for (int n = 0; n < 2; ++n) _Pragma("unroll") for (int k = 0; k < 2; ++k) \
        acc[ai][bj][m][n] = __builtin_amdgcn_mfma_f32_16x16x32_bf16(Bt[n][k], At[m][k], acc[ai][bj][m][n], 0, 0, 0); __builtin_amdgcn_s_setprio(0); } while (0)
#define PG8_WAIT_V(n) asm volatile("s_waitcnt vmcnt(" #n ")" ::: "memory")
#define PG8_WAIT_L(n) asm volatile("s_waitcnt lgkmcnt(" #n ")" ::: "memory")
#define PG8_BAR __builtin_amdgcn_s_barrier()
#define PG8_SCHED __builtin_amdgcn_sched_barrier(0)
    Unit cur, nxt; int ui = 0;
    if (!S.next(0, cur)) return;
    f32x4 acc[2][2][4][2];
#pragma unroll
    for (int a = 0; a < 2; ++a)
#pragma unroll
        for (int b = 0; b < 2; ++b)
#pragma unroll
            for (int m = 0; m < 4; ++m)
#pragma unroll
                for (int n = 0; n < 2; ++n) acc[a][b][m][n] = (f32x4){0.f, 0.f, 0.f, 0.f};
    bf16x8 At[4][2], B0[2][2], B1[2][2];
    const char* cA = (const char*)g.A + (size_t)cur.pm * tstep; const char* cB = (const char*)g.Bt + (size_t)cur.pn * tstep;
    S.a_ready(cur);
    if constexpr (SP2) {
        PG8_STAGE(PG8_SB(0, 0), cB, voffB); PG8_STAGE(PG8_SB(0, 1), cB + hstep, voffB); PG8_STAGE(PG8_SA(0, 0), cA, voffA); PG8_STAGE(PG8_SA(0, 1), cA + hstep, voffA);
        if (wr == 1) PG8_BAR;
        PG8_WAIT_V(2); PG8_BAR;
        PG8_STAGE(PG8_SB(1, 0), cB + kstep, voffB); PG8_STAGE(PG8_SA(1, 0), cA + kstep, voffA); PG8_STAGE(PG8_SB(1, 1), cB + hstep + kstep, voffB);
        PG8_WAIT_V(6); PG8_BAR;
    } else {
        PG8_STAGE(PG8_SB(0, 0), cB, voffB); PG8_STAGE(PG8_SA(0, 0), cA, voffA); PG8_STAGE(PG8_SB(0, 1), cB + hstep, voffB); PG8_STAGE(PG8_SA(0, 1), cA + hstep, voffA);
        if (wr == 1) PG8_BAR;
        PG8_WAIT_V(4); PG8_BAR;
        PG8_STAGE(PG8_SB(1, 0), cB + kstep, voffB); PG8_STAGE(PG8_SA(1, 0), cA + kstep, voffA); PG8_STAGE(PG8_SB(1, 1), cB + hstep + kstep, voffB);
        PG8_WAIT_V(6); PG8_BAR;
    }
    for (;;) {
        const bool has_next = S.next(ui + 1, nxt);
        const char* nA = has_next ? (const char*)g.A + (size_t)nxt.pm * tstep : cA; const char* nB = has_next ? (const char*)g.Bt + (size_t)nxt.pn * tstep : cB;
        for (int t = 0; t < nt; t += 2) {
            const bool last = (t == nt - 2);
            const char* a1 = cA + (size_t)(t + 1) * kstep;
            const char* a2 = last ? nA : cA + (size_t)(t + 2) * kstep; const char* b2 = last ? nB : cB + (size_t)(t + 2) * kstep;
            const char* a3 = a2 + kstep; const char* b3 = b2 + kstep;
            if (last && has_next) S.a_ready(nxt);
            if constexpr (SP2) {
            PG8_LDB(B0, 0, 0); PG8_LDB(B1, 0, 1); PG8_SCHED; PG8_LDA(At, 0, 0); PG8_STAGE(PG8_SA(1, 1), a1 + hstep, voffA);
            PG8_WAIT_V(8); PG8_WAIT_L(0); PG8_BAR; PG8_MMA(0, 0, At, B0); PG8_MMA(0, 1, At, B1); PG8_BAR; PG8_SCHED;
            PG8_LDA(At, 0, 1); PG8_STAGE(PG8_SB(0, 0), b2, voffB); PG8_STAGE(PG8_SB(0, 1), b2 + hstep, voffB); PG8_STAGE(PG8_SA(0, 0), a2, voffA);
            PG8_WAIT_V(8); PG8_WAIT_L(0); PG8_BAR; PG8_MMA(1, 0, At, B0); PG8_MMA(1, 1, At, B1); PG8_BAR; PG8_SCHED;
            PG8_LDB(B0, 1, 0); PG8_LDB(B1, 1, 1); PG8_SCHED; PG8_LDA(At, 1, 0); PG8_STAGE(PG8_SA(0, 1), a2 + hstep, voffA);
            PG8_WAIT_V(8); PG8_WAIT_L(0); PG8_BAR; PG8_MMA(0, 0, At, B0); PG8_MMA(0, 1, At, B1); PG8_BAR; PG8_SCHED;
            PG8_LDA(At, 1, 1); PG8_STAGE(PG8_SB(1, 0), b3, voffB); PG8_STAGE(PG8_SB(1, 1), b3 + hstep, voffB); PG8_STAGE(PG8_SA(1, 0), a3, voffA);
            PG8_WAIT_V(8); PG8_WAIT_L(0); PG8_BAR; PG8_MMA(1, 0, At, B0); PG8_MMA(1, 1, At, B1); PG8_BAR; PG8_SCHED;
            } else {
            PG8_LDB(B0, 0, 0); PG8_SCHED; PG8_LDA(At, 0, 0); PG8_STAGE(PG8_SA(1, 1), a1 + hstep, voffA);
            PG8_WAIT_L(8); PG8_BAR; PG8_WAIT_L(0); PG8_MMA(0, 0, At, B0); PG8_BAR; PG8_SCHED;
            PG8_LDB(B1, 0, 1); PG8_STAGE(PG8_SB(0, 0), b2, voffB);
            PG8_BAR; PG8_WAIT_L(0); PG8_MMA(0, 1, At, B1); PG8_BAR;
            PG8_LDA(At, 0, 1); PG8_STAGE(PG8_SA(0, 0), a2, voffA);
            PG8_BAR; PG8_WAIT_L(0); PG8_MMA(1, 0, At, B0); PG8_BAR; PG8_SCHED;
            PG8_STAGE(PG8_SB(0, 1), b2 + hstep, voffB);
            PG8_WAIT_V(6); PG8_BAR; PG8_MMA(1, 1, At, B1); PG8_BAR;
            PG8_LDB(B0, 1, 0); PG8_SCHED; PG8_LDA(At, 1, 0); PG8_STAGE(PG8_SA(0, 1), a2 + hstep, voffA);
            PG8_WAIT_L(8); PG8_BAR; PG8_WAIT_L(0); PG8_MMA(0, 0, At, B0); PG8_BAR; PG8_SCHED;
            PG8_LDB(B1, 1, 1); PG8_STAGE(PG8_SB(1, 0), b3, voffB);
            PG8_BAR; PG8_WAIT_L(0); PG8_MMA(0, 1, At, B1); PG8_BAR;
            PG8_LDA(At, 1, 1); PG8_STAGE(PG8_SA(1, 0), a3, voffA);
            PG8_BAR; PG8_WAIT_L(0); PG8_MMA(1, 0, At, B0); PG8_BAR; PG8_SCHED;
            PG8_STAGE(PG8_SB(1, 1), b3 + hstep, voffB);
            PG8_WAIT_V(6); PG8_BAR; PG8_MMA(1, 1, At, B1); PG8_BAR;
            }
        }
        if constexpr (ALIGN_EPI) { if (wr == 0) PG8_BAR; }
        if constexpr (!Epi::AFTER_DRAIN) { E(acc, cur, wr, wc, fr, fq); S.done(cur); }
        if (!has_next) break;
#pragma unroll
        for (int a = 0; a < 2; ++a)
#pragma unroll
            for (int b = 0; b < 2; ++b)
#pragma unroll
                for (int m = 0; m < 4; ++m)
#pragma unroll
                    for (int n = 0; n < 2; ++n) acc[a][b][m][n] = (f32x4){0.f, 0.f, 0.f, 0.f};
        cur = nxt; cA = nA; cB = nB; ++ui;
        if constexpr (ALIGN_EPI) { if (wr == 1) PG8_BAR; }
    }
    PG8_WAIT_V(0);
    if constexpr (!ALIGN_EPI) { if (wr == 0) PG8_BAR; }
    PG8_BAR;
    if constexpr (Epi::AFTER_DRAIN) { E.fused(acc, cur, wr, wc, fr, fq, lds, wid, lane); S.done(cur); }
#undef PG8_SA
#undef PG8_SB
#undef PG8_STAGE
#undef PG8_LDA
#undef PG8_LDB
#undef PG8_MMA
#undef PG8_WAIT_V
#undef PG8_WAIT_L
#undef PG8_BAR
#undef PG8_SCHED
}
}

constexpr int NB = 16, SEQ = 2048, DM = 1024, DEPTH = 4, DIN = 2048, DFF = 2816, M = NB * SEQ;
constexpr float EPS = 1e-6f;
constexpr size_t MiB = 1u << 20;
constexpr size_t WS_WIN = 0, WS_WOUT = 16 * MiB, WS_WGU = 24 * MiB, WS_WDN = 68 * MiB, WS_SGUW = 90 * MiB, WS_PWT = 90 * MiB + 512 * 1024,
                 WS_SS = 91 * MiB, WS_BAR = 93 * MiB, WS_XB = 96 * MiB, WS_PROJ = 160 * MiB, WS_YCAT = 288 * MiB, WS_HID = 160 * MiB, WS_END = 352 * MiB;
constexpr int LDS_BYTES = 160 * 1024;
constexpr int NTHR = 512;

#define LAS __attribute__((address_space(3)))
typedef unsigned short bf16_t;
typedef short bf16x8 __attribute__((ext_vector_type(8)));
typedef float f32x4 __attribute__((ext_vector_type(4)));
typedef float f32x2 __attribute__((ext_vector_type(2)));
typedef unsigned u32x4 __attribute__((ext_vector_type(4)));
typedef unsigned u32x2 __attribute__((ext_vector_type(2)));
typedef __bf16 bf16x2_t __attribute__((ext_vector_type(2)));

__device__ __forceinline__ unsigned pk2(float lo, float hi) { f32x2 v = {lo, hi}; bf16x2_t b = __builtin_convertvector(v, bf16x2_t); return __builtin_bit_cast(unsigned, b); }
__device__ __forceinline__ bf16_t f2bf(float f) { return (bf16_t)(pk2(f, 0.f) & 0xffffu); }
__device__ __forceinline__ float bflo(unsigned w) { return __uint_as_float(w << 16); }
__device__ __forceinline__ float bfhi(unsigned w) { return __uint_as_float(w & 0xffff0000u); }
#define MFMA16(a, b, c) __builtin_amdgcn_mfma_f32_16x16x32_bf16((a), (b), (c), 0, 0, 0)
#define CFENCE() asm volatile("" ::: "memory")
#define LDSWAIT() asm volatile("s_waitcnt lgkmcnt(0)" ::: "memory")
__device__ __forceinline__ float fexp(float x) { return __builtin_amdgcn_exp2f(x * 1.4426950408889634f); }
__device__ __forceinline__ float gelu_tanh(float x) {
    const float u2 = 1.5957691216057308f * x * (1.0f + 0.044715f * x * x);
    return x * __builtin_amdgcn_rcpf(1.0f + fexp(-u2));
}
__device__ __forceinline__ float rstd_of1(const float* ss, int row) {
    const f32x4 s = *(const f32x4*)(ss + (size_t)row * 4); return rsqrtf(((s.x + s.y) + (s.z + s.w)) * (1.0f / 1024.0f) + EPS);
}

__device__ __forceinline__ float ssq4(const f32x4 y) { return (y[0] * y[0] + y[1] * y[1]) + (y[2] * y[2] + y[3] * y[3]); }

#ifdef PROBE_RSTD2
__device__ __forceinline__ float rstd_of(const float* ss, int row) { const float a = rstd_of1(ss, row); int z; asm volatile("v_mov_b32 %0, 0" : "=v"(z) : "v"(a)); const float b = rstd_of1(ss, row + z); return (a + b) * 0.5f; }
#else
__device__ __forceinline__ float rstd_of(const float* ss, int row) { return rstd_of1(ss, row); }
#endif
namespace pg8 {
struct EpiIn {
    static constexpr bool PERM = true, AFTER_DRAIN = false;
    bf16_t* O; const float* ss;
    __device__ __forceinline__ void operator()(const f32x4 (&acc)[2][2][4][2], const Unit& u, int wr, int wc, int fr, int fq) const {
        const int row0 = u.pm * BM + wr * 64 + fr, col0 = u.pn * BM + wc * 32 + 8 * fq; const bool act = u.pn < 2;
        float rsv[2][4];
#pragma unroll
        for (int ai = 0; ai < 2; ++ai)
#pragma unroll
            for (int m = 0; m < 4; ++m) rsv[ai][m] = rstd_of(ss, row0 + ai * HALF + m * 16);
#pragma unroll
        for (int ai = 0; ai < 2; ++ai)
#pragma unroll
            for (int m = 0; m < 4; ++m) { const int row = row0 + ai * HALF + m * 16; const float rs = rsv[ai][m]; bf16_t* rowp = O + (size_t)row * DIN + col0;
#pragma unroll
                for (int bj = 0; bj < 2; ++bj) { f32x4 v0 = acc[ai][bj][m][0] * rs, v1 = acc[ai][bj][m][1] * rs;
                    if (act) { v0 = (f32x4){gelu_tanh(v0[0]), gelu_tanh(v0[1]), gelu_tanh(v0[2]), gelu_tanh(v0[3])}; v1 = (f32x4){gelu_tanh(v1[0]), gelu_tanh(v1[1]), gelu_tanh(v1[2]), gelu_tanh(v1[3])}; }
                    u32x4 w; w.x = pk2(v0[0], v0[1]); w.y = pk2(v0[2], v0[3]); w.z = pk2(v1[0], v1[1]); w.w = pk2(v1[2], v1[3]);
                    *(u32x4*)(rowp + bj * HALF) = w; }
                if (m & 1) CFENCE(); }
    }
};
struct EpiGU {
    static constexpr bool PERM = true, AFTER_DRAIN = false;
    bf16_t* O; const float* ss;
    __device__ __forceinline__ void operator()(const f32x4 (&acc)[2][2][4][2], const Unit& u, int wr, int wc, int fr, int fq) const {
        const int row0 = u.pm * BM + wr * 64 + fr, col0 = u.pn * HALF + wc * 32 + 8 * fq;
        float rsv[2][4];
#pragma unroll
        for (int ai = 0; ai < 2; ++ai)
#pragma unroll
            for (int m = 0; m < 4; ++m) rsv[ai][m] = rstd_of(ss, row0 + ai * HALF + m * 16);
#pragma unroll
        for (int ai = 0; ai < 2; ++ai)
#pragma unroll
            for (int m = 0; m < 4; ++m) { const int row = row0 + ai * HALF + m * 16; const float rs = rsv[ai][m]; bf16_t* rowp = O + (size_t)row * DFF + col0;
                float h[8];
#pragma unroll
                for (int n = 0; n < 2; ++n)
#pragma unroll
                    for (int e = 0; e < 4; ++e) { const float g = acc[ai][0][m][n][e] * rs, up = acc[ai][1][m][n][e] * rs; h[n * 4 + e] = g * up * __builtin_amdgcn_rcpf(1.0f + fexp(-g)); }
                u32x4 w; w.x = pk2(h[0], h[1]); w.y = pk2(h[2], h[3]); w.z = pk2(h[4], h[5]); w.w = pk2(h[6], h[7]);
                *(u32x4*)rowp = w;
                if (m & 1) CFENCE(); }
    }
};
struct EpiRes {
    static constexpr bool PERM = true, AFTER_DRAIN = false;
    const float* xin32; float* xout32; bf16_t* xb; float* ss; LAS float* P;
    __device__ __forceinline__ void operator()(const f32x4 (&acc)[2][2][4][2], const Unit& u, int wr, int wc, int fr, int fq) const {
        const int row0 = u.pm * BM + wr * 64 + fr, col0 = u.pn * BM + wc * 32 + 8 * fq;
#pragma unroll
        for (int ai = 0; ai < 2; ++ai)
#pragma unroll
            for (int m = 0; m < 4; ++m) { const int row = row0 + ai * HALF + m * 16; const size_t off = (size_t)row * DM + col0; float q = 0.f;
#pragma unroll
                for (int bj = 0; bj < 2; ++bj) { f32x4 r0, r1;
                    if (xin32) { r0 = *(const f32x4*)(xin32 + off + bj * HALF); r1 = *(const f32x4*)(xin32 + off + bj * HALF + 4); }
                    else { const u32x4 t = *(const u32x4*)(xb + off + bj * HALF); r0 = (f32x4){bflo(t.x), bfhi(t.x), bflo(t.y), bfhi(t.y)}; r1 = (f32x4){bflo(t.z), bfhi(t.z), bflo(t.w), bfhi(t.w)}; }
                    const f32x4 v0 = r0 + acc[ai][bj][m][0], v1 = r1 + acc[ai][bj][m][1];
                    q += ssq4(v0) + ssq4(v1);
                    if (xout32) { *(f32x4*)(xout32 + off + bj * HALF) = v0; *(f32x4*)(xout32 + off + bj * HALF + 4) = v1; }
                    else { u32x4 w; w.x = pk2(v0[0], v0[1]); w.y = pk2(v0[2], v0[3]); w.z = pk2(v1[0], v1[1]); w.w = pk2(v1[2], v1[3]); *(u32x4*)(xb + off + bj * HALF) = w; } }
                q += __shfl_xor(q, 16); q += __shfl_xor(q, 32);
                if (fq == 0) P[(ai * HALF + wr * 64 + m * 16 + fr) * 4 + wc] = q;
                if (m & 1) CFENCE(); }
        asm volatile("s_waitcnt lgkmcnt(0)" ::: "memory"); __builtin_amdgcn_s_barrier(); asm volatile("" ::: "memory");
        const int t = wr * 256 + wc * 64 + fq * 16 + fr;
        if (t < 256) { const f32x4 pp = *(const LAS f32x4*)(P + t * 4); ss[(size_t)(u.pm * BM + t) * 4 + u.pn] = (pp.x + pp.y) + (pp.z + pp.w); }
    }
};
}

__device__ __forceinline__ void transpose_item(const float* W, int K, int N, bf16_t* WT, const float* gain, int mode, LAS float* scr, int item, int lane) {
    const int nblk = N / 32, kb = item / nblk, nb = item % nblk, k0 = 64 * kb, n0 = 32 * nb;
#pragma unroll 8
    for (int i = 0; i < 32; ++i) { const int kk = 2 * i + (lane >> 5); const float g = gain ? gain[k0 + kk] : 1.0f; scr[kk * 33 + (lane & 31)] = W[(size_t)(k0 + kk) * N + n0 + (lane & 31)] * g; }
    LDSWAIT();
    const int c = lane & 7;
#pragma unroll
    for (int j = 0; j < 4; ++j) { const int n = (lane >> 3) + 8 * j, gn = n0 + n; const LAS float* s = scr + (8 * c) * 33 + n;
        float cs = 1.0f; int row = gn;
        if (mode == 1) { if ((gn >= 768 && gn < 1024) || (gn >= 1280 && gn < 1536)) cs = 0.125f; }
        if (mode == 2) { const int jj = gn < DFF ? gn : gn - DFF; row = 256 * (jj >> 7) + (jj & 127) + (gn < DFF ? 0 : 128); }
        u32x4 o; o.x = pk2(s[0 * 33] * cs, s[1 * 33] * cs); o.y = pk2(s[2 * 33] * cs, s[3 * 33] * cs); o.z = pk2(s[4 * 33] * cs, s[5 * 33] * cs); o.w = pk2(s[6 * 33] * cs, s[7 * 33] * cs);
        *(u32x4*)(WT + (size_t)row * K + k0 + 8 * c) = o; }
    LDSWAIT();
}
__device__ __forceinline__ float wave_sum(float v) {
#pragma unroll
    for (int o = 1; o < 64; o <<= 1) v += __shfl_xor(v, o);
    return v;
}

struct Params {
    const float *x, *w_in, *w_out, *sgu_w, *sgu_b, *pool_w, *pool_scale, *swa_sinks, *rel_bias, *mix_out_gain, *norm_mix, *norm_ffn, *w_gate_up, *w_down, *norm_final;
    float* out; unsigned char* ws;
};


__device__ __forceinline__ void st4(bf16_t* p, const f32x4 y) { u32x2 o; o.x = pk2(y[0], y[1]); o.y = pk2(y[2], y[3]); *(u32x2*)p = o; }
__device__ __forceinline__ void rescale4(bf16_t* p, float rs) {
    const unsigned long long v = __hip_atomic_load((unsigned long long*)p, __ATOMIC_RELAXED, __HIP_MEMORY_SCOPE_AGENT); const unsigned lo = (unsigned)v, hi = (unsigned)(v >> 32);
    u32x2 o; o.x = pk2(bflo(lo) * rs, bfhi(lo) * rs); o.y = pk2(bflo(hi) * rs, bfhi(hi) * rs); *(u32x2*)p = o;
}
#define VMWAIT() asm volatile("s_waitcnt vmcnt(0)" ::: "memory")

__device__ __forceinline__ void mixer_A(LAS unsigned char* L, const bf16_t* proj, const bf16_t* sguw, const float* sgub, bf16_t* ycat, int b, int ch, int tid, int lane, int w) {
    constexpr int VTS = 136;
    LAS bf16_t* VT = (LAS bf16_t*)L;
    const size_t row0 = (size_t)b * SEQ + ch * 128;
    {
        const int tok = tid >> 2, h = tid & 3;
        const bf16_t* src = proj + (row0 + tok) * DIN + 256 + h * 64;
        float v[64]; float s = 0.f;
#pragma unroll
        for (int i = 0; i < 8; ++i) { const u32x4 t = *(const u32x4*)(src + 8 * i);
            v[8 * i + 0] = bflo(t.x); v[8 * i + 1] = bfhi(t.x); v[8 * i + 2] = bflo(t.y); v[8 * i + 3] = bfhi(t.y); v[8 * i + 4] = bflo(t.z); v[8 * i + 5] = bfhi(t.z); v[8 * i + 6] = bflo(t.w); v[8 * i + 7] = bfhi(t.w); }
#pragma unroll
        for (int i = 0; i < 64; ++i) s += v[i];
        const float mean = s * (1.0f / 64.0f); float s2 = 0.f;
#pragma unroll
        for (int i = 0; i < 64; ++i) { v[i] -= mean; s2 += v[i] * v[i]; }
        const float rstd = rsqrtf(s2 * (1.0f / 64.0f) + EPS);
        LAS bf16_t* dst = VT + (h * 64) * VTS + tok;
#pragma unroll
        for (int i = 0; i < 64; ++i) dst[i * VTS] = f2bf(v[i] * rstd);
    }
    __syncthreads();
    const int c = lane & 15, q = lane >> 4, wv = tid >> 6;
    const int nks = (w >> 1) + 1;
    const size_t trow = row0 + 16 * wv + c; float ssq = 0.f;
    bf16_t* yrow = ycat + trow * DM + 0 + 4 * q;
    const bf16_t* urow = proj + trow * DIN + 4 * q;
    const LAS bf16_t* vbase = VT + c * VTS + 8 * q;
    const bf16_t* wbase = sguw + (size_t)(16 * wv + c) * 128 + 8 * q;
#pragma unroll 1
    for (int h = 0; h < 4; ++h) {
        f32x4 acc[4];
#pragma unroll
        for (int n = 0; n < 4; ++n) acc[n] = (f32x4){0.f, 0.f, 0.f, 0.f};
#pragma unroll
        for (int ks = 0; ks < 4; ++ks) if (ks < nks) {
            const bf16x8 bfrag = *(const bf16x8*)(wbase + h * 128 * 128 + 32 * ks);
#pragma unroll
            for (int n = 0; n < 4; ++n) { const bf16x8 a = *(const LAS bf16x8*)(vbase + (h * 64 + 16 * n) * VTS + 32 * ks); acc[n] = MFMA16(a, bfrag, acc[n]); }
        }
        const float bias = sgub[h * 128 + 16 * wv + c];
#pragma unroll
        for (int n = 0; n < 4; ++n) { const u32x2 uu = *(const u32x2*)(urow + h * 64 + 16 * n);
            f32x4 y; y[0] = bflo(uu.x) * (acc[n][0] + bias); y[1] = bfhi(uu.x) * (acc[n][1] + bias); y[2] = bflo(uu.y) * (acc[n][2] + bias); y[3] = bfhi(uu.y) * (acc[n][3] + bias);
            ssq += ssq4(y); st4(yrow + h * 64 + 16 * n, y); }
    }
    ssq += __shfl_xor(ssq, 16); ssq += __shfl_xor(ssq, 32);
    const float rs = rsqrtf(ssq * (1.0f / 256.0f) + EPS);
    VMWAIT();
#pragma unroll 4
    for (int i = 0; i < 16; ++i) rescale4(yrow + 16 * i, rs);
}

__device__ __forceinline__ void mixer_B(LAS unsigned char* L, const bf16_t* proj, const bf16_t* pwt, const float* pscale, bf16_t* ycat, int b, int ch, int tid, int lane, int w) {
    constexpr int YS = 264;
    LAS bf16_t* Y = (LAS bf16_t*)L;
    const size_t row0 = (size_t)b * SEQ + ch * 128;
    {
        const int tok = tid >> 2, g = tid & 3; const int win = 2 << g; const int tseq = ch * 128 + tok; const int cnt = (tseq + 1 < win) ? (tseq + 1) : win;
        const float inv = 1.0f / (float)cnt;
#pragma unroll 1
        for (int hf = 0; hf < 2; ++hf) {
            const bf16_t* src = proj + (row0 + tok) * DIN + 512 + g * 64 + hf * 32;
            float p0[32], s[32];
#pragma unroll
            for (int i = 0; i < 4; ++i) { const u32x4 t = *(const u32x4*)(src + 8 * i);
                p0[8 * i + 0] = bflo(t.x); p0[8 * i + 1] = bfhi(t.x); p0[8 * i + 2] = bflo(t.y); p0[8 * i + 3] = bfhi(t.y); p0[8 * i + 4] = bflo(t.z); p0[8 * i + 5] = bfhi(t.z); p0[8 * i + 6] = bflo(t.w); p0[8 * i + 7] = bfhi(t.w); }
#pragma unroll
            for (int i = 0; i < 32; ++i) s[i] = p0[i];
#pragma unroll 1
            for (int j = 1; j < cnt; ++j) { const bf16_t* sj = src - (size_t)j * DIN;
#pragma unroll
                for (int i = 0; i < 4; ++i) { const u32x4 t = *(const u32x4*)(sj + 8 * i);
                    s[8 * i + 0] += bflo(t.x); s[8 * i + 1] += bfhi(t.x); s[8 * i + 2] += bflo(t.y); s[8 * i + 3] += bfhi(t.y); s[8 * i + 4] += bflo(t.z); s[8 * i + 5] += bfhi(t.z); s[8 * i + 6] += bflo(t.w); s[8 * i + 7] += bfhi(t.w); } }
#pragma unroll
            for (int i = 0; i < 4; ++i) { u32x4 o; o.x = pk2(s[8 * i + 0] * inv - p0[8 * i + 0], s[8 * i + 1] * inv - p0[8 * i + 1]); o.y = pk2(s[8 * i + 2] * inv - p0[8 * i + 2], s[8 * i + 3] * inv - p0[8 * i + 3]);
                o.z = pk2(s[8 * i + 4] * inv - p0[8 * i + 4], s[8 * i + 5] * inv - p0[8 * i + 5]); o.w = pk2(s[8 * i + 6] * inv - p0[8 * i + 6], s[8 * i + 7] * inv - p0[8 * i + 7]);
                *(LAS u32x4*)(Y + tok * YS + g * 64 + hf * 32 + 8 * i) = o; }
        }
    }
    __syncthreads();
    const int c = lane & 15, q = lane >> 4, wv = tid >> 6;
    const size_t trow = row0 + 16 * wv + c; float ssq = 0.f;
    bf16_t* yrow = ycat + trow * DM + 256 + 4 * q;
    const LAS bf16_t* ybase = Y + (16 * wv + c) * YS + 8 * q;
    const bf16_t* pbase = pwt + (size_t)c * 64 + 8 * q;
#pragma unroll 1
    for (int g = 0; g < 4; ++g) {
        f32x4 acc[4];
#pragma unroll
        for (int n = 0; n < 4; ++n) acc[n] = (f32x4){0.f, 0.f, 0.f, 0.f};
#pragma unroll
        for (int ks = 0; ks < 2; ++ks) { const bf16x8 bfrag = *(const LAS bf16x8*)(ybase + g * 64 + 32 * ks);
#pragma unroll
            for (int n = 0; n < 4; ++n) { const bf16x8 a = *(const bf16x8*)(pbase + (g * 64 + 16 * n) * 64 + 32 * ks); acc[n] = MFMA16(a, bfrag, acc[n]); } }
#pragma unroll
        for (int n = 0; n < 4; ++n) { const f32x4 sc = *(const f32x4*)(pscale + g * 64 + 16 * n + 4 * q); const f32x4 y = acc[n] * sc; ssq += ssq4(y); st4(yrow + g * 64 + 16 * n, y); }
    }
    ssq += __shfl_xor(ssq, 16); ssq += __shfl_xor(ssq, 32);
    const float rs = rsqrtf(ssq * (1.0f / 256.0f) + EPS);
    VMWAIT();
#pragma unroll 4
    for (int i = 0; i < 16; ++i) rescale4(yrow + 16 * i, rs);
}

__device__ __forceinline__ void mixer_C(LAS unsigned char* L, const bf16_t* proj, const float* sinks, const float* rel_bias, bf16_t* ycat, int b, int qb, int tid, int lane, int w) {
    constexpr int KS = 72, VS = 280, SS = 164;
    const int wv = tid >> 6;
    LAS bf16_t* KL = (LAS bf16_t*)L;
    LAS bf16_t* VT = (LAS bf16_t*)(L + 36864);
    LAS float* S = (LAS float*)(L + 72704) + wv * 16 * SS;
    LAS float* BT = (LAS float*)(L + 156672);
    const size_t row0 = (size_t)b * SEQ + qb * 128;
    {
        const int j = tid >> 7, dist = tid & 127; int bucket = dist;
        if (dist >= 16) { const int lg = 16 + (int)(__logf((float)dist * (1.0f / 16.0f)) / 2.0794415416798357f * 16.0f); bucket = lg < 31 ? lg : 31; }
        BT[j * 128 + dist] = rel_bias[bucket * 4 + j];
    }
    const int c = lane & 15, q = lane >> 4;
    const size_t trow = row0 + 16 * wv + c; float ssq = 0.f;
    bf16_t* yrow = ycat + trow * DM + 512 + 4 * q;
    const LAS bf16_t* kbase = KL + (16 * wv + c) * KS + 8 * q;
    const LAS bf16_t* vbase = VT + c * VS + 16 * wv + 8 * q;
    LAS float* swr = S + c * SS + 4 * q;
    const LAS bf16_t* wrd = (const LAS bf16_t*)(S + c * SS) + 8 * q;
    const int row = lane >> 2, seg = lane & 3;
    LAS float* srd = S + row * SS + 40 * seg;
#pragma unroll 1
    for (int kvh = 0; kvh < 2; ++kvh) {
        __syncthreads();
        {
            const int key = tid >> 1, half = tid & 1; const bool okk = (qb > 0) || (key >= 128);
            const bf16_t* ksrc = proj + (row0 - 128 + key) * DIN + 1024 + kvh * 64 + half * 32;
            const bf16_t* vsrc = ksrc + 128;
            LAS bf16_t* vdst = VT + (half * 32) * VS + key;
#pragma unroll
            for (int i = 0; i < 4; ++i) { u32x4 kk = {0u, 0u, 0u, 0u}, vv = {0u, 0u, 0u, 0u};
                if (okk) { kk = *(const u32x4*)(ksrc + 8 * i); vv = *(const u32x4*)(vsrc + 8 * i); }
                *(LAS u32x4*)(KL + key * KS + half * 32 + 8 * i) = kk;
                vdst[(8 * i + 0) * VS] = (bf16_t)(vv.x & 0xffffu); vdst[(8 * i + 1) * VS] = (bf16_t)(vv.x >> 16); vdst[(8 * i + 2) * VS] = (bf16_t)(vv.y & 0xffffu); vdst[(8 * i + 3) * VS] = (bf16_t)(vv.y >> 16);
                vdst[(8 * i + 4) * VS] = (bf16_t)(vv.z & 0xffffu); vdst[(8 * i + 5) * VS] = (bf16_t)(vv.z >> 16); vdst[(8 * i + 6) * VS] = (bf16_t)(vv.w & 0xffffu); vdst[(8 * i + 7) * VS] = (bf16_t)(vv.w >> 16); }
            if (tid < 64) {
#pragma unroll
                for (int i = 0; i < 3; ++i) *(LAS u32x4*)(VT + tid * VS + 256 + 8 * i) = (u32x4){0u, 0u, 0u, 0u}; }
        }
        __syncthreads();
#pragma unroll 1
        for (int g = 0; g < 2; ++g) { const int j = 2 * kvh + g;
            bf16x8 qf[2];
#pragma unroll
            for (int ks = 0; ks < 2; ++ks) qf[ks] = *(const bf16x8*)(proj + trow * DIN + 768 + j * 64 + 32 * ks + 8 * q);
#pragma unroll
            for (int kti = 0; kti < 9; ++kti) { f32x4 s = {0.f, 0.f, 0.f, 0.f};
#pragma unroll
                for (int ks = 0; ks < 2; ++ks) { const bf16x8 a = *(const LAS bf16x8*)(kbase + 16 * kti * KS + 32 * ks); s = MFMA16(a, qf[ks], s); }
                *(LAS f32x4*)(swr + 16 * kti) = s; }
            LDSWAIT();
            { const float sink = sinks[j]; const LAS float* bt = BT + j * 128;
                int zz; asm volatile("v_mov_b32 %0, 0" : "=v"(zz));
                const int rowz = row + zz; const int klo = (qb > 0) ? (rowz + 1) : max(rowz + 1, 128 - 16 * w), khi = rowz + 128;
                float lg[40]; float mx = sink;
#pragma unroll
                for (int i4 = 0; i4 < 10; ++i4) { const f32x4 sv = *(const LAS f32x4*)(srd + 4 * i4);
#pragma unroll
                    for (int e = 0; e < 4; ++e) { const int kl = 40 * seg + 4 * i4 + e; const int dist = 128 + rowz - kl; const bool valid = (unsigned)(kl - klo) <= (unsigned)(khi - klo);
                        const int dcl = dist & 127; const float bb = bt[dcl];
                        const float v = valid ? (sv[e] + bb) : -1e30f; lg[4 * i4 + e] = v; mx = fmaxf(mx, v); } }
                mx = fmaxf(mx, __shfl_xor(mx, 1)); mx = fmaxf(mx, __shfl_xor(mx, 2));
                float sum = 0.f;
#pragma unroll
                for (int i = 0; i < 40; ++i) { const float p = (lg[i] > -1e29f) ? fexp(lg[i] - mx) : 0.f; lg[i] = p; sum += p; }
                sum += __shfl_xor(sum, 1); sum += __shfl_xor(sum, 2);
                const float inv = 1.0f / (sum + fexp(sink - mx));
                LDSWAIT();
                LAS bf16_t* Wr = (LAS bf16_t*)(S + row * SS) + 40 * seg;
#pragma unroll
                for (int i8 = 0; i8 < 5; ++i8) { u32x4 o; o.x = pk2(lg[8 * i8 + 0] * inv, lg[8 * i8 + 1] * inv); o.y = pk2(lg[8 * i8 + 2] * inv, lg[8 * i8 + 3] * inv); o.z = pk2(lg[8 * i8 + 4] * inv, lg[8 * i8 + 5] * inv); o.w = pk2(lg[8 * i8 + 6] * inv, lg[8 * i8 + 7] * inv);
                    *(LAS u32x4*)(Wr + 8 * i8) = o; }
            }
            LDSWAIT();
            f32x4 acc[4];
#pragma unroll
            for (int n = 0; n < 4; ++n) acc[n] = (f32x4){0.f, 0.f, 0.f, 0.f};
#pragma unroll
            for (int ks = 0; ks < 5; ++ks) { const bf16x8 bfrag = *(const LAS bf16x8*)(wrd + 32 * ks);
#pragma unroll
                for (int n = 0; n < 4; ++n) { const bf16x8 a = *(const LAS bf16x8*)(vbase + 16 * n * VS + 32 * ks); acc[n] = MFMA16(a, bfrag, acc[n]); } }
            LDSWAIT();
#pragma unroll
            for (int n = 0; n < 4; ++n) { ssq += ssq4(acc[n]); st4(yrow + j * 64 + 16 * n, acc[n]); }
        }
    }
    ssq += __shfl_xor(ssq, 16); ssq += __shfl_xor(ssq, 32);
    const float rs = rsqrtf(ssq * (1.0f / 256.0f) + EPS);
    VMWAIT();
#pragma unroll 4
    for (int i = 0; i < 16; ++i) rescale4(yrow + 16 * i, rs);
}

__device__ __forceinline__ void mixer_D(LAS unsigned char* L, const bf16_t* proj, bf16_t* ycat, int b, int qb64, int tid, int lane, int w) {
    constexpr int KS = 264, VS = 72, SS = 68, WS = 72;
    const int wv = tid >> 6;
    LAS bf16_t* KL = (LAS bf16_t*)L;
    LAS bf16_t* VT = (LAS bf16_t*)(L + 33792);
    LAS float* S = (LAS float*)(L + 70656) + wv * 16 * SS;
    LAS bf16_t* Wl = (LAS bf16_t*)(L + 105472) + wv * 16 * WS;
    LAS float* RED = (LAS float*)(L + 123904);
    volatile LAS unsigned* FLG = (volatile LAS unsigned*)(L + 124416);
    const int rg = wv & 3, hp = wv >> 2, c = lane & 15, q = lane >> 4;
    const size_t seq0 = (size_t)b * SEQ; const size_t trow = seq0 + qb64 * 64 + 16 * rg + c;
    bf16x8 qf[2][2];
#pragma unroll
    for (int hh = 0; hh < 2; ++hh)
#pragma unroll
        for (int ks = 0; ks < 2; ++ks) qf[hh][ks] = *(const bf16x8*)(proj + trow * DIN + 1280 + (2 * hp + hh) * 64 + 32 * ks + 8 * q);
    f32x4 acc[2][4];
#pragma unroll
    for (int hh = 0; hh < 2; ++hh)
#pragma unroll
        for (int n = 0; n < 4; ++n) acc[hh][n] = (f32x4){0.f, 0.f, 0.f, 0.f};
    float carry[2] = {0.f, 0.f};
    const int srow = lane >> 2, seg = lane & 3, qloc = 16 * rg + srow;
    const LAS bf16_t* kbase = KL + c * KS + hp * 128 + 8 * q;
    const LAS bf16_t* vbase = VT + (hp * 128 + c) * VS + 8 * q;
    LAS float* swr = S + c * SS + 4 * q;
    const LAS float* srd = S + srow * SS + 16 * seg;
    LAS bf16_t* wwr = Wl + srow * WS + 16 * seg;
    const LAS bf16_t* wrd = Wl + c * WS + 8 * q;
    const int skey = tid >> 3, spart = tid & 7;
    const bf16_t* ksrc0 = proj + (seq0 + skey) * DIN + 1536 + spart * 32;
    LAS bf16_t* kdst = KL + skey * KS + spart * 32;
    LAS bf16_t* vdst = VT + (spart * 32) * VS + skey;
    if (tid < 2) FLG[tid] = 0u;
    int it = 0;
#pragma unroll 1
    for (int kt = qb64; kt >= 0; --kt, ++it) {
        __syncthreads();
        if (it > 0 && FLG[(it - 1) & 1] == 0u) break;
        {
            const bf16_t* ksrc = ksrc0 + (size_t)kt * 64 * DIN;
            const bf16_t* vsrc = ksrc + 256;
#pragma unroll
            for (int i = 0; i < 4; ++i) { const u32x4 kk = *(const u32x4*)(ksrc + 8 * i), vv = *(const u32x4*)(vsrc + 8 * i);
                *(LAS u32x4*)(kdst + 8 * i) = kk;
                vdst[(8 * i + 0) * VS] = (bf16_t)(vv.x & 0xffffu); vdst[(8 * i + 1) * VS] = (bf16_t)(vv.x >> 16); vdst[(8 * i + 2) * VS] = (bf16_t)(vv.y & 0xffffu); vdst[(8 * i + 3) * VS] = (bf16_t)(vv.y >> 16);
                vdst[(8 * i + 4) * VS] = (bf16_t)(vv.z & 0xffffu); vdst[(8 * i + 5) * VS] = (bf16_t)(vv.z >> 16); vdst[(8 * i + 6) * VS] = (bf16_t)(vv.w & 0xffffu); vdst[(8 * i + 7) * VS] = (bf16_t)(vv.w >> 16); }
        }
        __syncthreads();
        if (tid == 0) FLG[(it + 1) & 1] = 0u;
        const bool diag = (kt == qb64);
#pragma unroll
        for (int hh = 0; hh < 2; ++hh) {
#pragma unroll
            for (int kti = 0; kti < 4; ++kti) { f32x4 s = {0.f, 0.f, 0.f, 0.f};
#pragma unroll
                for (int ks = 0; ks < 2; ++ks) { const bf16x8 a = *(const LAS bf16x8*)(kbase + 16 * kti * KS + hh * 64 + 32 * ks); s = MFMA16(a, qf[hh][ks], s); }
                *(LAS f32x4*)(swr + 16 * kti) = s; }
            LDSWAIT();
            {
                float z[16], cs[16];
#pragma unroll
                for (int i4 = 0; i4 < 4; ++i4) { const f32x4 sv = *(const LAS f32x4*)(srd + 4 * i4); z[4 * i4 + 0] = sv[0]; z[4 * i4 + 1] = sv[1]; z[4 * i4 + 2] = sv[2]; z[4 * i4 + 3] = sv[3]; }
                float run = 0.f;
#pragma unroll
                for (int i = 15; i >= 0; --i) { const bool valid = !diag || (16 * seg + i < qloc);
                    const float zz = z[i]; const float e = fexp(-fabsf(zz)); const float sp = fmaxf(zz, 0.f) + __logf(1.0f + e);
                    run += valid ? sp : 0.f; cs[i] = run; }
                const int lb = lane & ~3;
                const float t0 = __shfl(run, lb + 0), t1 = __shfl(run, lb + 1), t2 = __shfl(run, lb + 2), t3 = __shfl(run, lb + 3);
                const float off = carry[hh] + (seg < 1 ? t1 : 0.f) + (seg < 2 ? t2 : 0.f) + (seg < 3 ? t3 : 0.f);
                carry[hh] += (t0 + t1) + (t2 + t3);
                float wvv[16];
#pragma unroll
                for (int i = 0; i < 16; ++i) { const bool valid = !diag || (16 * seg + i < qloc); wvv[i] = valid ? fexp(z[i] - (off + cs[i])) : 0.f; }
                u32x4 o0, o1; o0.x = pk2(wvv[0], wvv[1]); o0.y = pk2(wvv[2], wvv[3]); o0.z = pk2(wvv[4], wvv[5]); o0.w = pk2(wvv[6], wvv[7]); o1.x = pk2(wvv[8], wvv[9]); o1.y = pk2(wvv[10], wvv[11]); o1.z = pk2(wvv[12], wvv[13]); o1.w = pk2(wvv[14], wvv[15]);
                *(LAS u32x4*)(wwr) = o0; *(LAS u32x4*)(wwr + 8) = o1;
            }
            LDSWAIT();
#pragma unroll
            for (int ks = 0; ks < 2; ++ks) { const bf16x8 bfrag = *(const LAS bf16x8*)(wrd + 32 * ks);
#pragma unroll
                for (int n = 0; n < 4; ++n) { const bf16x8 a = *(const LAS bf16x8*)(vbase + (hh * 64 + 16 * n) * VS + 32 * ks); acc[hh][n] = MFMA16(a, bfrag, acc[hh][n]); } }
            LDSWAIT();
        }
        if (__builtin_amdgcn_ballot_w64(fminf(carry[0], carry[1]) < 32.0f) != 0ull) { if (lane == 0) FLG[it & 1] = 1u; }
    }
    float ssq = 0.f;
#pragma unroll
    for (int hh = 0; hh < 2; ++hh)
#pragma unroll
        for (int n = 0; n < 4; ++n) ssq += ssq4(acc[hh][n]);
    ssq += __shfl_xor(ssq, 16); ssq += __shfl_xor(ssq, 32);
    __syncthreads();
    if (q == 0) RED[(16 * rg + c) * 2 + hp] = ssq;
    __syncthreads();
    const float tot = RED[(16 * rg + c) * 2 + 0] + RED[(16 * rg + c) * 2 + 1];
    const float rs = rsqrtf(tot * (1.0f / 256.0f) + EPS);
    bf16_t* yrow = ycat + trow * DM + 768 + hp * 128 + 4 * q;
#pragma unroll
    for (int hh = 0; hh < 2; ++hh)
#pragma unroll
        for (int n = 0; n < 4; ++n) st4(yrow + hh * 64 + 16 * n, acc[hh][n] * rs);
}

#define XB_TMO      128
#define XB_XCNT(j)  (256  + 64 * (j))
#define XB_XSUB(j)  (1280 + 64 * (j))
#define XB_XGEN(j)  (2304 + 64 * (j))
#define XB_TOP      3328
#define XB_TOPGEN   3392
#define XCD_BAR_WORDS 3456
#define XB_SPIN_CAP (1u << 18)

__device__ __forceinline__ unsigned xb_ld(unsigned* p)              { return __hip_atomic_load(p, __ATOMIC_RELAXED, __HIP_MEMORY_SCOPE_AGENT); }
__device__ __forceinline__ unsigned xb_add(unsigned* p, unsigned v) { return __hip_atomic_fetch_add(p, v, __ATOMIC_RELAXED, __HIP_MEMORY_SCOPE_AGENT); }
__device__ __forceinline__ unsigned xb_xcc_id() { return (unsigned)__builtin_amdgcn_s_getreg((3 << 11) | 20) & 0xFu; }
#define XB_SPIN(cond, bar) do { unsigned _sp = 0; while (cond) { __builtin_amdgcn_s_sleep(1); \
    if ((++_sp & 255u) == 0u) { if (xb_ld(&(bar)[XB_TMO])) break; if (_sp > XB_SPIN_CAP) { atomicAdd(&(bar)[XB_TMO], 1u); break; } } } } while (0)

struct XcdBarrier {
    unsigned* bar; unsigned x;
    volatile LAS unsigned* st;
};

__device__ __forceinline__ XcdBarrier xcd_barrier_post(unsigned* bar, volatile LAS unsigned* st) {
    XcdBarrier b; b.bar = bar; b.x = xb_xcc_id(); b.st = st;
    if (threadIdx.x == 0) (void)xb_add(&bar[XB_XCNT(b.x)], 1u);
    return b;
}
__device__ __forceinline__ void xcd_barrier_complete(unsigned* bar, unsigned x, unsigned& nloc, unsigned& nx) {
    const unsigned G = gridDim.x * gridDim.y * gridDim.z;
    unsigned sum, cnt, mine, sp = 0u;
    for (;;) {
        sum = 0u; cnt = 0u; mine = 0u;
#pragma unroll
        for (unsigned j = 0; j < 16; ++j) { const unsigned c = xb_ld(&bar[XB_XCNT(j)]); sum += c; cnt += (c > 0u) ? 1u : 0u; mine = (j == x) ? c : mine; }
        if (sum == G) break;
        __builtin_amdgcn_s_sleep(1);
        if ((++sp & 255u) == 0u) { if (xb_ld(&bar[XB_TMO])) break; if (sp > XB_SPIN_CAP) { atomicAdd(&bar[XB_TMO], 1u); break; } }
    }
    nloc = mine > 0u ? mine : 1u; nx = cnt > 0u ? cnt : 1u;
}

__device__ __forceinline__ void xcd_barrier(const XcdBarrier& b) {
    asm volatile("s_waitcnt vmcnt(0)" ::: "memory");
    __syncthreads();
    if (threadIdx.x == 0) {
        unsigned* bar = b.bar;
        __builtin_amdgcn_s_waitcnt(0);
        unsigned nloc = b.st[0], nx = b.st[1];
        if (nloc == 0u) { xcd_barrier_complete(bar, b.x, nloc, nx); b.st[0] = nloc; b.st[1] = nx; }
        const unsigned old = xb_add(&bar[XB_XSUB(b.x)], 1u);
        const unsigned gen = old / nloc;
        if (old + 1u == (gen + 1u) * nloc) {
            __builtin_amdgcn_fence(__ATOMIC_RELEASE, "agent");
            asm volatile("s_waitcnt vmcnt(0)" ::: "memory");
            const unsigned og = xb_add(&bar[XB_TOP], 1u);
            const unsigned tg = og / nx;
            if (og + 1u == (tg + 1u) * nx) xb_add(&bar[XB_TOPGEN], 1u);
            else XB_SPIN(xb_ld(&bar[XB_TOPGEN]) == tg, bar);
            __builtin_amdgcn_fence(__ATOMIC_ACQUIRE, "agent");
            xb_add(&bar[XB_XGEN(b.x)], 1u);
            asm volatile("s_waitcnt vmcnt(0)" ::: "memory");
        } else {
            XB_SPIN(xb_ld(&bar[XB_XGEN(b.x)]) == gen, bar);
            __builtin_amdgcn_fence(__ATOMIC_ACQUIRE, "agent");
            asm volatile("s_waitcnt vmcnt(0)" ::: "memory");
        }
    }
    __syncthreads();
}

#ifndef REP_SYNC
#define REP_SYNC 1
#endif
#define GSYNC() do { for (int _r = 0; _r < REP_SYNC; ++_r) xcd_barrier(xbar); } while (0)
__global__ void __launch_bounds__(NTHR, 2) fwd_megakernel(Params p) {
    extern __shared__ __attribute__((aligned(16))) unsigned char lds[];
    cg::grid_group grid = cg::this_grid();
    LAS unsigned char* L = (LAS unsigned char*)lds;
    const int tid = threadIdx.x, lane = tid & 63, wave = __builtin_amdgcn_readfirstlane(tid >> 6);
    const int G = gridDim.x, bx = blockIdx.x;
    unsigned char* ws = p.ws;
    bf16_t* Win_t = (bf16_t*)(ws + WS_WIN); bf16_t* Wout_t = (bf16_t*)(ws + WS_WOUT); bf16_t* Wgu_t = (bf16_t*)(ws + WS_WGU); bf16_t* Wdn_t = (bf16_t*)(ws + WS_WDN);
    bf16_t* SGUW = (bf16_t*)(ws + WS_SGUW); bf16_t* PWT = (bf16_t*)(ws + WS_PWT); float* SSQ = (float*)(ws + WS_SS);
    bf16_t* XB = (bf16_t*)(ws + WS_XB); bf16_t* PROJ = (bf16_t*)(ws + WS_PROJ); bf16_t* YCAT = (bf16_t*)(ws + WS_YCAT); bf16_t* HID = (bf16_t*)(ws + WS_HID);

    volatile LAS unsigned* xst = (volatile LAS unsigned*)(L + LDS_BYTES - 16);
    if (tid < 4) xst[tid] = 0u;
    unsigned* barw = (unsigned*)(ws + WS_BAR);
    if (bx == 0) for (int i = tid; i < XCD_BAR_WORDS; i += NTHR) __hip_atomic_store(barw + i, 0u, __ATOMIC_RELAXED, __HIP_MEMORY_SCOPE_AGENT);
    {
        LAS float* scr = (LAS float*)(L + wave * 16384);
        const int gw = bx * 8 + wave, NGW = G * 8;
        constexpr int I_IN = (DM / 64) * (DIN / 32), I_OUT = (DM / 64) * (DM / 32), I_GU = (DM / 64) * (2 * DFF / 32), I_DN = (DFF / 64) * (DM / 32), I_L = I_IN + I_OUT + I_GU + I_DN;
        for (int it = gw; it < DEPTH * I_L; it += NGW) {
            const int l = it / I_L; int r = it % I_L;
            if (r < I_IN) { transpose_item(p.w_in + (size_t)l * DM * DIN, DM, DIN, Win_t + (size_t)l * DIN * DM, p.norm_mix + l * DM, 1, scr, r, lane); continue; } r -= I_IN;
            if (r < I_OUT) { transpose_item(p.w_out + (size_t)l * DM * DM, DM, DM, Wout_t + (size_t)l * DM * DM, p.mix_out_gain + l * DM, 0, scr, r, lane); continue; } r -= I_OUT;
            if (r < I_GU) { transpose_item(p.w_gate_up + (size_t)l * DM * 2 * DFF, DM, 2 * DFF, Wgu_t + (size_t)l * 2 * DFF * DM, p.norm_ffn + l * DM, 2, scr, r, lane); continue; } r -= I_GU;
            transpose_item(p.w_down + (size_t)l * DFF * DM, DFF, DM, Wdn_t + (size_t)l * DM * DFF, nullptr, 0, scr, r, lane);
        }
        for (int m = gw; m < M; m += NGW) {
            const f32x4* xr = (const f32x4*)(p.x + (size_t)m * DM) + lane; u32x2* o8 = (u32x2*)(XB + (size_t)m * DM) + lane; float s = 0.f;
#pragma unroll
            for (int j = 0; j < 4; ++j) { const f32x4 v = xr[64 * j]; s += (v.x * v.x + v.y * v.y) + (v.z * v.z + v.w * v.w); u32x2 o; o.x = pk2(v.x, v.y); o.y = pk2(v.z, v.w); o8[64 * j] = o; }
            s = wave_sum(s);
            if (lane < 4) SSQ[(size_t)m * 4 + lane] = (lane == 0) ? s : 0.f;
        }
        const int gt = bx * NTHR + tid, NGT = G * NTHR;
        for (int e = gt; e < DEPTH * 4 * 128 * 128 / 8; e += NGT) { const int s0 = (e & 15) * 8, t = (e >> 4) & 127; const float* src = p.sgu_w + (size_t)e * 8;
            const f32x4 a = *(const f32x4*)src, bq = *(const f32x4*)(src + 4); float v[8] = {a.x, a.y, a.z, a.w, bq.x, bq.y, bq.z, bq.w};
#pragma unroll
            for (int i = 0; i < 8; ++i) v[i] = (s0 + i <= t) ? v[i] : 0.f;
            u32x4 o; o.x = pk2(v[0], v[1]); o.y = pk2(v[2], v[3]); o.z = pk2(v[4], v[5]); o.w = pk2(v[6], v[7]); *(u32x4*)(SGUW + (size_t)e * 8) = o; }
        for (int e = gt; e < DEPTH * 4 * 64 * 64; e += NGT) { const int cc = e & 63, d = (e >> 6) & 63, lg = e >> 12; PWT[e] = f2bf(p.pool_w[((size_t)lg * 64 + cc) * 64 + d]); }
    }
    grid.sync();
    const XcdBarrier xbar = xcd_barrier_post(barw, xst);

    for (int l = 0; l < DEPTH; ++l) {
#ifndef REP_P1
#define REP_P1 1
#endif
#ifndef NO_P1
        for (int rep = 0; rep < REP_P1; ++rep) { int zk; asm volatile("s_mov_b32 %0, 0" : "=s"(zk)); pg8::Gemm g{XB, Win_t + (size_t)l * DIN * DM, M, DIN, DM + zk}; pg8::StaticOrder S; S.init(M, DIN, G + zk, bx); pg8::EpiIn E{PROJ, SSQ};
          pg8::gemm_phase<pg8::EpiIn, pg8::StaticOrder, true, true>(L, g, S, E, zk); }
#endif
        GSYNC();
#ifndef REP_MIX
#define REP_MIX 1
#endif
#ifndef REP_D
#define REP_D 1
#endif
        for (int rep = 0; rep < REP_MIX; ++rep)
        for (int u = bx; u < 256; u += G) { const int b = u >> 4, ch = u & 15;
            __syncthreads();
#ifndef NO_A
            { int zt; asm volatile("v_mov_b32 %0, 0" : "=v"(zt)); const int t2 = tid + zt; mixer_A(L, PROJ, SGUW + (size_t)l * 4 * 128 * 128, p.sgu_b + l * 4 * 128, YCAT, b, ch, t2, t2 & 63, __builtin_amdgcn_readfirstlane(t2 >> 6)); }
#endif
            __syncthreads();
#ifndef NO_B
            { int zt; asm volatile("v_mov_b32 %0, 0" : "=v"(zt)); const int t2 = tid + zt; mixer_B(L, PROJ, PWT + (size_t)l * 4 * 64 * 64, p.pool_scale + l * 256, YCAT, b, ch, t2, t2 & 63, __builtin_amdgcn_readfirstlane(t2 >> 6)); }
#endif
            __syncthreads();
#ifndef NO_C
            { int zt; asm volatile("v_mov_b32 %0, 0" : "=v"(zt)); const int t2 = tid + zt; mixer_C(L, PROJ, p.swa_sinks + l * 4, p.rel_bias, YCAT, b, ch, t2, t2 & 63, __builtin_amdgcn_readfirstlane(t2 >> 6)); }
#endif
            __syncthreads();
#ifndef NO_D
#pragma unroll 1
            for (int hf = 0; hf < 2 * REP_D; ++hf) { int zt; asm volatile("v_mov_b32 %0, 0" : "=v"(zt)); const int t2 = tid + zt; mixer_D(L, PROJ, YCAT, b, (hf & 1) ? 31 - ch : ch, t2, t2 & 63, __builtin_amdgcn_readfirstlane(t2 >> 6)); __syncthreads(); }
#endif
        }
        GSYNC();
#ifndef NO_P3
        { int zk; asm volatile("s_mov_b32 %0, 0" : "=s"(zk)); pg8::Gemm g{YCAT, Wout_t + (size_t)l * DM * DM, M, DM, DM + zk}; pg8::StaticOrder S; S.init(M, DM, G + zk, bx); pg8::EpiRes E{l == 0 ? p.x : nullptr, nullptr, XB, SSQ, (LAS float*)(L + 131072)};
          pg8::gemm_phase<pg8::EpiRes, pg8::StaticOrder, true, true>(L, g, S, E, zk); }
#endif
        GSYNC();
#ifndef REP_P4
#define REP_P4 1
#endif
#ifndef NO_P4
        for (int rep = 0; rep < REP_P4; ++rep) { int zk; asm volatile("s_mov_b32 %0, 0" : "=s"(zk)); pg8::Gemm g{XB, Wgu_t + (size_t)l * 2 * DFF * DM, M, 2 * DFF, DM + zk}; pg8::StaticOrder S; S.init(M, 2 * DFF, G + zk, bx); pg8::EpiGU E{HID, SSQ};
          pg8::gemm_phase<pg8::EpiGU, pg8::StaticOrder, true, true>(L, g, S, E, zk); }
#endif
        GSYNC();
#ifndef NO_P5
        { int zk; asm volatile("s_mov_b32 %0, 0" : "=s"(zk)); pg8::Gemm g{HID, Wdn_t + (size_t)l * DM * DFF, M, DM, DFF + zk}; pg8::StaticOrder S; S.init(M, DM, G + zk, bx); pg8::EpiRes E{nullptr, l == DEPTH - 1 ? p.out : nullptr, XB, SSQ, (LAS float*)(L + 131072)};
          pg8::gemm_phase<pg8::EpiRes, pg8::StaticOrder, true, true>(L, g, S, E, zk); }
#endif
        GSYNC();
    }
    {
        const int gw = bx * 8 + wave, NGW = G * 8;
        for (int m = gw; m < M; m += NGW) { const float rs = rstd_of(SSQ, m); f32x4* xr = (f32x4*)(p.out + (size_t)m * DM) + lane; const f32x4* gr = (const f32x4*)p.norm_final + lane;
#pragma unroll
            for (int j = 0; j < 4; ++j) { const f32x4 v = xr[64 * j], gg = gr[64 * j]; xr[64 * j] = v * rs * gg; } }
    }
}

extern "C" void kernel_launch(void* const* d_in, const int* in_sizes, int n_in, void* d_out, int out_size, void* d_ws, size_t ws_size, hipStream_t stream) {
    static int grid_blocks = 0;
    if (grid_blocks == 0) {
        if (n_in != 15 || in_sizes[0] != M * DM || out_size != M * DM || ws_size < WS_END) { fprintf(stderr, "kernel_launch: unexpected shapes (n_in %d, in0 %d, out %d, ws %zu)\n", n_in, n_in > 0 ? in_sizes[0] : -1, out_size, ws_size); grid_blocks = -1; return; }
        int dev = 0, cus = 0, per_cu = 0;
        hipGetDevice(&dev); hipDeviceGetAttribute(&cus, hipDeviceAttributeMultiprocessorCount, dev);
        if (hipFuncSetAttribute((const void*)fwd_megakernel, hipFuncAttributeMaxDynamicSharedMemorySize, LDS_BYTES) != hipSuccess) { fprintf(stderr, "kernel_launch: hipFuncSetAttribute failed\n"); }
        if (hipOccupancyMaxActiveBlocksPerMultiprocessor(&per_cu, (const void*)fwd_megakernel, NTHR, LDS_BYTES) != hipSuccess || per_cu < 1) { fprintf(stderr, "kernel_launch: occupancy query says %d\n", per_cu); per_cu = 1; }
        (void)hipGetLastError();
        grid_blocks = cus * 1;
        if (grid_blocks <= 0) grid_blocks = 256;
    }
    if (grid_blocks < 0) return;
    Params p{};
    p.x = (const float*)d_in[0]; p.w_in = (const float*)d_in[1]; p.w_out = (const float*)d_in[2]; p.sgu_w = (const float*)d_in[3]; p.sgu_b = (const float*)d_in[4];
    p.pool_w = (const float*)d_in[5]; p.pool_scale = (const float*)d_in[6]; p.swa_sinks = (const float*)d_in[7]; p.rel_bias = (const float*)d_in[8]; p.mix_out_gain = (const float*)d_in[9];
    p.norm_mix = (const float*)d_in[10]; p.norm_ffn = (const float*)d_in[11]; p.w_gate_up = (const float*)d_in[12]; p.w_down = (const float*)d_in[13]; p.norm_final = (const float*)d_in[14];
    p.out = (float*)d_out; p.ws = (unsigned char*)d_ws;
    void* args[] = {&p};
    hipError_t e = hipLaunchCooperativeKernel((const void*)fwd_megakernel, dim3(grid_blocks), dim3(NTHR), args, LDS_BYTES, stream);
    if (e != hipSuccess) fprintf(stderr, "cooperative launch failed: %s (grid %d)\n", hipGetErrorString(e), grid_blocks);
}
```

```cpp
#include <hip/hip_runtime.h>
#include <hip/hip_cooperative_groups.h>
#include <cstdio>
#include <cstdint>
namespace cg = cooperative_groups;
namespace pg8 {
#define PG8_LAS __attribute__((address_space(3)))
typedef unsigned short bf16_t;
typedef short bf16x8 __attribute__((ext_vector_type(8)));
typedef float f32x4 __attribute__((ext_vector_type(4)));
typedef unsigned u32x4 __attribute__((ext_vector_type(4)));
constexpr int BM = 256, BK = 64, HALF = 128, HTB = HALF * BK * 2  , STAGE_BYTES = 8 * HTB, NXCD = 8, WGM = 8;

__host__ __device__ __forceinline__ int lds_byte(int r, int c) { const int st = (r >> 4) * 2 + (c >> 5), rr = r & 15, cc = c & 31, ob = rr * 64 + cc * 2; return st * 1024 + (ob ^ (((ob >> 9) & 1) << 5)); }
__host__ __device__ __forceinline__ void stage_rc(int b, int& R, int& C) { const int st = b / 1024, sb = b % 1024, swz = sb ^ (((sb >> 9) & 1) << 5); R = (st >> 1) * 16 + swz / 64; C = (st & 1) * 32 + (swz % 64) / 2; }
__host__ __device__ __forceinline__ int perm32(int rho) { const int n = rho >> 4, i = rho & 15; return 8 * (i >> 2) + 4 * n + (i & 3); }

struct Unit { int pm, pn; };
struct Gemm { const bf16_t* A; const bf16_t* Bt; int M, N, K; };

struct StaticOrder {
    int nM, nN, nwg, G, c;
    __host__ __device__ void init(int M, int N, int G_, int c_) { nM = M / BM; nN = N / BM; nwg = nM * nN; G = G_; c = c_; }
    __host__ __device__ bool next(int i, Unit& u) const {
        const long L = (long)i * G + c; if (L >= nwg) return false;
        int wgid = (int)L; { const int q = nwg / NXCD, r = nwg % NXCD, xcd = wgid % NXCD, off = wgid / NXCD; wgid = (xcd < r ? xcd * (q + 1) : r * (q + 1) + (xcd - r) * q) + off; }
        const int nig = WGM * nN, gid = wgid / nig, fm = gid * WGM, gsz = (nM - fm) < WGM ? (nM - fm) : WGM;
        u.pm = fm + ((wgid % nig) % gsz); u.pn = (wgid % nig) / gsz; return true;
    }
    __device__ __forceinline__ void a_ready(const Unit&) const {}
    __device__ __forceinline__ void done(const Unit&) const {}
};

__device__ __forceinline__ unsigned cvt_pk_bf16(float lo, float hi) { unsigned r; asm volatile("v_cvt_pk_bf16_f32 %0, %1, %2" : "=v"(r) : "v"(lo), "v"(hi)); return r; }
typedef float f32x2 __attribute__((ext_vector_type(2)));
template <class Epi, class Sched, bool ALIGN_EPI = false, bool SP2 = false>
__device__ __forceinline__ void gemm_phase(PG8_LAS unsigned char* lds, const Gemm g, const Sched& S, const Epi& E, const int opq) {
    const int tid = threadIdx.x + opq, wid = __builtin_amdgcn_readfirstlane(tid >> 6), lane = tid & 63, wr = wid >> 2, wc = wid & 3, fr = lane & 15, fq = lane >> 4;
    const int K = g.K, nt = K / BK;
    unsigned voffA[2], voffB[2];
#pragma unroll
    for (int i = 0; i < 2; ++i) { int R, C; stage_rc(tid * 16 + i * 8192, R, C); const int Rb = Epi::PERM ? ((R & ~31) + perm32(R & 31)) : R;
        voffA[i] = (unsigned)(R * K + C) * 2u; voffB[i] = (unsigned)(Rb * K + C) * 2u; }
    const size_t kstep = (size_t)(BK * 2);
    const size_t hstep = (size_t)HALF * K * 2;
    const size_t tstep = 2 * hstep;
    const unsigned ldsw = (unsigned)wid * 1024u;
    const int aoff = lds_byte(wr * 64 + fr, fq * 8), boff = lds_byte(wc * 32 + fr, fq * 8);
#define PG8_SA(b, h) (((b) * 2 + (h)) * HTB)
#define PG8_SB(b, h) ((4 + (b) * 2 + (h)) * HTB)
#define PG8_STAGE(bufoff, gbase, voff) do { _Pragma("unroll") for (int _i = 0; _i < 2; ++_i) \
        __builtin_amdgcn_global_load_lds((const unsigned*)((const char*)(gbase) + (voff)[_i]), (PG8_LAS unsigned*)(lds + (bufoff) + ldsw + _i * 8192), 16, 0, 0); } while (0)
#define PG8_LDA(dst, b, h) do { _Pragma("unroll") for (int m = 0; m < 4; ++m) _Pragma("unroll") for (int k = 0; k < 2; ++k) dst[m][k] = *(const PG8_LAS bf16x8*)(lds + PG8_SA(b, h) + aoff + m * 2048 + k * 1024); } while (0)
#define PG8_LDB(dst, b, h) do { _Pragma("unroll") for (int n = 0; n < 2; ++n) _Pragma("unroll") for (int k = 0; k < 2; ++k) dst[n][k] = *(const PG8_LAS bf16x8*)(lds + PG8_SB(b, h) + boff + n * 2048 + k * 1024); } while (0)
#define PG8_MMA(ai, bj, At, Bt) do { __builtin_amdgcn_s_setprio(1); _Pragma("unroll") for (int m = 0; m < 4; ++m) _Pragma("unroll") for (int n = 0; n < 2; ++n) _Pragma("unroll") for (int k = 0; k < 2; ++k) \
        acc[ai][bj][m][n] = __builtin_amdgcn_mfma_f32_16x16x32_bf16(Bt[n][k], At[m][k], acc[ai][bj][m][n], 0, 0, 0); __builtin_amdgcn_s_setprio(0); } while (0)
#define PG8_WAIT_V(n) asm volatile("s_waitcnt vmcnt(" #n ")" ::: "memory")
#define PG8_WAIT_L(n) asm volatile("s_waitcnt lgkmcnt(" #n ")" ::: "memory")
#define PG8_BAR __builtin_amdgcn_s_barrier()
#define PG8_SCHED __builtin_amdgcn_sched_barrier(0)
    Unit cur, nxt; int ui = 0;
    if (!S.next(0, cur)) return;
    f32x4 acc[2][2][4][2];
#pragma unroll
    for (int a = 0; a < 2; ++a)
#pragma unroll
        for (int b = 0; b < 2; ++b)
#pragma unroll
            for (int m = 0; m < 4; ++m)
#pragma unroll
                for (int n = 0; n < 2; ++n) acc[a][b][m][n] = (f32x4){0.f, 0.f, 0.f, 0.f};
    bf16x8 At[4][2], B0[2][2], B1[2][2];
    const char* cA = (const char*)g.A + (size_t)cur.pm * tstep; const char* cB = (const char*)g.Bt + (size_t)cur.pn * tstep;
    S.a_ready(cur);
    if constexpr (SP2) {
        PG8_STAGE(PG8_SB(0, 0), cB, voffB); PG8_STAGE(PG8_SB(0, 1), cB + hstep, voffB); PG8_STAGE(PG8_SA(0, 0), cA, voffA); PG8_STAGE(PG8_SA(0, 1), cA + hstep, voffA);
        if (wr == 1) PG8_BAR;
        PG8_WAIT_V(2); PG8_BAR;
        PG8_STAGE(PG8_SB(1, 0), cB + kstep, voffB); PG8_STAGE(PG8_SA(1, 0), cA + kstep, voffA); PG8_STAGE(PG8_SB(1, 1), cB + hstep + kstep, voffB);
        PG8_WAIT_V(6); PG8_BAR;
    } else {
        PG8_STAGE(PG8_SB(0, 0), cB, voffB); PG8_STAGE(PG8_SA(0, 0), cA, voffA); PG8_STAGE(PG8_SB(0, 1), cB + hstep, voffB); PG8_STAGE(PG8_SA(0, 1), cA + hstep, voffA);
        if (wr == 1) PG8_BAR;
        PG8_WAIT_V(4); PG8_BAR;
        PG8_STAGE(PG8_SB(1, 0), cB + kstep, voffB); PG8_STAGE(PG8_SA(1, 0), cA + kstep, voffA); PG8_STAGE(PG8_SB(1, 1), cB + hstep + kstep, voffB);
        PG8_WAIT_V(6); PG8_BAR;
    }
    for (;;) {
        const bool has_next = S.next(ui + 1, nxt);
        const char* nA = has_next ? (const char*)g.A + (size_t)nxt.pm * tstep : cA; const char* nB = has_next ? (const char*)g.Bt + (size_t)nxt.pn * tstep : cB;
        for (int t = 0; t < nt; t += 2) {
            const bool last = (t == nt - 2);
            const char* a1 = cA + (size_t)(t + 1) * kstep;
            const char* a2 = last ? nA : cA + (size_t)(t + 2) * kstep; const char* b2 = last ? nB : cB + (size_t)(t + 2) * kstep;
            const char* a3 = a2 + kstep; const char* b3 = b2 + kstep;
            if (last && has_next) S.a_ready(nxt);
            if constexpr (SP2) {
            PG8_LDB(B0, 0, 0); PG8_LDB(B1, 0, 1); PG8_SCHED; PG8_LDA(At, 0, 0); PG8_STAGE(PG8_SA(1, 1), a1 + hstep, voffA);
            PG8_WAIT_V(8); PG8_WAIT_L(0); PG8_BAR; PG8_MMA(0, 0, At, B0); PG8_MMA(0, 1, At, B1); PG8_BAR; PG8_SCHED;
            PG8_LDA(At, 0, 1); PG8_STAGE(PG8_SB(0, 0), b2, voffB); PG8_STAGE(PG8_SB(0, 1), b2 + hstep, voffB); PG8_STAGE(PG8_SA(0, 0), a2, voffA);
            PG8_WAIT_V(8); PG8_WAIT_L(0); PG8_BAR; PG8_MMA(1, 0, At, B0); PG8_MMA(1, 1, At, B1); PG8_BAR; PG8_SCHED;
            PG8_LDB(B0, 1, 0); PG8_LDB(B1, 1, 1); PG8_SCHED; PG8_LDA(At, 1, 0); PG8_STAGE(PG8_SA(0, 1), a2 + hstep, voffA);
            PG8_WAIT_V(8); PG8_WAIT_L(0); PG8_BAR; PG8_MMA(0, 0, At, B0); PG8_MMA(0, 1, At, B1); PG8_BAR; PG8_SCHED;
            PG8_LDA(At, 1, 1); PG8_STAGE(PG8_SB(1, 0), b3, voffB); PG8_STAGE(PG8_SB(1, 1), b3 + hstep, voffB); PG8_STAGE(PG8_SA(1, 0), a3, voffA);
            PG8_WAIT_V(8); PG8_WAIT_L(0); PG8_BAR; PG8_MMA(1, 0, At, B0); PG8_MMA(1, 1, At, B1); PG8_BAR; PG8_SCHED;
            } else {
            PG8_LDB(B0, 0, 0); PG8_SCHED; PG8_LDA(At, 0, 0); PG8_STAGE(PG8_SA(1, 1), a1 + hstep, voffA);
            PG8_WAIT_L(8); PG8_BAR; PG8_WAIT_L(0); PG8_MMA(0, 0, At, B0); PG8_BAR; PG8_SCHED;
            PG8_LDB(B1, 0, 1); PG8_STAGE(PG8_SB(0, 0), b2, voffB);
            PG8_BAR; PG8_WAIT_L(0); PG8_MMA(0, 1, At, B1); PG8_BAR;
            PG8_LDA(At, 0, 1); PG8_STAGE(PG8_SA(0, 0), a2, voffA);
            PG8_BAR; PG8_WAIT_L(0); PG8_MMA(1, 0, At, B0); PG8_BAR; PG8_SCHED;
            PG8_STAGE(PG8_SB(0, 1), b2 + hstep, voffB);
            PG8_WAIT_V(6); PG8_BAR; PG8_MMA(1, 1, At, B1); PG8_BAR;
            PG8_LDB(B0, 1, 0); PG8_SCHED; PG8_LDA(At, 1, 0); PG8_STAGE(PG8_SA(0, 1), a2 + hstep, voffA);
            PG8_WAIT_L(8); PG8_BAR; PG8_WAIT_L(0); PG8_MMA(0, 0, At, B0); PG8_BAR; PG8_SCHED;
            PG8_LDB(B1, 1, 1); PG8_STAGE(PG8_SB(1, 0), b3, voffB);
            PG8_BAR; PG8_WAIT_L(0); PG8_MMA(0, 1, At, B1); PG8_BAR;
            PG8_LDA(At, 1, 1); PG8_STAGE(PG8_SA(1, 0), a3, voffA);
            PG8_BAR; PG8_WAIT_L(0); PG8_MMA(1, 0, At, B0); PG8_BAR; PG8_SCHED;
            PG8_STAGE(PG8_SB(1, 1), b3 + hstep, voffB);
            PG8_WAIT_V(6); PG8_BAR; PG8_MMA(1, 1, At, B1); PG8_BAR;
            }
        }
        if constexpr (ALIGN_EPI) { if (wr == 0) PG8_BAR; }
        if constexpr (!Epi::AFTER_DRAIN) { E(acc, cur, wr, wc, fr, fq); S.done(cur); }
        if (!has_next) break;
#pragma unroll
        for (int a = 0; a < 2; ++a)
#pragma unroll
            for (int b = 0; b < 2; ++b)
#pragma unroll
                for (int m = 0; m < 4; ++m)
#pragma unroll
                    for (int n = 0; n < 2; ++n) acc[a][b][m][n] = (f32x4){0.f, 0.f, 0.f, 0.f};
        cur = nxt; cA = nA; cB = nB; ++ui;
        if constexpr (ALIGN_EPI) { if (wr == 1) PG8_BAR; }
    }
    PG8_WAIT_V(0);
    if constexpr (!ALIGN_EPI) { if (wr == 0) PG8_BAR; }
    PG8_BAR;
    if constexpr (Epi::AFTER_DRAIN) { E.fused(acc, cur, wr, wc, fr, fq, lds, wid, lane); S.done(cur); }
#undef PG8_SA
#undef PG8_SB
#undef PG8_STAGE
#undef PG8_LDA
#undef PG8_LDB
#undef PG8_MMA
#undef PG8_WAIT_V
#undef PG8_WAIT_L
#undef PG8_BAR
#undef PG8_SCHED
}
}

constexpr int NB = 16, SEQ = 2048, DM = 1024, DEPTH = 4, DIN = 2048, DFF = 2816, M = NB * SEQ;
constexpr float EPS = 1e-6f;
constexpr size_t MiB = 1u << 20;
constexpr size_t WS_WIN = 0, WS_WOUT = 16 * MiB, WS_WGU = 24 * MiB, WS_WDN = 68 * MiB, WS_SGUW = 90 * MiB, WS_PWT = 90 * MiB + 512 * 1024,
                 WS_SS = 91 * MiB, WS_BAR = 93 * MiB, WS_XB = 96 * MiB, WS_PROJ = 160 * MiB, WS_YCAT = 288 * MiB, WS_HID = 160 * MiB, WS_END = 352 * MiB;
constexpr int LDS_BYTES = 160 * 1024;
constexpr int NTHR = 512;

#define LAS __attribute__((address_space(3)))
typedef unsigned short bf16_t;
typedef short bf16x8 __attribute__((ext_vector_type(8)));
typedef float f32x4 __attribute__((ext_vector_type(4)));
typedef float f32x2 __attribute__((ext_vector_type(2)));
typedef unsigned u32x4 __attribute__((ext_vector_type(4)));
typedef unsigned u32x2 __attribute__((ext_vector_type(2)));
typedef __bf16 bf16x2_t __attribute__((ext_vector_type(2)));

__device__ __forceinline__ unsigned pk2(float lo, float hi) { f32x2 v = {lo, hi}; bf16x2_t b = __builtin_convertvector(v, bf16x2_t); return __builtin_bit_cast(unsigned, b); }
__device__ __forceinline__ bf16_t f2bf(float f) { return (bf16_t)(pk2(f, 0.f) & 0xffffu); }
__device__ __forceinline__ float bflo(unsigned w) { return __uint_as_float(w << 16); }
__device__ __forceinline__ float bfhi(unsigned w) { return __uint_as_float(w & 0xffff0000u); }
#define MFMA16(a, b, c) __builtin_amdgcn_mfma_f32_16x16x32_bf16((a), (b), (c), 0, 0, 0)
#define CFENCE() asm volatile("" ::: "memory")
#define LDSWAIT() asm volatile("s_waitcnt lgkmcnt(0)" ::: "memory")
__device__ __forceinline__ float fexp(float x) { return __builtin_amdgcn_exp2f(x * 1.4426950408889634f); }
__device__ __forceinline__ float gelu_tanh(float x) {
    const float u2 = 1.5957691216057308f * x * (1.0f + 0.044715f * x * x);
    return x * __builtin_amdgcn_rcpf(1.0f + fexp(-u2));
}
__device__ __forceinline__ float rstd_of1(const float* ss, int row) {
    const f32x4 s = *(const f32x4*)(ss + (size_t)row * 4); return rsqrtf(((s.x + s.y) + (s.z + s.w)) * (1.0f / 1024.0f) + EPS);
}

__device__ __forceinline__ float ssq4(const f32x4 y) { return (y[0] * y[0] + y[1] * y[1]) + (y[2] * y[2] + y[3] * y[3]); }

#ifdef PROBE_RSTD2
__device__ __forceinline__ float rstd_of(const float* ss, int row) { const float a = rstd_of1(ss, row); int z; asm volatile("v_mov_b32 %0, 0" : "=v"(z) : "v"(a)); const float b = rstd_of1(ss, row + z); return (a + b) * 0.5f; }
#else
__device__ __forceinline__ float rstd_of(const float* ss, int row) { return rstd_of1(ss, row); }
#endif
namespace pg8 {
struct EpiIn {
    static constexpr bool PERM = true, AFTER_DRAIN = false;
    bf16_t* O; const float* ss;
    __device__ __forceinline__ void operator()(const f32x4 (&acc)[2][2][4][2], const Unit& u, int wr, int wc, int fr, int fq) const {
        const int row0 = u.pm * BM + wr * 64 + fr, col0 = u.pn * BM + wc * 32 + 8 * fq; const bool act = u.pn < 2;
        float rsv[2][4];
#pragma unroll
        for (int ai = 0; ai < 2; ++ai)
#pragma unroll
            for (int m = 0; m < 4; ++m) rsv[ai][m] = rstd_of(ss, row0 + ai * HALF + m * 16);
#pragma unroll
        for (int ai = 0; ai < 2; ++ai)
#pragma unroll
            for (int m = 0; m < 4; ++m) { const int row = row0 + ai * HALF + m * 16; const float rs = rsv[ai][m]; bf16_t* rowp = O + (size_t)row * DIN + col0;
#pragma unroll
                for (int bj = 0; bj < 2; ++bj) { f32x4 v0 = acc[ai][bj][m][0] * rs, v1 = acc[ai][bj][m][1] * rs;
                    if (act) { v0 = (f32x4){gelu_tanh(v0[0]), gelu_tanh(v0[1]), gelu_tanh(v0[2]), gelu_tanh(v0[3])}; v1 = (f32x4){gelu_tanh(v1[0]), gelu_tanh(v1[1]), gelu_tanh(v1[2]), gelu_tanh(v1[3])}; }
                    u32x4 w; w.x = pk2(v0[0], v0[1]); w.y = pk2(v0[2], v0[3]); w.z = pk2(v1[0], v1[1]); w.w = pk2(v1[2], v1[3]);
                    *(u32x4*)(rowp + bj * HALF) = w; }
                if (m & 1) CFENCE(); }
    }
};
struct EpiGU {
    static constexpr bool PERM = true, AFTER_DRAIN = false;
    bf16_t* O; const float* ss;
    __device__ __forceinline__ void operator()(const f32x4 (&acc)[2][2][4][2], const Unit& u, int wr, int wc, int fr, int fq) const {
        const int row0 = u.pm * BM + wr * 64 + fr, col0 = u.pn * HALF + wc * 32 + 8 * fq;
        float rsv[2][4];
#pragma unroll
        for (int ai = 0; ai < 2; ++ai)
#pragma unroll
            for (int m = 0; m < 4; ++m) rsv[ai][m] = rstd_of(ss, row0 + ai * HALF + m * 16);
#pragma unroll
        for (int ai = 0; ai < 2; ++ai)
#pragma unroll
            for (int m = 0; m < 4; ++m) { const int row = row0 + ai * HALF + m * 16; const float rs = rsv[ai][m]; bf16_t* rowp = O + (size_t)row * DFF + col0;
                float h[8];
#pragma unroll
                for (int n = 0; n < 2; ++n)
#pragma unroll
                    for (int e = 0; e < 4; ++e) { const float g = acc[ai][0][m][n][e] * rs, up = acc[ai][1][m][n][e] * rs; h[n * 4 + e] = g * up * __builtin_amdgcn_rcpf(1.0f + fexp(-g)); }
                u32x4 w; w.x = pk2(h[0], h[1]); w.y = pk2(h[2], h[3]); w.z = pk2(h[4], h[5]); w.w = pk2(h[6], h[7]);
                *(u32x4*)rowp = w;
                if (m & 1) CFENCE(); }
    }
};
struct EpiRes {
    static constexpr bool PERM = true, AFTER_DRAIN = false;
    const float* xin32; float* xout32; bf16_t* xb; float* ss; LAS float* P;
    __device__ __forceinline__ void operator()(const f32x4 (&acc)[2][2][4][2], const Unit& u, int wr, int wc, int fr, int fq) const {
        const int row0 = u.pm * BM + wr * 64 + fr, col0 = u.pn * BM + wc * 32 + 8 * fq;
#pragma unroll
        for (int ai = 0; ai < 2; ++ai)
#pragma unroll
            for (int m = 0; m < 4; ++m) { const int row = row0 + ai * HALF + m * 16; const size_t off = (size_t)row * DM + col0; float q = 0.f;
#pragma unroll
                for (int bj = 0; bj < 2; ++bj) { f32x4 r0, r1;
                    if (xin32) { r0 = *(const f32x4*)(xin32 + off + bj * HALF); r1 = *(const f32x4*)(xin32 + off + bj * HALF + 4); }
                    else { const u32x4 t = *(const u32x4*)(xb + off + bj * HALF); r0 = (f32x4){bflo(t.x), bfhi(t.x), bflo(t.y), bfhi(t.y)}; r1 = (f32x4){bflo(t.z), bfhi(t.z), bflo(t.w), bfhi(t.w)}; }
                    const f32x4 v0 = r0 + acc[ai][bj][m][0], v1 = r1 + acc[ai][bj][m][1];
                    q += ssq4(v0) + ssq4(v1);
                    if (xout32) { *(f32x4*)(xout32 + off + bj * HALF) = v0; *(f32x4*)(xout32 + off + bj * HALF + 4) = v1; }
                    else { u32x4 w; w.x = pk2(v0[0], v0[1]); w.y = pk2(v0[2], v0[3]); w.z = pk2(v1[0], v1[1]); w.w = pk2(v1[2], v1[3]); *(u32x4*)(xb + off + bj * HALF) = w; } }
                q += __shfl_xor(q, 16); q += __shfl_xor(q, 32);
                if (fq == 0) P[(ai * HALF + wr * 64 + m * 16 + fr) * 4 + wc] = q;
                if (m & 1) CFENCE(); }
        asm volatile("s_waitcnt lgkmcnt(0)" ::: "memory"); __builtin_amdgcn_s_barrier(); asm volatile("" ::: "memory");
        const int t = wr * 256 + wc * 64 + fq * 16 + fr;
        if (t < 256) { const f32x4 pp = *(const LAS f32x4*)(P + t * 4); ss[(size_t)(u.pm * BM + t) * 4 + u.pn] = (pp.x + pp.y) + (pp.z + pp.w); }
    }
};
}

__device__ __forceinline__ void transpose_item(const float* W, int K, int N, bf16_t* WT, const float* gain, int mode, LAS float* scr, int item, int lane) {
    const int nblk = N / 32, kb = item / nblk, nb = item % nblk, k0 = 64 * kb, n0 = 32 * nb;
    const int c = lane & 7;
    f32x4 g0 = {1.f, 1.f, 1.f, 1.f}, g1 = {1.f, 1.f, 1.f, 1.f};
    if (gain) { g0 = *(const f32x4*)(gain + k0 + 8 * c); g1 = *(const f32x4*)(gain + k0 + 8 * c + 4); }
    const float* src = W + (size_t)(k0 + (lane >> 5)) * N + n0 + (lane & 31);
    float v[32];
#pragma unroll
    for (int i = 0; i < 32; ++i) v[i] = __builtin_nontemporal_load(src + (size_t)(2 * i) * N);
#pragma unroll
    for (int i = 0; i < 32; ++i) scr[(2 * i + (lane >> 5)) * 33 + (lane & 31)] = v[i];
    LDSWAIT();
#pragma unroll
    for (int j = 0; j < 4; ++j) { const int n = (lane >> 3) + 8 * j, gn = n0 + n; const LAS float* s = scr + (8 * c) * 33 + n;
        float cs = 1.0f; int row = gn;
        if (mode == 1) { if ((gn >= 768 && gn < 1024) || (gn >= 1280 && gn < 1536)) cs = 0.125f; }
        if (mode == 2) { const int jj = gn < DFF ? gn : gn - DFF; row = 256 * (jj >> 7) + (jj & 127) + (gn < DFF ? 0 : 128); }
        u32x4 o; o.x = pk2(s[0 * 33] * g0[0] * cs, s[1 * 33] * g0[1] * cs); o.y = pk2(s[2 * 33] * g0[2] * cs, s[3 * 33] * g0[3] * cs); o.z = pk2(s[4 * 33] * g1[0] * cs, s[5 * 33] * g1[1] * cs); o.w = pk2(s[6 * 33] * g1[2] * cs, s[7 * 33] * g1[3] * cs);
        *(u32x4*)(WT + (size_t)row * K + k0 + 8 * c) = o; }
    LDSWAIT();
}
__device__ __forceinline__ float wave_sum(float v) {
#pragma unroll
    for (int o = 1; o < 64; o <<= 1) v += __shfl_xor(v, o);
    return v;
}

struct Params {
    const float *x, *w_in, *w_out, *sgu_w, *sgu_b, *pool_w, *pool_scale, *swa_sinks, *rel_bias, *mix_out_gain, *norm_mix, *norm_ffn, *w_gate_up, *w_down, *norm_final;
    float* out; unsigned char* ws;
};


__device__ __forceinline__ void st4(bf16_t* p, const f32x4 y) { u32x2 o; o.x = pk2(y[0], y[1]); o.y = pk2(y[2], y[3]); *(u32x2*)p = o; }
__device__ __forceinline__ void rescale4(bf16_t* p, float rs) {
    const unsigned long long v = __hip_atomic_load((unsigned long long*)p, __ATOMIC_RELAXED, __HIP_MEMORY_SCOPE_AGENT); const unsigned lo = (unsigned)v, hi = (unsigned)(v >> 32);
    u32x2 o; o.x = pk2(bflo(lo) * rs, bfhi(lo) * rs); o.y = pk2(bflo(hi) * rs, bfhi(hi) * rs); *(u32x2*)p = o;
}
#define VMWAIT() asm volatile("s_waitcnt vmcnt(0)" ::: "memory")

__device__ __forceinline__ void mixer_A(LAS unsigned char* L, const bf16_t* proj, const bf16_t* sguw, const float* sgub, bf16_t* ycat, int b, int ch, int tid, int lane, int w) {
    constexpr int VTS = 136;
    LAS bf16_t* VT = (LAS bf16_t*)L;
    const size_t row0 = (size_t)b * SEQ + ch * 128;
    {
        const int tok = tid >> 2, h = tid & 3;
        const bf16_t* src = proj + (row0 + tok) * DIN + 256 + h * 64;
        float v[64]; float s = 0.f;
#pragma unroll
        for (int i = 0; i < 8; ++i) { const u32x4 t = *(const u32x4*)(src + 8 * i);
            v[8 * i + 0] = bflo(t.x); v[8 * i + 1] = bfhi(t.x); v[8 * i + 2] = bflo(t.y); v[8 * i + 3] = bfhi(t.y); v[8 * i + 4] = bflo(t.z); v[8 * i + 5] = bfhi(t.z); v[8 * i + 6] = bflo(t.w); v[8 * i + 7] = bfhi(t.w); }
#pragma unroll
        for (int i = 0; i < 64; ++i) s += v[i];
        const float mean = s * (1.0f / 64.0f); float s2 = 0.f;
#pragma unroll
        for (int i = 0; i < 64; ++i) { v[i] -= mean; s2 += v[i] * v[i]; }
        const float rstd = rsqrtf(s2 * (1.0f / 64.0f) + EPS);
        LAS bf16_t* dst = VT + (h * 64) * VTS + tok;
#pragma unroll
        for (int i = 0; i < 64; ++i) dst[i * VTS] = f2bf(v[i] * rstd);
    }
    __syncthreads();
    const int c = lane & 15, q = lane >> 4, wv = tid >> 6;
    const int nks = (w >> 1) + 1;
    const size_t trow = row0 + 16 * wv + c; float ssq = 0.f;
    bf16_t* yrow = ycat + trow * DM + 0 + 4 * q;
    const bf16_t* urow = proj + trow * DIN + 4 * q;
    const LAS bf16_t* vbase = VT + c * VTS + 8 * q;
    const bf16_t* wbase = sguw + (size_t)(16 * wv + c) * 128 + 8 * q;
#pragma unroll 1
    for (int h = 0; h < 4; ++h) {
        f32x4 acc[4];
#pragma unroll
        for (int n = 0; n < 4; ++n) acc[n] = (f32x4){0.f, 0.f, 0.f, 0.f};
#pragma unroll
        for (int ks = 0; ks < 4; ++ks) if (ks < nks) {
            const bf16x8 bfrag = *(const bf16x8*)(wbase + h * 128 * 128 + 32 * ks);
#pragma unroll
            for (int n = 0; n < 4; ++n) { const bf16x8 a = *(const LAS bf16x8*)(vbase + (h * 64 + 16 * n) * VTS + 32 * ks); acc[n] = MFMA16(a, bfrag, acc[n]); }
        }
        const float bias = sgub[h * 128 + 16 * wv + c];
#pragma unroll
        for (int n = 0; n < 4; ++n) { const u32x2 uu = *(const u32x2*)(urow + h * 64 + 16 * n);
            f32x4 y; y[0] = bflo(uu.x) * (acc[n][0] + bias); y[1] = bfhi(uu.x) * (acc[n][1] + bias); y[2] = bflo(uu.y) * (acc[n][2] + bias); y[3] = bfhi(uu.y) * (acc[n][3] + bias);
            ssq += ssq4(y); st4(yrow + h * 64 + 16 * n, y); }
    }
    ssq += __shfl_xor(ssq, 16); ssq += __shfl_xor(ssq, 32);
    const float rs = rsqrtf(ssq * (1.0f / 256.0f) + EPS);
    VMWAIT();
#pragma unroll 4
    for (int i = 0; i < 16; ++i) rescale4(yrow + 16 * i, rs);
}

__device__ __forceinline__ void mixer_B(LAS unsigned char* L, const bf16_t* proj, const bf16_t* pwt, const float* pscale, bf16_t* ycat, int b, int ch, int tid, int lane, int w) {
    constexpr int YS = 264;
    LAS bf16_t* Y = (LAS bf16_t*)L;
    const size_t row0 = (size_t)b * SEQ + ch * 128;
    {
        const int tok = tid >> 2, g = tid & 3; const int win = 2 << g; const int tseq = ch * 128 + tok; const int cnt = (tseq + 1 < win) ? (tseq + 1) : win;
        const float inv = 1.0f / (float)cnt;
#pragma unroll 1
        for (int hf = 0; hf < 2; ++hf) {
            const bf16_t* src = proj + (row0 + tok) * DIN + 512 + g * 64 + hf * 32;
            float p0[32], s[32];
#pragma unroll
            for (int i = 0; i < 4; ++i) { const u32x4 t = *(const u32x4*)(src + 8 * i);
                p0[8 * i + 0] = bflo(t.x); p0[8 * i + 1] = bfhi(t.x); p0[8 * i + 2] = bflo(t.y); p0[8 * i + 3] = bfhi(t.y); p0[8 * i + 4] = bflo(t.z); p0[8 * i + 5] = bfhi(t.z); p0[8 * i + 6] = bflo(t.w); p0[8 * i + 7] = bfhi(t.w); }
#pragma unroll
            for (int i = 0; i < 32; ++i) s[i] = p0[i];
#pragma unroll 1
            for (int j = 1; j < cnt; ++j) { const bf16_t* sj = src - (size_t)j * DIN;
#pragma unroll
                for (int i = 0; i < 4; ++i) { const u32x4 t = *(const u32x4*)(sj + 8 * i);
                    s[8 * i + 0] += bflo(t.x); s[8 * i + 1] += bfhi(t.x); s[8 * i + 2] += bflo(t.y); s[8 * i + 3] += bfhi(t.y); s[8 * i + 4] += bflo(t.z); s[8 * i + 5] += bfhi(t.z); s[8 * i + 6] += bflo(t.w); s[8 * i + 7] += bfhi(t.w); } }
#pragma unroll
            for (int i = 0; i < 4; ++i) { u32x4 o; o.x = pk2(s[8 * i + 0] * inv - p0[8 * i + 0], s[8 * i + 1] * inv - p0[8 * i + 1]); o.y = pk2(s[8 * i + 2] * inv - p0[8 * i + 2], s[8 * i + 3] * inv - p0[8 * i + 3]);
                o.z = pk2(s[8 * i + 4] * inv - p0[8 * i + 4], s[8 * i + 5] * inv - p0[8 * i + 5]); o.w = pk2(s[8 * i + 6] * inv - p0[8 * i + 6], s[8 * i + 7] * inv - p0[8 * i + 7]);
                *(LAS u32x4*)(Y + tok * YS + g * 64 + hf * 32 + 8 * i) = o; }
        }
    }
    __syncthreads();
    const int c = lane & 15, q = lane >> 4, wv = tid >> 6;
    const size_t trow = row0 + 16 * wv + c; float ssq = 0.f;
    bf16_t* yrow = ycat + trow * DM + 256 + 4 * q;
    const LAS bf16_t* ybase = Y + (16 * wv + c) * YS + 8 * q;
    const bf16_t* pbase = pwt + (size_t)c * 64 + 8 * q;
#pragma unroll 1
    for (int g = 0; g < 4; ++g) {
        f32x4 acc[4];
#pragma unroll
        for (int n = 0; n < 4; ++n) acc[n] = (f32x4){0.f, 0.f, 0.f, 0.f};
#pragma unroll
        for (int ks = 0; ks < 2; ++ks) { const bf16x8 bfrag = *(const LAS bf16x8*)(ybase + g * 64 + 32 * ks);
#pragma unroll
            for (int n = 0; n < 4; ++n) { const bf16x8 a = *(const bf16x8*)(pbase + (g * 64 + 16 * n) * 64 + 32 * ks); acc[n] = MFMA16(a, bfrag, acc[n]); } }
#pragma unroll
        for (int n = 0; n < 4; ++n) { const f32x4 sc = *(const f32x4*)(pscale + g * 64 + 16 * n + 4 * q); const f32x4 y = acc[n] * sc; ssq += ssq4(y); st4(yrow + g * 64 + 16 * n, y); }
    }
    ssq += __shfl_xor(ssq, 16); ssq += __shfl_xor(ssq, 32);
    const float rs = rsqrtf(ssq * (1.0f / 256.0f) + EPS);
    VMWAIT();
#pragma unroll 4
    for (int i = 0; i < 16; ++i) rescale4(yrow + 16 * i, rs);
}

__device__ __forceinline__ void mixer_C(LAS unsigned char* L, const bf16_t* proj, const float* sinks, const float* rel_bias, bf16_t* ycat, int b, int qb, int tid, int lane, int w) {
    constexpr int KS = 72, VS = 280, SS = 164;
    const int wv = tid >> 6;
    LAS bf16_t* KL = (LAS bf16_t*)L;
    LAS bf16_t* VT = (LAS bf16_t*)(L + 36864);
    LAS float* S = (LAS float*)(L + 72704) + wv * 16 * SS;
    LAS float* BT = (LAS float*)(L + 156672);
    const size_t row0 = (size_t)b * SEQ + qb * 128;
    {
        const int j = tid >> 7, dist = tid & 127; int bucket = dist;
        if (dist >= 16) { const int lg = 16 + (int)(__logf((float)dist * (1.0f / 16.0f)) / 2.0794415416798357f * 16.0f); bucket = lg < 31 ? lg : 31; }
        BT[j * 128 + dist] = rel_bias[bucket * 4 + j];
    }
    const int c = lane & 15, q = lane >> 4;
    const size_t trow = row0 + 16 * wv + c; float ssq = 0.f;
    bf16_t* yrow = ycat + trow * DM + 512 + 4 * q;
    const LAS bf16_t* kbase = KL + (16 * wv + c) * KS + 8 * q;
    const LAS bf16_t* vbase = VT + c * VS + 16 * wv + 8 * q;
    LAS float* swr = S + c * SS + 4 * q;
    const LAS bf16_t* wrd = (const LAS bf16_t*)(S + c * SS) + 8 * q;
    const int row = lane >> 2, seg = lane & 3;
    LAS float* srd = S + row * SS + 40 * seg;
#pragma unroll 1
    for (int kvh = 0; kvh < 2; ++kvh) {
        __syncthreads();
        {
            const int key = tid >> 1, half = tid & 1; const bool okk = (qb > 0) || (key >= 128);
            const bf16_t* ksrc = proj + (row0 - 128 + key) * DIN + 1024 + kvh * 64 + half * 32;
            const bf16_t* vsrc = ksrc + 128;
            LAS bf16_t* vdst = VT + (half * 32) * VS + key;
#pragma unroll
            for (int i = 0; i < 4; ++i) { u32x4 kk = {0u, 0u, 0u, 0u}, vv = {0u, 0u, 0u, 0u};
                if (okk) { kk = *(const u32x4*)(ksrc + 8 * i); vv = *(const u32x4*)(vsrc + 8 * i); }
                *(LAS u32x4*)(KL + key * KS + half * 32 + 8 * i) = kk;
                vdst[(8 * i + 0) * VS] = (bf16_t)(vv.x & 0xffffu); vdst[(8 * i + 1) * VS] = (bf16_t)(vv.x >> 16); vdst[(8 * i + 2) * VS] = (bf16_t)(vv.y & 0xffffu); vdst[(8 * i + 3) * VS] = (bf16_t)(vv.y >> 16);
                vdst[(8 * i + 4) * VS] = (bf16_t)(vv.z & 0xffffu); vdst[(8 * i + 5) * VS] = (bf16_t)(vv.z >> 16); vdst[(8 * i + 6) * VS] = (bf16_t)(vv.w & 0xffffu); vdst[(8 * i + 7) * VS] = (bf16_t)(vv.w >> 16); }
            if (tid < 64) {
#pragma unroll
                for (int i = 0; i < 3; ++i) *(LAS u32x4*)(VT + tid * VS + 256 + 8 * i) = (u32x4){0u, 0u, 0u, 0u}; }
        }
        __syncthreads();
#pragma unroll 1
        for (int g = 0; g < 2; ++g) { const int j = 2 * kvh + g;
            bf16x8 qf[2];
#pragma unroll
            for (int ks = 0; ks < 2; ++ks) qf[ks] = *(const bf16x8*)(proj + trow * DIN + 768 + j * 64 + 32 * ks + 8 * q);
#pragma unroll
            for (int kti = 0; kti < 9; ++kti) { f32x4 s = {0.f, 0.f, 0.f, 0.f};
#pragma unroll
                for (int ks = 0; ks < 2; ++ks) { const bf16x8 a = *(const LAS bf16x8*)(kbase + 16 * kti * KS + 32 * ks); s = MFMA16(a, qf[ks], s); }
                *(LAS f32x4*)(swr + 16 * kti) = s; }
            LDSWAIT();
            { const float sink = sinks[j]; const LAS float* bt = BT + j * 128;
                int zz; asm volatile("v_mov_b32 %0, 0" : "=v"(zz));
                const int rowz = row + zz; const int klo = (qb > 0) ? (rowz + 1) : max(rowz + 1, 128 - 16 * w), khi = rowz + 128;
                float lg[40]; float mx = sink;
#pragma unroll
                for (int i4 = 0; i4 < 10; ++i4) { const f32x4 sv = *(const LAS f32x4*)(srd + 4 * i4);
#pragma unroll
                    for (int e = 0; e < 4; ++e) { const int kl = 40 * seg + 4 * i4 + e; const int dist = 128 + rowz - kl; const bool valid = (unsigned)(kl - klo) <= (unsigned)(khi - klo);
                        const int dcl = dist & 127; const float bb = bt[dcl];
                        const float v = valid ? (sv[e] + bb) : -1e30f; lg[4 * i4 + e] = v; mx = fmaxf(mx, v); } }
                mx = fmaxf(mx, __shfl_xor(mx, 1)); mx = fmaxf(mx, __shfl_xor(mx, 2));
                float sum = 0.f;
#pragma unroll
                for (int i = 0; i < 40; ++i) { const float p = (lg[i] > -1e29f) ? fexp(lg[i] - mx) : 0.f; lg[i] = p; sum += p; }
                sum += __shfl_xor(sum, 1); sum += __shfl_xor(sum, 2);
                const float inv = 1.0f / (sum + fexp(sink - mx));
                LDSWAIT();
                LAS bf16_t* Wr = (LAS bf16_t*)(S + row * SS) + 40 * seg;
#pragma unroll
                for (int i8 = 0; i8 < 5; ++i8) { u32x4 o; o.x = pk2(lg[8 * i8 + 0] * inv, lg[8 * i8 + 1] * inv); o.y = pk2(lg[8 * i8 + 2] * inv, lg[8 * i8 + 3] * inv); o.z = pk2(lg[8 * i8 + 4] * inv, lg[8 * i8 + 5] * inv); o.w = pk2(lg[8 * i8 + 6] * inv, lg[8 * i8 + 7] * inv);
                    *(LAS u32x4*)(Wr + 8 * i8) = o; }
            }
            LDSWAIT();
            f32x4 acc[4];
#pragma unroll
            for (int n = 0; n < 4; ++n) acc[n] = (f32x4){0.f, 0.f, 0.f, 0.f};
#pragma unroll
            for (int ks = 0; ks < 5; ++ks) { const bf16x8 bfrag = *(const LAS bf16x8*)(wrd + 32 * ks);
#pragma unroll
                for (int n = 0; n < 4; ++n) { const bf16x8 a = *(const LAS bf16x8*)(vbase + 16 * n * VS + 32 * ks); acc[n] = MFMA16(a, bfrag, acc[n]); } }
            LDSWAIT();
#pragma unroll
            for (int n = 0; n < 4; ++n) { ssq += ssq4(acc[n]); st4(yrow + j * 64 + 16 * n, acc[n]); }
        }
    }
    ssq += __shfl_xor(ssq, 16); ssq += __shfl_xor(ssq, 32);
    const float rs = rsqrtf(ssq * (1.0f / 256.0f) + EPS);
    VMWAIT();
#pragma unroll 4
    for (int i = 0; i < 16; ++i) rescale4(yrow + 16 * i, rs);
}

__device__ __forceinline__ void mixer_D(LAS unsigned char* L, const bf16_t* proj, bf16_t* ycat, int b, int qb64, int tid, int lane, int w) {
    constexpr int KS = 264, VS = 72, SS = 68, WS = 72;
    const int wv = tid >> 6;
    LAS bf16_t* KL = (LAS bf16_t*)L;
    LAS bf16_t* VT = (LAS bf16_t*)(L + 33792);
    LAS float* S = (LAS float*)(L + 70656) + wv * 16 * SS;
    LAS bf16_t* Wl = (LAS bf16_t*)(L + 105472) + wv * 16 * WS;
    LAS float* RED = (LAS float*)(L + 123904);
    volatile LAS unsigned* FLG = (volatile LAS unsigned*)(L + 124416);
    const int rg = wv & 3, hp = wv >> 2, c = lane & 15, q = lane >> 4;
    const size_t seq0 = (size_t)b * SEQ; const size_t trow = seq0 + qb64 * 64 + 16 * rg + c;
    bf16x8 qf[2][2];
#pragma unroll
    for (int hh = 0; hh < 2; ++hh)
#pragma unroll
        for (int ks = 0; ks < 2; ++ks) qf[hh][ks] = *(const bf16x8*)(proj + trow * DIN + 1280 + (2 * hp + hh) * 64 + 32 * ks + 8 * q);
    f32x4 acc[2][4];
#pragma unroll
    for (int hh = 0; hh < 2; ++hh)
#pragma unroll
        for (int n = 0; n < 4; ++n) acc[hh][n] = (f32x4){0.f, 0.f, 0.f, 0.f};
    float carry[2] = {0.f, 0.f};
    const int srow = lane >> 2, seg = lane & 3, qloc = 16 * rg + srow;
    const LAS bf16_t* kbase = KL + c * KS + hp * 128 + 8 * q;
    const LAS bf16_t* vbase = VT + (hp * 128 + c) * VS + 8 * q;
    LAS float* swr = S + c * SS + 4 * q;
    const LAS float* srd = S + srow * SS + 16 * seg;
    LAS bf16_t* wwr = Wl + srow * WS + 16 * seg;
    const LAS bf16_t* wrd = Wl + c * WS + 8 * q;
    const int skey = tid >> 3, spart = tid & 7;
    const bf16_t* ksrc0 = proj + (seq0 + skey) * DIN + 1536 + spart * 32;
    LAS bf16_t* kdst = KL + skey * KS + spart * 32;
    LAS bf16_t* vdst = VT + (spart * 32) * VS + skey;
    if (tid < 2) FLG[tid] = 0u;
    int it = 0;
#pragma unroll 1
    for (int kt = qb64; kt >= 0; --kt, ++it) {
        __syncthreads();
        if (it > 0 && FLG[(it - 1) & 1] == 0u) break;
        {
            const bf16_t* ksrc = ksrc0 + (size_t)kt * 64 * DIN;
            const bf16_t* vsrc = ksrc + 256;
#pragma unroll
            for (int i = 0; i < 4; ++i) { const u32x4 kk = *(const u32x4*)(ksrc + 8 * i), vv = *(const u32x4*)(vsrc + 8 * i);
                *(LAS u32x4*)(kdst + 8 * i) = kk;
                vdst[(8 * i + 0) * VS] = (bf16_t)(vv.x & 0xffffu); vdst[(8 * i + 1) * VS] = (bf16_t)(vv.x >> 16); vdst[(8 * i + 2) * VS] = (bf16_t)(vv.y & 0xffffu); vdst[(8 * i + 3) * VS] = (bf16_t)(vv.y >> 16);
                vdst[(8 * i + 4) * VS] = (bf16_t)(vv.z & 0xffffu); vdst[(8 * i + 5) * VS] = (bf16_t)(vv.z >> 16); vdst[(8 * i + 6) * VS] = (bf16_t)(vv.w & 0xffffu); vdst[(8 * i + 7) * VS] = (bf16_t)(vv.w >> 16); }
        }
        __syncthreads();
        if (tid == 0) FLG[(it + 1) & 1] = 0u;
        const bool diag = (kt == qb64);
#pragma unroll
        for (int hh = 0; hh < 2; ++hh) {
#pragma unroll
            for (int kti = 0; kti < 4; ++kti) { f32x4 s = {0.f, 0.f, 0.f, 0.f};
#pragma unroll
                for (int ks = 0; ks < 2; ++ks) { const bf16x8 a = *(const LAS bf16x8*)(kbase + 16 * kti * KS + hh * 64 + 32 * ks); s = MFMA16(a, qf[hh][ks], s); }
                *(LAS f32x4*)(swr + 16 * kti) = s; }
            LDSWAIT();
            {
                float z[16], cs[16];
#pragma unroll
                for (int i4 = 0; i4 < 4; ++i4) { const f32x4 sv = *(const LAS f32x4*)(srd + 4 * i4); z[4 * i4 + 0] = sv[0]; z[4 * i4 + 1] = sv[1]; z[4 * i4 + 2] = sv[2]; z[4 * i4 + 3] = sv[3]; }
                float run = 0.f;
#pragma unroll
                for (int i = 15; i >= 0; --i) { const bool valid = !diag || (16 * seg + i < qloc);
                    const float zz = z[i]; const float e = fexp(-fabsf(zz)); const float sp = fmaxf(zz, 0.f) + __logf(1.0f + e);
                    run += valid ? sp : 0.f; cs[i] = run; }
                const int lb = lane & ~3;
                const float t0 = __shfl(run, lb + 0), t1 = __shfl(run, lb + 1), t2 = __shfl(run, lb + 2), t3 = __shfl(run, lb + 3);
                const float off = carry[hh] + (seg < 1 ? t1 : 0.f) + (seg < 2 ? t2 : 0.f) + (seg < 3 ? t3 : 0.f);
                carry[hh] += (t0 + t1) + (t2 + t3);
                float wvv[16];
#pragma unroll
                for (int i = 0; i < 16; ++i) { const bool valid = !diag || (16 * seg + i < qloc); wvv[i] = valid ? fexp(z[i] - (off + cs[i])) : 0.f; }
                u32x4 o0, o1; o0.x = pk2(wvv[0], wvv[1]); o0.y = pk2(wvv[2], wvv[3]); o0.z = pk2(wvv[4], wvv[5]); o0.w = pk2(wvv[6], wvv[7]); o1.x = pk2(wvv[8], wvv[9]); o1.y = pk2(wvv[10], wvv[11]); o1.z = pk2(wvv[12], wvv[13]); o1.w = pk2(wvv[14], wvv[15]);
                *(LAS u32x4*)(wwr) = o0; *(LAS u32x4*)(wwr + 8) = o1;
            }
            LDSWAIT();
#pragma unroll
            for (int ks = 0; ks < 2; ++ks) { const bf16x8 bfrag = *(const LAS bf16x8*)(wrd + 32 * ks);
#pragma unroll
                for (int n = 0; n < 4; ++n) { const bf16x8 a = *(const LAS bf16x8*)(vbase + (hh * 64 + 16 * n) * VS + 32 * ks); acc[hh][n] = MFMA16(a, bfrag, acc[hh][n]); } }
            LDSWAIT();
        }
        if (__builtin_amdgcn_ballot_w64(fminf(carry[0], carry[1]) < 32.0f) != 0ull) { if (lane == 0) FLG[it & 1] = 1u; }
    }
    float ssq = 0.f;
#pragma unroll
    for (int hh = 0; hh < 2; ++hh)
#pragma unroll
        for (int n = 0; n < 4; ++n) ssq += ssq4(acc[hh][n]);
    ssq += __shfl_xor(ssq, 16); ssq += __shfl_xor(ssq, 32);
    __syncthreads();
    if (q == 0) RED[(16 * rg + c) * 2 + hp] = ssq;
    __syncthreads();
    const float tot = RED[(16 * rg + c) * 2 + 0] + RED[(16 * rg + c) * 2 + 1];
    const float rs = rsqrtf(tot * (1.0f / 256.0f) + EPS);
    bf16_t* yrow = ycat + trow * DM + 768 + hp * 128 + 4 * q;
#pragma unroll
    for (int hh = 0; hh < 2; ++hh)
#pragma unroll
        for (int n = 0; n < 4; ++n) st4(yrow + hh * 64 + 16 * n, acc[hh][n] * rs);
}

#define XB_TMO      128
#define XB_XCNT(j)  (256  + 64 * (j))
#define XB_XSUB(j)  (1280 + 64 * (j))
#define XB_XGEN(j)  (2304 + 64 * (j))
#define XB_TOP      3328
#define XB_TOPGEN   3392
#define XCD_BAR_WORDS 3456
#define XB_SPIN_CAP (1u << 18)

__device__ __forceinline__ unsigned xb_ld(unsigned* p)              { return __hip_atomic_load(p, __ATOMIC_RELAXED, __HIP_MEMORY_SCOPE_AGENT); }
__device__ __forceinline__ unsigned xb_add(unsigned* p, unsigned v) { return __hip_atomic_fetch_add(p, v, __ATOMIC_RELAXED, __HIP_MEMORY_SCOPE_AGENT); }
__device__ __forceinline__ unsigned xb_xcc_id() { return (unsigned)__builtin_amdgcn_s_getreg((3 << 11) | 20) & 0xFu; }
#define XB_SPIN(cond, bar) do { unsigned _sp = 0; while (cond) { __builtin_amdgcn_s_sleep(1); \
    if ((++_sp & 255u) == 0u) { if (xb_ld(&(bar)[XB_TMO])) break; if (_sp > XB_SPIN_CAP) { atomicAdd(&(bar)[XB_TMO], 1u); break; } } } } while (0)

struct XcdBarrier {
    unsigned* bar; unsigned x;
    volatile LAS unsigned* st;
};

__device__ __forceinline__ XcdBarrier xcd_barrier_post(unsigned* bar, volatile LAS unsigned* st) {
    XcdBarrier b; b.bar = bar; b.x = xb_xcc_id(); b.st = st;
    if (threadIdx.x == 0) (void)xb_add(&bar[XB_XCNT(b.x)], 1u);
    return b;
}
__device__ __forceinline__ void xcd_barrier_complete(unsigned* bar, unsigned x, unsigned& nloc, unsigned& nx) {
    const unsigned G = gridDim.x * gridDim.y * gridDim.z;
    unsigned sum, cnt, mine, sp = 0u;
    for (;;) {
        sum = 0u; cnt = 0u; mine = 0u;
#pragma unroll
        for (unsigned j = 0; j < 16; ++j) { const unsigned c = xb_ld(&bar[XB_XCNT(j)]); sum += c; cnt += (c > 0u) ? 1u : 0u; mine = (j == x) ? c : mine; }
        if (sum == G) break;
        __builtin_amdgcn_s_sleep(1);
        if ((++sp & 255u) == 0u) { if (xb_ld(&bar[XB_TMO])) break; if (sp > XB_SPIN_CAP) { atomicAdd(&bar[XB_TMO], 1u); break; } }
    }
    nloc = mine > 0u ? mine : 1u; nx = cnt > 0u ? cnt : 1u;
}

__device__ __forceinline__ void xcd_barrier(const XcdBarrier& b) {
    asm volatile("s_waitcnt vmcnt(0)" ::: "memory");
    __syncthreads();
    if (threadIdx.x == 0) {
        unsigned* bar = b.bar;
        __builtin_amdgcn_s_waitcnt(0);
        unsigned nloc = b.st[0], nx = b.st[1];
        if (nloc == 0u) { xcd_barrier_complete(bar, b.x, nloc, nx); b.st[0] = nloc; b.st[1] = nx; }
        const unsigned old = xb_add(&bar[XB_XSUB(b.x)], 1u);
        const unsigned gen = old / nloc;
        if (old + 1u == (gen + 1u) * nloc) {
            __builtin_amdgcn_fence(__ATOMIC_RELEASE, "agent");
            asm volatile("s_waitcnt vmcnt(0)" ::: "memory");
            const unsigned og = xb_add(&bar[XB_TOP], 1u);
            const unsigned tg = og / nx;
            if (og + 1u == (tg + 1u) * nx) xb_add(&bar[XB_TOPGEN], 1u);
            else XB_SPIN(xb_ld(&bar[XB_TOPGEN]) == tg, bar);
            __builtin_amdgcn_fence(__ATOMIC_ACQUIRE, "agent");
            xb_add(&bar[XB_XGEN(b.x)], 1u);
            asm volatile("s_waitcnt vmcnt(0)" ::: "memory");
        } else {
            XB_SPIN(xb_ld(&bar[XB_XGEN(b.x)]) == gen, bar);
            __builtin_amdgcn_fence(__ATOMIC_ACQUIRE, "agent");
            asm volatile("s_waitcnt vmcnt(0)" ::: "memory");
        }
    }
    __syncthreads();
}

#ifndef REP_SYNC
#define REP_SYNC 1
#endif
#define GSYNC() do { for (int _r = 0; _r < REP_SYNC; ++_r) xcd_barrier(xbar); } while (0)
__global__ void __launch_bounds__(NTHR, 2) fwd_megakernel(Params p) {
    extern __shared__ __attribute__((aligned(16))) unsigned char lds[];
    cg::grid_group grid = cg::this_grid();
    LAS unsigned char* L = (LAS unsigned char*)lds;
    const int tid = threadIdx.x, lane = tid & 63, wave = __builtin_amdgcn_readfirstlane(tid >> 6);
    const int G = gridDim.x, bx = blockIdx.x;
    unsigned char* ws = p.ws;
    bf16_t* Win_t = (bf16_t*)(ws + WS_WIN); bf16_t* Wout_t = (bf16_t*)(ws + WS_WOUT); bf16_t* Wgu_t = (bf16_t*)(ws + WS_WGU); bf16_t* Wdn_t = (bf16_t*)(ws + WS_WDN);
    bf16_t* SGUW = (bf16_t*)(ws + WS_SGUW); bf16_t* PWT = (bf16_t*)(ws + WS_PWT); float* SSQ = (float*)(ws + WS_SS);
    bf16_t* XB = (bf16_t*)(ws + WS_XB); bf16_t* PROJ = (bf16_t*)(ws + WS_PROJ); bf16_t* YCAT = (bf16_t*)(ws + WS_YCAT); bf16_t* HID = (bf16_t*)(ws + WS_HID);

    volatile LAS unsigned* xst = (volatile LAS unsigned*)(L + LDS_BYTES - 16);
    if (tid < 4) xst[tid] = 0u;
    unsigned* barw = (unsigned*)(ws + WS_BAR);
    if (bx == 0) for (int i = tid; i < XCD_BAR_WORDS; i += NTHR) __hip_atomic_store(barw + i, 0u, __ATOMIC_RELAXED, __HIP_MEMORY_SCOPE_AGENT);
#ifndef REP_P0
#define REP_P0 1
#endif
    for (int rep0 = 0; rep0 < REP_P0; ++rep0) {
        LAS float* scr = (LAS float*)(L + wave * 16384);
        const int gw = bx * 8 + wave, NGW = G * 8;
        constexpr int I_IN = (DM / 64) * (DIN / 32), I_OUT = (DM / 64) * (DM / 32), I_GU = (DM / 64) * (2 * DFF / 32), I_DN = (DFF / 64) * (DM / 32), I_L = I_IN + I_OUT + I_GU + I_DN;
        for (int it = gw; it < DEPTH * I_L; it += NGW) {
            const int l = it / I_L; int r = it % I_L;
            if (r < I_IN) { transpose_item(p.w_in + (size_t)l * DM * DIN, DM, DIN, Win_t + (size_t)l * DIN * DM, p.norm_mix + l * DM, 1, scr, r, lane); continue; } r -= I_IN;
            if (r < I_OUT) { transpose_item(p.w_out + (size_t)l * DM * DM, DM, DM, Wout_t + (size_t)l * DM * DM, p.mix_out_gain + l * DM, 0, scr, r, lane); continue; } r -= I_OUT;
            if (r < I_GU) { transpose_item(p.w_gate_up + (size_t)l * DM * 2 * DFF, DM, 2 * DFF, Wgu_t + (size_t)l * 2 * DFF * DM, p.norm_ffn + l * DM, 2, scr, r, lane); continue; } r -= I_GU;
            transpose_item(p.w_down + (size_t)l * DFF * DM, DFF, DM, Wdn_t + (size_t)l * DM * DFF, nullptr, 0, scr, r, lane);
        }
        for (int m = 2 * gw; m < M; m += 2 * NGW) {
            const f32x4* xr = (const f32x4*)(p.x + (size_t)m * DM) + lane; u32x2* o8 = (u32x2*)(XB + (size_t)m * DM) + lane; f32x4 v[2][4];
#pragma unroll
            for (int r = 0; r < 2; ++r)
#pragma unroll
                for (int j = 0; j < 4; ++j) v[r][j] = __builtin_nontemporal_load(xr + r * 256 + 64 * j);
#pragma unroll
            for (int r = 0; r < 2; ++r) { float s = 0.f;
#pragma unroll
                for (int j = 0; j < 4; ++j) { const f32x4 t = v[r][j]; s += ssq4(t); u32x2 o; o.x = pk2(t.x, t.y); o.y = pk2(t.z, t.w); o8[r * 256 + 64 * j] = o; }
                s = wave_sum(s);
                if (lane < 4) SSQ[(size_t)(m + r) * 4 + lane] = (lane == 0) ? s : 0.f; }
        }
        const int gt = bx * NTHR + tid, NGT = G * NTHR;
        for (int e = gt; e < DEPTH * 4 * 128 * 128 / 8; e += NGT) { const int s0 = (e & 15) * 8, t = (e >> 4) & 127; const float* src = p.sgu_w + (size_t)e * 8;
            const f32x4 a = *(const f32x4*)src, bq = *(const f32x4*)(src + 4); float v[8] = {a.x, a.y, a.z, a.w, bq.x, bq.y, bq.z, bq.w};
#pragma unroll
            for (int i = 0; i < 8; ++i) v[i] = (s0 + i <= t) ? v[i] : 0.f;
            u32x4 o; o.x = pk2(v[0], v[1]); o.y = pk2(v[2], v[3]); o.z = pk2(v[4], v[5]); o.w = pk2(v[6], v[7]); *(u32x4*)(SGUW + (size_t)e * 8) = o; }
        for (int e = gt; e < DEPTH * 4 * 64 * 64; e += NGT) { const int cc = e & 63, d = (e >> 6) & 63, lg = e >> 12; PWT[e] = f2bf(p.pool_w[((size_t)lg * 64 + cc) * 64 + d]); }
    }
    grid.sync();
    const XcdBarrier xbar = xcd_barrier_post(barw, xst);

    for (int l = 0; l < DEPTH; ++l) {
#ifndef REP_P1
#define REP_P1 1
#endif
#ifndef NO_P1
        for (int rep = 0; rep < REP_P1; ++rep) { int zk; asm volatile("s_mov_b32 %0, 0" : "=s"(zk)); pg8::Gemm g{XB, Win_t + (size_t)l * DIN * DM, M, DIN, DM + zk}; pg8::StaticOrder S; S.init(M, DIN, G + zk, bx); pg8::EpiIn E{PROJ, SSQ};
          pg8::gemm_phase<pg8::EpiIn, pg8::StaticOrder, true, true>(L, g, S, E, zk); }
#endif
        GSYNC();
#ifndef REP_MIX
#define REP_MIX 1
#endif
#ifndef REP_D
#define REP_D 1
#endif
        for (int rep = 0; rep < REP_MIX; ++rep)
        for (int u = bx; u < 256; u += G) { const int b = u >> 4, ch = u & 15;
            __syncthreads();
#ifndef NO_A
            { int zt; asm volatile("v_mov_b32 %0, 0" : "=v"(zt)); const int t2 = tid + zt; mixer_A(L, PROJ, SGUW + (size_t)l * 4 * 128 * 128, p.sgu_b + l * 4 * 128, YCAT, b, ch, t2, t2 & 63, __builtin_amdgcn_readfirstlane(t2 >> 6)); }
#endif
            __syncthreads();
#ifndef NO_B
            { int zt; asm volatile("v_mov_b32 %0, 0" : "=v"(zt)); const int t2 = tid + zt; mixer_B(L, PROJ, PWT + (size_t)l * 4 * 64 * 64, p.pool_scale + l * 256, YCAT, b, ch, t2, t2 & 63, __builtin_amdgcn_readfirstlane(t2 >> 6)); }
#endif
            __syncthreads();
#ifndef NO_C
            { int zt; asm volatile("v_mov_b32 %0, 0" : "=v"(zt)); const int t2 = tid + zt; mixer_C(L, PROJ, p.swa_sinks + l * 4, p.rel_bias, YCAT, b, ch, t2, t2 & 63, __builtin_amdgcn_readfirstlane(t2 >> 6)); }
#endif
            __syncthreads();
#ifndef NO_D
#pragma unroll 1
            for (int hf = 0; hf < 2 * REP_D; ++hf) { int zt; asm volatile("v_mov_b32 %0, 0" : "=v"(zt)); const int t2 = tid + zt; mixer_D(L, PROJ, YCAT, b, (hf & 1) ? 31 - ch : ch, t2, t2 & 63, __builtin_amdgcn_readfirstlane(t2 >> 6)); __syncthreads(); }
#endif
        }
        GSYNC();
#ifndef NO_P3
        { int zk; asm volatile("s_mov_b32 %0, 0" : "=s"(zk)); pg8::Gemm g{YCAT, Wout_t + (size_t)l * DM * DM, M, DM, DM + zk}; pg8::StaticOrder S; S.init(M, DM, G + zk, bx); pg8::EpiRes E{l == 0 ? p.x : nullptr, nullptr, XB, SSQ, (LAS float*)(L + 131072)};
          pg8::gemm_phase<pg8::EpiRes, pg8::StaticOrder, true, true>(L, g, S, E, zk); }
#endif
        GSYNC();
#ifndef REP_P4
#define REP_P4 1
#endif
#ifndef NO_P4
        for (int rep = 0; rep < REP_P4; ++rep) { int zk; asm volatile("s_mov_b32 %0, 0" : "=s"(zk)); pg8::Gemm g{XB, Wgu_t + (size_t)l * 2 * DFF * DM, M, 2 * DFF, DM + zk}; pg8::StaticOrder S; S.init(M, 2 * DFF, G + zk, bx); pg8::EpiGU E{HID, SSQ};
          pg8::gemm_phase<pg8::EpiGU, pg8::StaticOrder, true, true>(L, g, S, E, zk); }
#endif
        GSYNC();
#ifndef NO_P5
        { int zk; asm volatile("s_mov_b32 %0, 0" : "=s"(zk)); pg8::Gemm g{HID, Wdn_t + (size_t)l * DM * DFF, M, DM, DFF + zk}; pg8::StaticOrder S; S.init(M, DM, G + zk, bx); pg8::EpiRes E{nullptr, l == DEPTH - 1 ? p.out : nullptr, XB, SSQ, (LAS float*)(L + 131072)};
          pg8::gemm_phase<pg8::EpiRes, pg8::StaticOrder, true, true>(L, g, S, E, zk); }
#endif
        GSYNC();
    }
    {
        const int gw = bx * 8 + wave, NGW = G * 8;
        for (int m = gw; m < M; m += NGW) { const float rs = rstd_of(SSQ, m); f32x4* xr = (f32x4*)(p.out + (size_t)m * DM) + lane; const f32x4* gr = (const f32x4*)p.norm_final + lane;
#pragma unroll
            for (int j = 0; j < 4; ++j) { const f32x4 v = xr[64 * j], gg = gr[64 * j]; xr[64 * j] = v * rs * gg; } }
    }
}

extern "C" void kernel_launch(void* const* d_in, const int* in_sizes, int n_in, void* d_out, int out_size, void* d_ws, size_t ws_size, hipStream_t stream) {
    static int grid_blocks = 0;
    if (grid_blocks == 0) {
        if (n_in != 15 || in_sizes[0] != M * DM || out_size != M * DM || ws_size < WS_END) { fprintf(stderr, "kernel_launch: unexpected shapes (n_in %d, in0 %d, out %d, ws %zu)\n", n_in, n_in > 0 ? in_sizes[0] : -1, out_size, ws_size); grid_blocks = -1; return; }
        int dev = 0, cus = 0, per_cu = 0;
        hipGetDevice(&dev); hipDeviceGetAttribute(&cus, hipDeviceAttributeMultiprocessorCount, dev);
        if (hipFuncSetAttribute((const void*)fwd_megakernel, hipFuncAttributeMaxDynamicSharedMemorySize, LDS_BYTES) != hipSuccess) { fprintf(stderr, "kernel_launch: hipFuncSetAttribute failed\n"); }
        if (hipOccupancyMaxActiveBlocksPerMultiprocessor(&per_cu, (const void*)fwd_megakernel, NTHR, LDS_BYTES) != hipSuccess || per_cu < 1) { fprintf(stderr, "kernel_launch: occupancy query says %d\n", per_cu); per_cu = 1; }
        (void)hipGetLastError();
        grid_blocks = cus * 1;
        if (grid_blocks <= 0) grid_blocks = 256;
    }
    if (grid_blocks < 0) return;
    Params p{};
    p.x = (const float*)d_in[0]; p.w_in = (const float*)d_in[1]; p.w_out = (const float*)d_in[2]; p.sgu_w = (const float*)d_in[3]; p.sgu_b = (const float*)d_in[4];
    p.pool_w = (const float*)d_in[5]; p.pool_scale = (const float*)d_in[6]; p.swa_sinks = (const float*)d_in[7]; p.rel_bias = (const float*)d_in[8]; p.mix_out_gain = (const float*)d_in[9];
    p.norm_mix = (const float*)d_in[10]; p.norm_ffn = (const float*)d_in[11]; p.w_gate_up = (const float*)d_in[12]; p.w_down = (const float*)d_in[13]; p.norm_final = (const float*)d_in[14];
    p.out = (float*)d_out; p.ws = (unsigned char*)d_ws;
    void* args[] = {&p};
    hipError_t e = hipLaunchCooperativeKernel((const void*)fwd_megakernel, dim3(grid_blocks), dim3(NTHR), args, LDS_BYTES, stream);
    if (e != hipSuccess) fprintf(stderr, "cooperative launch failed: %s (grid %d)\n", hipGetErrorString(e), grid_blocks);
}
```

```cpp
#include <hip/hip_runtime.h>
#include <hip/hip_cooperative_groups.h>
#include <cstdio>
#include <cstdint>
namespace cg = cooperative_groups;
namespace pg8 {
#define PG8_LAS __attribute__((address_space(3)))
typedef unsigned short bf16_t;
typedef short bf16x8 __attribute__((ext_vector_type(8)));
typedef float f32x4 __attribute__((ext_vector_type(4)));
typedef unsigned u32x4 __attribute__((ext_vector_type(4)));
constexpr int BM = 256, BK = 64, HALF = 128, HTB = HALF * BK * 2  , STAGE_BYTES = 8 * HTB, NXCD = 8, WGM = 8;

__host__ __device__ __forceinline__ int lds_byte(int r, int c) { const int st = (r >> 4) * 2 + (c >> 5), rr = r & 15, cc = c & 31, ob = rr * 64 + cc * 2; return st * 1024 + (ob ^ (((ob >> 9) & 1) << 5)); }
__host__ __device__ __forceinline__ void stage_rc(int b, int& R, int& C) { const int st = b / 1024, sb = b % 1024, swz = sb ^ (((sb >> 9) & 1) << 5); R = (st >> 1) * 16 + swz / 64; C = (st & 1) * 32 + (swz % 64) / 2; }
__host__ __device__ __forceinline__ int perm32(int rho) { const int n = rho >> 4, i = rho & 15; return 8 * (i >> 2) + 4 * n + (i & 3); }

struct Unit { int pm, pn; };
struct Gemm { const bf16_t* A; const bf16_t* Bt; int M, N, K; };

struct StaticOrder {
    int nM, nN, nwg, G, c;
    __host__ __device__ void init(int M, int N, int G_, int c_) { nM = M / BM; nN = N / BM; nwg = nM * nN; G = G_; c = c_; }
    __host__ __device__ bool next(int i, Unit& u) const {
        const long L = (long)i * G + c; if (L >= nwg) return false;
        int wgid = (int)L; { const int q = nwg / NXCD, r = nwg % NXCD, xcd = wgid % NXCD, off = wgid / NXCD; wgid = (xcd < r ? xcd * (q + 1) : r * (q + 1) + (xcd - r) * q) + off; }
        const int nig = WGM * nN, gid = wgid / nig, fm = gid * WGM, gsz = (nM - fm) < WGM ? (nM - fm) : WGM;
        u.pm = fm + ((wgid % nig) % gsz); u.pn = (wgid % nig) / gsz; return true;
    }
    __device__ __forceinline__ void a_ready(const Unit&) const {}
    __device__ __forceinline__ void done(const Unit&) const {}
};

__device__ __forceinline__ unsigned cvt_pk_bf16(float lo, float hi) { unsigned r; asm volatile("v_cvt_pk_bf16_f32 %0, %1, %2" : "=v"(r) : "v"(lo), "v"(hi)); return r; }
typedef float f32x2 __attribute__((ext_vector_type(2)));
template <class Epi, class Sched, bool ALIGN_EPI = false, bool SP2 = false>
__device__ __forceinline__ void gemm_phase(PG8_LAS unsigned char* lds, const Gemm g, const Sched& S, const Epi& E, const int opq) {
    const int tid = threadIdx.x + opq, wid = __builtin_amdgcn_readfirstlane(tid >> 6), lane = tid & 63, wr = wid >> 2, wc = wid & 3, fr = lane & 15, fq = lane >> 4;
    const int K = g.K, nt = K / BK;
    unsigned voffA[2], voffB[2];
#pragma unroll
    for (int i = 0; i < 2; ++i) { int R, C; stage_rc(tid * 16 + i * 8192, R, C); const int Rb = Epi::PERM ? ((R & ~31) + perm32(R & 31)) : R;
        voffA[i] = (unsigned)(R * K + C) * 2u; voffB[i] = (unsigned)(Rb * K + C) * 2u; }
    const size_t kstep = (size_t)(BK * 2);
    const size_t hstep = (size_t)HALF * K * 2;
    const size_t tstep = 2 * hstep;
    const unsigned ldsw = (unsigned)wid * 1024u;
    const int aoff = lds_byte(wr * 64 + fr, fq * 8), boff = lds_byte(wc * 32 + fr, fq * 8);
#define PG8_SA(b, h) (((b) * 2 + (h)) * HTB)
#define PG8_SB(b, h) ((4 + (b) * 2 + (h)) * HTB)
#define PG8_STAGE(bufoff, gbase, voff) do { _Pragma("unroll") for (int _i = 0; _i < 2; ++_i) \
        __builtin_amdgcn_global_load_lds((const unsigned*)((const char*)(gbase) + (voff)[_i]), (PG8_LAS unsigned*)(lds + (bufoff) + ldsw + _i * 8192), 16, 0, 0); } while (0)
#define PG8_LDA(dst, b, h) do { _Pragma("unroll") for (int m = 0; m < 4; ++m) _Pragma("unroll") for (int k = 0; k < 2; ++k) dst[m][k] = *(const PG8_LAS bf16x8*)(lds + PG8_SA(b, h) + aoff + m * 2048 + k * 1024); } while (0)
#define PG8_LDB(dst, b, h) do { _Pragma("unroll") for (int n = 0; n < 2; ++n) _Pragma("unroll") for (int k = 0; k < 2; ++k) dst[n][k] = *(const PG8_LAS bf16x8*)(lds + PG8_SB(b, h) + boff + n * 2048 + k * 1024); } while (0)
#define PG8_MMA(ai, bj, At, Bt) do { __builtin_amdgcn_s_setprio(1); _Pragma("unroll") for (int m = 0; m < 4; ++m) _Pragma("unroll") for (int n = 0; n < 2; ++n) _Pragma("unroll") for (int k = 0; k < 2; ++k) \
        acc[ai][bj][m][n] = __builtin_amdgcn_mfma_f32_16x16x32_bf16(Bt[n][k], At[m][k], acc[ai][bj][m][n], 0, 0, 0); __builtin_amdgcn_s_setprio(0); } while (0)
#define PG8_WAIT_V(n) asm volatile("s_waitcnt vmcnt(" #n ")" ::: "memory")
#define PG8_WAIT_L(n) asm volatile("s_waitcnt lgkmcnt(" #n ")" ::: "memory")
#define PG8_BAR __builtin_amdgcn_s_barrier()
#define PG8_SCHED __builtin_amdgcn_sched_barrier(0)
    Unit cur, nxt; int ui = 0;
    if (!S.next(0, cur)) return;
    f32x4 acc[2][2][4][2];
#pragma unroll
    for (int a = 0; a < 2; ++a)
#pragma unroll
        for (int b = 0; b < 2; ++b)
#pragma unroll
            for (int m = 0; m < 4; ++m)
#pragma unroll
                for (int n = 0; n < 2; ++n) acc[a][b][m][n] = (f32x4){0.f, 0.f, 0.f, 0.f};
    bf16x8 At[4][2], B0[2][2], B1[2][2];
    const char* cA = (const char*)g.A + (size_t)cur.pm * tstep; const char* cB = (const char*)g.Bt + (size_t)cur.pn * tstep;
    S.a_ready(cur);
    if constexpr (SP2) {
        PG8_STAGE(PG8_SB(0, 0), cB, voffB); PG8_STAGE(PG8_SB(0, 1), cB + hstep, voffB); PG8_STAGE(PG8_SA(0, 0), cA, voffA); PG8_STAGE(PG8_SA(0, 1), cA + hstep, voffA);
        if (wr == 1) PG8_BAR;
        PG8_WAIT_V(2); PG8_BAR;
        PG8_STAGE(PG8_SB(1, 0), cB + kstep, voffB); PG8_STAGE(PG8_SA(1, 0), cA + kstep, voffA); PG8_STAGE(PG8_SB(1, 1), cB + hstep + kstep, voffB);
        PG8_WAIT_V(6); PG8_BAR;
    } else {
        PG8_STAGE(PG8_SB(0, 0), cB, voffB); PG8_STAGE(PG8_SA(0, 0), cA, voffA); PG8_STAGE(PG8_SB(0, 1), cB + hstep, voffB); PG8_STAGE(PG8_SA(0, 1), cA + hstep, voffA);
        if (wr == 1) PG8_BAR;
        PG8_WAIT_V(4); PG8_BAR;
        PG8_STAGE(PG8_SB(1, 0), cB + kstep, voffB); PG8_STAGE(PG8_SA(1, 0), cA + kstep, voffA); PG8_STAGE(PG8_SB(1, 1), cB + hstep + kstep, voffB);
        PG8_WAIT_V(6); PG8_BAR;
    }
    for (;;) {
        const bool has_next = S.next(ui + 1, nxt);
        const char* nA = has_next ? (const char*)g.A + (size_t)nxt.pm * tstep : cA; const char* nB = has_next ? (const char*)g.Bt + (size_t)nxt.pn * tstep : cB;
        for (int t = 0; t < nt; t += 2) {
            const bool last = (t == nt - 2);
            const char* a1 = cA + (size_t)(t + 1) * kstep;
            const char* a2 = last ? nA : cA + (size_t)(t + 2) * kstep; const char* b2 = last ? nB : cB + (size_t)(t + 2) * kstep;
            const char* a3 = a2 + kstep; const char* b3 = b2 + kstep;
            if (last && has_next) S.a_ready(nxt);
            if constexpr (SP2) {
            PG8_LDB(B0, 0, 0); PG8_LDB(B1, 0, 1); PG8_SCHED; PG8_LDA(At, 0, 0); PG8_STAGE(PG8_SA(1, 1), a1 + hstep, voffA);
            PG8_WAIT_V(8); PG8_WAIT_L(0); PG8_BAR; PG8_MMA(0, 0, At, B0); PG8_MMA(0, 1, At, B1); PG8_BAR; PG8_SCHED;
            PG8_LDA(At, 0, 1); PG8_STAGE(PG8_SB(0, 0), b2, voffB); PG8_STAGE(PG8_SB(0, 1), b2 + hstep, voffB); PG8_STAGE(PG8_SA(0, 0), a2, voffA);
            PG8_WAIT_V(8); PG8_WAIT_L(0); PG8_BAR; PG8_MMA(1, 0, At, B0); PG8_MMA(1, 1, At, B1); PG8_BAR; PG8_SCHED;
            PG8_LDB(B0, 1, 0); PG8_LDB(B1, 1, 1); PG8_SCHED; PG8_LDA(At, 1, 0); PG8_STAGE(PG8_SA(0, 1), a2 + hstep, voffA);
            PG8_WAIT_V(8); PG8_WAIT_L(0); PG8_BAR; PG8_MMA(0, 0, At, B0); PG8_MMA(0, 1, At, B1); PG8_BAR; PG8_SCHED;
            PG8_LDA(At, 1, 1); PG8_STAGE(PG8_SB(1, 0), b3, voffB); PG8_STAGE(PG8_SB(1, 1), b3 + hstep, voffB); PG8_STAGE(PG8_SA(1, 0), a3, voffA);
            PG8_WAIT_V(8); PG8_WAIT_L(0); PG8_BAR; PG8_MMA(1, 0, At, B0); PG8_MMA(1, 1, At, B1); PG8_BAR; PG8_SCHED;
            } else {
            PG8_LDB(B0, 0, 0); PG8_SCHED; PG8_LDA(At, 0, 0); PG8_STAGE(PG8_SA(1, 1), a1 + hstep, voffA);
            PG8_WAIT_L(8); PG8_BAR; PG8_WAIT_L(0); PG8_MMA(0, 0, At, B0); PG8_BAR; PG8_SCHED;
            PG8_LDB(B1, 0, 1); PG8_STAGE(PG8_SB(0, 0), b2, voffB);
            PG8_BAR; PG8_WAIT_L(0); PG8_MMA(0, 1, At, B1); PG8_BAR;
            PG8_LDA(At, 0, 1); PG8_STAGE(PG8_SA(0, 0), a2, voffA);
            PG8_BAR; PG8_WAIT_L(0); PG8_MMA(1, 0, At, B0); PG8_BAR; PG8_SCHED;
            PG8_STAGE(PG8_SB(0, 1), b2 + hstep, voffB);
            PG8_WAIT_V(6); PG8_BAR; PG8_MMA(1, 1, At, B1); PG8_BAR;
            PG8_LDB(B0, 1, 0); PG8_SCHED; PG8_LDA(At, 1, 0); PG8_STAGE(PG8_SA(0, 1), a2 + hstep, voffA);
            PG8_WAIT_L(8); PG8_BAR; PG8_WAIT_L(0); PG8_MMA(0, 0, At, B0); PG8_BAR; PG8_SCHED;
            PG8_LDB(B1, 1, 1); PG8_STAGE(PG8_SB(1, 0), b3, voffB);
            PG8_BAR; PG8_WAIT_L(0); PG8_MMA(0, 1, At, B1); PG8_BAR;
            PG8_LDA(At, 1, 1); PG8_STAGE(PG8_SA(1, 0), a3, voffA);
            PG8_BAR; PG8_WAIT_L(0); PG8_MMA(1, 0, At, B0); PG8_BAR; PG8_SCHED;
            PG8_STAGE(PG8_SB(1, 1), b3 + hstep, voffB);
            PG8_WAIT_V(6); PG8_BAR; PG8_MMA(1, 1, At, B1); PG8_BAR;
            }
        }
        if constexpr (ALIGN_EPI) { if (wr == 0) PG8_BAR; }
        if constexpr (!Epi::AFTER_DRAIN) { E(acc, cur, wr, wc, fr, fq); S.done(cur); }
        if (!has_next) break;
#pragma unroll
        for (int a = 0; a < 2; ++a)
#pragma unroll
            for (int b = 0; b < 2; ++b)
#pragma unroll
                for (int m = 0; m < 4; ++m)
#pragma unroll
                    for (int n = 0; n < 2; ++n) acc[a][b][m][n] = (f32x4){0.f, 0.f, 0.f, 0.f};
        cur = nxt; cA = nA; cB = nB; ++ui;
        if constexpr (ALIGN_EPI) { if (wr == 1) PG8_BAR; }
    }
    PG8_WAIT_V(0);
    if constexpr (!ALIGN_EPI) { if (wr == 0) PG8_BAR; }
    PG8_BAR;
    if constexpr (Epi::AFTER_DRAIN) { E.fused(acc, cur, wr, wc, fr, fq, lds, wid, lane); S.done(cur); }
#undef PG8_SA
#undef PG8_SB
#undef PG8_STAGE
#undef PG8_LDA
#undef PG8_LDB
#undef PG8_MMA
#undef PG8_WAIT_V
#undef PG8_WAIT_L
#undef PG8_BAR
#undef PG8_SCHED
}
}

constexpr int NB = 16, SEQ = 2048, DM = 1024, DEPTH = 4, DIN = 2048, DFF = 2816, M = NB * SEQ;
constexpr float EPS = 1e-6f;
constexpr size_t MiB = 1u << 20;
constexpr size_t WS_WIN = 0, WS_WOUT = 16 * MiB, WS_WGU = 24 * MiB, WS_WDN = 68 * MiB, WS_SGUW = 90 * MiB, WS_PWT = 90 * MiB + 512 * 1024,
                 WS_SS = 91 * MiB, WS_BAR = 93 * MiB, WS_XB = 96 * MiB, WS_PROJ = 160 * MiB, WS_YCAT = 288 * MiB, WS_HID = 160 * MiB, WS_END = 352 * MiB;
constexpr int LDS_BYTES = 160 * 1024;
constexpr int NTHR = 512;

#define LAS __attribute__((address_space(3)))
typedef unsigned short bf16_t;
typedef short bf16x8 __attribute__((ext_vector_type(8)));
typedef float f32x4 __attribute__((ext_vector_type(4)));
typedef float f32x2 __attribute__((ext_vector_type(2)));
typedef unsigned u32x4 __attribute__((ext_vector_type(4)));
typedef unsigned u32x2 __attribute__((ext_vector_type(2)));
typedef __bf16 bf16x2_t __attribute__((ext_vector_type(2)));

__device__ __forceinline__ unsigned pk2(float lo, float hi) { f32x2 v = {lo, hi}; bf16x2_t b = __builtin_convertvector(v, bf16x2_t); return __builtin_bit_cast(unsigned, b); }
__device__ __forceinline__ bf16_t f2bf(float f) { return (bf16_t)(pk2(f, 0.f) & 0xffffu); }
__device__ __forceinline__ float bflo(unsigned w) { return __uint_as_float(w << 16); }
__device__ __forceinline__ float bfhi(unsigned w) { return __uint_as_float(w & 0xffff0000u); }
#define MFMA16(a, b, c) __builtin_amdgcn_mfma_f32_16x16x32_bf16((a), (b), (c), 0, 0, 0)
#define CFENCE() asm volatile("" ::: "memory")
#define LDSWAIT() asm volatile("s_waitcnt lgkmcnt(0)" ::: "memory")
__device__ __forceinline__ float fexp(float x) { return __builtin_amdgcn_exp2f(x * 1.4426950408889634f); }
__device__ __forceinline__ float gelu_tanh(float x) {
    const float u2 = 1.5957691216057308f * x * (1.0f + 0.044715f * x * x);
    return x * __builtin_amdgcn_rcpf(1.0f + fexp(-u2));
}
__device__ __forceinline__ float rstd_of1(const float* ss, int row) {
    const f32x4 s = *(const f32x4*)(ss + (size_t)row * 4); return rsqrtf(((s.x + s.y) + (s.z + s.w)) * (1.0f / 1024.0f) + EPS);
}

__device__ __forceinline__ float ssq4(const f32x4 y) { return (y[0] * y[0] + y[1] * y[1]) + (y[2] * y[2] + y[3] * y[3]); }

#ifdef PROBE_RSTD2
__device__ __forceinline__ float rstd_of(const float* ss, int row) { const float a = rstd_of1(ss, row); int z; asm volatile("v_mov_b32 %0, 0" : "=v"(z) : "v"(a)); const float b = rstd_of1(ss, row + z); return (a + b) * 0.5f; }
#else
__device__ __forceinline__ float rstd_of(const float* ss, int row) { return rstd_of1(ss, row); }
#endif
namespace pg8 {
struct EpiIn {
    static constexpr bool PERM = true, AFTER_DRAIN = false;
    bf16_t* O; const float* ss;
    __device__ __forceinline__ void operator()(const f32x4 (&acc)[2][2][4][2], const Unit& u, int wr, int wc, int fr, int fq) const {
        const int row0 = u.pm * BM + wr * 64 + fr, col0 = u.pn * BM + wc * 32 + 8 * fq; const bool act = u.pn < 2;
        float rsv[2][4];
#pragma unroll
        for (int ai = 0; ai < 2; ++ai)
#pragma unroll
            for (int m = 0; m < 4; ++m) rsv[ai][m] = rstd_of(ss, row0 + ai * HALF + m * 16);
#pragma unroll
        for (int ai = 0; ai < 2; ++ai)
#pragma unroll
            for (int m = 0; m < 4; ++m) { const int row = row0 + ai * HALF + m * 16; const float rs = rsv[ai][m]; bf16_t* rowp = O + (size_t)row * DIN + col0;
#pragma unroll
                for (int bj = 0; bj < 2; ++bj) { f32x4 v0 = acc[ai][bj][m][0] * rs, v1 = acc[ai][bj][m][1] * rs;
                    if (act) { v0 = (f32x4){gelu_tanh(v0[0]), gelu_tanh(v0[1]), gelu_tanh(v0[2]), gelu_tanh(v0[3])}; v1 = (f32x4){gelu_tanh(v1[0]), gelu_tanh(v1[1]), gelu_tanh(v1[2]), gelu_tanh(v1[3])}; }
                    u32x4 w; w.x = pk2(v0[0], v0[1]); w.y = pk2(v0[2], v0[3]); w.z = pk2(v1[0], v1[1]); w.w = pk2(v1[2], v1[3]);
                    *(u32x4*)(rowp + bj * HALF) = w; }
                if (m & 1) CFENCE(); }
    }
};
struct EpiGU {
    static constexpr bool PERM = true, AFTER_DRAIN = false;
    bf16_t* O; const float* ss;
    __device__ __forceinline__ void operator()(const f32x4 (&acc)[2][2][4][2], const Unit& u, int wr, int wc, int fr, int fq) const {
        const int row0 = u.pm * BM + wr * 64 + fr, col0 = u.pn * HALF + wc * 32 + 8 * fq;
        float rsv[2][4];
#pragma unroll
        for (int ai = 0; ai < 2; ++ai)
#pragma unroll
            for (int m = 0; m < 4; ++m) rsv[ai][m] = rstd_of(ss, row0 + ai * HALF + m * 16);
#pragma unroll
        for (int ai = 0; ai < 2; ++ai)
#pragma unroll
            for (int m = 0; m < 4; ++m) { const int row = row0 + ai * HALF + m * 16; const float rs = rsv[ai][m]; bf16_t* rowp = O + (size_t)row * DFF + col0;
                float h[8];
#pragma unroll
                for (int n = 0; n < 2; ++n)
#pragma unroll
                    for (int e = 0; e < 4; ++e) { const float g = acc[ai][0][m][n][e] * rs, up = acc[ai][1][m][n][e] * rs; h[n * 4 + e] = g * up * __builtin_amdgcn_rcpf(1.0f + fexp(-g)); }
                u32x4 w; w.x = pk2(h[0], h[1]); w.y = pk2(h[2], h[3]); w.z = pk2(h[4], h[5]); w.w = pk2(h[6], h[7]);
                *(u32x4*)rowp = w;
                if (m & 1) CFENCE(); }
    }
};
struct EpiRes {
    static constexpr bool PERM = true, AFTER_DRAIN = false;
    const float* xin32; float* xout32; bf16_t* xb; float* ss; LAS float* P;
    __device__ __forceinline__ void operator()(const f32x4 (&acc)[2][2][4][2], const Unit& u, int wr, int wc, int fr, int fq) const {
        const int row0 = u.pm * BM + wr * 64 + fr, col0 = u.pn * BM + wc * 32 + 8 * fq;
#pragma unroll
        for (int ai = 0; ai < 2; ++ai)
#pragma unroll
            for (int m = 0; m < 4; ++m) { const int row = row0 + ai * HALF + m * 16; const size_t off = (size_t)row * DM + col0; float q = 0.f;
#pragma unroll
                for (int bj = 0; bj < 2; ++bj) { f32x4 r0, r1;
                    if (xin32) { r0 = *(const f32x4*)(xin32 + off + bj * HALF); r1 = *(const f32x4*)(xin32 + off + bj * HALF + 4); }
                    else { const u32x4 t = *(const u32x4*)(xb + off + bj * HALF); r0 = (f32x4){bflo(t.x), bfhi(t.x), bflo(t.y), bfhi(t.y)}; r1 = (f32x4){bflo(t.z), bfhi(t.z), bflo(t.w), bfhi(t.w)}; }
                    const f32x4 v0 = r0 + acc[ai][bj][m][0], v1 = r1 + acc[ai][bj][m][1];
                    q += ssq4(v0) + ssq4(v1);
                    if (xout32) { *(f32x4*)(xout32 + off + bj * HALF) = v0; *(f32x4*)(xout32 + off + bj * HALF + 4) = v1; }
                    else { u32x4 w; w.x = pk2(v0[0], v0[1]); w.y = pk2(v0[2], v0[3]); w.z = pk2(v1[0], v1[1]); w.w = pk2(v1[2], v1[3]); *(u32x4*)(xb + off + bj * HALF) = w; } }
                q += __shfl_xor(q, 16); q += __shfl_xor(q, 32);
                if (fq == 0) P[(ai * HALF + wr * 64 + m * 16 + fr) * 4 + wc] = q;
                if (m & 1) CFENCE(); }
        asm volatile("s_waitcnt lgkmcnt(0)" ::: "memory"); __builtin_amdgcn_s_barrier(); asm volatile("" ::: "memory");
        const int t = wr * 256 + wc * 64 + fq * 16 + fr;
        if (t < 256) { const f32x4 pp = *(const LAS f32x4*)(P + t * 4); ss[(size_t)(u.pm * BM + t) * 4 + u.pn] = (pp.x + pp.y) + (pp.z + pp.w); }
    }
};
}

__device__ __forceinline__ void transpose_item(const float* W, int K, int N, bf16_t* WT, const float* gain, int mode, LAS float* scr, int item, int lane) {
    const int nblk = N / 32, kb = item / nblk, nb = item % nblk, k0 = 64 * kb, n0 = 32 * nb;
    const int c = lane & 7;
    f32x4 g0 = {1.f, 1.f, 1.f, 1.f}, g1 = {1.f, 1.f, 1.f, 1.f};
    if (gain) { g0 = *(const f32x4*)(gain + k0 + 8 * c); g1 = *(const f32x4*)(gain + k0 + 8 * c + 4); }
    const float* src = W + (size_t)(k0 + (lane >> 5)) * N + n0 + (lane & 31);
    float v[32];
#pragma unroll
    for (int i = 0; i < 32; ++i) v[i] = __builtin_nontemporal_load(src + (size_t)(2 * i) * N);
#pragma unroll
    for (int i = 0; i < 32; ++i) scr[(2 * i + (lane >> 5)) * 33 + (lane & 31)] = v[i];
    LDSWAIT();
#pragma unroll
    for (int j = 0; j < 4; ++j) { const int n = (lane >> 3) + 8 * j, gn = n0 + n; const LAS float* s = scr + (8 * c) * 33 + n;
        float cs = 1.0f; int row = gn;
        if (mode == 1) { if ((gn >= 768 && gn < 1024) || (gn >= 1280 && gn < 1536)) cs = 0.125f; }
        if (mode == 2) { const int jj = gn < DFF ? gn : gn - DFF; row = 256 * (jj >> 7) + (jj & 127) + (gn < DFF ? 0 : 128); }
        u32x4 o; o.x = pk2(s[0 * 33] * g0[0] * cs, s[1 * 33] * g0[1] * cs); o.y = pk2(s[2 * 33] * g0[2] * cs, s[3 * 33] * g0[3] * cs); o.z = pk2(s[4 * 33] * g1[0] * cs, s[5 * 33] * g1[1] * cs); o.w = pk2(s[6 * 33] * g1[2] * cs, s[7 * 33] * g1[3] * cs);
        *(u32x4*)(WT + (size_t)row * K + k0 + 8 * c) = o; }
    LDSWAIT();
}
__device__ __forceinline__ float wave_sum(float v) {
#pragma unroll
    for (int o = 1; o < 64; o <<= 1) v += __shfl_xor(v, o);
    return v;
}

struct Params {
    const float *x, *w_in, *w_out, *sgu_w, *sgu_b, *pool_w, *pool_scale, *swa_sinks, *rel_bias, *mix_out_gain, *norm_mix, *norm_ffn, *w_gate_up, *w_down, *norm_final;
    float* out; unsigned char* ws;
};


__device__ __forceinline__ void st4(bf16_t* p, const f32x4 y) { u32x2 o; o.x = pk2(y[0], y[1]); o.y = pk2(y[2], y[3]); *(u32x2*)p = o; }
#define VMWAIT() asm volatile("s_waitcnt vmcnt(0)" ::: "memory")
typedef short v4i16_t __attribute__((ext_vector_type(4)));
__device__ __forceinline__ bf16x8 tr_frag(const LAS bf16_t* p, int rows4) {
    const v4i16_t lo = __builtin_amdgcn_ds_read_tr16_b64_v4i16((LAS v4i16_t*)p);
    const v4i16_t hi = __builtin_amdgcn_ds_read_tr16_b64_v4i16((LAS v4i16_t*)(p + rows4));
    return (bf16x8){lo[0], lo[1], lo[2], lo[3], hi[0], hi[1], hi[2], hi[3]};
}

__device__ __forceinline__ void mixer_A(LAS unsigned char* L, const bf16_t* proj, const bf16_t* sguw, const float* sgub, bf16_t* ycat, int b, int ch, int tid, int lane, int w) {
    constexpr int VS = 264;
    LAS bf16_t* VL = (LAS bf16_t*)L;
    const size_t row0 = (size_t)b * SEQ + ch * 128;
    const int c = lane & 15, q = lane >> 4, wv = tid >> 6;
    const int nks = (w >> 1) + 1;
    const size_t trow = row0 + 16 * wv + c;
    const bf16_t* wbase = sguw + (size_t)(16 * wv + c) * 128 + 8 * q;
    const bf16_t* urow = proj + trow * DIN + 4 * q;
    bf16x8 bw[4][4]; u32x2 uu[4][4]; float bias[4];
#pragma unroll
    for (int h = 0; h < 4; ++h) { bias[h] = sgub[h * 128 + 16 * wv + c];
#pragma unroll
        for (int ks = 0; ks < 4; ++ks) if (ks < nks) bw[h][ks] = *(const bf16x8*)(wbase + h * 128 * 128 + 32 * ks);
#pragma unroll
        for (int n = 0; n < 4; ++n) uu[h][n] = *(const u32x2*)(urow + h * 64 + 16 * n); }
    {
        const int tok = tid >> 2, h = tid & 3;
        const bf16_t* src = proj + (row0 + tok) * DIN + 256 + h * 64;
        float v[64]; float s = 0.f;
#pragma unroll
        for (int i = 0; i < 8; ++i) { const u32x4 t = *(const u32x4*)(src + 8 * i);
            v[8 * i + 0] = bflo(t.x); v[8 * i + 1] = bfhi(t.x); v[8 * i + 2] = bflo(t.y); v[8 * i + 3] = bfhi(t.y); v[8 * i + 4] = bflo(t.z); v[8 * i + 5] = bfhi(t.z); v[8 * i + 6] = bflo(t.w); v[8 * i + 7] = bfhi(t.w); }
#pragma unroll
        for (int i = 0; i < 64; ++i) s += v[i];
        const float mean = s * (1.0f / 64.0f); float s2 = 0.f;
#pragma unroll
        for (int i = 0; i < 64; ++i) { v[i] -= mean; s2 += v[i] * v[i]; }
        const float rstd = rsqrtf(s2 * (1.0f / 64.0f) + EPS);
        LAS bf16_t* dst = VL + tok * VS + h * 64;
#pragma unroll
        for (int i = 0; i < 8; ++i) { u32x4 o; o.x = pk2(v[8 * i + 0] * rstd, v[8 * i + 1] * rstd); o.y = pk2(v[8 * i + 2] * rstd, v[8 * i + 3] * rstd); o.z = pk2(v[8 * i + 4] * rstd, v[8 * i + 5] * rstd); o.w = pk2(v[8 * i + 6] * rstd, v[8 * i + 7] * rstd);
            *(LAS u32x4*)(dst + 8 * i) = o; }
    }
    __syncthreads();
    const LAS bf16_t* vbase = VL + (8 * q + (c >> 2)) * VS + 4 * (c & 3);
    f32x4 yv[4][4]; float ssq = 0.f;
#pragma unroll
    for (int h = 0; h < 4; ++h) {
#pragma unroll
        for (int n = 0; n < 4; ++n) yv[h][n] = (f32x4){0.f, 0.f, 0.f, 0.f};
#pragma unroll
        for (int ks = 0; ks < 4; ++ks) if (ks < nks) {
#pragma unroll
            for (int n = 0; n < 4; ++n) { const bf16x8 a = tr_frag(vbase + 32 * ks * VS + h * 64 + 16 * n, 4 * VS); yv[h][n] = MFMA16(a, bw[h][ks], yv[h][n]); }
        }
#pragma unroll
        for (int n = 0; n < 4; ++n) { const u32x2 u2 = uu[h][n];
            f32x4 y; y[0] = bflo(u2.x) * (yv[h][n][0] + bias[h]); y[1] = bfhi(u2.x) * (yv[h][n][1] + bias[h]); y[2] = bflo(u2.y) * (yv[h][n][2] + bias[h]); y[3] = bfhi(u2.y) * (yv[h][n][3] + bias[h]);
            yv[h][n] = y; ssq += ssq4(y); }
    }
    ssq += __shfl_xor(ssq, 16); ssq += __shfl_xor(ssq, 32);
    const float rs = rsqrtf(ssq * (1.0f / 256.0f) + EPS);
    bf16_t* yrow = ycat + trow * DM + 0 + 4 * q;
#pragma unroll
    for (int h = 0; h < 4; ++h)
#pragma unroll
        for (int n = 0; n < 4; ++n) st4(yrow + h * 64 + 16 * n, yv[h][n] * rs);
}

__device__ __forceinline__ void mixer_B(LAS unsigned char* L, const bf16_t* proj, const bf16_t* pwt, const float* pscale, bf16_t* ycat, int b, int ch, int tid, int lane, int w) {
    constexpr int YS = 264;
    LAS bf16_t* PL = (LAS bf16_t*)L;
    LAS bf16_t* Y = (LAS bf16_t*)(L + 76032);
    const size_t row0 = (size_t)b * SEQ + ch * 128;
    {
        u32x4 t[9];
#pragma unroll
        for (int i = 0; i < 9; ++i) { const int id = tid + 512 * i, r = id >> 5, cc = id & 31; t[i] = (u32x4){0u, 0u, 0u, 0u};
            if (id < 143 * 32 && (ch > 0 || r >= 15)) t[i] = *(const u32x4*)(proj + (row0 - 15 + r) * DIN + 512 + 8 * cc); }
#pragma unroll
        for (int i = 0; i < 9; ++i) { const int id = tid + 512 * i, r = id >> 5, cc = id & 31; if (id < 143 * 32) *(LAS u32x4*)(PL + r * YS + 8 * cc) = t[i]; }
    }
    __syncthreads();
    {
        const int tok = tid >> 2, g = tid & 3; const int win = 2 << g; const int tseq = ch * 128 + tok; const int cnt = (tseq + 1 < win) ? (tseq + 1) : win;
        const float inv = 1.0f / (float)cnt;
#pragma unroll 1
        for (int hf = 0; hf < 2; ++hf) {
            const LAS bf16_t* src = PL + (tok + 15) * YS + g * 64 + hf * 32;
            float p0[32], s[32];
#pragma unroll
            for (int i = 0; i < 4; ++i) { const u32x4 t = *(const LAS u32x4*)(src + 8 * i);
                p0[8 * i + 0] = bflo(t.x); p0[8 * i + 1] = bfhi(t.x); p0[8 * i + 2] = bflo(t.y); p0[8 * i + 3] = bfhi(t.y); p0[8 * i + 4] = bflo(t.z); p0[8 * i + 5] = bfhi(t.z); p0[8 * i + 6] = bflo(t.w); p0[8 * i + 7] = bfhi(t.w); }
#pragma unroll
            for (int i = 0; i < 32; ++i) s[i] = p0[i];
#pragma unroll 1
            for (int j = 1; j < cnt; ++j) { const LAS bf16_t* sj = src - j * YS;
#pragma unroll
                for (int i = 0; i < 4; ++i) { const u32x4 t = *(const LAS u32x4*)(sj + 8 * i);
                    s[8 * i + 0] += bflo(t.x); s[8 * i + 1] += bfhi(t.x); s[8 * i + 2] += bflo(t.y); s[8 * i + 3] += bfhi(t.y); s[8 * i + 4] += bflo(t.z); s[8 * i + 5] += bfhi(t.z); s[8 * i + 6] += bflo(t.w); s[8 * i + 7] += bfhi(t.w); } }
#pragma unroll
            for (int i = 0; i < 4; ++i) { u32x4 o; o.x = pk2(s[8 * i + 0] * inv - p0[8 * i + 0], s[8 * i + 1] * inv - p0[8 * i + 1]); o.y = pk2(s[8 * i + 2] * inv - p0[8 * i + 2], s[8 * i + 3] * inv - p0[8 * i + 3]);
                o.z = pk2(s[8 * i + 4] * inv - p0[8 * i + 4], s[8 * i + 5] * inv - p0[8 * i + 5]); o.w = pk2(s[8 * i + 6] * inv - p0[8 * i + 6], s[8 * i + 7] * inv - p0[8 * i + 7]);
                *(LAS u32x4*)(Y + tok * YS + g * 64 + hf * 32 + 8 * i) = o; }
        }
    }
    __syncthreads();
    const int c = lane & 15, q = lane >> 4, wv = tid >> 6;
    const size_t trow = row0 + 16 * wv + c; float ssq = 0.f;
    const LAS bf16_t* ybase = Y + (16 * wv + c) * YS + 8 * q;
    const bf16_t* pbase = pwt + (size_t)c * 64 + 8 * q;
    f32x4 yv[4][4];
#pragma unroll
    for (int g = 0; g < 4; ++g) {
#pragma unroll
        for (int n = 0; n < 4; ++n) yv[g][n] = (f32x4){0.f, 0.f, 0.f, 0.f};
#pragma unroll
        for (int ks = 0; ks < 2; ++ks) { const bf16x8 bfrag = *(const LAS bf16x8*)(ybase + g * 64 + 32 * ks);
#pragma unroll
            for (int n = 0; n < 4; ++n) { const bf16x8 a = *(const bf16x8*)(pbase + (g * 64 + 16 * n) * 64 + 32 * ks); yv[g][n] = MFMA16(a, bfrag, yv[g][n]); } }
#pragma unroll
        for (int n = 0; n < 4; ++n) { const f32x4 sc = *(const f32x4*)(pscale + g * 64 + 16 * n + 4 * q); yv[g][n] = yv[g][n] * sc; ssq += ssq4(yv[g][n]); }
    }
    ssq += __shfl_xor(ssq, 16); ssq += __shfl_xor(ssq, 32);
    const float rs = rsqrtf(ssq * (1.0f / 256.0f) + EPS);
    bf16_t* yrow = ycat + trow * DM + 256 + 4 * q;
#pragma unroll
    for (int g = 0; g < 4; ++g)
#pragma unroll
        for (int n = 0; n < 4; ++n) st4(yrow + g * 64 + 16 * n, yv[g][n] * rs);
}

__device__ __forceinline__ void mixer_C(LAS unsigned char* L, const bf16_t* proj, const float* sinks, const float* rel_bias, bf16_t* ycat, int b, int qb, int tid, int lane, int w) {
    constexpr int KS = 72, SS = 164;
    const int wv = tid >> 6;
    LAS bf16_t* KL = (LAS bf16_t*)L;
    LAS bf16_t* VL = (LAS bf16_t*)(L + 36864);
    LAS float* S = (LAS float*)(L + 76032) + wv * 16 * SS;
    LAS float* BT = (LAS float*)(L + 160000);
    const size_t row0 = (size_t)b * SEQ + qb * 128;
    const int c = lane & 15, q = lane >> 4;
    const size_t trow = row0 + 16 * wv + c;
    const int skey = tid >> 1, shalf = tid & 1; const bool okk = (qb > 0) || (skey >= 128);
    const bf16_t* ksrc = proj + (row0 - 128 + skey) * DIN + 1024 + shalf * 32;
    u32x4 kr[4], vr[4];
#pragma unroll
    for (int i = 0; i < 4; ++i) { kr[i] = (u32x4){0u, 0u, 0u, 0u}; vr[i] = (u32x4){0u, 0u, 0u, 0u}; if (okk) { kr[i] = *(const u32x4*)(ksrc + 8 * i); vr[i] = *(const u32x4*)(ksrc + 128 + 8 * i); } }
    bf16x8 qf[4][2];
#pragma unroll
    for (int j = 0; j < 4; ++j)
#pragma unroll
        for (int ks = 0; ks < 2; ++ks) qf[j][ks] = *(const bf16x8*)(proj + trow * DIN + 768 + j * 64 + 32 * ks + 8 * q);
    {
        const int j = tid >> 7, dist = tid & 127; int bucket = dist;
        if (dist >= 16) { const int lg = 16 + (int)(__logf((float)dist * (1.0f / 16.0f)) / 2.0794415416798357f * 16.0f); bucket = lg < 31 ? lg : 31; }
        BT[j * 128 + dist] = rel_bias[bucket * 4 + j];
        if (tid < 144) *(LAS u32x4*)(VL + 256 * KS + 8 * tid) = (u32x4){0u, 0u, 0u, 0u};
    }
    const LAS bf16_t* kbase = KL + (16 * wv + c) * KS + 8 * q;
    const LAS bf16_t* vbase = VL + (16 * wv + 8 * q + (c >> 2)) * KS + 4 * (c & 3);
    LAS float* swr = S + c * SS + 4 * q;
    const LAS bf16_t* wrd = (const LAS bf16_t*)(S + c * SS) + 8 * q;
    const int row = lane >> 2, seg = lane & 3;
    LAS float* srd = S + row * SS + 40 * seg;
    f32x4 yv[4][4]; float ssq = 0.f;
#pragma unroll
    for (int kvh = 0; kvh < 2; ++kvh) {
        if (kvh) __syncthreads();
#pragma unroll
        for (int i = 0; i < 4; ++i) { *(LAS u32x4*)(KL + skey * KS + shalf * 32 + 8 * i) = kr[i]; *(LAS u32x4*)(VL + skey * KS + shalf * 32 + 8 * i) = vr[i]; }
        __syncthreads();
        if (kvh == 0 && okk) {
#pragma unroll
            for (int i = 0; i < 4; ++i) { kr[i] = *(const u32x4*)(ksrc + 64 + 8 * i); vr[i] = *(const u32x4*)(ksrc + 64 + 128 + 8 * i); } }
#pragma unroll
        for (int g = 0; g < 2; ++g) { const int j = 2 * kvh + g;
#pragma unroll
            for (int kti = 0; kti < 9; ++kti) { f32x4 s = {0.f, 0.f, 0.f, 0.f};
#pragma unroll
                for (int ks = 0; ks < 2; ++ks) { const bf16x8 a = *(const LAS bf16x8*)(kbase + 16 * kti * KS + 32 * ks); s = MFMA16(a, qf[j][ks], s); }
                *(LAS f32x4*)(swr + 16 * kti) = s; }
            LDSWAIT();
            { const float sink = sinks[j]; const LAS float* bt = BT + j * 128;
                int zz; asm volatile("v_mov_b32 %0, 0" : "=v"(zz));
                const int rowz = row + zz; const int klo = (qb > 0) ? (rowz + 1) : max(rowz + 1, 128 - 16 * w), khi = rowz + 128;
                float lg[40]; float mx = sink;
#pragma unroll
                for (int i4 = 0; i4 < 10; ++i4) { const f32x4 sv = *(const LAS f32x4*)(srd + 4 * i4);
#pragma unroll
                    for (int e = 0; e < 4; ++e) { const int kl = 40 * seg + 4 * i4 + e; const int dist = 128 + rowz - kl; const bool valid = (unsigned)(kl - klo) <= (unsigned)(khi - klo);
                        const int dcl = dist & 127; const float bb = bt[dcl];
                        const float v = valid ? (sv[e] + bb) : -1e30f; lg[4 * i4 + e] = v; mx = fmaxf(mx, v); } }
                mx = fmaxf(mx, __shfl_xor(mx, 1)); mx = fmaxf(mx, __shfl_xor(mx, 2));
                float sum = 0.f;
#pragma unroll
                for (int i = 0; i < 40; ++i) { const float p = (lg[i] > -1e29f) ? fexp(lg[i] - mx) : 0.f; lg[i] = p; sum += p; }
                sum += __shfl_xor(sum, 1); sum += __shfl_xor(sum, 2);
                const float inv = 1.0f / (sum + fexp(sink - mx));
                LDSWAIT();
                LAS bf16_t* Wr = (LAS bf16_t*)(S + row * SS) + 40 * seg;
#pragma unroll
                for (int i8 = 0; i8 < 5; ++i8) { u32x4 o; o.x = pk2(lg[8 * i8 + 0] * inv, lg[8 * i8 + 1] * inv); o.y = pk2(lg[8 * i8 + 2] * inv, lg[8 * i8 + 3] * inv); o.z = pk2(lg[8 * i8 + 4] * inv, lg[8 * i8 + 5] * inv); o.w = pk2(lg[8 * i8 + 6] * inv, lg[8 * i8 + 7] * inv);
                    *(LAS u32x4*)(Wr + 8 * i8) = o; }
            }
            LDSWAIT();
#pragma unroll
            for (int n = 0; n < 4; ++n) yv[j][n] = (f32x4){0.f, 0.f, 0.f, 0.f};
#pragma unroll
            for (int ks = 0; ks < 5; ++ks) { const bf16x8 bfrag = *(const LAS bf16x8*)(wrd + 32 * ks);
#pragma unroll
                for (int n = 0; n < 4; ++n) { const bf16x8 a = tr_frag(vbase + 32 * ks * KS + 16 * n, 4 * KS); yv[j][n] = MFMA16(a, bfrag, yv[j][n]); } }
            LDSWAIT();
#pragma unroll
            for (int n = 0; n < 4; ++n) ssq += ssq4(yv[j][n]);
        }
    }
    ssq += __shfl_xor(ssq, 16); ssq += __shfl_xor(ssq, 32);
    const float rs = rsqrtf(ssq * (1.0f / 256.0f) + EPS);
    bf16_t* yrow = ycat + trow * DM + 512 + 4 * q;
#pragma unroll
    for (int j = 0; j < 4; ++j)
#pragma unroll
        for (int n = 0; n < 4; ++n) st4(yrow + j * 64 + 16 * n, yv[j][n] * rs);
}

__device__ __forceinline__ void mixer_D(LAS unsigned char* L, const bf16_t* proj, bf16_t* ycat, int b, int qb64, int tid, int lane, int w) {
    constexpr int KS = 264, SS = 68, WS = 72;
    const int wv = tid >> 6;
    LAS bf16_t* KL = (LAS bf16_t*)L;
    LAS bf16_t* VL = (LAS bf16_t*)(L + 33792);
    LAS float* S = (LAS float*)(L + 67584) + wv * 16 * SS;
    LAS bf16_t* Wl = (LAS bf16_t*)(L + 102400) + wv * 16 * WS;
    LAS float* RED = (LAS float*)(L + 120832);
    volatile LAS unsigned* FLG = (volatile LAS unsigned*)(L + 121344);
    const int rg = wv & 3, hp = wv >> 2, c = lane & 15, q = lane >> 4;
    const size_t seq0 = (size_t)b * SEQ; const size_t trow = seq0 + qb64 * 64 + 16 * rg + c;
    const int skey = tid >> 3, spart = tid & 7;
    const bf16_t* ksrc0 = proj + (seq0 + skey) * DIN + 1536 + spart * 32;
    LAS bf16_t* kdst = KL + skey * KS + spart * 32;
    LAS bf16_t* vdst = VL + skey * KS + spart * 32;
    u32x4 kr[4], vr[4];
    { const bf16_t* ksrc = ksrc0 + (size_t)qb64 * 64 * DIN;
#pragma unroll
        for (int i = 0; i < 4; ++i) { kr[i] = *(const u32x4*)(ksrc + 8 * i); vr[i] = *(const u32x4*)(ksrc + 256 + 8 * i); } }
    bf16x8 qf[2][2];
#pragma unroll
    for (int hh = 0; hh < 2; ++hh)
#pragma unroll
        for (int ks = 0; ks < 2; ++ks) qf[hh][ks] = *(const bf16x8*)(proj + trow * DIN + 1280 + (2 * hp + hh) * 64 + 32 * ks + 8 * q);
    f32x4 acc[2][4];
#pragma unroll
    for (int hh = 0; hh < 2; ++hh)
#pragma unroll
        for (int n = 0; n < 4; ++n) acc[hh][n] = (f32x4){0.f, 0.f, 0.f, 0.f};
    float carry[2] = {0.f, 0.f};
    const int srow = lane >> 2, seg = lane & 3, qloc = 16 * rg + srow;
    const LAS bf16_t* kbase = KL + c * KS + hp * 128 + 8 * q;
    const LAS bf16_t* vbase = VL + (8 * q + (c >> 2)) * KS + hp * 128 + 4 * (c & 3);
    LAS float* swr = S + c * SS + 4 * q;
    const LAS float* srd = S + srow * SS + 16 * seg;
    LAS bf16_t* wwr = Wl + srow * WS + 16 * seg;
    const LAS bf16_t* wrd = Wl + c * WS + 8 * q;
    if (tid < 2) FLG[tid] = 0u;
    int it = 0;
#pragma unroll 1
    for (int kt = qb64; kt >= 0; --kt, ++it) {
        __syncthreads();
        if (it > 0 && FLG[(it - 1) & 1] == 0u) break;
#pragma unroll
        for (int i = 0; i < 4; ++i) { *(LAS u32x4*)(kdst + 8 * i) = kr[i]; *(LAS u32x4*)(vdst + 8 * i) = vr[i]; }
        __syncthreads();
        if (tid == 0) FLG[(it + 1) & 1] = 0u;
        if (kt > 0) {
            const bf16_t* ksrc = ksrc0 + (size_t)(kt - 1) * 64 * DIN;
#pragma unroll
            for (int i = 0; i < 4; ++i) { kr[i] = *(const u32x4*)(ksrc + 8 * i); vr[i] = *(const u32x4*)(ksrc + 256 + 8 * i); } }
        const bool diag = (kt == qb64);
#pragma unroll
        for (int hh = 0; hh < 2; ++hh) {
#pragma unroll
            for (int kti = 0; kti < 4; ++kti) { f32x4 s = {0.f, 0.f, 0.f, 0.f};
#pragma unroll
                for (int ks = 0; ks < 2; ++ks) { const bf16x8 a = *(const LAS bf16x8*)(kbase + 16 * kti * KS + hh * 64 + 32 * ks); s = MFMA16(a, qf[hh][ks], s); }
                *(LAS f32x4*)(swr + 16 * kti) = s; }
            LDSWAIT();
            {
                float z[16], cs[16];
#pragma unroll
                for (int i4 = 0; i4 < 4; ++i4) { const f32x4 sv = *(const LAS f32x4*)(srd + 4 * i4); z[4 * i4 + 0] = sv[0]; z[4 * i4 + 1] = sv[1]; z[4 * i4 + 2] = sv[2]; z[4 * i4 + 3] = sv[3]; }
                float run = 0.f;
#pragma unroll
                for (int i = 15; i >= 0; --i) { const bool valid = !diag || (16 * seg + i < qloc);
                    const float zz = z[i]; const float e = fexp(-fabsf(zz)); const float sp = fmaxf(zz, 0.f) + __logf(1.0f + e);
                    run += valid ? sp : 0.f; cs[i] = run; }
                const int lb = lane & ~3;
                const float t0 = __shfl(run, lb + 0), t1 = __shfl(run, lb + 1), t2 = __shfl(run, lb + 2), t3 = __shfl(run, lb + 3);
                const float off = carry[hh] + (seg < 1 ? t1 : 0.f) + (seg < 2 ? t2 : 0.f) + (seg < 3 ? t3 : 0.f);
                carry[hh] += (t0 + t1) + (t2 + t3);
                float wvv[16];
#pragma unroll
                for (int i = 0; i < 16; ++i) { const bool valid = !diag || (16 * seg + i < qloc); wvv[i] = valid ? fexp(z[i] - (off + cs[i])) : 0.f; }
                u32x4 o0, o1; o0.x = pk2(wvv[0], wvv[1]); o0.y = pk2(wvv[2], wvv[3]); o0.z = pk2(wvv[4], wvv[5]); o0.w = pk2(wvv[6], wvv[7]); o1.x = pk2(wvv[8], wvv[9]); o1.y = pk2(wvv[10], wvv[11]); o1.z = pk2(wvv[12], wvv[13]); o1.w = pk2(wvv[14], wvv[15]);
                *(LAS u32x4*)(wwr) = o0; *(LAS u32x4*)(wwr + 8) = o1;
            }
            LDSWAIT();
#pragma unroll
            for (int ks = 0; ks < 2; ++ks) { const bf16x8 bfrag = *(const LAS bf16x8*)(wrd + 32 * ks);
#pragma unroll
                for (int n = 0; n < 4; ++n) { const bf16x8 a = tr_frag(vbase + 32 * ks * KS + hh * 64 + 16 * n, 4 * KS); acc[hh][n] = MFMA16(a, bfrag, acc[hh][n]); } }
            LDSWAIT();
        }
        if (__builtin_amdgcn_ballot_w64(fminf(carry[0], carry[1]) < 32.0f) != 0ull) { if (lane == 0) FLG[it & 1] = 1u; }
    }
    float ssq = 0.f;
#pragma unroll
    for (int hh = 0; hh < 2; ++hh)
#pragma unroll
        for (int n = 0; n < 4; ++n) ssq += ssq4(acc[hh][n]);
    ssq += __shfl_xor(ssq, 16); ssq += __shfl_xor(ssq, 32);
    __syncthreads();
    if (q == 0) RED[(16 * rg + c) * 2 + hp] = ssq;
    __syncthreads();
    const float tot = RED[(16 * rg + c) * 2 + 0] + RED[(16 * rg + c) * 2 + 1];
    const float rs = rsqrtf(tot * (1.0f / 256.0f) + EPS);
    bf16_t* yrow = ycat + trow * DM + 768 + hp * 128 + 4 * q;
#pragma unroll
    for (int hh = 0; hh < 2; ++hh)
#pragma unroll
        for (int n = 0; n < 4; ++n) st4(yrow + hh * 64 + 16 * n, acc[hh][n] * rs);
}

#define XB_TMO      128
#define XB_XCNT(j)  (256  + 64 * (j))
#define XB_XSUB(j)  (1280 + 64 * (j))
#define XB_XGEN(j)  (2304 + 64 * (j))
#define XB_TOP      3328
#define XB_TOPGEN   3392
#define XCD_BAR_WORDS 3456
#define XB_SPIN_CAP (1u << 18)

__device__ __forceinline__ unsigned xb_ld(unsigned* p)              { return __hip_atomic_load(p, __ATOMIC_RELAXED, __HIP_MEMORY_SCOPE_AGENT); }
__device__ __forceinline__ unsigned xb_add(unsigned* p, unsigned v) { return __hip_atomic_fetch_add(p, v, __ATOMIC_RELAXED, __HIP_MEMORY_SCOPE_AGENT); }
__device__ __forceinline__ unsigned xb_xcc_id() { return (unsigned)__builtin_amdgcn_s_getreg((3 << 11) | 20) & 0xFu; }
#define XB_SPIN(cond, bar) do { unsigned _sp = 0; while (cond) { __builtin_amdgcn_s_sleep(1); \
    if ((++_sp & 255u) == 0u) { if (xb_ld(&(bar)[XB_TMO])) break; if (_sp > XB_SPIN_CAP) { atomicAdd(&(bar)[XB_TMO], 1u); break; } } } } while (0)

struct XcdBarrier {
    unsigned* bar; unsigned x;
    volatile LAS unsigned* st;
};

__device__ __forceinline__ XcdBarrier xcd_barrier_post(unsigned* bar, volatile LAS unsigned* st) {
    XcdBarrier b; b.bar = bar; b.x = xb_xcc_id(); b.st = st;
    if (threadIdx.x == 0) (void)xb_add(&bar[XB_XCNT(b.x)], 1u);
    return b;
}
__device__ __forceinline__ void xcd_barrier_complete(unsigned* bar, unsigned x, unsigned& nloc, unsigned& nx) {
    const unsigned G = gridDim.x * gridDim.y * gridDim.z;
    unsigned sum, cnt, mine, sp = 0u;
    for (;;) {
        sum = 0u; cnt = 0u; mine = 0u;
#pragma unroll
        for (unsigned j = 0; j < 16; ++j) { const unsigned c = xb_ld(&bar[XB_XCNT(j)]); sum += c; cnt += (c > 0u) ? 1u : 0u; mine = (j == x) ? c : mine; }
        if (sum == G) break;
        __builtin_amdgcn_s_sleep(1);
        if ((++sp & 255u) == 0u) { if (xb_ld(&bar[XB_TMO])) break; if (sp > XB_SPIN_CAP) { atomicAdd(&bar[XB_TMO], 1u); break; } }
    }
    nloc = mine > 0u ? mine : 1u; nx = cnt > 0u ? cnt : 1u;
}

__device__ __forceinline__ void xcd_barrier(const XcdBarrier& b) {
    asm volatile("s_waitcnt vmcnt(0)" ::: "memory");
    __syncthreads();
    if (threadIdx.x == 0) {
        unsigned* bar = b.bar;
        __builtin_amdgcn_s_waitcnt(0);
        unsigned nloc = b.st[0], nx = b.st[1];
        if (nloc == 0u) { xcd_barrier_complete(bar, b.x, nloc, nx); b.st[0] = nloc; b.st[1] = nx; }
        const unsigned old = xb_add(&bar[XB_XSUB(b.x)], 1u);
        const unsigned gen = old / nloc;
        if (old + 1u == (gen + 1u) * nloc) {
            __builtin_amdgcn_fence(__ATOMIC_RELEASE, "agent");
            asm volatile("s_waitcnt vmcnt(0)" ::: "memory");
            const unsigned og = xb_add(&bar[XB_TOP], 1u);
            const unsigned tg = og / nx;
            if (og + 1u == (tg + 1u) * nx) xb_add(&bar[XB_TOPGEN], 1u);
            else XB_SPIN(xb_ld(&bar[XB_TOPGEN]) == tg, bar);
            __builtin_amdgcn_fence(__ATOMIC_ACQUIRE, "agent");
            xb_add(&bar[XB_XGEN(b.x)], 1u);
            asm volatile("s_waitcnt vmcnt(0)" ::: "memory");
        } else {
            XB_SPIN(xb_ld(&bar[XB_XGEN(b.x)]) == gen, bar);
            __builtin_amdgcn_fence(__ATOMIC_ACQUIRE, "agent");
            asm volatile("s_waitcnt vmcnt(0)" ::: "memory");
        }
    }
    __syncthreads();
}

#ifndef REP_SYNC
#define REP_SYNC 1
#endif
#define GSYNC() do { for (int _r = 0; _r < REP_SYNC; ++_r) xcd_barrier(xbar); } while (0)
__global__ void __launch_bounds__(NTHR, 2) fwd_megakernel(Params p) {
    extern __shared__ __attribute__((aligned(16))) unsigned char lds[];
    cg::grid_group grid = cg::this_grid();
    LAS unsigned char* L = (LAS unsigned char*)lds;
    const int tid = threadIdx.x, lane = tid & 63, wave = __builtin_amdgcn_readfirstlane(tid >> 6);
    const int G = gridDim.x, bx = blockIdx.x;
    unsigned char* ws = p.ws;
    bf16_t* Win_t = (bf16_t*)(ws + WS_WIN); bf16_t* Wout_t = (bf16_t*)(ws + WS_WOUT); bf16_t* Wgu_t = (bf16_t*)(ws + WS_WGU); bf16_t* Wdn_t = (bf16_t*)(ws + WS_WDN);
    bf16_t* SGUW = (bf16_t*)(ws + WS_SGUW); bf16_t* PWT = (bf16_t*)(ws + WS_PWT); float* SSQ = (float*)(ws + WS_SS);
    bf16_t* XB = (bf16_t*)(ws + WS_XB); bf16_t* PROJ = (bf16_t*)(ws + WS_PROJ); bf16_t* YCAT = (bf16_t*)(ws + WS_YCAT); bf16_t* HID = (bf16_t*)(ws + WS_HID);

    volatile LAS unsigned* xst = (volatile LAS unsigned*)(L + LDS_BYTES - 16);
    if (tid < 4) xst[tid] = 0u;
    unsigned* barw = (unsigned*)(ws + WS_BAR);
    if (bx == 0) for (int i = tid; i < XCD_BAR_WORDS; i += NTHR) __hip_atomic_store(barw + i, 0u, __ATOMIC_RELAXED, __HIP_MEMORY_SCOPE_AGENT);
#ifndef REP_P0
#define REP_P0 1
#endif
    for (int rep0 = 0; rep0 < REP_P0; ++rep0) {
        LAS float* scr = (LAS float*)(L + wave * 16384);
        const int gw = bx * 8 + wave, NGW = G * 8;
        constexpr int I_IN = (DM / 64) * (DIN / 32), I_OUT = (DM / 64) * (DM / 32), I_GU = (DM / 64) * (2 * DFF / 32), I_DN = (DFF / 64) * (DM / 32), I_L = I_IN + I_OUT + I_GU + I_DN;
        for (int it = gw; it < DEPTH * I_L; it += NGW) {
            const int l = it / I_L; int r = it % I_L;
            if (r < I_IN) { transpose_item(p.w_in + (size_t)l * DM * DIN, DM, DIN, Win_t + (size_t)l * DIN * DM, p.norm_mix + l * DM, 1, scr, r, lane); continue; } r -= I_IN;
            if (r < I_OUT) { transpose_item(p.w_out + (size_t)l * DM * DM, DM, DM, Wout_t + (size_t)l * DM * DM, p.mix_out_gain + l * DM, 0, scr, r, lane); continue; } r -= I_OUT;
            if (r < I_GU) { transpose_item(p.w_gate_up + (size_t)l * DM * 2 * DFF, DM, 2 * DFF, Wgu_t + (size_t)l * 2 * DFF * DM, p.norm_ffn + l * DM, 2, scr, r, lane); continue; } r -= I_GU;
            transpose_item(p.w_down + (size_t)l * DFF * DM, DFF, DM, Wdn_t + (size_t)l * DM * DFF, nullptr, 0, scr, r, lane);
        }
        for (int m = 2 * gw; m < M; m += 2 * NGW) {
            const f32x4* xr = (const f32x4*)(p.x + (size_t)m * DM) + lane; u32x2* o8 = (u32x2*)(XB + (size_t)m * DM) + lane; f32x4 v[2][4];
#pragma unroll
            for (int r = 0; r < 2; ++r)
#pragma unroll
                for (int j = 0; j < 4; ++j) v[r][j] = __builtin_nontemporal_load(xr + r * 256 + 64 * j);
#pragma unroll
            for (int r = 0; r < 2; ++r) { float s = 0.f;
#pragma unroll
                for (int j = 0; j < 4; ++j) { const f32x4 t = v[r][j]; s += ssq4(t); u32x2 o; o.x = pk2(t.x, t.y); o.y = pk2(t.z, t.w); o8[r * 256 + 64 * j] = o; }
                s = wave_sum(s);
                if (lane < 4) SSQ[(size_t)(m + r) * 4 + lane] = (lane == 0) ? s : 0.f; }
        }
        const int gt = bx * NTHR + tid, NGT = G * NTHR;
        for (int e = gt; e < DEPTH * 4 * 128 * 128 / 8; e += NGT) { const int s0 = (e & 15) * 8, t = (e >> 4) & 127; const float* src = p.sgu_w + (size_t)e * 8;
            const f32x4 a = *(const f32x4*)src, bq = *(const f32x4*)(src + 4); float v[8] = {a.x, a.y, a.z, a.w, bq.x, bq.y, bq.z, bq.w};
#pragma unroll
            for (int i = 0; i < 8; ++i) v[i] = (s0 + i <= t) ? v[i] : 0.f;
            u32x4 o; o.x = pk2(v[0], v[1]); o.y = pk2(v[2], v[3]); o.z = pk2(v[4], v[5]); o.w = pk2(v[6], v[7]); *(u32x4*)(SGUW + (size_t)e * 8) = o; }
        for (int e = gt; e < DEPTH * 4 * 64 * 64; e += NGT) { const int cc = e & 63, d = (e >> 6) & 63, lg = e >> 12; PWT[e] = f2bf(p.pool_w[((size_t)lg * 64 + cc) * 64 + d]); }
    }
    grid.sync();
    const XcdBarrier xbar = xcd_barrier_post(barw, xst);

    for (int l = 0; l < DEPTH; ++l) {
#ifndef REP_P1
#define REP_P1 1
#endif
#ifndef NO_P1
        for (int rep = 0; rep < REP_P1; ++rep) { int zk; asm volatile("s_mov_b32 %0, 0" : "=s"(zk)); pg8::Gemm g{XB, Win_t + (size_t)l * DIN * DM, M, DIN, DM + zk}; pg8::StaticOrder S; S.init(M, DIN, G + zk, bx); pg8::EpiIn E{PROJ, SSQ};
          pg8::gemm_phase<pg8::EpiIn, pg8::StaticOrder, true, true>(L, g, S, E, zk); }
#endif
        GSYNC();
#ifndef REP_MIX
#define REP_MIX 1
#endif
#ifndef REP_D
#define REP_D 1
#endif
        for (int rep = 0; rep < REP_MIX; ++rep)
        for (int u = bx; u < 256; u += G) { const int b = u >> 4, ch = u & 15;
            __syncthreads();
#ifndef NO_A
            { int zt; asm volatile("v_mov_b32 %0, 0" : "=v"(zt)); const int t2 = tid + zt; mixer_A(L, PROJ, SGUW + (size_t)l * 4 * 128 * 128, p.sgu_b + l * 4 * 128, YCAT, b, ch, t2, t2 & 63, __builtin_amdgcn_readfirstlane(t2 >> 6)); }
#endif
            __syncthreads();
#ifndef NO_B
            { int zt; asm volatile("v_mov_b32 %0, 0" : "=v"(zt)); const int t2 = tid + zt; mixer_B(L, PROJ, PWT + (size_t)l * 4 * 64 * 64, p.pool_scale + l * 256, YCAT, b, ch, t2, t2 & 63, __builtin_amdgcn_readfirstlane(t2 >> 6)); }
#endif
            __syncthreads();
#ifndef NO_C
            { int zt; asm volatile("v_mov_b32 %0, 0" : "=v"(zt)); const int t2 = tid + zt; mixer_C(L, PROJ, p.swa_sinks + l * 4, p.rel_bias, YCAT, b, ch, t2, t2 & 63, __builtin_amdgcn_readfirstlane(t2 >> 6)); }
#endif
            __syncthreads();
#ifndef NO_D
#pragma unroll 1
            for (int hf = 0; hf < 2 * REP_D; ++hf) { int zt; asm volatile("v_mov_b32 %0, 0" : "=v"(zt)); const int t2 = tid + zt; mixer_D(L, PROJ, YCAT, b, (hf & 1) ? 31 - ch : ch, t2, t2 & 63, __builtin_amdgcn_readfirstlane(t2 >> 6)); __syncthreads(); }
#endif
        }
        GSYNC();
#ifndef NO_P3
        { int zk; asm volatile("s_mov_b32 %0, 0" : "=s"(zk)); pg8::Gemm g{YCAT, Wout_t + (size_t)l * DM * DM, M, DM, DM + zk}; pg8::StaticOrder S; S.init(M, DM, G + zk, bx); pg8::EpiRes E{l == 0 ? p.x : nullptr, nullptr, XB, SSQ, (LAS float*)(L + 131072)};
          pg8::gemm_phase<pg8::EpiRes, pg8::StaticOrder, true, true>(L, g, S, E, zk); }
#endif
        GSYNC();
#ifndef REP_P4
#define REP_P4 1
#endif
#ifndef NO_P4
        for (int rep = 0; rep < REP_P4; ++rep) { int zk; asm volatile("s_mov_b32 %0, 0" : "=s"(zk)); pg8::Gemm g{XB, Wgu_t + (size_t)l * 2 * DFF * DM, M, 2 * DFF, DM + zk}; pg8::StaticOrder S; S.init(M, 2 * DFF, G + zk, bx); pg8::EpiGU E{HID, SSQ};
          pg8::gemm_phase<pg8::EpiGU, pg8::StaticOrder, true, true>(L, g, S, E, zk); }
#endif
        GSYNC();
#ifndef NO_P5
        { int zk; asm volatile("s_mov_b32 %0, 0" : "=s"(zk)); pg8::Gemm g{HID, Wdn_t + (size_t)l * DM * DFF, M, DM, DFF + zk}; pg8::StaticOrder S; S.init(M, DM, G + zk, bx); pg8::EpiRes E{nullptr, l == DEPTH - 1 ? p.out : nullptr, XB, SSQ, (LAS float*)(L + 131072)};
          pg8::gemm_phase<pg8::EpiRes, pg8::StaticOrder, true, true>(L, g, S, E, zk); }
#endif
        GSYNC();
    }
    {
        const int gw = bx * 8 + wave, NGW = G * 8;
        for (int m = gw; m < M; m += NGW) { const float rs = rstd_of(SSQ, m); f32x4* xr = (f32x4*)(p.out + (size_t)m * DM) + lane; const f32x4* gr = (const f32x4*)p.norm_final + lane;
#pragma unroll
            for (int j = 0; j < 4; ++j) { const f32x4 v = xr[64 * j], gg = gr[64 * j]; xr[64 * j] = v * rs * gg; } }
    }
}

extern "C" void kernel_launch(void* const* d_in, const int* in_sizes, int n_in, void* d_out, int out_size, void* d_ws, size_t ws_size, hipStream_t stream) {
    static int grid_blocks = 0;
    if (grid_blocks == 0) {
        if (n_in != 15 || in_sizes[0] != M * DM || out_size != M * DM || ws_size < WS_END) { fprintf(stderr, "kernel_launch: unexpected shapes (n_in %d, in0 %d, out %d, ws %zu)\n", n_in, n_in > 0 ? in_sizes[0] : -1, out_size, ws_size); grid_blocks = -1; return; }
        int dev = 0, cus = 0, per_cu = 0;
        hipGetDevice(&dev); hipDeviceGetAttribute(&cus, hipDeviceAttributeMultiprocessorCount, dev);
        if (hipFuncSetAttribute((const void*)fwd_megakernel, hipFuncAttributeMaxDynamicSharedMemorySize, LDS_BYTES) != hipSuccess) { fprintf(stderr, "kernel_launch: hipFuncSetAttribute failed\n"); }
        if (hipOccupancyMaxActiveBlocksPerMultiprocessor(&per_cu, (const void*)fwd_megakernel, NTHR, LDS_BYTES) != hipSuccess || per_cu < 1) { fprintf(stderr, "kernel_launch: occupancy query says %d\n", per_cu); per_cu = 1; }
        (void)hipGetLastError();
        grid_blocks = cus * 1;
        if (grid_blocks <= 0) grid_blocks = 256;
    }
    if (grid_blocks < 0) return;
    Params p{};
    p.x = (const float*)d_in[0]; p.w_in = (const float*)d_in[1]; p.w_out = (const float*)d_in[2]; p.sgu_w = (const float*)d_in[3]; p.sgu_b = (const float*)d_in[4];
    p.pool_w = (const float*)d_in[5]; p.pool_scale = (const float*)d_in[6]; p.swa_sinks = (const float*)d_in[7]; p.rel_bias = (const float*)d_in[8]; p.mix_out_gain = (const float*)d_in[9];
    p.norm_mix = (const float*)d_in[10]; p.norm_ffn = (const float*)d_in[11]; p.w_gate_up = (const float*)d_in[12]; p.w_down = (const float*)d_in[13]; p.norm_final = (const float*)d_in[14];
    p.out = (float*)d_out; p.ws = (unsigned char*)d_ws;
    void* args[] = {&p};
    hipError_t e = hipLaunchCooperativeKernel((const void*)fwd_megakernel, dim3(grid_blocks), dim3(NTHR), args, LDS_BYTES, stream);
    if (e != hipSuccess) fprintf(stderr, "cooperative launch failed: %s (grid %d)\n", hipGetErrorString(e), grid_blocks);
}
```

```cpp
#include <hip/hip_runtime.h>
#include <hip/hip_cooperative_groups.h>
#include <cstdio>
#include <cstdint>
namespace cg = cooperative_groups;
namespace pg8 {
#define PG8_LAS __attribute__((address_space(3)))
typedef unsigned short bf16_t;
typedef short bf16x8 __attribute__((ext_vector_type(8)));
typedef float f32x4 __attribute__((ext_vector_type(4)));
typedef unsigned u32x4 __attribute__((ext_vector_type(4)));
constexpr int BM = 256, BK = 64, HALF = 128, HTB = HALF * BK * 2  , STAGE_BYTES = 8 * HTB, NXCD = 8, WGM = 8;

__host__ __device__ __forceinline__ int lds_byte(int r, int c) { const int st = (r >> 4) * 2 + (c >> 5), rr = r & 15, cc = c & 31, ob = rr * 64 + cc * 2; return st * 1024 + (ob ^ (((ob >> 9) & 1) << 5)); }
__host__ __device__ __forceinline__ void stage_rc(int b, int& R, int& C) { const int st = b / 1024, sb = b % 1024, swz = sb ^ (((sb >> 9) & 1) << 5); R = (st >> 1) * 16 + swz / 64; C = (st & 1) * 32 + (swz % 64) / 2; }
__host__ __device__ __forceinline__ int perm32(int rho) { const int n = rho >> 4, i = rho & 15; return 8 * (i >> 2) + 4 * n + (i & 3); }

struct Unit { int pm, pn; };
struct Gemm { const bf16_t* A; const bf16_t* Bt; int M, N, K; };

struct StaticOrder {
    int nM, nN, nwg, G, c;
    __host__ __device__ void init(int M, int N, int G_, int c_) { nM = M / BM; nN = N / BM; nwg = nM * nN; G = G_; c = c_; }
    __host__ __device__ bool next(int i, Unit& u) const {
        const long L = (long)i * G + c; if (L >= nwg) return false;
        int wgid = (int)L; { const int q = nwg / NXCD, r = nwg % NXCD, xcd = wgid % NXCD, off = wgid / NXCD; wgid = (xcd < r ? xcd * (q + 1) : r * (q + 1) + (xcd - r) * q) + off; }
        const int nig = WGM * nN, gid = wgid / nig, fm = gid * WGM, gsz = (nM - fm) < WGM ? (nM - fm) : WGM;
        u.pm = fm + ((wgid % nig) % gsz); u.pn = (wgid % nig) / gsz; return true;
    }
    __device__ __forceinline__ void a_ready(const Unit&) const {}
    __device__ __forceinline__ void done(const Unit&) const {}
};

__device__ __forceinline__ unsigned cvt_pk_bf16(float lo, float hi) { unsigned r; asm volatile("v_cvt_pk_bf16_f32 %0, %1, %2" : "=v"(r) : "v"(lo), "v"(hi)); return r; }
typedef float f32x2 __attribute__((ext_vector_type(2)));
template <class Epi, class Sched, bool ALIGN_EPI = false, bool SP2 = false>
__device__ __forceinline__ void gemm_phase(PG8_LAS unsigned char* lds, const Gemm g, const Sched& S, const Epi& E, const int opq) {
    const int tid = threadIdx.x + opq, wid = __builtin_amdgcn_readfirstlane(tid >> 6), lane = tid & 63, wr = wid >> 2, wc = wid & 3, fr = lane & 15, fq = lane >> 4;
    const int K = g.K, nt = K / BK;
    unsigned voffA[2], voffB[2];
#pragma unroll
    for (int i = 0; i < 2; ++i) { int R, C; stage_rc(tid * 16 + i * 8192, R, C); const int Rb = Epi::PERM ? ((R & ~31) + perm32(R & 31)) : R;
        voffA[i] = (unsigned)(R * K + C) * 2u; voffB[i] = (unsigned)(Rb * K + C) * 2u; }
    const size_t kstep = (size_t)(BK * 2);
    const size_t hstep = (size_t)HALF * K * 2;
    const size_t tstep = 2 * hstep;
    const unsigned ldsw = (unsigned)wid * 1024u;
    const int aoff = lds_byte(wr * 64 + fr, fq * 8), boff = lds_byte(wc * 32 + fr, fq * 8);
#define PG8_SA(b, h) (((b) * 2 + (h)) * HTB)
#define PG8_SB(b, h) ((4 + (b) * 2 + (h)) * HTB)
#define PG8_STAGE(bufoff, gbase, voff) do { _Pragma("unroll") for (int _i = 0; _i < 2; ++_i) \
        __builtin_amdgcn_global_load_lds((const unsigned*)((const char*)(gbase) + (voff)[_i]), (PG8_LAS unsigned*)(lds + (bufoff) + ldsw + _i * 8192), 16, 0, 0); } while (0)
#define PG8_LDA(dst, b, h) do { _Pragma("unroll") for (int m = 0; m < 4; ++m) _Pragma("unroll") for (int k = 0; k < 2; ++k) dst[m][k] = *(const PG8_LAS bf16x8*)(lds + PG8_SA(b, h) + aoff + m * 2048 + k * 1024); } while (0)
#define PG8_LDB(dst, b, h) do { _Pragma("unroll") for (int n = 0; n < 2; ++n) _Pragma("unroll") for (int k = 0; k < 2; ++k) dst[n][k] = *(const PG8_LAS bf16x8*)(lds + PG8_SB(b, h) + boff + n * 2048 + k * 1024); } while (0)
#define PG8_MMA(ai, bj, At, Bt) do { __builtin_amdgcn_s_setprio(1); _Pragma("unroll") for (int m = 0; m < 4; ++m) _Pragma("unroll") for (int n = 0; n < 2; ++n) _Pragma("unroll") for (int k = 0; k < 2; ++k) \
        acc[ai][bj][m][n] = __builtin_amdgcn_mfma_f32_16x16x32_bf16(Bt[n][k], At[m][k], acc[ai][bj][m][n], 0, 0, 0); __builtin_amdgcn_s_setprio(0); } while (0)
#define PG8_WAIT_V(n) asm volatile("s_waitcnt vmcnt(" #n ")" ::: "memory")
#define PG8_WAIT_L(n) asm volatile("s_waitcnt lgkmcnt(" #n ")" ::: "memory")
#define PG8_BAR __builtin_amdgcn_s_barrier()
#define PG8_SCHED __builtin_amdgcn_sched_barrier(0)
    Unit cur, nxt; int ui = 0;
    if (!S.next(0, cur)) return;
    f32x4 acc[2][2][4][2];
#pragma unroll
    for (int a = 0; a < 2; ++a)
#pragma unroll
        for (int b = 0; b < 2; ++b)
#pragma unroll
            for (int m = 0; m < 4; ++m)
#pragma unroll
                for (int n = 0; n < 2; ++n) acc[a][b][m][n] = (f32x4){0.f, 0.f, 0.f, 0.f};
    bf16x8 At[4][2], B0[2][2], B1[2][2];
    const char* cA = (const char*)g.A + (size_t)cur.pm * tstep; const char* cB = (const char*)g.Bt + (size_t)cur.pn * tstep;
    S.a_ready(cur);
    if constexpr (SP2) {
        PG8_STAGE(PG8_SB(0, 0), cB, voffB); PG8_STAGE(PG8_SB(0, 1), cB + hstep, voffB); PG8_STAGE(PG8_SA(0, 0), cA, voffA); PG8_STAGE(PG8_SA(0, 1), cA + hstep, voffA);
        if (wr == 1) PG8_BAR;
        PG8_WAIT_V(2); PG8_BAR;
        PG8_STAGE(PG8_SB(1, 0), cB + kstep, voffB); PG8_STAGE(PG8_SA(1, 0), cA + kstep, voffA); PG8_STAGE(PG8_SB(1, 1), cB + hstep + kstep, voffB);
        PG8_WAIT_V(6); PG8_BAR;
    } else {
        PG8_STAGE(PG8_SB(0, 0), cB, voffB); PG8_STAGE(PG8_SA(0, 0), cA, voffA); PG8_STAGE(PG8_SB(0, 1), cB + hstep, voffB); PG8_STAGE(PG8_SA(0, 1), cA + hstep, voffA);
        if (wr == 1) PG8_BAR;
        PG8_WAIT_V(4); PG8_BAR;
        PG8_STAGE(PG8_SB(1, 0), cB + kstep, voffB); PG8_STAGE(PG8_SA(1, 0), cA + kstep, voffA); PG8_STAGE(PG8_SB(1, 1), cB + hstep + kstep, voffB);
        PG8_WAIT_V(6); PG8_BAR;
    }
    for (;;) {
        const bool has_next = S.next(ui + 1, nxt);
        const char* nA = has_next ? (const char*)g.A + (size_t)nxt.pm * tstep : cA; const char* nB = has_next ? (const char*)g.Bt + (size_t)nxt.pn * tstep : cB;
        for (int t = 0; t < nt; t += 2) {
            const bool last = (t == nt - 2);
            const char* a1 = cA + (size_t)(t + 1) * kstep;
            const char* a2 = last ? nA : cA + (size_t)(t + 2) * kstep; const char* b2 = last ? nB : cB + (size_t)(t + 2) * kstep;
            const char* a3 = a2 + kstep; const char* b3 = b2 + kstep;
            if (last && has_next) S.a_ready(nxt);
            if constexpr (SP2) {
            PG8_LDB(B0, 0, 0); PG8_LDB(B1, 0, 1); PG8_SCHED; PG8_LDA(At, 0, 0); PG8_STAGE(PG8_SA(1, 1), a1 + hstep, voffA);
            PG8_WAIT_V(8); PG8_WAIT_L(0); PG8_BAR; PG8_MMA(0, 0, At, B0); PG8_MMA(0, 1, At, B1); PG8_BAR; PG8_SCHED;
            PG8_LDA(At, 0, 1); PG8_STAGE(PG8_SB(0, 0), b2, voffB); PG8_STAGE(PG8_SB(0, 1), b2 + hstep, voffB); PG8_STAGE(PG8_SA(0, 0), a2, voffA);
            PG8_WAIT_V(8); PG8_WAIT_L(0); PG8_BAR; PG8_MMA(1, 0, At, B0); PG8_MMA(1, 1, At, B1); PG8_BAR; PG8_SCHED;
            PG8_LDB(B0, 1, 0); PG8_LDB(B1, 1, 1); PG8_SCHED; PG8_LDA(At, 1, 0); PG8_STAGE(PG8_SA(0, 1), a2 + hstep, voffA);
            PG8_WAIT_V(8); PG8_WAIT_L(0); PG8_BAR; PG8_MMA(0, 0, At, B0); PG8_MMA(0, 1, At, B1); PG8_BAR; PG8_SCHED;
            PG8_LDA(At, 1, 1); PG8_STAGE(PG8_SB(1, 0), b3, voffB); PG8_STAGE(PG8_SB(1, 1), b3 + hstep, voffB); PG8_STAGE(PG8_SA(1, 0), a3, voffA);
            PG8_WAIT_V(8); PG8_WAIT_L(0); PG8_BAR; PG8_MMA(1, 0, At, B0); PG8_MMA(1, 1, At, B1); PG8_BAR; PG8_SCHED;
            } else {
            PG8_LDB(B0, 0, 0); PG8_SCHED; PG8_LDA(At, 0, 0); PG8_STAGE(PG8_SA(1, 1), a1 + hstep, voffA);
            PG8_WAIT_L(8); PG8_BAR; PG8_WAIT_L(0); PG8_MMA(0, 0, At, B0); PG8_BAR; PG8_SCHED;
            PG8_LDB(B1, 0, 1); PG8_STAGE(PG8_SB(0, 0), b2, voffB);
            PG8_BAR; PG8_WAIT_L(0); PG8_MMA(0, 1, At, B1); PG8_BAR;
            PG8_LDA(At, 0, 1); PG8_STAGE(PG8_SA(0, 0), a2, voffA);
            PG8_BAR; PG8_WAIT_L(0); PG8_MMA(1, 0, At, B0); PG8_BAR; PG8_SCHED;
            PG8_STAGE(PG8_SB(0, 1), b2 + hstep, voffB);
            PG8_WAIT_V(6); PG8_BAR; PG8_MMA(1, 1, At, B1); PG8_BAR;
            PG8_LDB(B0, 1, 0); PG8_SCHED; PG8_LDA(At, 1, 0); PG8_STAGE(PG8_SA(0, 1), a2 + hstep, voffA);
            PG8_WAIT_L(8); PG8_BAR; PG8_WAIT_L(0); PG8_MMA(0, 0, At, B0); PG8_BAR; PG8_SCHED;
            PG8_LDB(B1, 1, 1); PG8_STAGE(PG8_SB(1, 0), b3, voffB);
            PG8_BAR; PG8_WAIT_L(0); PG8_MMA(0, 1, At, B1); PG8_BAR;
            PG8_LDA(At, 1, 1); PG8_STAGE(PG8_SA(1, 0), a3, voffA);
            PG8_BAR; PG8_WAIT_L(0); PG8_MMA(1, 0, At, B0); PG8_BAR; PG8_SCHED;
            PG8_STAGE(PG8_SB(1, 1), b3 + hstep, voffB);
            PG8_WAIT_V(6); PG8_BAR; PG8_MMA(1, 1, At, B1); PG8_BAR;
            }
        }
        if constexpr (ALIGN_EPI) { if (wr == 0) PG8_BAR; }
        if constexpr (!Epi::AFTER_DRAIN) { E(acc, cur, wr, wc, fr, fq); S.done(cur); }
        if (!has_next) break;
#pragma unroll
        for (int a = 0; a < 2; ++a)
#pragma unroll
            for (int b = 0; b < 2; ++b)
#pragma unroll
                for (int m = 0; m < 4; ++m)
#pragma unroll
                    for (int n = 0; n < 2; ++n) acc[a][b][m][n] = (f32x4){0.f, 0.f, 0.f, 0.f};
        cur = nxt; cA = nA; cB = nB; ++ui;
        if constexpr (ALIGN_EPI) { if (wr == 1) PG8_BAR; }
    }
    PG8_WAIT_V(0);
    if constexpr (!ALIGN_EPI) { if (wr == 0) PG8_BAR; }
    PG8_BAR;
    if constexpr (Epi::AFTER_DRAIN) { E.fused(acc, cur, wr, wc, fr, fq, lds, wid, lane); S.done(cur); }
#undef PG8_SA
#undef PG8_SB
#undef PG8_STAGE
#undef PG8_LDA
#undef PG8_LDB
#undef PG8_MMA
#undef PG8_WAIT_V
#undef PG8_WAIT_L
#undef PG8_BAR
#undef PG8_SCHED
}
}

constexpr int NB = 16, SEQ = 2048, DM = 1024, DEPTH = 4, DIN = 2048, DFF = 2816, M = NB * SEQ;
constexpr float EPS = 1e-6f;
constexpr size_t MiB = 1u << 20;
constexpr size_t WS_WIN = 0, WS_WOUT = 16 * MiB, WS_WGU = 24 * MiB, WS_WDN = 68 * MiB, WS_SGUW = 90 * MiB, WS_PWT = 90 * MiB + 512 * 1024,
                 WS_SS = 91 * MiB, WS_BAR = 93 * MiB, WS_XB = 96 * MiB, WS_PROJ = 160 * MiB, WS_YCAT = 288 * MiB, WS_HID = 160 * MiB, WS_END = 352 * MiB;
constexpr int LDS_BYTES = 160 * 1024;
constexpr int NTHR = 512;

#define LAS __attribute__((address_space(3)))
typedef unsigned short bf16_t;
typedef short bf16x8 __attribute__((ext_vector_type(8)));
typedef float f32x4 __attribute__((ext_vector_type(4)));
typedef float f32x2 __attribute__((ext_vector_type(2)));
typedef unsigned u32x4 __attribute__((ext_vector_type(4)));
typedef unsigned u32x2 __attribute__((ext_vector_type(2)));
typedef __bf16 bf16x2_t __attribute__((ext_vector_type(2)));

__device__ __forceinline__ unsigned pk2(float lo, float hi) { f32x2 v = {lo, hi}; bf16x2_t b = __builtin_convertvector(v, bf16x2_t); return __builtin_bit_cast(unsigned, b); }
__device__ __forceinline__ bf16_t f2bf(float f) { return (bf16_t)(pk2(f, 0.f) & 0xffffu); }
__device__ __forceinline__ float bflo(unsigned w) { return __uint_as_float(w << 16); }
__device__ __forceinline__ float bfhi(unsigned w) { return __uint_as_float(w & 0xffff0000u); }
#define MFMA16(a, b, c) __builtin_amdgcn_mfma_f32_16x16x32_bf16((a), (b), (c), 0, 0, 0)
#define CFENCE() asm volatile("" ::: "memory")
#define LDSWAIT() asm volatile("s_waitcnt lgkmcnt(0)" ::: "memory")
__device__ __forceinline__ float fexp(float x) { return __builtin_amdgcn_exp2f(x * 1.4426950408889634f); }
__device__ __forceinline__ float gelu_tanh(float x) {
    const float u2 = 1.5957691216057308f * x * (1.0f + 0.044715f * x * x);
    return x * __builtin_amdgcn_rcpf(1.0f + fexp(-u2));
}
__device__ __forceinline__ float rstd_of1(const float* ss, int row) {
    const f32x4 s = *(const f32x4*)(ss + (size_t)row * 4); return rsqrtf(((s.x + s.y) + (s.z + s.w)) * (1.0f / 1024.0f) + EPS);
}

__device__ __forceinline__ float ssq4(const f32x4 y) { return (y[0] * y[0] + y[1] * y[1]) + (y[2] * y[2] + y[3] * y[3]); }

#ifdef PROBE_RSTD2
__device__ __forceinline__ float rstd_of(const float* ss, int row) { const float a = rstd_of1(ss, row); int z; asm volatile("v_mov_b32 %0, 0" : "=v"(z) : "v"(a)); const float b = rstd_of1(ss, row + z); return (a + b) * 0.5f; }
#else
__device__ __forceinline__ float rstd_of(const float* ss, int row) { return rstd_of1(ss, row); }
#endif
namespace pg8 {
struct EpiIn {
    static constexpr bool PERM = true, AFTER_DRAIN = false;
    bf16_t* O; const float* ss;
    __device__ __forceinline__ void operator()(const f32x4 (&acc)[2][2][4][2], const Unit& u, int wr, int wc, int fr, int fq) const {
        const int row0 = u.pm * BM + wr * 64 + fr, col0 = u.pn * BM + wc * 32 + 8 * fq; const bool act = u.pn < 2;
        float rsv[2][4];
#pragma unroll
        for (int ai = 0; ai < 2; ++ai)
#pragma unroll
            for (int m = 0; m < 4; ++m) rsv[ai][m] = rstd_of(ss, row0 + ai * HALF + m * 16);
#pragma unroll
        for (int ai = 0; ai < 2; ++ai)
#pragma unroll
            for (int m = 0; m < 4; ++m) { const int row = row0 + ai * HALF + m * 16; const float rs = rsv[ai][m]; bf16_t* rowp = O + (size_t)row * DIN + col0;
#pragma unroll
                for (int bj = 0; bj < 2; ++bj) { f32x4 v0 = acc[ai][bj][m][0] * rs, v1 = acc[ai][bj][m][1] * rs;
                    if (act) { v0 = (f32x4){gelu_tanh(v0[0]), gelu_tanh(v0[1]), gelu_tanh(v0[2]), gelu_tanh(v0[3])}; v1 = (f32x4){gelu_tanh(v1[0]), gelu_tanh(v1[1]), gelu_tanh(v1[2]), gelu_tanh(v1[3])}; }
                    u32x4 w; w.x = pk2(v0[0], v0[1]); w.y = pk2(v0[2], v0[3]); w.z = pk2(v1[0], v1[1]); w.w = pk2(v1[2], v1[3]);
                    *(u32x4*)(rowp + bj * HALF) = w; }
                if (m & 1) CFENCE(); }
    }
};
struct EpiGU {
    static constexpr bool PERM = true, AFTER_DRAIN = false;
    bf16_t* O; const float* ss;
    __device__ __forceinline__ void operator()(const f32x4 (&acc)[2][2][4][2], const Unit& u, int wr, int wc, int fr, int fq) const {
        const int row0 = u.pm * BM + wr * 64 + fr, col0 = u.pn * HALF + wc * 32 + 8 * fq;
        float rsv[2][4];
#pragma unroll
        for (int ai = 0; ai < 2; ++ai)
#pragma unroll
            for (int m = 0; m < 4; ++m) rsv[ai][m] = rstd_of(ss, row0 + ai * HALF + m * 16);
#pragma unroll
        for (int ai = 0; ai < 2; ++ai)
#pragma unroll
            for (int m = 0; m < 4; ++m) { const int row = row0 + ai * HALF + m * 16; const float rs = rsv[ai][m]; bf16_t* rowp = O + (size_t)row * DFF + col0;
                float h[8];
#pragma unroll
                for (int n = 0; n < 2; ++n)
#pragma unroll
                    for (int e = 0; e < 4; ++e) { const float g = acc[ai][0][m][n][e] * rs, up = acc[ai][1][m][n][e] * rs; h[n * 4 + e] = g * up * __builtin_amdgcn_rcpf(1.0f + fexp(-g)); }
                u32x4 w; w.x = pk2(h[0], h[1]); w.y = pk2(h[2], h[3]); w.z = pk2(h[4], h[5]); w.w = pk2(h[6], h[7]);
                *(u32x4*)rowp = w;
                if (m & 1) CFENCE(); }
    }
};
struct EpiRes {
    static constexpr bool PERM = true, AFTER_DRAIN = false;
    const float* xin32; float* xout32; bf16_t* xb; float* ss; LAS float* P;
    __device__ __forceinline__ void operator()(const f32x4 (&acc)[2][2][4][2], const Unit& u, int wr, int wc, int fr, int fq) const {
        const int row0 = u.pm * BM + wr * 64 + fr, col0 = u.pn * BM + wc * 32 + 8 * fq;
#pragma unroll
        for (int ai = 0; ai < 2; ++ai)
#pragma unroll
            for (int m = 0; m < 4; ++m) { const int row = row0 + ai * HALF + m * 16; const size_t off = (size_t)row * DM + col0; float q = 0.f;
#pragma unroll
                for (int bj = 0; bj < 2; ++bj) { f32x4 r0, r1;
                    if (xin32) { r0 = *(const f32x4*)(xin32 + off + bj * HALF); r1 = *(const f32x4*)(xin32 + off + bj * HALF + 4); }
                    else { const u32x4 t = *(const u32x4*)(xb + off + bj * HALF); r0 = (f32x4){bflo(t.x), bfhi(t.x), bflo(t.y), bfhi(t.y)}; r1 = (f32x4){bflo(t.z), bfhi(t.z), bflo(t.w), bfhi(t.w)}; }
                    const f32x4 v0 = r0 + acc[ai][bj][m][0], v1 = r1 + acc[ai][bj][m][1];
                    q += ssq4(v0) + ssq4(v1);
                    if (xout32) { *(f32x4*)(xout32 + off + bj * HALF) = v0; *(f32x4*)(xout32 + off + bj * HALF + 4) = v1; }
                    else { u32x4 w; w.x = pk2(v0[0], v0[1]); w.y = pk2(v0[2], v0[3]); w.z = pk2(v1[0], v1[1]); w.w = pk2(v1[2], v1[3]); *(u32x4*)(xb + off + bj * HALF) = w; } }
                q += __shfl_xor(q, 16); q += __shfl_xor(q, 32);
                if (fq == 0) P[(ai * HALF + wr * 64 + m * 16 + fr) * 4 + wc] = q;
                if (m & 1) CFENCE(); }
        asm volatile("s_waitcnt lgkmcnt(0)" ::: "memory"); __builtin_amdgcn_s_barrier(); asm volatile("" ::: "memory");
        const int t = wr * 256 + wc * 64 + fq * 16 + fr;
        if (t < 256) { const f32x4 pp = *(const LAS f32x4*)(P + t * 4); ss[(size_t)(u.pm * BM + t) * 4 + u.pn] = (pp.x + pp.y) + (pp.z + pp.w); }
    }
};
}

__device__ __forceinline__ void transpose_item(const float* W, int K, int N, bf16_t* WT, const float* gain, int mode, LAS float* scr, int item, int lane) {
    const int nblk = N / 32, kb = item / nblk, nb = item % nblk, k0 = 64 * kb, n0 = 32 * nb;
    const int c = lane & 7;
    f32x4 g0 = {1.f, 1.f, 1.f, 1.f}, g1 = {1.f, 1.f, 1.f, 1.f};
    if (gain) { g0 = *(const f32x4*)(gain + k0 + 8 * c); g1 = *(const f32x4*)(gain + k0 + 8 * c + 4); }
    const float* src = W + (size_t)(k0 + (lane >> 5)) * N + n0 + (lane & 31);
    float v[32];
#pragma unroll
    for (int i = 0; i < 32; ++i) v[i] = __builtin_nontemporal_load(src + (size_t)(2 * i) * N);
#pragma unroll
    for (int i = 0; i < 32; ++i) scr[(2 * i + (lane >> 5)) * 33 + (lane & 31)] = v[i];
    LDSWAIT();
#pragma unroll
    for (int j = 0; j < 4; ++j) { const int n = (lane >> 3) + 8 * j, gn = n0 + n; const LAS float* s = scr + (8 * c) * 33 + n;
        float cs = 1.0f; int row = gn;
        if (mode == 1) { if ((gn >= 768 && gn < 1024) || (gn >= 1280 && gn < 1536)) cs = 0.125f; }
        if (mode == 2) { const int jj = gn < DFF ? gn : gn - DFF; row = 256 * (jj >> 7) + (jj & 127) + (gn < DFF ? 0 : 128); }
        u32x4 o; o.x = pk2(s[0 * 33] * g0[0] * cs, s[1 * 33] * g0[1] * cs); o.y = pk2(s[2 * 33] * g0[2] * cs, s[3 * 33] * g0[3] * cs); o.z = pk2(s[4 * 33] * g1[0] * cs, s[5 * 33] * g1[1] * cs); o.w = pk2(s[6 * 33] * g1[2] * cs, s[7 * 33] * g1[3] * cs);
        *(u32x4*)(WT + (size_t)row * K + k0 + 8 * c) = o; }
    LDSWAIT();
}
__device__ __forceinline__ float wave_sum(float v) {
#pragma unroll
    for (int o = 1; o < 64; o <<= 1) v += __shfl_xor(v, o);
    return v;
}

struct Params {
    const float *x, *w_in, *w_out, *sgu_w, *sgu_b, *pool_w, *pool_scale, *swa_sinks, *rel_bias, *mix_out_gain, *norm_mix, *norm_ffn, *w_gate_up, *w_down, *norm_final;
    float* out; unsigned char* ws;
};


__device__ __forceinline__ void st4(bf16_t* p, const f32x4 y) { u32x2 o; o.x = pk2(y[0], y[1]); o.y = pk2(y[2], y[3]); *(u32x2*)p = o; }
#define VMWAIT() asm volatile("s_waitcnt vmcnt(0)" ::: "memory")
typedef short v4i16_t __attribute__((ext_vector_type(4)));
__device__ __forceinline__ bf16x8 tr_frag(const LAS bf16_t* p, int rows4) {
    const v4i16_t lo = __builtin_amdgcn_ds_read_tr16_b64_v4i16((LAS v4i16_t*)p);
    const v4i16_t hi = __builtin_amdgcn_ds_read_tr16_b64_v4i16((LAS v4i16_t*)(p + rows4));
    return (bf16x8){lo[0], lo[1], lo[2], lo[3], hi[0], hi[1], hi[2], hi[3]};
}

__device__ __forceinline__ void mixer_A(LAS unsigned char* L, const bf16_t* proj, const bf16_t* sguw, const float* sgub, bf16_t* ycat, int b, int ch, int tid, int lane, int w) {
    constexpr int VS = 264;
    LAS bf16_t* VL = (LAS bf16_t*)L;
    const size_t row0 = (size_t)b * SEQ + ch * 128;
    const int c = lane & 15, q = lane >> 4, wv = tid >> 6;
    const int nks = (w >> 1) + 1;
    const size_t trow = row0 + 16 * wv + c;
    const bf16_t* wbase = sguw + (size_t)(16 * wv + c) * 128 + 8 * q;
    const bf16_t* urow = proj + trow * DIN + 4 * q;
    bf16x8 bw[4][4]; u32x2 uu[4][4]; float bias[4];
#pragma unroll
    for (int h = 0; h < 4; ++h) { bias[h] = sgub[h * 128 + 16 * wv + c];
#pragma unroll
        for (int ks = 0; ks < 4; ++ks) if (ks < nks) bw[h][ks] = *(const bf16x8*)(wbase + h * 128 * 128 + 32 * ks);
#pragma unroll
        for (int n = 0; n < 4; ++n) uu[h][n] = *(const u32x2*)(urow + h * 64 + 16 * n); }
    {
        const int tok = tid >> 2, h = tid & 3;
        const bf16_t* src = proj + (row0 + tok) * DIN + 256 + h * 64;
        float v[64]; float s = 0.f;
#pragma unroll
        for (int i = 0; i < 8; ++i) { const u32x4 t = *(const u32x4*)(src + 8 * i);
            v[8 * i + 0] = bflo(t.x); v[8 * i + 1] = bfhi(t.x); v[8 * i + 2] = bflo(t.y); v[8 * i + 3] = bfhi(t.y); v[8 * i + 4] = bflo(t.z); v[8 * i + 5] = bfhi(t.z); v[8 * i + 6] = bflo(t.w); v[8 * i + 7] = bfhi(t.w); }
#pragma unroll
        for (int i = 0; i < 64; ++i) s += v[i];
        const float mean = s * (1.0f / 64.0f); float s2 = 0.f;
#pragma unroll
        for (int i = 0; i < 64; ++i) { v[i] -= mean; s2 += v[i] * v[i]; }
        const float rstd = rsqrtf(s2 * (1.0f / 64.0f) + EPS);
        LAS bf16_t* dst = VL + tok * VS + h * 64;
#pragma unroll
        for (int i = 0; i < 8; ++i) { u32x4 o; o.x = pk2(v[8 * i + 0] * rstd, v[8 * i + 1] * rstd); o.y = pk2(v[8 * i + 2] * rstd, v[8 * i + 3] * rstd); o.z = pk2(v[8 * i + 4] * rstd, v[8 * i + 5] * rstd); o.w = pk2(v[8 * i + 6] * rstd, v[8 * i + 7] * rstd);
            *(LAS u32x4*)(dst + 8 * i) = o; }
    }
    __syncthreads();
    const LAS bf16_t* vbase = VL + (8 * q + (c >> 2)) * VS + 4 * (c & 3);
    f32x4 yv[4][4]; float ssq = 0.f;
#pragma unroll
    for (int h = 0; h < 4; ++h) {
#pragma unroll
        for (int n = 0; n < 4; ++n) yv[h][n] = (f32x4){0.f, 0.f, 0.f, 0.f};
#pragma unroll
        for (int ks = 0; ks < 4; ++ks) if (ks < nks) {
#pragma unroll
            for (int n = 0; n < 4; ++n) { const bf16x8 a = tr_frag(vbase + 32 * ks * VS + h * 64 + 16 * n, 4 * VS); yv[h][n] = MFMA16(a, bw[h][ks], yv[h][n]); }
        }
#pragma unroll
        for (int n = 0; n < 4; ++n) { const u32x2 u2 = uu[h][n];
            f32x4 y; y[0] = bflo(u2.x) * (yv[h][n][0] + bias[h]); y[1] = bfhi(u2.x) * (yv[h][n][1] + bias[h]); y[2] = bflo(u2.y) * (yv[h][n][2] + bias[h]); y[3] = bfhi(u2.y) * (yv[h][n][3] + bias[h]);
            yv[h][n] = y; ssq += ssq4(y); }
    }
    ssq += __shfl_xor(ssq, 16); ssq += __shfl_xor(ssq, 32);
    const float rs = rsqrtf(ssq * (1.0f / 256.0f) + EPS);
    bf16_t* yrow = ycat + trow * DM + 0 + 4 * q;
#pragma unroll
    for (int h = 0; h < 4; ++h)
#pragma unroll
        for (int n = 0; n < 4; ++n) st4(yrow + h * 64 + 16 * n, yv[h][n] * rs);
}

__device__ __forceinline__ void mixer_B(LAS unsigned char* L, const bf16_t* proj, const bf16_t* pwt, const float* pscale, bf16_t* ycat, int b, int ch, int tid, int lane, int w) {
    constexpr int YS = 264;
    LAS bf16_t* PL = (LAS bf16_t*)L;
    LAS bf16_t* Y = (LAS bf16_t*)(L + 76032);
    const size_t row0 = (size_t)b * SEQ + ch * 128;
    {
        u32x4 t[9];
#pragma unroll
        for (int i = 0; i < 9; ++i) { const int id = tid + 512 * i, r = id >> 5, cc = id & 31; t[i] = (u32x4){0u, 0u, 0u, 0u};
            if (id < 143 * 32 && (ch > 0 || r >= 15)) t[i] = *(const u32x4*)(proj + (row0 - 15 + r) * DIN + 512 + 8 * cc); }
#pragma unroll
        for (int i = 0; i < 9; ++i) { const int id = tid + 512 * i, r = id >> 5, cc = id & 31; if (id < 143 * 32) *(LAS u32x4*)(PL + r * YS + 8 * cc) = t[i]; }
    }
    __syncthreads();
    {
        const int tok = tid >> 2, g = tid & 3; const int win = 2 << g; const int tseq = ch * 128 + tok; const int cnt = (tseq + 1 < win) ? (tseq + 1) : win;
        const float inv = 1.0f / (float)cnt;
#pragma unroll 1
        for (int hf = 0; hf < 2; ++hf) {
            const LAS bf16_t* src = PL + (tok + 15) * YS + g * 64 + hf * 32;
            float p0[32], s[32];
#pragma unroll
            for (int i = 0; i < 4; ++i) { const u32x4 t = *(const LAS u32x4*)(src + 8 * i);
                p0[8 * i + 0] = bflo(t.x); p0[8 * i + 1] = bfhi(t.x); p0[8 * i + 2] = bflo(t.y); p0[8 * i + 3] = bfhi(t.y); p0[8 * i + 4] = bflo(t.z); p0[8 * i + 5] = bfhi(t.z); p0[8 * i + 6] = bflo(t.w); p0[8 * i + 7] = bfhi(t.w); }
#pragma unroll
            for (int i = 0; i < 32; ++i) s[i] = p0[i];
#pragma unroll 1
            for (int j = 1; j < cnt; ++j) { const LAS bf16_t* sj = src - j * YS;
#pragma unroll
                for (int i = 0; i < 4; ++i) { const u32x4 t = *(const LAS u32x4*)(sj + 8 * i);
                    s[8 * i + 0] += bflo(t.x); s[8 * i + 1] += bfhi(t.x); s[8 * i + 2] += bflo(t.y); s[8 * i + 3] += bfhi(t.y); s[8 * i + 4] += bflo(t.z); s[8 * i + 5] += bfhi(t.z); s[8 * i + 6] += bflo(t.w); s[8 * i + 7] += bfhi(t.w); } }
#pragma unroll
            for (int i = 0; i < 4; ++i) { u32x4 o; o.x = pk2(s[8 * i + 0] * inv - p0[8 * i + 0], s[8 * i + 1] * inv - p0[8 * i + 1]); o.y = pk2(s[8 * i + 2] * inv - p0[8 * i + 2], s[8 * i + 3] * inv - p0[8 * i + 3]);
                o.z = pk2(s[8 * i + 4] * inv - p0[8 * i + 4], s[8 * i + 5] * inv - p0[8 * i + 5]); o.w = pk2(s[8 * i + 6] * inv - p0[8 * i + 6], s[8 * i + 7] * inv - p0[8 * i + 7]);
                *(LAS u32x4*)(Y + tok * YS + g * 64 + hf * 32 + 8 * i) = o; }
        }
    }
    __syncthreads();
    const int c = lane & 15, q = lane >> 4, wv = tid >> 6;
    const size_t trow = row0 + 16 * wv + c; float ssq = 0.f;
    const LAS bf16_t* ybase = Y + (16 * wv + c) * YS + 8 * q;
    const bf16_t* pbase = pwt + (size_t)c * 64 + 8 * q;
    f32x4 yv[4][4];
#pragma unroll
    for (int g = 0; g < 4; ++g) {
#pragma unroll
        for (int n = 0; n < 4; ++n) yv[g][n] = (f32x4){0.f, 0.f, 0.f, 0.f};
#pragma unroll
        for (int ks = 0; ks < 2; ++ks) { const bf16x8 bfrag = *(const LAS bf16x8*)(ybase + g * 64 + 32 * ks);
#pragma unroll
            for (int n = 0; n < 4; ++n) { const bf16x8 a = *(const bf16x8*)(pbase + (g * 64 + 16 * n) * 64 + 32 * ks); yv[g][n] = MFMA16(a, bfrag, yv[g][n]); } }
#pragma unroll
        for (int n = 0; n < 4; ++n) { const f32x4 sc = *(const f32x4*)(pscale + g * 64 + 16 * n + 4 * q); yv[g][n] = yv[g][n] * sc; ssq += ssq4(yv[g][n]); }
    }
    ssq += __shfl_xor(ssq, 16); ssq += __shfl_xor(ssq, 32);
    const float rs = rsqrtf(ssq * (1.0f / 256.0f) + EPS);
    bf16_t* yrow = ycat + trow * DM + 256 + 4 * q;
#pragma unroll
    for (int g = 0; g < 4; ++g)
#pragma unroll
        for (int n = 0; n < 4; ++n) st4(yrow + g * 64 + 16 * n, yv[g][n] * rs);
}

__device__ __forceinline__ bf16x8 tr_frag_perm(const LAS bf16_t* p, int rows16) {
    const v4i16_t lo = __builtin_amdgcn_ds_read_tr16_b64_v4i16((LAS v4i16_t*)p);
    const v4i16_t hi = __builtin_amdgcn_ds_read_tr16_b64_v4i16((LAS v4i16_t*)(p + rows16));
    return (bf16x8){lo[0], lo[1], lo[2], lo[3], hi[0], hi[1], hi[2], hi[3]};
}
__device__ __forceinline__ bf16x8 pack8(const f32x4 a, const f32x4 b) { u32x4 o; o.x = pk2(a[0], a[1]); o.y = pk2(a[2], a[3]); o.z = pk2(b[0], b[1]); o.w = pk2(b[2], b[3]); return __builtin_bit_cast(bf16x8, o); }

__device__ __forceinline__ void mixer_C(LAS unsigned char* L, const bf16_t* proj, const float* sinks, const float* rel_bias, bf16_t* ycat, int b, int qb, int tid, int lane, int w) {
    constexpr int KS = 144;
    const int wv = tid >> 6;
    LAS bf16_t* KL = (LAS bf16_t*)L;
    LAS bf16_t* VL = (LAS bf16_t*)(L + 73728);
    LAS float* BT = (LAS float*)(L + 152064);
    const size_t row0 = (size_t)b * SEQ + qb * 128;
    const int c = lane & 15, q = lane >> 4;
    const size_t trow = row0 + 16 * wv + c;
    {
        const int skey = tid >> 1, shalf = tid & 1; const bool okk = (qb > 0) || (skey >= 128);
        const bf16_t* ksrc = proj + (row0 - 128 + skey) * DIN + 1024 + shalf * 64;
        u32x4 kr[8], vr[8];
#pragma unroll
        for (int i = 0; i < 8; ++i) { kr[i] = (u32x4){0u, 0u, 0u, 0u}; vr[i] = (u32x4){0u, 0u, 0u, 0u}; if (okk) { kr[i] = *(const u32x4*)(ksrc + 8 * i); vr[i] = *(const u32x4*)(ksrc + 128 + 8 * i); } }
        { const int j = tid >> 7, dist = tid & 127; int bucket = dist;
          if (dist >= 16) { const int lg = 16 + (int)(__logf((float)dist * (1.0f / 16.0f)) / 2.0794415416798357f * 16.0f); bucket = lg < 31 ? lg : 31; }
          BT[j * 128 + dist] = rel_bias[bucket * 4 + j];
          if (tid < 288) *(LAS u32x4*)(VL + 256 * KS + 8 * tid) = (u32x4){0u, 0u, 0u, 0u}; }
#pragma unroll
        for (int i = 0; i < 8; ++i) { *(LAS u32x4*)(KL + skey * KS + shalf * 64 + 8 * i) = kr[i]; *(LAS u32x4*)(VL + skey * KS + shalf * 64 + 8 * i) = vr[i]; }
    }
    bf16x8 qf[4][2];
#pragma unroll
    for (int j = 0; j < 4; ++j)
#pragma unroll
        for (int ks = 0; ks < 2; ++ks) qf[j][ks] = *(const bf16x8*)(proj + trow * DIN + 768 + j * 64 + 32 * ks + 8 * q);
    __syncthreads();
    const LAS bf16_t* kbase = KL + (16 * wv + c) * KS + 8 * q;
    const LAS bf16_t* vbase = VL + (16 * wv + 4 * q + (c >> 2)) * KS + 4 * (c & 3);
    f32x4 yv[4][4]; float ssq = 0.f;
#pragma unroll
    for (int j = 0; j < 4; ++j) { const int kvh = j >> 1;
        f32x4 z[9];
#pragma unroll
        for (int kti = 0; kti < 9; ++kti) { z[kti] = (f32x4){0.f, 0.f, 0.f, 0.f};
#pragma unroll
            for (int ks = 0; ks < 2; ++ks) { const bf16x8 a = *(const LAS bf16x8*)(kbase + 16 * kti * KS + kvh * 64 + 32 * ks); z[kti] = MFMA16(a, qf[j][ks], z[kti]); } }
        const float sink = sinks[j]; const LAS float* bt = BT + j * 128;
        int zz; asm volatile("v_mov_b32 %0, 0" : "=v"(zz));
        const int cz = c + zz; const int klo = (qb > 0) ? (cz + 1) : max(cz + 1, 128 - 16 * w), khi = cz + 128;
        float mx = sink;
#pragma unroll
        for (int kti = 0; kti < 9; ++kti)
#pragma unroll
            for (int r = 0; r < 4; ++r) { const int kl = 16 * kti + 4 * q + r; const int dist = 128 + cz - kl; const bool valid = (unsigned)(kl - klo) <= (unsigned)(khi - klo);
                const float bb = bt[dist & 127]; const float v = valid ? (z[kti][r] + bb) : -1e30f; z[kti][r] = v; mx = fmaxf(mx, v); }
        mx = fmaxf(mx, __shfl_xor(mx, 16)); mx = fmaxf(mx, __shfl_xor(mx, 32));
        float sum = 0.f;
#pragma unroll
        for (int kti = 0; kti < 9; ++kti)
#pragma unroll
            for (int r = 0; r < 4; ++r) { const float p = (z[kti][r] > -1e29f) ? fexp(z[kti][r] - mx) : 0.f; z[kti][r] = p; sum += p; }
        sum += __shfl_xor(sum, 16); sum += __shfl_xor(sum, 32);
        const float inv = 1.0f / (sum + fexp(sink - mx));
#pragma unroll
        for (int n = 0; n < 4; ++n) yv[j][n] = (f32x4){0.f, 0.f, 0.f, 0.f};
#pragma unroll
        for (int ks = 0; ks < 5; ++ks) { const f32x4 zero4 = {0.f, 0.f, 0.f, 0.f};
            const bf16x8 bfrag = pack8(z[2 * ks] * inv, (ks < 4) ? (z[(ks < 4) ? 2 * ks + 1 : 0] * inv) : zero4);
#pragma unroll
            for (int n = 0; n < 4; ++n) { const bf16x8 a = tr_frag_perm(vbase + 32 * ks * KS + kvh * 64 + 16 * n, 16 * KS); yv[j][n] = MFMA16(a, bfrag, yv[j][n]); } }
#pragma unroll
        for (int n = 0; n < 4; ++n) ssq += ssq4(yv[j][n]);
    }
    ssq += __shfl_xor(ssq, 16); ssq += __shfl_xor(ssq, 32);
    const float rs = rsqrtf(ssq * (1.0f / 256.0f) + EPS);
    bf16_t* yrow = ycat + trow * DM + 512 + 4 * q;
#pragma unroll
    for (int j = 0; j < 4; ++j)
#pragma unroll
        for (int n = 0; n < 4; ++n) st4(yrow + j * 64 + 16 * n, yv[j][n] * rs);
}

#ifndef D_CUT
#define D_CUT 2.0e-9f
#endif
__device__ __forceinline__ void mixer_D(LAS unsigned char* L, const bf16_t* proj, bf16_t* ycat, int b, int qb64, int tid, int lane, int w) {
    constexpr int KS = 272;
    constexpr int TILE = 64 * KS;
    const int wv = tid >> 6;
    LAS bf16_t* KL = (LAS bf16_t*)L;
    LAS bf16_t* VL = (LAS bf16_t*)(L + 69632);
    LAS float* RED = (LAS float*)(L + 139264);
    volatile LAS unsigned* FLG = (volatile LAS unsigned*)(L + 139776);
    const int rg = wv & 3, hp = wv >> 2, c = lane & 15, q = lane >> 4;
    const size_t seq0 = (size_t)b * SEQ; const size_t trow = seq0 + qb64 * 64 + 16 * rg + c;
    const int skey = tid >> 3, spart = tid & 7;
    const bf16_t* ksrc0 = proj + (seq0 + skey) * DIN + 1536 + spart * 32;
    LAS bf16_t* kdst = KL + skey * KS + spart * 32;
    LAS bf16_t* vdst = VL + skey * KS + spart * 32;
    u32x4 kr[4], vr[4];
    { const bf16_t* ksrc = ksrc0 + (size_t)qb64 * 64 * DIN;
#pragma unroll
        for (int i = 0; i < 4; ++i) { kr[i] = *(const u32x4*)(ksrc + 8 * i); vr[i] = *(const u32x4*)(ksrc + 256 + 8 * i); } }
    bf16x8 qf[2][2];
#pragma unroll
    for (int hh = 0; hh < 2; ++hh)
#pragma unroll
        for (int ks = 0; ks < 2; ++ks) qf[hh][ks] = *(const bf16x8*)(proj + trow * DIN + 1280 + (2 * hp + hh) * 64 + 32 * ks + 8 * q);
    f32x4 acc[2][4];
#pragma unroll
    for (int hh = 0; hh < 2; ++hh)
#pragma unroll
        for (int n = 0; n < 4; ++n) acc[hh][n] = (f32x4){0.f, 0.f, 0.f, 0.f};
    float rem[2] = {1.f, 1.f};
    const int qloc = 16 * rg + c;
    const LAS bf16_t* kbase = KL + c * KS + hp * 128 + 8 * q;
    const LAS bf16_t* vbase = VL + (4 * q + (c >> 2)) * KS + hp * 128 + 4 * (c & 3);
    if (tid < 3) FLG[tid] = 0u;
#pragma unroll
    for (int i = 0; i < 4; ++i) { *(LAS u32x4*)(kdst + 8 * i) = kr[i]; *(LAS u32x4*)(vdst + 8 * i) = vr[i]; }
    if (qb64 > 0) { const bf16_t* ksrc = ksrc0 + (size_t)(qb64 - 1) * 64 * DIN;
#pragma unroll
        for (int i = 0; i < 4; ++i) { kr[i] = *(const u32x4*)(ksrc + 8 * i); vr[i] = *(const u32x4*)(ksrc + 256 + 8 * i); } }
    int it = 0, fprev = 2, fcur = 0, fnext = 1;
#pragma unroll 1
    for (int kt = qb64; kt >= 0; --kt, ++it) {
        __syncthreads();
        if (it > 0 && FLG[fprev] == 0u) break;
        const int bo = (it & 1) * TILE, bn = ((it + 1) & 1) * TILE;
        if (kt > 0) {
#pragma unroll
            for (int i = 0; i < 4; ++i) { *(LAS u32x4*)(kdst + bn + 8 * i) = kr[i]; *(LAS u32x4*)(vdst + bn + 8 * i) = vr[i]; }
            if (kt > 1) { const bf16_t* ksrc = ksrc0 + (size_t)(kt - 2) * 64 * DIN;
#pragma unroll
                for (int i = 0; i < 4; ++i) { kr[i] = *(const u32x4*)(ksrc + 8 * i); vr[i] = *(const u32x4*)(ksrc + 256 + 8 * i); } }
        }
        if (tid == 0) FLG[fnext] = 0u;
        const bool diag = (kt == qb64);
#pragma unroll
        for (int hh = 0; hh < 2; ++hh) {
            f32x4 z[4];
#pragma unroll
            for (int kti = 0; kti < 4; ++kti) { z[kti] = (f32x4){0.f, 0.f, 0.f, 0.f};
#pragma unroll
                for (int ks = 0; ks < 2; ++ks) { const bf16x8 a = *(const LAS bf16x8*)(kbase + bo + 16 * kti * KS + hh * 64 + 32 * ks); z[kti] = MFMA16(a, qf[hh][ks], z[kti]); } }
            f32x4 ex[4]; float G[4];
            if (diag) {
#pragma unroll
                for (int kti = 0; kti < 4; ++kti) { float run = 1.f;
#pragma unroll
                    for (int r = 3; r >= 0; --r) { const bool valid = (16 * kti + 4 * q + r < qloc);
                        const float u = fexp(fminf(z[kti][r], 80.f)); const float om = __builtin_amdgcn_rcpf(1.0f + u);
                        z[kti][r] = valid ? u * om : 0.f; ex[kti][r] = run; run *= valid ? om : 1.f; }
                    G[kti] = run; }
            } else {
#pragma unroll
                for (int kti = 0; kti < 4; ++kti) { float run = 1.f;
#pragma unroll
                    for (int r = 3; r >= 0; --r) { const float u = fexp(fminf(z[kti][r], 80.f)); const float om = __builtin_amdgcn_rcpf(1.0f + u);
                        z[kti][r] = u * om; ex[kti][r] = run; run *= om; }
                    G[kti] = run; }
            }
            float E[4], Tk[4];
#pragma unroll
            for (int kti = 0; kti < 4; ++kti) { const float bq = __shfl_xor(G[kti], 16); const float ps = G[kti] * bq; const float c2 = __shfl_xor(ps, 32);
                E[kti] = ((q & 1) ? 1.f : bq) * ((q < 2) ? c2 : 1.f); Tk[kti] = ps * c2; }
            const float U2 = Tk[3], U1 = U2 * Tk[2], U0 = U1 * Tk[1];
            const float cb = rem[hh];
            const float base[4] = {cb * U0 * E[0], cb * U1 * E[1], cb * U2 * E[2], cb * E[3]};
            rem[hh] = cb * U0 * Tk[0];
#pragma unroll
            for (int kti = 0; kti < 4; ++kti)
#pragma unroll
                for (int r = 0; r < 4; ++r) z[kti][r] = z[kti][r] * (base[kti] * ex[kti][r]);
#pragma unroll
            for (int ks = 0; ks < 2; ++ks) { const bf16x8 bfrag = pack8(z[2 * ks], z[2 * ks + 1]);
#pragma unroll
                for (int n = 0; n < 4; ++n) { const bf16x8 a = tr_frag_perm(vbase + bo + 32 * ks * KS + hh * 64 + 16 * n, 16 * KS); acc[hh][n] = MFMA16(a, bfrag, acc[hh][n]); } }
        }
        if (__builtin_amdgcn_ballot_w64(fmaxf(rem[0], rem[1]) > D_CUT) != 0ull) { if (lane == 0) FLG[fcur] = 1u; }
        { const int t = fprev; fprev = fcur; fcur = fnext; fnext = t; }
    }
    float ssq = 0.f;
#pragma unroll
    for (int hh = 0; hh < 2; ++hh)
#pragma unroll
        for (int n = 0; n < 4; ++n) ssq += ssq4(acc[hh][n]);
    ssq += __shfl_xor(ssq, 16); ssq += __shfl_xor(ssq, 32);
    __syncthreads();
    if (q == 0) RED[(16 * rg + c) * 2 + hp] = ssq;
    __syncthreads();
    const float tot = RED[(16 * rg + c) * 2 + 0] + RED[(16 * rg + c) * 2 + 1];
    const float rs = rsqrtf(tot * (1.0f / 256.0f) + EPS);
    bf16_t* yrow = ycat + trow * DM + 768 + hp * 128 + 4 * q;
#pragma unroll
    for (int hh = 0; hh < 2; ++hh)
#pragma unroll
        for (int n = 0; n < 4; ++n) st4(yrow + hh * 64 + 16 * n, acc[hh][n] * rs);
}

#define XB_TMO      128
#define XB_XCNT(j)  (256  + 64 * (j))
#define XB_XSUB(j)  (1280 + 64 * (j))
#define XB_XGEN(j)  (2304 + 64 * (j))
#define XB_TOP      3328
#define XB_TOPGEN   3392
#define XCD_BAR_WORDS 3456
#define XB_SPIN_CAP (1u << 18)

__device__ __forceinline__ unsigned xb_ld(unsigned* p)              { return __hip_atomic_load(p, __ATOMIC_RELAXED, __HIP_MEMORY_SCOPE_AGENT); }
__device__ __forceinline__ unsigned xb_add(unsigned* p, unsigned v) { return __hip_atomic_fetch_add(p, v, __ATOMIC_RELAXED, __HIP_MEMORY_SCOPE_AGENT); }
__device__ __forceinline__ unsigned xb_xcc_id() { return (unsigned)__builtin_amdgcn_s_getreg((3 << 11) | 20) & 0xFu; }
#define XB_SPIN(cond, bar) do { unsigned _sp = 0; while (cond) { __builtin_amdgcn_s_sleep(1); \
    if ((++_sp & 255u) == 0u) { if (xb_ld(&(bar)[XB_TMO])) break; if (_sp > XB_SPIN_CAP) { atomicAdd(&(bar)[XB_TMO], 1u); break; } } } } while (0)

struct XcdBarrier {
    unsigned* bar; unsigned x;
    volatile LAS unsigned* st;
};

__device__ __forceinline__ XcdBarrier xcd_barrier_post(unsigned* bar, volatile LAS unsigned* st) {
    XcdBarrier b; b.bar = bar; b.x = xb_xcc_id(); b.st = st;
    if (threadIdx.x == 0) (void)xb_add(&bar[XB_XCNT(b.x)], 1u);
    return b;
}
__device__ __forceinline__ void xcd_barrier_complete(unsigned* bar, unsigned x, unsigned& nloc, unsigned& nx) {
    const unsigned G = gridDim.x * gridDim.y * gridDim.z;
    unsigned sum, cnt, mine, sp = 0u;
    for (;;) {
        sum = 0u; cnt = 0u; mine = 0u;
#pragma unroll
        for (unsigned j = 0; j < 16; ++j) { const unsigned c = xb_ld(&bar[XB_XCNT(j)]); sum += c; cnt += (c > 0u) ? 1u : 0u; mine = (j == x) ? c : mine; }
        if (sum == G) break;
        __builtin_amdgcn_s_sleep(1);
        if ((++sp & 255u) == 0u) { if (xb_ld(&bar[XB_TMO])) break; if (sp > XB_SPIN_CAP) { atomicAdd(&bar[XB_TMO], 1u); break; } }
    }
    nloc = mine > 0u ? mine : 1u; nx = cnt > 0u ? cnt : 1u;
}

__device__ __forceinline__ void xcd_barrier(const XcdBarrier& b) {
    asm volatile("s_waitcnt vmcnt(0)" ::: "memory");
    __syncthreads();
    if (threadIdx.x == 0) {
        unsigned* bar = b.bar;
        __builtin_amdgcn_s_waitcnt(0);
        unsigned nloc = b.st[0], nx = b.st[1];
        if (nloc == 0u) { xcd_barrier_complete(bar, b.x, nloc, nx); b.st[0] = nloc; b.st[1] = nx; }
        const unsigned old = xb_add(&bar[XB_XSUB(b.x)], 1u);
        const unsigned gen = old / nloc;
        if (old + 1u == (gen + 1u) * nloc) {
            __builtin_amdgcn_fence(__ATOMIC_RELEASE, "agent");
            asm volatile("s_waitcnt vmcnt(0)" ::: "memory");
            const unsigned og = xb_add(&bar[XB_TOP], 1u);
            const unsigned tg = og / nx;
            if (og + 1u == (tg + 1u) * nx) xb_add(&bar[XB_TOPGEN], 1u);
            else XB_SPIN(xb_ld(&bar[XB_TOPGEN]) == tg, bar);
            __builtin_amdgcn_fence(__ATOMIC_ACQUIRE, "agent");
            xb_add(&bar[XB_XGEN(b.x)], 1u);
            asm volatile("s_waitcnt vmcnt(0)" ::: "memory");
        } else {
            XB_SPIN(xb_ld(&bar[XB_XGEN(b.x)]) == gen, bar);
            __builtin_amdgcn_fence(__ATOMIC_ACQUIRE, "agent");
            asm volatile("s_waitcnt vmcnt(0)" ::: "memory");
        }
    }
    __syncthreads();
}

#ifndef REP_SYNC
#define REP_SYNC 1
#endif
#define GSYNC() do { for (int _r = 0; _r < REP_SYNC; ++_r) xcd_barrier(xbar); } while (0)
__global__ void __launch_bounds__(NTHR, 2) fwd_megakernel(Params p) {
    extern __shared__ __attribute__((aligned(16))) unsigned char lds[];
    cg::grid_group grid = cg::this_grid();
    LAS unsigned char* L = (LAS unsigned char*)lds;
    const int tid = threadIdx.x, lane = tid & 63, wave = __builtin_amdgcn_readfirstlane(tid >> 6);
    const int G = gridDim.x, bx = blockIdx.x;
    unsigned char* ws = p.ws;
    bf16_t* Win_t = (bf16_t*)(ws + WS_WIN); bf16_t* Wout_t = (bf16_t*)(ws + WS_WOUT); bf16_t* Wgu_t = (bf16_t*)(ws + WS_WGU); bf16_t* Wdn_t = (bf16_t*)(ws + WS_WDN);
    bf16_t* SGUW = (bf16_t*)(ws + WS_SGUW); bf16_t* PWT = (bf16_t*)(ws + WS_PWT); float* SSQ = (float*)(ws + WS_SS);
    bf16_t* XB = (bf16_t*)(ws + WS_XB); bf16_t* PROJ = (bf16_t*)(ws + WS_PROJ); bf16_t* YCAT = (bf16_t*)(ws + WS_YCAT); bf16_t* HID = (bf16_t*)(ws + WS_HID);

    volatile LAS unsigned* xst = (volatile LAS unsigned*)(L + LDS_BYTES - 16);
    if (tid < 4) xst[tid] = 0u;
    unsigned* barw = (unsigned*)(ws + WS_BAR);
    if (bx == 0) for (int i = tid; i < XCD_BAR_WORDS; i += NTHR) __hip_atomic_store(barw + i, 0u, __ATOMIC_RELAXED, __HIP_MEMORY_SCOPE_AGENT);
#ifndef REP_P0
#define REP_P0 1
#endif
    for (int rep0 = 0; rep0 < REP_P0; ++rep0) {
        LAS float* scr = (LAS float*)(L + wave * 16384);
        const int gw = bx * 8 + wave, NGW = G * 8;
        constexpr int I_IN = (DM / 64) * (DIN / 32), I_OUT = (DM / 64) * (DM / 32), I_GU = (DM / 64) * (2 * DFF / 32), I_DN = (DFF / 64) * (DM / 32), I_L = I_IN + I_OUT + I_GU + I_DN;
        for (int it = gw; it < DEPTH * I_L; it += NGW) {
            const int l = it / I_L; int r = it % I_L;
            if (r < I_IN) { transpose_item(p.w_in + (size_t)l * DM * DIN, DM, DIN, Win_t + (size_t)l * DIN * DM, p.norm_mix + l * DM, 1, scr, r, lane); continue; } r -= I_IN;
            if (r < I_OUT) { transpose_item(p.w_out + (size_t)l * DM * DM, DM, DM, Wout_t + (size_t)l * DM * DM, p.mix_out_gain + l * DM, 0, scr, r, lane); continue; } r -= I_OUT;
            if (r < I_GU) { transpose_item(p.w_gate_up + (size_t)l * DM * 2 * DFF, DM, 2 * DFF, Wgu_t + (size_t)l * 2 * DFF * DM, p.norm_ffn + l * DM, 2, scr, r, lane); continue; } r -= I_GU;
            transpose_item(p.w_down + (size_t)l * DFF * DM, DFF, DM, Wdn_t + (size_t)l * DM * DFF, nullptr, 0, scr, r, lane);
        }
        for (int m = 2 * gw; m < M; m += 2 * NGW) {
            const f32x4* xr = (const f32x4*)(p.x + (size_t)m * DM) + lane; u32x2* o8 = (u32x2*)(XB + (size_t)m * DM) + lane; f32x4 v[2][4];
#pragma unroll
            for (int r = 0; r < 2; ++r)
#pragma unroll
                for (int j = 0; j < 4; ++j) v[r][j] = __builtin_nontemporal_load(xr + r * 256 + 64 * j);
#pragma unroll
            for (int r = 0; r < 2; ++r) { float s = 0.f;
#pragma unroll
                for (int j = 0; j < 4; ++j) { const f32x4 t = v[r][j]; s += ssq4(t); u32x2 o; o.x = pk2(t.x, t.y); o.y = pk2(t.z, t.w); o8[r * 256 + 64 * j] = o; }
                s = wave_sum(s);
                if (lane < 4) SSQ[(size_t)(m + r) * 4 + lane] = (lane == 0) ? s : 0.f; }
        }
        const int gt = bx * NTHR + tid, NGT = G * NTHR;
        for (int e = gt; e < DEPTH * 4 * 128 * 128 / 8; e += NGT) { const int s0 = (e & 15) * 8, t = (e >> 4) & 127; const float* src = p.sgu_w + (size_t)e * 8;
            const f32x4 a = *(const f32x4*)src, bq = *(const f32x4*)(src + 4); float v[8] = {a.x, a.y, a.z, a.w, bq.x, bq.y, bq.z, bq.w};
#pragma unroll
            for (int i = 0; i < 8; ++i) v[i] = (s0 + i <= t) ? v[i] : 0.f;
            u32x4 o; o.x = pk2(v[0], v[1]); o.y = pk2(v[2], v[3]); o.z = pk2(v[4], v[5]); o.w = pk2(v[6], v[7]); *(u32x4*)(SGUW + (size_t)e * 8) = o; }
        for (int e = gt; e < DEPTH * 4 * 64 * 64; e += NGT) { const int cc = e & 63, d = (e >> 6) & 63, lg = e >> 12; PWT[e] = f2bf(p.pool_w[((size_t)lg * 64 + cc) * 64 + d]); }
    }
    grid.sync();
    const XcdBarrier xbar = xcd_barrier_post(barw, xst);

    for (int l = 0; l < DEPTH; ++l) {
#ifndef REP_P1
#define REP_P1 1
#endif
#ifndef NO_P1
        for (int rep = 0; rep < REP_P1; ++rep) { int zk; asm volatile("s_mov_b32 %0, 0" : "=s"(zk)); pg8::Gemm g{XB, Win_t + (size_t)l * DIN * DM, M, DIN, DM + zk}; pg8::StaticOrder S; S.init(M, DIN, G + zk, bx); pg8::EpiIn E{PROJ, SSQ};
          pg8::gemm_phase<pg8::EpiIn, pg8::StaticOrder, true, true>(L, g, S, E, zk); }
#endif
        GSYNC();
#ifndef REP_MIX
#define REP_MIX 1
#endif
#ifndef REP_D
#define REP_D 1
#endif
        for (int rep = 0; rep < REP_MIX; ++rep)
        for (int u0 = bx; u0 < 256; u0 += G) {
            const int u = (G == 256) ? (((u0 & 7) << 5) | (u0 >> 3)) : u0; const int b = u >> 4, ch = u & 15;
            __syncthreads();
#ifndef REP_A
#define REP_A 1
#endif
#ifndef NO_A
            for (int rp = 0; rp < REP_A; ++rp) { __syncthreads(); int zt; asm volatile("v_mov_b32 %0, 0" : "=v"(zt)); const int t2 = tid + zt; mixer_A(L, PROJ, SGUW + (size_t)l * 4 * 128 * 128, p.sgu_b + l * 4 * 128, YCAT, b, ch, t2, t2 & 63, __builtin_amdgcn_readfirstlane(t2 >> 6)); }
#endif
            __syncthreads();
#ifndef REP_B
#define REP_B 1
#endif
#ifndef NO_B
            for (int rp = 0; rp < REP_B; ++rp) { __syncthreads(); int zt; asm volatile("v_mov_b32 %0, 0" : "=v"(zt)); const int t2 = tid + zt; mixer_B(L, PROJ, PWT + (size_t)l * 4 * 64 * 64, p.pool_scale + l * 256, YCAT, b, ch, t2, t2 & 63, __builtin_amdgcn_readfirstlane(t2 >> 6)); }
#endif
            __syncthreads();
#ifndef REP_C
#define REP_C 1
#endif
#ifndef NO_C
            for (int rp = 0; rp < REP_C; ++rp) { __syncthreads(); int zt; asm volatile("v_mov_b32 %0, 0" : "=v"(zt)); const int t2 = tid + zt; mixer_C(L, PROJ, p.swa_sinks + l * 4, p.rel_bias, YCAT, b, ch, t2, t2 & 63, __builtin_amdgcn_readfirstlane(t2 >> 6)); }
#endif
            __syncthreads();
#ifndef NO_D
#pragma unroll 1
            for (int hf = 0; hf < 2 * REP_D; ++hf) { int zt; asm volatile("v_mov_b32 %0, 0" : "=v"(zt)); const int t2 = tid + zt; mixer_D(L, PROJ, YCAT, b, (hf & 1) ? 31 - ch : ch, t2, t2 & 63, __builtin_amdgcn_readfirstlane(t2 >> 6)); __syncthreads(); }
#endif
        }
        GSYNC();
#ifndef NO_P3
        { int zk; asm volatile("s_mov_b32 %0, 0" : "=s"(zk)); pg8::Gemm g{YCAT, Wout_t + (size_t)l * DM * DM, M, DM, DM + zk}; pg8::StaticOrder S; S.init(M, DM, G + zk, bx); pg8::EpiRes E{l == 0 ? p.x : nullptr, nullptr, XB, SSQ, (LAS float*)(L + 131072)};
          pg8::gemm_phase<pg8::EpiRes, pg8::StaticOrder, true, true>(L, g, S, E, zk); }
#endif
        GSYNC();
#ifndef REP_P4
#define REP_P4 1
#endif
#ifndef NO_P4
        for (int rep = 0; rep < REP_P4; ++rep) { int zk; asm volatile("s_mov_b32 %0, 0" : "=s"(zk)); pg8::Gemm g{XB, Wgu_t + (size_t)l * 2 * DFF * DM, M, 2 * DFF, DM + zk}; pg8::StaticOrder S; S.init(M, 2 * DFF, G + zk, bx); pg8::EpiGU E{HID, SSQ};
          pg8::gemm_phase<pg8::EpiGU, pg8::StaticOrder, true, true>(L, g, S, E, zk); }
#endif
        GSYNC();
#ifndef NO_P5
        { int zk; asm volatile("s_mov_b32 %0, 0" : "=s"(zk)); pg8::Gemm g{HID, Wdn_t + (size_t)l * DM * DFF, M, DM, DFF + zk}; pg8::StaticOrder S; S.init(M, DM, G + zk, bx); pg8::EpiRes E{nullptr, l == DEPTH - 1 ? p.out : nullptr, XB, SSQ, (LAS float*)(L + 131072)};
          pg8::gemm_phase<pg8::EpiRes, pg8::StaticOrder, true, true>(L, g, S, E, zk); }
#endif
        GSYNC();
    }
    {
        const int gw = bx * 8 + wave, NGW = G * 8;
        for (int m = gw; m < M; m += NGW) { const float rs = rstd_of(SSQ, m); f32x4* xr = (f32x4*)(p.out + (size_t)m * DM) + lane; const f32x4* gr = (const f32x4*)p.norm_final + lane;
#pragma unroll
            for (int j = 0; j < 4; ++j) { const f32x4 v = xr[64 * j], gg = gr[64 * j]; xr[64 * j] = v * rs * gg; } }
    }
}

extern "C" void kernel_launch(void* const* d_in, const int* in_sizes, int n_in, void* d_out, int out_size, void* d_ws, size_t ws_size, hipStream_t stream) {
    static int grid_blocks = 0;
    if (grid_blocks == 0) {
        if (n_in != 15 || in_sizes[0] != M * DM || out_size != M * DM || ws_size < WS_END) { fprintf(stderr, "kernel_launch: unexpected shapes (n_in %d, in0 %d, out %d, ws %zu)\n", n_in, n_in > 0 ? in_sizes[0] : -1, out_size, ws_size); grid_blocks = -1; return; }
        int dev = 0, cus = 0, per_cu = 0;
        hipGetDevice(&dev); hipDeviceGetAttribute(&cus, hipDeviceAttributeMultiprocessorCount, dev);
        if (hipFuncSetAttribute((const void*)fwd_megakernel, hipFuncAttributeMaxDynamicSharedMemorySize, LDS_BYTES) != hipSuccess) { fprintf(stderr, "kernel_launch: hipFuncSetAttribute failed\n"); }
        if (hipOccupancyMaxActiveBlocksPerMultiprocessor(&per_cu, (const void*)fwd_megakernel, NTHR, LDS_BYTES) != hipSuccess || per_cu < 1) { fprintf(stderr, "kernel_launch: occupancy query says %d\n", per_cu); per_cu = 1; }
        (void)hipGetLastError();
        grid_blocks = cus * 1;
        if (grid_blocks <= 0) grid_blocks = 256;
    }
    if (grid_blocks < 0) return;
    Params p{};
    p.x = (const float*)d_in[0]; p.w_in = (const float*)d_in[1]; p.w_out = (const float*)d_in[2]; p.sgu_w = (const float*)d_in[3]; p.sgu_b = (const float*)d_in[4];
    p.pool_w = (const float*)d_in[5]; p.pool_scale = (const float*)d_in[6]; p.swa_sinks = (const float*)d_in[7]; p.rel_bias = (const float*)d_in[8]; p.mix_out_gain = (const float*)d_in[9];
    p.norm_mix = (const float*)d_in[10]; p.norm_ffn = (const float*)d_in[11]; p.w_gate_up = (const float*)d_in[12]; p.w_down = (const float*)d_in[13]; p.norm_final = (const float*)d_in[14];
    p.out = (float*)d_out; p.ws = (unsigned char*)d_ws;
    void* args[] = {&p};
    hipError_t e = hipLaunchCooperativeKernel((const void*)fwd_megakernel, dim3(grid_blocks), dim3(NTHR), args, LDS_BYTES, stream);
    if (e != hipSuccess) fprintf(stderr, "cooperative launch failed: %s (grid %d)\n", hipGetErrorString(e), grid_blocks);
}
```

```cpp
#include <hip/hip_runtime.h>
#include <hip/hip_cooperative_groups.h>
#include <cstdio>
#include <cstdint>
namespace cg = cooperative_groups;
namespace pg8 {
#define PG8_LAS __attribute__((address_space(3)))
typedef unsigned short bf16_t;
typedef short bf16x8 __attribute__((ext_vector_type(8)));
typedef float f32x4 __attribute__((ext_vector_type(4)));
typedef unsigned u32x4 __attribute__((ext_vector_type(4)));
constexpr int BM = 256, BK = 64, HALF = 128, HTB = HALF * BK * 2  , STAGE_BYTES = 8 * HTB, NXCD = 8, WGM = 8;

__host__ __device__ __forceinline__ int lds_byte(int r, int c) { const int st = (r >> 4) * 2 + (c >> 5), rr = r & 15, cc = c & 31, ob = rr * 64 + cc * 2; return st * 1024 + (ob ^ (((ob >> 9) & 1) << 5)); }
__host__ __device__ __forceinline__ void stage_rc(int b, int& R, int& C) { const int st = b / 1024, sb = b % 1024, swz = sb ^ (((sb >> 9) & 1) << 5); R = (st >> 1) * 16 + swz / 64; C = (st & 1) * 32 + (swz % 64) / 2; }
__host__ __device__ __forceinline__ int perm32(int rho) { const int n = rho >> 4, i = rho & 15; return 8 * (i >> 2) + 4 * n + (i & 3); }

struct Unit { int pm, pn; };
struct Gemm { const bf16_t* A; const bf16_t* Bt; int M, N, K; };

struct StaticOrder {
    int nM, nN, nwg, G, c;
    __host__ __device__ void init(int M, int N, int G_, int c_) { nM = M / BM; nN = N / BM; nwg = nM * nN; G = G_; c = c_; }
    __host__ __device__ bool next(int i, Unit& u) const {
        const long L = (long)i * G + c; if (L >= nwg) return false;
        int wgid = (int)L; { const int q = nwg / NXCD, r = nwg % NXCD, xcd = wgid % NXCD, off = wgid / NXCD; wgid = (xcd < r ? xcd * (q + 1) : r * (q + 1) + (xcd - r) * q) + off; }
        const int nig = WGM * nN, gid = wgid / nig, fm = gid * WGM, gsz = (nM - fm) < WGM ? (nM - fm) : WGM;
        u.pm = fm + ((wgid % nig) % gsz); u.pn = (wgid % nig) / gsz; return true;
    }
    __device__ __forceinline__ void a_ready(const Unit&) const {}
    __device__ __forceinline__ void done(const Unit&) const {}
};

__device__ __forceinline__ unsigned cvt_pk_bf16(float lo, float hi) { unsigned r; asm volatile("v_cvt_pk_bf16_f32 %0, %1, %2" : "=v"(r) : "v"(lo), "v"(hi)); return r; }
typedef float f32x2 __attribute__((ext_vector_type(2)));
template <class Epi, class Sched, bool ALIGN_EPI = false, bool SP2 = false>
__device__ __forceinline__ void gemm_phase(PG8_LAS unsigned char* lds, const Gemm g, const Sched& S, const Epi& E, const int opq) {
    const int tid = threadIdx.x + opq, wid = __builtin_amdgcn_readfirstlane(tid >> 6), lane = tid & 63, wr = wid >> 2, wc = wid & 3, fr = lane & 15, fq = lane >> 4;
    const int K = g.K, nt = K / BK;
    unsigned voffA[2], voffB[2];
#pragma unroll
    for (int i = 0; i < 2; ++i) { int R, C; stage_rc(tid * 16 + i * 8192, R, C); const int Rb = Epi::PERM ? ((R & ~31) + perm32(R & 31)) : R;
        voffA[i] = (unsigned)(R * K + C) * 2u; voffB[i] = (unsigned)(Rb * K + C) * 2u; }
    const size_t kstep = (size_t)(BK * 2);
    const size_t hstep = (size_t)HALF * K * 2;
    const size_t tstep = 2 * hstep;
    const unsigned ldsw = (unsigned)wid * 1024u;
    const int aoff = lds_byte(wr * 64 + fr, fq * 8), boff = lds_byte(wc * 32 + fr, fq * 8);
#define PG8_SA(b, h) (((b) * 2 + (h)) * HTB)
#define PG8_SB(b, h) ((4 + (b) * 2 + (h)) * HTB)
#define PG8_STAGE(bufoff, gbase, voff) do { _Pragma("unroll") for (int _i = 0; _i < 2; ++_i) \
        __builtin_amdgcn_global_load_lds((const unsigned*)((const char*)(gbase) + (voff)[_i]), (PG8_LAS unsigned*)(lds + (bufoff) + ldsw + _i * 8192), 16, 0, 0); } while (0)
#define PG8_LDA(dst, b, h) do { _Pragma("unroll") for (int m = 0; m < 4; ++m) _Pragma("unroll") for (int k = 0; k < 2; ++k) dst[m][k] = *(const PG8_LAS bf16x8*)(lds + PG8_SA(b, h) + aoff + m * 2048 + k * 1024); } while (0)
#define PG8_LDB(dst, b, h) do { _Pragma("unroll") for (int n = 0; n < 2; ++n) _Pragma("unroll") for (int k = 0; k < 2; ++k) dst[n][k] = *(const PG8_LAS bf16x8*)(lds + PG8_SB(b, h) + boff + n * 2048 + k * 1024); } while (0)
#define PG8_MMA(ai, bj, At, Bt) do { __builtin_amdgcn_s_setprio(1); _Pragma("unroll") for (int m = 0; m < 4; ++m) _Pragma("unroll") for (int n = 0; n < 2; ++n) _Pragma("unroll") for (int k = 0; k < 2; ++k) \
        acc[ai][bj][m][n] = __builtin_amdgcn_mfma_f32_16x16x32_bf16(Bt[n][k], At[m][k], acc[ai][bj][m][n], 0, 0, 0); __builtin_amdgcn_s_setprio(0); } while (0)
#define PG8_WAIT_V(n) asm volatile("s_waitcnt vmcnt(" #n ")" ::: "memory")
#define PG8_WAIT_L(n) asm volatile("s_waitcnt lgkmcnt(" #n ")" ::: "memory")
#define PG8_BAR __builtin_amdgcn_s_barrier()
#define PG8_SCHED __builtin_amdgcn_sched_barrier(0)
    Unit cur, nxt; int ui = 0;
    if (!S.next(0, cur)) return;
    f32x4 acc[2][2][4][2];
#pragma unroll
    for (int a = 0; a < 2; ++a)
#pragma unroll
        for (int b = 0; b < 2; ++b)
#pragma unroll
            for (int m = 0; m < 4; ++m)
#pragma unroll
                for (int n = 0; n < 2; ++n) acc[a][b][m][n] = (f32x4){0.f, 0.f, 0.f, 0.f};
    bf16x8 At[4][2], B0[2][2], B1[2][2];
    const char* cA = (const char*)g.A + (size_t)cur.pm * tstep; const char* cB = (const char*)g.Bt + (size_t)cur.pn * tstep;
    S.a_ready(cur);
    if constexpr (SP2) {
        PG8_STAGE(PG8_SB(0, 0), cB, voffB); PG8_STAGE(PG8_SB(0, 1), cB + hstep, voffB); PG8_STAGE(PG8_SA(0, 0), cA, voffA); PG8_STAGE(PG8_SA(0, 1), cA + hstep, voffA);
        if (wr == 1) PG8_BAR;
        PG8_WAIT_V(2); PG8_BAR;
        PG8_STAGE(PG8_SB(1, 0), cB + kstep, voffB); PG8_STAGE(PG8_SA(1, 0), cA + kstep, voffA); PG8_STAGE(PG8_SB(1, 1), cB + hstep + kstep, voffB);
        PG8_WAIT_V(6); PG8_BAR;
    } else {
        PG8_STAGE(PG8_SB(0, 0), cB, voffB); PG8_STAGE(PG8_SA(0, 0), cA, voffA); PG8_STAGE(PG8_SB(0, 1), cB + hstep, voffB); PG8_STAGE(PG8_SA(0, 1), cA + hstep, voffA);
        if (wr == 1) PG8_BAR;
        PG8_WAIT_V(4); PG8_BAR;
        PG8_STAGE(PG8_SB(1, 0), cB + kstep, voffB); PG8_STAGE(PG8_SA(1, 0), cA + kstep, voffA); PG8_STAGE(PG8_SB(1, 1), cB + hstep + kstep, voffB);
        PG8_WAIT_V(6); PG8_BAR;
    }
    for (;;) {
        const bool has_next = S.next(ui + 1, nxt);
        const char* nA = has_next ? (const char*)g.A + (size_t)nxt.pm * tstep : cA; const char* nB = has_next ? (const char*)g.Bt + (size_t)nxt.pn * tstep : cB;
        for (int t = 0; t < nt; t += 2) {
            const bool last = (t == nt - 2);
            const char* a1 = cA + (size_t)(t + 1) * kstep;
            const char* a2 = last ? nA : cA + (size_t)(t + 2) * kstep; const char* b2 = last ? nB : cB + (size_t)(t + 2) * kstep;
            const char* a3 = a2 + kstep; const char* b3 = b2 + kstep;
            if (last && has_next) S.a_ready(nxt);
            if constexpr (SP2) {
            PG8_LDB(B0, 0, 0); PG8_LDB(B1, 0, 1); PG8_SCHED; PG8_LDA(At, 0, 0); PG8_STAGE(PG8_SA(1, 1), a1 + hstep, voffA);
            PG8_WAIT_V(8); PG8_WAIT_L(0); PG8_BAR; PG8_MMA(0, 0, At, B0); PG8_MMA(0, 1, At, B1); PG8_BAR; PG8_SCHED;
            PG8_LDA(At, 0, 1); PG8_STAGE(PG8_SB(0, 0), b2, voffB); PG8_STAGE(PG8_SB(0, 1), b2 + hstep, voffB); PG8_STAGE(PG8_SA(0, 0), a2, voffA);
            PG8_WAIT_V(8); PG8_WAIT_L(0); PG8_BAR; PG8_MMA(1, 0, At, B0); PG8_MMA(1, 1, At, B1); PG8_BAR; PG8_SCHED;
            PG8_LDB(B0, 1, 0); PG8_LDB(B1, 1, 1); PG8_SCHED; PG8_LDA(At, 1, 0); PG8_STAGE(PG8_SA(0, 1), a2 + hstep, voffA);
            PG8_WAIT_V(8); PG8_WAIT_L(0); PG8_BAR; PG8_MMA(0, 0, At, B0); PG8_MMA(0, 1, At, B1); PG8_BAR; PG8_SCHED;
            PG8_LDA(At, 1, 1); PG8_STAGE(PG8_SB(1, 0), b3, voffB); PG8_STAGE(PG8_SB(1, 1), b3 + hstep, voffB); PG8_STAGE(PG8_SA(1, 0), a3, voffA);
            PG8_WAIT_V(8); PG8_WAIT_L(0); PG8_BAR; PG8_MMA(1, 0, At, B0); PG8_MMA(1, 1, At, B1); PG8_BAR; PG8_SCHED;
            } else {
            PG8_LDB(B0, 0, 0); PG8_SCHED; PG8_LDA(At, 0, 0); PG8_STAGE(PG8_SA(1, 1), a1 + hstep, voffA);
            PG8_WAIT_L(8); PG8_BAR; PG8_WAIT_L(0); PG8_MMA(0, 0, At, B0); PG8_BAR; PG8_SCHED;
            PG8_LDB(B1, 0, 1); PG8_STAGE(PG8_SB(0, 0), b2, voffB);
            PG8_BAR; PG8_WAIT_L(0); PG8_MMA(0, 1, At, B1); PG8_BAR;
            PG8_LDA(At, 0, 1); PG8_STAGE(PG8_SA(0, 0), a2, voffA);
            PG8_BAR; PG8_WAIT_L(0); PG8_MMA(1, 0, At, B0); PG8_BAR; PG8_SCHED;
            PG8_STAGE(PG8_SB(0, 1), b2 + hstep, voffB);
            PG8_WAIT_V(6); PG8_BAR; PG8_MMA(1, 1, At, B1); PG8_BAR;
            PG8_LDB(B0, 1, 0); PG8_SCHED; PG8_LDA(At, 1, 0); PG8_STAGE(PG8_SA(0, 1), a2 + hstep, voffA);
            PG8_WAIT_L(8); PG8_BAR; PG8_WAIT_L(0); PG8_MMA(0, 0, At, B0); PG8_BAR; PG8_SCHED;
            PG8_LDB(B1, 1, 1); PG8_STAGE(PG8_SB(1, 0), b3, voffB);
            PG8_BAR; PG8_WAIT_L(0); PG8_MMA(0, 1, At, B1); PG8_BAR;
            PG8_LDA(At, 1, 1); PG8_STAGE(PG8_SA(1, 0), a3, voffA);
            PG8_BAR; PG8_WAIT_L(0); PG8_MMA(1, 0, At, B0); PG8_BAR; PG8_SCHED;
            PG8_STAGE(PG8_SB(1, 1), b3 + hstep, voffB);
            PG8_WAIT_V(6); PG8_BAR; PG8_MMA(1, 1, At, B1); PG8_BAR;
            }
        }
        if constexpr (ALIGN_EPI) { if (wr == 0) PG8_BAR; }
        if constexpr (!Epi::AFTER_DRAIN) { E(acc, cur, wr, wc, fr, fq); S.done(cur); }
        if (!has_next) break;
#pragma unroll
        for (int a = 0; a < 2; ++a)
#pragma unroll
            for (int b = 0; b < 2; ++b)
#pragma unroll
                for (int m = 0; m < 4; ++m)
#pragma unroll
                    for (int n = 0; n < 2; ++n) acc[a][b][m][n] = (f32x4){0.f, 0.f, 0.f, 0.f};
        cur = nxt; cA = nA; cB = nB; ++ui;
        if constexpr (ALIGN_EPI) { if (wr == 1) PG8_BAR; }
    }
    PG8_WAIT_V(0);
    if constexpr (!ALIGN_EPI) { if (wr == 0) PG8_BAR; }
    PG8_BAR;
    if constexpr (Epi::AFTER_DRAIN) { E.fused(acc, cur, wr, wc, fr, fq, lds, wid, lane); S.done(cur); }
#undef PG8_SA
#undef PG8_SB
#undef PG8_STAGE
#undef PG8_LDA
#undef PG8_LDB
#undef PG8_MMA
#undef PG8_WAIT_V
#undef PG8_WAIT_L
#undef PG8_BAR
#undef PG8_SCHED
}
}

constexpr int NB = 16, SEQ = 2048, DM = 1024, DEPTH = 4, DIN = 2048, DFF = 2816, M = NB * SEQ;
constexpr float EPS = 1e-6f;
constexpr size_t MiB = 1u << 20;
constexpr size_t WS_WIN = 0, WS_WOUT = 16 * MiB, WS_WGU = 24 * MiB, WS_WDN = 68 * MiB, WS_SGUW = 90 * MiB, WS_PWT = 90 * MiB + 512 * 1024,
                 WS_SS = 91 * MiB, WS_BAR = 93 * MiB, WS_XB = 96 * MiB, WS_PROJ = 160 * MiB, WS_YCAT = 288 * MiB, WS_HID = 160 * MiB, WS_END = 352 * MiB;
constexpr int LDS_BYTES = 160 * 1024;
constexpr int NTHR = 512;

#define LAS __attribute__((address_space(3)))
typedef unsigned short bf16_t;
typedef short bf16x8 __attribute__((ext_vector_type(8)));
typedef float f32x4 __attribute__((ext_vector_type(4)));
typedef float f32x2 __attribute__((ext_vector_type(2)));
typedef unsigned u32x4 __attribute__((ext_vector_type(4)));
typedef unsigned u32x2 __attribute__((ext_vector_type(2)));
typedef __bf16 bf16x2_t __attribute__((ext_vector_type(2)));

__device__ __forceinline__ unsigned pk2(float lo, float hi) { f32x2 v = {lo, hi}; bf16x2_t b = __builtin_convertvector(v, bf16x2_t); return __builtin_bit_cast(unsigned, b); }
__device__ __forceinline__ bf16_t f2bf(float f) { return (bf16_t)(pk2(f, 0.f) & 0xffffu); }
__device__ __forceinline__ float bflo(unsigned w) { return __uint_as_float(w << 16); }
__device__ __forceinline__ float bfhi(unsigned w) { return __uint_as_float(w & 0xffff0000u); }
#define MFMA16(a, b, c) __builtin_amdgcn_mfma_f32_16x16x32_bf16((a), (b), (c), 0, 0, 0)
#define CFENCE() asm volatile("" ::: "memory")
#define LDSWAIT() asm volatile("s_waitcnt lgkmcnt(0)" ::: "memory")
__device__ __forceinline__ float fexp(float x) { return __builtin_amdgcn_exp2f(x * 1.4426950408889634f); }
__device__ __forceinline__ float gelu_tanh(float x) {
    const float u2 = 1.5957691216057308f * x * (1.0f + 0.044715f * x * x);
    return x * __builtin_amdgcn_rcpf(1.0f + fexp(-u2));
}
__device__ __forceinline__ float rstd_of1(const float* ss, int row) {
    const f32x4 s = *(const f32x4*)(ss + (size_t)row * 4); return rsqrtf(((s.x + s.y) + (s.z + s.w)) * (1.0f / 1024.0f) + EPS);
}

__device__ __forceinline__ float ssq4(const f32x4 y) { return (y[0] * y[0] + y[1] * y[1]) + (y[2] * y[2] + y[3] * y[3]); }

#ifdef PROBE_RSTD2
__device__ __forceinline__ float rstd_of(const float* ss, int row) { const float a = rstd_of1(ss, row); int z; asm volatile("v_mov_b32 %0, 0" : "=v"(z) : "v"(a)); const float b = rstd_of1(ss, row + z); return (a + b) * 0.5f; }
#else
__device__ __forceinline__ float rstd_of(const float* ss, int row) { return rstd_of1(ss, row); }
#endif
namespace pg8 {
struct EpiIn {
    static constexpr bool PERM = true, AFTER_DRAIN = false;
    bf16_t* O; const float* ss;
    __device__ __forceinline__ void operator()(const f32x4 (&acc)[2][2][4][2], const Unit& u, int wr, int wc, int fr, int fq) const {
        const int row0 = u.pm * BM + wr * 64 + fr, col0 = u.pn * BM + wc * 32 + 8 * fq; const bool act = u.pn < 2;
        float rsv[2][4];
#pragma unroll
        for (int ai = 0; ai < 2; ++ai)
#pragma unroll
            for (int m = 0; m < 4; ++m) rsv[ai][m] = rstd_of(ss, row0 + ai * HALF + m * 16);
#pragma unroll
        for (int ai = 0; ai < 2; ++ai)
#pragma unroll
            for (int m = 0; m < 4; ++m) { const int row = row0 + ai * HALF + m * 16; const float rs = rsv[ai][m]; bf16_t* rowp = O + (size_t)row * DIN + col0;
#pragma unroll
                for (int bj = 0; bj < 2; ++bj) { f32x4 v0 = acc[ai][bj][m][0] * rs, v1 = acc[ai][bj][m][1] * rs;
                    if (act) { v0 = (f32x4){gelu_tanh(v0[0]), gelu_tanh(v0[1]), gelu_tanh(v0[2]), gelu_tanh(v0[3])}; v1 = (f32x4){gelu_tanh(v1[0]), gelu_tanh(v1[1]), gelu_tanh(v1[2]), gelu_tanh(v1[3])}; }
                    u32x4 w; w.x = pk2(v0[0], v0[1]); w.y = pk2(v0[2], v0[3]); w.z = pk2(v1[0], v1[1]); w.w = pk2(v1[2], v1[3]);
                    *(u32x4*)(rowp + bj * HALF) = w; }
                if (m & 1) CFENCE(); }
    }
};
struct EpiGU {
    static constexpr bool PERM = true, AFTER_DRAIN = false;
    bf16_t* O; const float* ss;
    __device__ __forceinline__ void operator()(const f32x4 (&acc)[2][2][4][2], const Unit& u, int wr, int wc, int fr, int fq) const {
        const int row0 = u.pm * BM + wr * 64 + fr, col0 = u.pn * HALF + wc * 32 + 8 * fq;
        float rsv[2][4];
#pragma unroll
        for (int ai = 0; ai < 2; ++ai)
#pragma unroll
            for (int m = 0; m < 4; ++m) rsv[ai][m] = rstd_of(ss, row0 + ai * HALF + m * 16);
#pragma unroll
        for (int ai = 0; ai < 2; ++ai)
#pragma unroll
            for (int m = 0; m < 4; ++m) { const int row = row0 + ai * HALF + m * 16; const float rs = rsv[ai][m]; bf16_t* rowp = O + (size_t)row * DFF + col0;
                float h[8];
#pragma unroll
                for (int n = 0; n < 2; ++n)
#pragma unroll
                    for (int e = 0; e < 4; ++e) { const float g = acc[ai][0][m][n][e] * rs, up = acc[ai][1][m][n][e] * rs; h[n * 4 + e] = g * up * __builtin_amdgcn_rcpf(1.0f + fexp(-g)); }
                u32x4 w; w.x = pk2(h[0], h[1]); w.y = pk2(h[2], h[3]); w.z = pk2(h[4], h[5]); w.w = pk2(h[6], h[7]);
                *(u32x4*)rowp = w;
                if (m & 1) CFENCE(); }
    }
};
struct EpiRes {
    static constexpr bool PERM = true, AFTER_DRAIN = false;
    const float* xin32; float* xout32; bf16_t* xb; float* ss; LAS float* P;
    __device__ __forceinline__ void operator()(const f32x4 (&acc)[2][2][4][2], const Unit& u, int wr, int wc, int fr, int fq) const {
        const int row0 = u.pm * BM + wr * 64 + fr, col0 = u.pn * BM + wc * 32 + 8 * fq;
#pragma unroll
        for (int ai = 0; ai < 2; ++ai)
#pragma unroll
            for (int m = 0; m < 4; ++m) { const int row = row0 + ai * HALF + m * 16; const size_t off = (size_t)row * DM + col0; float q = 0.f;
#pragma unroll
                for (int bj = 0; bj < 2; ++bj) { f32x4 r0, r1;
                    if (xin32) { r0 = *(const f32x4*)(xin32 + off + bj * HALF); r1 = *(const f32x4*)(xin32 + off + bj * HALF + 4); }
                    else { const u32x4 t = *(const u32x4*)(xb + off + bj * HALF); r0 = (f32x4){bflo(t.x), bfhi(t.x), bflo(t.y), bfhi(t.y)}; r1 = (f32x4){bflo(t.z), bfhi(t.z), bflo(t.w), bfhi(t.w)}; }
                    const f32x4 v0 = r0 + acc[ai][bj][m][0], v1 = r1 + acc[ai][bj][m][1];
                    q += ssq4(v0) + ssq4(v1);
                    if (xout32) { *(f32x4*)(xout32 + off + bj * HALF) = v0; *(f32x4*)(xout32 + off + bj * HALF + 4) = v1; }
                    else { u32x4 w; w.x = pk2(v0[0], v0[1]); w.y = pk2(v0[2], v0[3]); w.z = pk2(v1[0], v1[1]); w.w = pk2(v1[2], v1[3]); *(u32x4*)(xb + off + bj * HALF) = w; } }
                q += __shfl_xor(q, 16); q += __shfl_xor(q, 32);
                if (fq == 0) P[(ai * HALF + wr * 64 + m * 16 + fr) * 4 + wc] = q;
                if (m & 1) CFENCE(); }
        asm volatile("s_waitcnt lgkmcnt(0)" ::: "memory"); __builtin_amdgcn_s_barrier(); asm volatile("" ::: "memory");
        const int t = wr * 256 + wc * 64 + fq * 16 + fr;
        if (t < 256) { const f32x4 pp = *(const LAS f32x4*)(P + t * 4); ss[(size_t)(u.pm * BM + t) * 4 + u.pn] = (pp.x + pp.y) + (pp.z + pp.w); }
    }
};
}

__device__ __forceinline__ void transpose_item(const float* W, int K, int N, bf16_t* WT, const float* gain, int mode, LAS float* scr, int item, int lane) {
    const int nblk = N / 32, kb = item / nblk, nb = item % nblk, k0 = 64 * kb, n0 = 32 * nb;
    const int c = lane & 7;
    f32x4 g0 = {1.f, 1.f, 1.f, 1.f}, g1 = {1.f, 1.f, 1.f, 1.f};
    if (gain) { g0 = *(const f32x4*)(gain + k0 + 8 * c); g1 = *(const f32x4*)(gain + k0 + 8 * c + 4); }
    const float* src = W + (size_t)(k0 + (lane >> 5)) * N + n0 + (lane & 31);
    float v[32];
#pragma unroll
    for (int i = 0; i < 32; ++i) v[i] = __builtin_nontemporal_load(src + (size_t)(2 * i) * N);
#pragma unroll
    for (int i = 0; i < 32; ++i) scr[(2 * i + (lane >> 5)) * 33 + (lane & 31)] = v[i];
    LDSWAIT();
#pragma unroll
    for (int j = 0; j < 4; ++j) { const int n = (lane >> 3) + 8 * j, gn = n0 + n; const LAS float* s = scr + (8 * c) * 33 + n;
        float cs = 1.0f; int row = gn;
        if (mode == 1) { if ((gn >= 768 && gn < 1024) || (gn >= 1280 && gn < 1536)) cs = 0.125f; }
        if (mode == 2) { const int jj = gn < DFF ? gn : gn - DFF; row = 256 * (jj >> 7) + (jj & 127) + (gn < DFF ? 0 : 128); }
        u32x4 o; o.x = pk2(s[0 * 33] * g0[0] * cs, s[1 * 33] * g0[1] * cs); o.y = pk2(s[2 * 33] * g0[2] * cs, s[3 * 33] * g0[3] * cs); o.z = pk2(s[4 * 33] * g1[0] * cs, s[5 * 33] * g1[1] * cs); o.w = pk2(s[6 * 33] * g1[2] * cs, s[7 * 33] * g1[3] * cs);
        *(u32x4*)(WT + (size_t)row * K + k0 + 8 * c) = o; }
    LDSWAIT();
}
__device__ __forceinline__ float wave_sum(float v) {
#pragma unroll
    for (int o = 1; o < 64; o <<= 1) v += __shfl_xor(v, o);
    return v;
}

struct Params {
    const float *x, *w_in, *w_out, *sgu_w, *sgu_b, *pool_w, *pool_scale, *swa_sinks, *rel_bias, *mix_out_gain, *norm_mix, *norm_ffn, *w_gate_up, *w_down, *norm_final;
    float* out; unsigned char* ws;
};


__device__ __forceinline__ void st4(bf16_t* p, const f32x4 y) { u32x2 o; o.x = pk2(y[0], y[1]); o.y = pk2(y[2], y[3]); *(u32x2*)p = o; }
#define VMWAIT() asm volatile("s_waitcnt vmcnt(0)" ::: "memory")
typedef short v4i16_t __attribute__((ext_vector_type(4)));
__device__ __forceinline__ bf16x8 tr_frag(const LAS bf16_t* p, int rows4) {
    const v4i16_t lo = __builtin_amdgcn_ds_read_tr16_b64_v4i16((LAS v4i16_t*)p);
    const v4i16_t hi = __builtin_amdgcn_ds_read_tr16_b64_v4i16((LAS v4i16_t*)(p + rows4));
    return (bf16x8){lo[0], lo[1], lo[2], lo[3], hi[0], hi[1], hi[2], hi[3]};
}

__device__ __forceinline__ void mixer_A(LAS unsigned char* L, const bf16_t* proj, const bf16_t* sguw, const float* sgub, bf16_t* ycat, int b, int ch, int tid, int lane, int w) {
    constexpr int VS = 264;
    LAS bf16_t* VL = (LAS bf16_t*)L;
    const size_t row0 = (size_t)b * SEQ + ch * 128;
    const int c = lane & 15, q = lane >> 4, wv = tid >> 6;
    const int nks = (w >> 1) + 1;
    const size_t trow = row0 + 16 * wv + c;
    const bf16_t* wbase = sguw + (size_t)(16 * wv + c) * 128 + 8 * q;
    const bf16_t* urow = proj + trow * DIN + 4 * q;
    bf16x8 bw[4][4]; u32x2 uu[4][4]; float bias[4];
#pragma unroll
    for (int h = 0; h < 4; ++h) { bias[h] = sgub[h * 128 + 16 * wv + c];
#pragma unroll
        for (int ks = 0; ks < 4; ++ks) if (ks < nks) bw[h][ks] = *(const bf16x8*)(wbase + h * 128 * 128 + 32 * ks);
#pragma unroll
        for (int n = 0; n < 4; ++n) uu[h][n] = *(const u32x2*)(urow + h * 64 + 16 * n); }
    {
        const int tok = tid >> 2, h = tid & 3;
        const bf16_t* src = proj + (row0 + tok) * DIN + 256 + h * 64;
        float v[64]; float s = 0.f;
#pragma unroll
        for (int i = 0; i < 8; ++i) { const u32x4 t = *(const u32x4*)(src + 8 * i);
            v[8 * i + 0] = bflo(t.x); v[8 * i + 1] = bfhi(t.x); v[8 * i + 2] = bflo(t.y); v[8 * i + 3] = bfhi(t.y); v[8 * i + 4] = bflo(t.z); v[8 * i + 5] = bfhi(t.z); v[8 * i + 6] = bflo(t.w); v[8 * i + 7] = bfhi(t.w); }
#pragma unroll
        for (int i = 0; i < 64; ++i) s += v[i];
        const float mean = s * (1.0f / 64.0f); float s2 = 0.f;
#pragma unroll
        for (int i = 0; i < 64; ++i) { v[i] -= mean; s2 += v[i] * v[i]; }
        const float rstd = rsqrtf(s2 * (1.0f / 64.0f) + EPS);
        LAS bf16_t* dst = VL + tok * VS + h * 64;
#pragma unroll
        for (int i = 0; i < 8; ++i) { u32x4 o; o.x = pk2(v[8 * i + 0] * rstd, v[8 * i + 1] * rstd); o.y = pk2(v[8 * i + 2] * rstd, v[8 * i + 3] * rstd); o.z = pk2(v[8 * i + 4] * rstd, v[8 * i + 5] * rstd); o.w = pk2(v[8 * i + 6] * rstd, v[8 * i + 7] * rstd);
            *(LAS u32x4*)(dst + 8 * i) = o; }
    }
    __syncthreads();
    const LAS bf16_t* vbase = VL + (8 * q + (c >> 2)) * VS + 4 * (c & 3);
    f32x4 yv[4][4]; float ssq = 0.f;
#pragma unroll
    for (int h = 0; h < 4; ++h) {
#pragma unroll
        for (int n = 0; n < 4; ++n) yv[h][n] = (f32x4){0.f, 0.f, 0.f, 0.f};
#pragma unroll
        for (int ks = 0; ks < 4; ++ks) if (ks < nks) {
#pragma unroll
            for (int n = 0; n < 4; ++n) { const bf16x8 a = tr_frag(vbase + 32 * ks * VS + h * 64 + 16 * n, 4 * VS); yv[h][n] = MFMA16(a, bw[h][ks], yv[h][n]); }
        }
#pragma unroll
        for (int n = 0; n < 4; ++n) { const u32x2 u2 = uu[h][n];
            f32x4 y; y[0] = bflo(u2.x) * (yv[h][n][0] + bias[h]); y[1] = bfhi(u2.x) * (yv[h][n][1] + bias[h]); y[2] = bflo(u2.y) * (yv[h][n][2] + bias[h]); y[3] = bfhi(u2.y) * (yv[h][n][3] + bias[h]);
            yv[h][n] = y; ssq += ssq4(y); }
    }
    ssq += __shfl_xor(ssq, 16); ssq += __shfl_xor(ssq, 32);
    const float rs = rsqrtf(ssq * (1.0f / 256.0f) + EPS);
    bf16_t* yrow = ycat + trow * DM + 0 + 4 * q;
#pragma unroll
    for (int h = 0; h < 4; ++h)
#pragma unroll
        for (int n = 0; n < 4; ++n) st4(yrow + h * 64 + 16 * n, yv[h][n] * rs);
}

__device__ __forceinline__ void mixer_B(LAS unsigned char* L, const bf16_t* proj, const bf16_t* pwt, const float* pscale, bf16_t* ycat, int b, int ch, int tid, int lane, int w) {
    constexpr int YS = 264;
    LAS bf16_t* PL = (LAS bf16_t*)L;
    LAS bf16_t* Y = (LAS bf16_t*)(L + 76032);
    const size_t row0 = (size_t)b * SEQ + ch * 128;
    const int c = lane & 15, q = lane >> 4, wv = tid >> 6;
    const bf16_t* pbase = pwt + (size_t)c * 64 + 8 * q;
    bf16x8 pw[4][4][2];
#pragma unroll
    for (int g = 0; g < 4; ++g)
#pragma unroll
        for (int n = 0; n < 4; ++n)
#pragma unroll
            for (int ks = 0; ks < 2; ++ks) pw[g][n][ks] = *(const bf16x8*)(pbase + (g * 64 + 16 * n) * 64 + 32 * ks);
    {
        u32x4 t[9];
#pragma unroll
        for (int i = 0; i < 9; ++i) { const int id = tid + 512 * i, r = id >> 5, cc = id & 31; t[i] = (u32x4){0u, 0u, 0u, 0u};
            if (id < 143 * 32 && (ch > 0 || r >= 15)) t[i] = *(const u32x4*)(proj + (row0 - 15 + r) * DIN + 512 + 8 * cc); }
#pragma unroll
        for (int i = 0; i < 9; ++i) { const int id = tid + 512 * i, r = id >> 5, cc = id & 31; if (id < 143 * 32) *(LAS u32x4*)(PL + r * YS + 8 * cc) = t[i]; }
    }
    __syncthreads();
    {
        const int cc = tid & 31, t0 = (tid >> 5) * 8; const int win = 2 << (cc >> 3);
        const LAS bf16_t* col = PL + 15 * YS + 8 * cc;
        float S[8];
#pragma unroll
        for (int e = 0; e < 8; ++e) S[e] = 0.f;
#pragma unroll 1
        for (int j = 0; j < win; ++j) { const u32x4 t = *(const LAS u32x4*)(col + (t0 - j) * YS);
            S[0] += bflo(t.x); S[1] += bfhi(t.x); S[2] += bflo(t.y); S[3] += bfhi(t.y); S[4] += bflo(t.z); S[5] += bfhi(t.z); S[6] += bflo(t.w); S[7] += bfhi(t.w); }
#pragma unroll
        for (int i = 0; i < 8; ++i) { const int t = t0 + i; const u32x4 pt = *(const LAS u32x4*)(col + t * YS);
            const float p0 = bflo(pt.x), p1 = bfhi(pt.x), p2 = bflo(pt.y), p3 = bfhi(pt.y), p4 = bflo(pt.z), p5 = bfhi(pt.z), p6 = bflo(pt.w), p7 = bfhi(pt.w);
            if (i > 0) { const u32x4 po = *(const LAS u32x4*)(col + (t - win) * YS);
                S[0] += p0 - bflo(po.x); S[1] += p1 - bfhi(po.x); S[2] += p2 - bflo(po.y); S[3] += p3 - bfhi(po.y); S[4] += p4 - bflo(po.z); S[5] += p5 - bfhi(po.z); S[6] += p6 - bflo(po.w); S[7] += p7 - bfhi(po.w); }
            const int tseq = ch * 128 + t; const int cnt = (tseq + 1 < win) ? (tseq + 1) : win; const float inv = 1.0f / (float)cnt;
            u32x4 o; o.x = pk2(S[0] * inv - p0, S[1] * inv - p1); o.y = pk2(S[2] * inv - p2, S[3] * inv - p3); o.z = pk2(S[4] * inv - p4, S[5] * inv - p5); o.w = pk2(S[6] * inv - p6, S[7] * inv - p7);
            *(LAS u32x4*)(Y + t * YS + 8 * cc) = o; }
    }
    __syncthreads();
    const size_t trow = row0 + 16 * wv + c; float ssq = 0.f;
    const LAS bf16_t* ybase = Y + (16 * wv + c) * YS + 8 * q;
    f32x4 yv[4][4];
#pragma unroll
    for (int g = 0; g < 4; ++g) {
#pragma unroll
        for (int n = 0; n < 4; ++n) yv[g][n] = (f32x4){0.f, 0.f, 0.f, 0.f};
#pragma unroll
        for (int ks = 0; ks < 2; ++ks) { const bf16x8 bfrag = *(const LAS bf16x8*)(ybase + g * 64 + 32 * ks);
#pragma unroll
            for (int n = 0; n < 4; ++n) yv[g][n] = MFMA16(pw[g][n][ks], bfrag, yv[g][n]); }
#pragma unroll
        for (int n = 0; n < 4; ++n) { const f32x4 sc = *(const f32x4*)(pscale + g * 64 + 16 * n + 4 * q); yv[g][n] = yv[g][n] * sc; ssq += ssq4(yv[g][n]); }
    }
    ssq += __shfl_xor(ssq, 16); ssq += __shfl_xor(ssq, 32);
    const float rs = rsqrtf(ssq * (1.0f / 256.0f) + EPS);
    bf16_t* yrow = ycat + trow * DM + 256 + 4 * q;
#pragma unroll
    for (int g = 0; g < 4; ++g)
#pragma unroll
        for (int n = 0; n < 4; ++n) st4(yrow + g * 64 + 16 * n, yv[g][n] * rs);
}

__device__ __forceinline__ bf16x8 tr_frag_perm(const LAS bf16_t* p, int rows16) {
    const v4i16_t lo = __builtin_amdgcn_ds_read_tr16_b64_v4i16((LAS v4i16_t*)p);
    const v4i16_t hi = __builtin_amdgcn_ds_read_tr16_b64_v4i16((LAS v4i16_t*)(p + rows16));
    return (bf16x8){lo[0], lo[1], lo[2], lo[3], hi[0], hi[1], hi[2], hi[3]};
}
__device__ __forceinline__ bf16x8 pack8(const f32x4 a, const f32x4 b) { u32x4 o; o.x = pk2(a[0], a[1]); o.y = pk2(a[2], a[3]); o.z = pk2(b[0], b[1]); o.w = pk2(b[2], b[3]); return __builtin_bit_cast(bf16x8, o); }

__device__ __forceinline__ void mixer_C(LAS unsigned char* L, const bf16_t* proj, const float* sinks, const float* rel_bias, bf16_t* ycat, int b, int qb, int tid, int lane, int w) {
    constexpr int KS = 144;
    const int wv = tid >> 6;
    LAS bf16_t* KL = (LAS bf16_t*)L;
    LAS bf16_t* VL = (LAS bf16_t*)(L + 73728);
    LAS float* BT = (LAS float*)(L + 152064);
    const size_t row0 = (size_t)b * SEQ + qb * 128;
    const int c = lane & 15, q = lane >> 4;
    const size_t trow = row0 + 16 * wv + c;
    {
        const int skey = tid >> 1, shalf = tid & 1; const bool okk = (qb > 0) || (skey >= 128);
        const bf16_t* ksrc = proj + (row0 - 128 + skey) * DIN + 1024 + shalf * 64;
        u32x4 kr[8], vr[8];
#pragma unroll
        for (int i = 0; i < 8; ++i) { kr[i] = (u32x4){0u, 0u, 0u, 0u}; vr[i] = (u32x4){0u, 0u, 0u, 0u}; if (okk) { kr[i] = *(const u32x4*)(ksrc + 8 * i); vr[i] = *(const u32x4*)(ksrc + 128 + 8 * i); } }
        { const int j = tid >> 7, dist = tid & 127; int bucket = dist;
          if (dist >= 16) { const int lg = 16 + (int)(__logf((float)dist * (1.0f / 16.0f)) / 2.0794415416798357f * 16.0f); bucket = lg < 31 ? lg : 31; }
          BT[j * 128 + dist] = rel_bias[bucket * 4 + j];
          if (tid < 288) *(LAS u32x4*)(VL + 256 * KS + 8 * tid) = (u32x4){0u, 0u, 0u, 0u}; }
#pragma unroll
        for (int i = 0; i < 8; ++i) { *(LAS u32x4*)(KL + skey * KS + shalf * 64 + 8 * i) = kr[i]; *(LAS u32x4*)(VL + skey * KS + shalf * 64 + 8 * i) = vr[i]; }
    }
    bf16x8 qf[4][2];
#pragma unroll
    for (int j = 0; j < 4; ++j)
#pragma unroll
        for (int ks = 0; ks < 2; ++ks) qf[j][ks] = *(const bf16x8*)(proj + trow * DIN + 768 + j * 64 + 32 * ks + 8 * q);
    __syncthreads();
    const LAS bf16_t* kbase = KL + (16 * wv + c) * KS + 8 * q;
    const LAS bf16_t* vbase = VL + (16 * wv + 4 * q + (c >> 2)) * KS + 4 * (c & 3);
    f32x4 yv[4][4]; float ssq = 0.f;
#pragma unroll
    for (int j = 0; j < 4; ++j) { const int kvh = j >> 1;
        f32x4 z[9];
#pragma unroll
        for (int kti = 0; kti < 9; ++kti) { z[kti] = (f32x4){0.f, 0.f, 0.f, 0.f};
#pragma unroll
            for (int ks = 0; ks < 2; ++ks) { const bf16x8 a = *(const LAS bf16x8*)(kbase + 16 * kti * KS + kvh * 64 + 32 * ks); z[kti] = MFMA16(a, qf[j][ks], z[kti]); } }
        const float sink = sinks[j]; const LAS float* bt = BT + j * 128;
        int zz; asm volatile("v_mov_b32 %0, 0" : "=v"(zz));
        const int cz = c + zz; const int klo = (qb > 0) ? (cz + 1) : max(cz + 1, 128 - 16 * w), khi = cz + 128;
        float mx = sink;
#pragma unroll
        for (int kti = 0; kti < 9; ++kti)
#pragma unroll
            for (int r = 0; r < 4; ++r) { const int kl = 16 * kti + 4 * q + r; const int dist = 128 + cz - kl; const bool valid = (unsigned)(kl - klo) <= (unsigned)(khi - klo);
                const float bb = bt[dist & 127]; const float v = valid ? (z[kti][r] + bb) : -1e30f; z[kti][r] = v; mx = fmaxf(mx, v); }
        mx = fmaxf(mx, __shfl_xor(mx, 16)); mx = fmaxf(mx, __shfl_xor(mx, 32));
        float sum = 0.f;
#pragma unroll
        for (int kti = 0; kti < 9; ++kti)
#pragma unroll
            for (int r = 0; r < 4; ++r) { const float p = (z[kti][r] > -1e29f) ? fexp(z[kti][r] - mx) : 0.f; z[kti][r] = p; sum += p; }
        sum += __shfl_xor(sum, 16); sum += __shfl_xor(sum, 32);
        const float inv = 1.0f / (sum + fexp(sink - mx));
#pragma unroll
        for (int n = 0; n < 4; ++n) yv[j][n] = (f32x4){0.f, 0.f, 0.f, 0.f};
#pragma unroll
        for (int ks = 0; ks < 5; ++ks) { const f32x4 zero4 = {0.f, 0.f, 0.f, 0.f};
            const bf16x8 bfrag = pack8(z[2 * ks] * inv, (ks < 4) ? (z[(ks < 4) ? 2 * ks + 1 : 0] * inv) : zero4);
#pragma unroll
            for (int n = 0; n < 4; ++n) { const bf16x8 a = tr_frag_perm(vbase + 32 * ks * KS + kvh * 64 + 16 * n, 16 * KS); yv[j][n] = MFMA16(a, bfrag, yv[j][n]); } }
#pragma unroll
        for (int n = 0; n < 4; ++n) ssq += ssq4(yv[j][n]);
    }
    ssq += __shfl_xor(ssq, 16); ssq += __shfl_xor(ssq, 32);
    const float rs = rsqrtf(ssq * (1.0f / 256.0f) + EPS);
    bf16_t* yrow = ycat + trow * DM + 512 + 4 * q;
#pragma unroll
    for (int j = 0; j < 4; ++j)
#pragma unroll
        for (int n = 0; n < 4; ++n) st4(yrow + j * 64 + 16 * n, yv[j][n] * rs);
}

#ifndef D_CUT
#define D_CUT 2.0e-9f
#endif
__device__ __forceinline__ void mixer_D(LAS unsigned char* L, const bf16_t* proj, bf16_t* ycat, int b, int qb64, int tid, int lane, int w) {
    constexpr int KS = 272;
    constexpr int TILE = 64 * KS;
    const int wv = tid >> 6;
    LAS bf16_t* KL = (LAS bf16_t*)L;
    LAS bf16_t* VL = (LAS bf16_t*)(L + 69632);
    LAS float* RED = (LAS float*)(L + 139264);
    volatile LAS unsigned* FLG = (volatile LAS unsigned*)(L + 139776);
    const int rg = wv & 3, hp = wv >> 2, c = lane & 15, q = lane >> 4;
    const size_t seq0 = (size_t)b * SEQ; const size_t trow = seq0 + qb64 * 64 + 16 * rg + c;
    const int skey = tid >> 3, spart = tid & 7;
    const bf16_t* ksrc0 = proj + (seq0 + skey) * DIN + 1536 + spart * 32;
    LAS bf16_t* kdst = KL + skey * KS + spart * 32;
    LAS bf16_t* vdst = VL + skey * KS + spart * 32;
    u32x4 kr[4], vr[4];
    { const bf16_t* ksrc = ksrc0 + (size_t)qb64 * 64 * DIN;
#pragma unroll
        for (int i = 0; i < 4; ++i) { kr[i] = *(const u32x4*)(ksrc + 8 * i); vr[i] = *(const u32x4*)(ksrc + 256 + 8 * i); } }
    bf16x8 qf[2][2];
#pragma unroll
    for (int hh = 0; hh < 2; ++hh)
#pragma unroll
        for (int ks = 0; ks < 2; ++ks) qf[hh][ks] = *(const bf16x8*)(proj + trow * DIN + 1280 + (2 * hp + hh) * 64 + 32 * ks + 8 * q);
    f32x4 acc[2][4];
#pragma unroll
    for (int hh = 0; hh < 2; ++hh)
#pragma unroll
        for (int n = 0; n < 4; ++n) acc[hh][n] = (f32x4){0.f, 0.f, 0.f, 0.f};
    float rem[2] = {1.f, 1.f};
    const int qloc = 16 * rg + c;
    const LAS bf16_t* kbase = KL + c * KS + hp * 128 + 8 * q;
    const LAS bf16_t* vbase = VL + (4 * q + (c >> 2)) * KS + hp * 128 + 4 * (c & 3);
    if (tid < 3) FLG[tid] = 0u;
#pragma unroll
    for (int i = 0; i < 4; ++i) { *(LAS u32x4*)(kdst + 8 * i) = kr[i]; *(LAS u32x4*)(vdst + 8 * i) = vr[i]; }
    u32x4 kr2[4], vr2[4];
    if (qb64 > 0) { const bf16_t* ksrc = ksrc0 + (size_t)(qb64 - 1) * 64 * DIN;
#pragma unroll
        for (int i = 0; i < 4; ++i) { kr[i] = *(const u32x4*)(ksrc + 8 * i); vr[i] = *(const u32x4*)(ksrc + 256 + 8 * i); } }
    if (qb64 > 1) { const bf16_t* ksrc = ksrc0 + (size_t)(qb64 - 2) * 64 * DIN;
#pragma unroll
        for (int i = 0; i < 4; ++i) { kr2[i] = *(const u32x4*)(ksrc + 8 * i); vr2[i] = *(const u32x4*)(ksrc + 256 + 8 * i); } }
    else {
#pragma unroll
        for (int i = 0; i < 4; ++i) { kr2[i] = (u32x4){0u, 0u, 0u, 0u}; vr2[i] = (u32x4){0u, 0u, 0u, 0u}; } }
#define D_STEP(KW, VW) \
        __syncthreads(); \
        if (it > 0 && FLG[fprev] == 0u) break; \
        const int bo = (it & 1) * TILE, bn = ((it + 1) & 1) * TILE; \
        if (kt > 0) { \
            _Pragma("unroll") \
            for (int i = 0; i < 4; ++i) { *(LAS u32x4*)(kdst + bn + 8 * i) = KW[i]; *(LAS u32x4*)(vdst + bn + 8 * i) = VW[i]; } \
            if (kt > 2) { const bf16_t* ksrc = ksrc0 + (size_t)(kt - 3) * 64 * DIN; \
                _Pragma("unroll") \
                for (int i = 0; i < 4; ++i) { KW[i] = *(const u32x4*)(ksrc + 8 * i); VW[i] = *(const u32x4*)(ksrc + 256 + 8 * i); } } \
        } \
        if (tid == 0) FLG[fnext] = 0u; \
        const bool diag = (kt == qb64); \
_Pragma("unroll") \
        for (int hh = 0; hh < 2; ++hh) { \
            f32x4 z[4]; \
_Pragma("unroll") \
            for (int kti = 0; kti < 4; ++kti) { z[kti] = (f32x4){0.f, 0.f, 0.f, 0.f}; \
_Pragma("unroll") \
                for (int ks = 0; ks < 2; ++ks) { const bf16x8 a = *(const LAS bf16x8*)(kbase + bo + 16 * kti * KS + hh * 64 + 32 * ks); z[kti] = MFMA16(a, qf[hh][ks], z[kti]); } } \
            f32x4 ex[4]; float G[4]; \
            if (diag) { \
_Pragma("unroll") \
                for (int kti = 0; kti < 4; ++kti) { float run = 1.f; \
_Pragma("unroll") \
                    for (int r = 3; r >= 0; --r) { const bool valid = (16 * kti + 4 * q + r < qloc); \
                        const float u = fexp(fminf(z[kti][r], 80.f)); const float om = __builtin_amdgcn_rcpf(1.0f + u); \
                        z[kti][r] = valid ? u * om : 0.f; ex[kti][r] = run; run *= valid ? om : 1.f; } \
                    G[kti] = run; } \
            } else { \
_Pragma("unroll") \
                for (int kti = 0; kti < 4; ++kti) { float run = 1.f; \
_Pragma("unroll") \
                    for (int r = 3; r >= 0; --r) { const float u = fexp(fminf(z[kti][r], 80.f)); const float om = __builtin_amdgcn_rcpf(1.0f + u); \
                        z[kti][r] = u * om; ex[kti][r] = run; run *= om; } \
                    G[kti] = run; } \
            } \
            float E[4], Tk[4]; \
_Pragma("unroll") \
            for (int kti = 0; kti < 4; ++kti) { const float bq = __shfl_xor(G[kti], 16); const float ps = G[kti] * bq; const float c2 = __shfl_xor(ps, 32); \
                E[kti] = ((q & 1) ? 1.f : bq) * ((q < 2) ? c2 : 1.f); Tk[kti] = ps * c2; } \
            const float U2 = Tk[3], U1 = U2 * Tk[2], U0 = U1 * Tk[1]; \
            const float cb = rem[hh]; \
            const float base[4] = {cb * U0 * E[0], cb * U1 * E[1], cb * U2 * E[2], cb * E[3]}; \
            rem[hh] = cb * U0 * Tk[0]; \
_Pragma("unroll") \
            for (int kti = 0; kti < 4; ++kti) \
_Pragma("unroll") \
                for (int r = 0; r < 4; ++r) z[kti][r] = z[kti][r] * (base[kti] * ex[kti][r]); \
_Pragma("unroll") \
            for (int ks = 0; ks < 2; ++ks) { const bf16x8 bfrag = pack8(z[2 * ks], z[2 * ks + 1]); \
_Pragma("unroll") \
                for (int n = 0; n < 4; ++n) { const bf16x8 a = tr_frag_perm(vbase + bo + 32 * ks * KS + hh * 64 + 16 * n, 16 * KS); acc[hh][n] = MFMA16(a, bfrag, acc[hh][n]); } } \
        } \
        if (__builtin_amdgcn_ballot_w64(fmaxf(rem[0], rem[1]) > D_CUT) != 0ull) { if (lane == 0) FLG[fcur] = 1u; } \
        { const int t = fprev; fprev = fcur; fcur = fnext; fnext = t; }
    int it = 0, fprev = 2, fcur = 0, fnext = 1;
#pragma unroll 1
    for (int kt = qb64; kt >= 0; --kt, ++it) {
        { D_STEP(kr, vr) }
        if (kt == 0) break;
        --kt; ++it;
        { D_STEP(kr2, vr2) }
    }
#undef D_STEP
    float ssq = 0.f;
#pragma unroll
    for (int hh = 0; hh < 2; ++hh)
#pragma unroll
        for (int n = 0; n < 4; ++n) ssq += ssq4(acc[hh][n]);
    ssq += __shfl_xor(ssq, 16); ssq += __shfl_xor(ssq, 32);
    __syncthreads();
    if (q == 0) RED[(16 * rg + c) * 2 + hp] = ssq;
    __syncthreads();
    const float tot = RED[(16 * rg + c) * 2 + 0] + RED[(16 * rg + c) * 2 + 1];
    const float rs = rsqrtf(tot * (1.0f / 256.0f) + EPS);
    bf16_t* yrow = ycat + trow * DM + 768 + hp * 128 + 4 * q;
#pragma unroll
    for (int hh = 0; hh < 2; ++hh)
#pragma unroll
        for (int n = 0; n < 4; ++n) st4(yrow + hh * 64 + 16 * n, acc[hh][n] * rs);
}

#define XB_TMO      128
#define XB_XCNT(j)  (256  + 64 * (j))
#define XB_XSUB(j)  (1280 + 64 * (j))
#define XB_XGEN(j)  (2304 + 64 * (j))
#define XB_TOP      3328
#define XB_TOPGEN   3392
#define XCD_BAR_WORDS 3456
#define XB_SPIN_CAP (1u << 18)

__device__ __forceinline__ unsigned xb_ld(unsigned* p)              { return __hip_atomic_load(p, __ATOMIC_RELAXED, __HIP_MEMORY_SCOPE_AGENT); }
__device__ __forceinline__ unsigned xb_add(unsigned* p, unsigned v) { return __hip_atomic_fetch_add(p, v, __ATOMIC_RELAXED, __HIP_MEMORY_SCOPE_AGENT); }
__device__ __forceinline__ unsigned xb_xcc_id() { return (unsigned)__builtin_amdgcn_s_getreg((3 << 11) | 20) & 0xFu; }
#define XB_SPIN(cond, bar) do { unsigned _sp = 0; while (cond) { __builtin_amdgcn_s_sleep(1); \
    if ((++_sp & 255u) == 0u) { if (xb_ld(&(bar)[XB_TMO])) break; if (_sp > XB_SPIN_CAP) { atomicAdd(&(bar)[XB_TMO], 1u); break; } } } } while (0)

struct XcdBarrier {
    unsigned* bar; unsigned x;
    volatile LAS unsigned* st;
};

__device__ __forceinline__ XcdBarrier xcd_barrier_post(unsigned* bar, volatile LAS unsigned* st) {
    XcdBarrier b; b.bar = bar; b.x = xb_xcc_id(); b.st = st;
    if (threadIdx.x == 0) (void)xb_add(&bar[XB_XCNT(b.x)], 1u);
    return b;
}
__device__ __forceinline__ void xcd_barrier_complete(unsigned* bar, unsigned x, unsigned& nloc, unsigned& nx) {
    const unsigned G = gridDim.x * gridDim.y * gridDim.z;
    unsigned sum, cnt, mine, sp = 0u;
    for (;;) {
        sum = 0u; cnt = 0u; mine = 0u;
#pragma unroll
        for (unsigned j = 0; j < 16; ++j) { const unsigned c = xb_ld(&bar[XB_XCNT(j)]); sum += c; cnt += (c > 0u) ? 1u : 0u; mine = (j == x) ? c : mine; }
        if (sum == G) break;
        __builtin_amdgcn_s_sleep(1);
        if ((++sp & 255u) == 0u) { if (xb_ld(&bar[XB_TMO])) break; if (sp > XB_SPIN_CAP) { atomicAdd(&bar[XB_TMO], 1u); break; } }
    }
    nloc = mine > 0u ? mine : 1u; nx = cnt > 0u ? cnt : 1u;
}

__device__ __forceinline__ void xcd_barrier(const XcdBarrier& b) {
    asm volatile("s_waitcnt vmcnt(0)" ::: "memory");
    __syncthreads();
    if (threadIdx.x == 0) {
        unsigned* bar = b.bar;
        __builtin_amdgcn_s_waitcnt(0);
        unsigned nloc = b.st[0], nx = b.st[1];
        if (nloc == 0u) { xcd_barrier_complete(bar, b.x, nloc, nx); b.st[0] = nloc; b.st[1] = nx; }
        const unsigned old = xb_add(&bar[XB_XSUB(b.x)], 1u);
        const unsigned gen = old / nloc;
        if (old + 1u == (gen + 1u) * nloc) {
            __builtin_amdgcn_fence(__ATOMIC_RELEASE, "agent");
            asm volatile("s_waitcnt vmcnt(0)" ::: "memory");
            const unsigned og = xb_add(&bar[XB_TOP], 1u);
            const unsigned tg = og / nx;
            if (og + 1u == (tg + 1u) * nx) xb_add(&bar[XB_TOPGEN], 1u);
            else XB_SPIN(xb_ld(&bar[XB_TOPGEN]) == tg, bar);
            __builtin_amdgcn_fence(__ATOMIC_ACQUIRE, "agent");
            xb_add(&bar[XB_XGEN(b.x)], 1u);
            asm volatile("s_waitcnt vmcnt(0)" ::: "memory");
        } else {
            XB_SPIN(xb_ld(&bar[XB_XGEN(b.x)]) == gen, bar);
            __builtin_amdgcn_fence(__ATOMIC_ACQUIRE, "agent");
            asm volatile("s_waitcnt vmcnt(0)" ::: "memory");
        }
    }
    __syncthreads();
}

#ifndef REP_SYNC
#define REP_SYNC 1
#endif
#define GSYNC() do { for (int _r = 0; _r < REP_SYNC; ++_r) xcd_barrier(xbar); } while (0)
__global__ void __launch_bounds__(NTHR, 2) fwd_megakernel(Params p) {
    extern __shared__ __attribute__((aligned(16))) unsigned char lds[];
    cg::grid_group grid = cg::this_grid();
    LAS unsigned char* L = (LAS unsigned char*)lds;
    const int tid = threadIdx.x, lane = tid & 63, wave = __builtin_amdgcn_readfirstlane(tid >> 6);
    const int G = gridDim.x, bx = blockIdx.x;
    unsigned char* ws = p.ws;
    bf16_t* Win_t = (bf16_t*)(ws + WS_WIN); bf16_t* Wout_t = (bf16_t*)(ws + WS_WOUT); bf16_t* Wgu_t = (bf16_t*)(ws + WS_WGU); bf16_t* Wdn_t = (bf16_t*)(ws + WS_WDN);
    bf16_t* SGUW = (bf16_t*)(ws + WS_SGUW); bf16_t* PWT = (bf16_t*)(ws + WS_PWT); float* SSQ = (float*)(ws + WS_SS);
    bf16_t* XB = (bf16_t*)(ws + WS_XB); bf16_t* PROJ = (bf16_t*)(ws + WS_PROJ); bf16_t* YCAT = (bf16_t*)(ws + WS_YCAT); bf16_t* HID = (bf16_t*)(ws + WS_HID);

    volatile LAS unsigned* xst = (volatile LAS unsigned*)(L + LDS_BYTES - 16);
    if (tid < 4) xst[tid] = 0u;
    unsigned* barw = (unsigned*)(ws + WS_BAR);
    if (bx == 0) for (int i = tid; i < XCD_BAR_WORDS; i += NTHR) __hip_atomic_store(barw + i, 0u, __ATOMIC_RELAXED, __HIP_MEMORY_SCOPE_AGENT);
#ifndef REP_P0
#define REP_P0 1
#endif
    for (int rep0 = 0; rep0 < REP_P0; ++rep0) {
        LAS float* scr = (LAS float*)(L + wave * 16384);
        const int gw = bx * 8 + wave, NGW = G * 8;
        constexpr int I_IN = (DM / 64) * (DIN / 32), I_OUT = (DM / 64) * (DM / 32), I_GU = (DM / 64) * (2 * DFF / 32), I_DN = (DFF / 64) * (DM / 32), I_L = I_IN + I_OUT + I_GU + I_DN;
        for (int it = gw; it < DEPTH * I_L; it += NGW) {
            const int l = it / I_L; int r = it % I_L;
            if (r < I_IN) { transpose_item(p.w_in + (size_t)l * DM * DIN, DM, DIN, Win_t + (size_t)l * DIN * DM, p.norm_mix + l * DM, 1, scr, r, lane); continue; } r -= I_IN;
            if (r < I_OUT) { transpose_item(p.w_out + (size_t)l * DM * DM, DM, DM, Wout_t + (size_t)l * DM * DM, p.mix_out_gain + l * DM, 0, scr, r, lane); continue; } r -= I_OUT;
            if (r < I_GU) { transpose_item(p.w_gate_up + (size_t)l * DM * 2 * DFF, DM, 2 * DFF, Wgu_t + (size_t)l * 2 * DFF * DM, p.norm_ffn + l * DM, 2, scr, r, lane); continue; } r -= I_GU;
            transpose_item(p.w_down + (size_t)l * DFF * DM, DFF, DM, Wdn_t + (size_t)l * DM * DFF, nullptr, 0, scr, r, lane);
        }
        for (int m = 2 * gw; m < M; m += 2 * NGW) {
            const f32x4* xr = (const f32x4*)(p.x + (size_t)m * DM) + lane; u32x2* o8 = (u32x2*)(XB + (size_t)m * DM) + lane; f32x4 v[2][4];
#pragma unroll
            for (int r = 0; r < 2; ++r)
#pragma unroll
                for (int j = 0; j < 4; ++j) v[r][j] = __builtin_nontemporal_load(xr + r * 256 + 64 * j);
#pragma unroll
            for (int r = 0; r < 2; ++r) { float s = 0.f;
#pragma unroll
                for (int j = 0; j < 4; ++j) { const f32x4 t = v[r][j]; s += ssq4(t); u32x2 o; o.x = pk2(t.x, t.y); o.y = pk2(t.z, t.w); o8[r * 256 + 64 * j] = o; }
                s = wave_sum(s);
                if (lane < 4) SSQ[(size_t)(m + r) * 4 + lane] = (lane == 0) ? s : 0.f; }
        }
        const int gt = bx * NTHR + tid, NGT = G * NTHR;
        for (int e = gt; e < DEPTH * 4 * 128 * 128 / 8; e += NGT) { const int s0 = (e & 15) * 8, t = (e >> 4) & 127; const float* src = p.sgu_w + (size_t)e * 8;
            const f32x4 a = *(const f32x4*)src, bq = *(const f32x4*)(src + 4); float v[8] = {a.x, a.y, a.z, a.w, bq.x, bq.y, bq.z, bq.w};
#pragma unroll
            for (int i = 0; i < 8; ++i) v[i] = (s0 + i <= t) ? v[i] : 0.f;
            u32x4 o; o.x = pk2(v[0], v[1]); o.y = pk2(v[2], v[3]); o.z = pk2(v[4], v[5]); o.w = pk2(v[6], v[7]); *(u32x4*)(SGUW + (size_t)e * 8) = o; }
        for (int e = gt; e < DEPTH * 4 * 64 * 64; e += NGT) { const int cc = e & 63, d = (e >> 6) & 63, lg = e >> 12; PWT[e] = f2bf(p.pool_w[((size_t)lg * 64 + cc) * 64 + d]); }
    }
    grid.sync();
    const XcdBarrier xbar = xcd_barrier_post(barw, xst);

    for (int l = 0; l < DEPTH; ++l) {
#ifndef REP_P1
#define REP_P1 1
#endif
#ifndef NO_P1
        for (int rep = 0; rep < REP_P1; ++rep) { int zk; asm volatile("s_mov_b32 %0, 0" : "=s"(zk)); pg8::Gemm g{XB, Win_t + (size_t)l * DIN * DM, M, DIN, DM + zk}; pg8::StaticOrder S; S.init(M, DIN, G + zk, bx); pg8::EpiIn E{PROJ, SSQ};
          pg8::gemm_phase<pg8::EpiIn, pg8::StaticOrder, true, true>(L, g, S, E, zk); }
#endif
        GSYNC();
#ifndef REP_MIX
#define REP_MIX 1
#endif
#ifndef REP_D
#define REP_D 1
#endif
        for (int rep = 0; rep < REP_MIX; ++rep)
        for (int u0 = bx; u0 < 256; u0 += G) {
            const int u = (G == 256) ? (((u0 & 7) << 5) | (u0 >> 3)) : u0; const int b = u >> 4, ch = u & 15;
            __syncthreads();
#ifndef REP_A
#define REP_A 1
#endif
#ifndef NO_A
            for (int rp = 0; rp < REP_A; ++rp) { __syncthreads(); int zt; asm volatile("v_mov_b32 %0, 0" : "=v"(zt)); const int t2 = tid + zt; mixer_A(L, PROJ, SGUW + (size_t)l * 4 * 128 * 128, p.sgu_b + l * 4 * 128, YCAT, b, ch, t2, t2 & 63, __builtin_amdgcn_readfirstlane(t2 >> 6)); }
#endif
            __syncthreads();
#ifndef REP_B
#define REP_B 1
#endif
#ifndef NO_B
            for (int rp = 0; rp < REP_B; ++rp) { __syncthreads(); int zt; asm volatile("v_mov_b32 %0, 0" : "=v"(zt)); const int t2 = tid + zt; mixer_B(L, PROJ, PWT + (size_t)l * 4 * 64 * 64, p.pool_scale + l * 256, YCAT, b, ch, t2, t2 & 63, __builtin_amdgcn_readfirstlane(t2 >> 6)); }
#endif
            __syncthreads();
#ifndef REP_C
#define REP_C 1
#endif
#ifndef NO_C
            for (int rp = 0; rp < REP_C; ++rp) { __syncthreads(); int zt; asm volatile("v_mov_b32 %0, 0" : "=v"(zt)); const int t2 = tid + zt; mixer_C(L, PROJ, p.swa_sinks + l * 4, p.rel_bias, YCAT, b, ch, t2, t2 & 63, __builtin_amdgcn_readfirstlane(t2 >> 6)); }
#endif
            __syncthreads();
#ifndef NO_D
#pragma unroll 1
            for (int hf = 0; hf < 2 * REP_D; ++hf) { int zt; asm volatile("v_mov_b32 %0, 0" : "=v"(zt)); const int t2 = tid + zt; mixer_D(L, PROJ, YCAT, b, (hf & 1) ? 31 - ch : ch, t2, t2 & 63, __builtin_amdgcn_readfirstlane(t2 >> 6)); __syncthreads(); }
#endif
        }
        GSYNC();
#ifndef NO_P3
        { int zk; asm volatile("s_mov_b32 %0, 0" : "=s"(zk)); pg8::Gemm g{YCAT, Wout_t + (size_t)l * DM * DM, M, DM, DM + zk}; pg8::StaticOrder S; S.init(M, DM, G + zk, bx); pg8::EpiRes E{l == 0 ? p.x : nullptr, nullptr, XB, SSQ, (LAS float*)(L + 131072)};
          pg8::gemm_phase<pg8::EpiRes, pg8::StaticOrder, true, true>(L, g, S, E, zk); }
#endif
        GSYNC();
#ifndef REP_P4
#define REP_P4 1
#endif
#ifndef NO_P4
        for (int rep = 0; rep < REP_P4; ++rep) { int zk; asm volatile("s_mov_b32 %0, 0" : "=s"(zk)); pg8::Gemm g{XB, Wgu_t + (size_t)l * 2 * DFF * DM, M, 2 * DFF, DM + zk}; pg8::StaticOrder S; S.init(M, 2 * DFF, G + zk, bx); pg8::EpiGU E{HID, SSQ};
          pg8::gemm_phase<pg8::EpiGU, pg8::StaticOrder, true, true>(L, g, S, E, zk); }
#endif
        GSYNC();
#ifndef NO_P5
        { int zk; asm volatile("s_mov_b32 %0, 0" : "=s"(zk)); pg8::Gemm g{HID, Wdn_t + (size_t)l * DM * DFF, M, DM, DFF + zk}; pg8::StaticOrder S; S.init(M, DM, G + zk, bx); pg8::EpiRes E{nullptr, l == DEPTH - 1 ? p.out : nullptr, XB, SSQ, (LAS float*)(L + 131072)};
          pg8::gemm_phase<pg8::EpiRes, pg8::StaticOrder, true, true>(L, g, S, E, zk); }
#endif
        GSYNC();
    }
    {
        const int gw = bx * 8 + wave, NGW = G * 8;
        for (int m = gw; m < M; m += NGW) { const float rs = rstd_of(SSQ, m); f32x4* xr = (f32x4*)(p.out + (size_t)m * DM) + lane; const f32x4* gr = (const f32x4*)p.norm_final + lane;
#pragma unroll
            for (int j = 0; j < 4; ++j) { const f32x4 v = xr[64 * j], gg = gr[64 * j]; xr[64 * j] = v * rs * gg; } }
    }
}

extern "C" void kernel_launch(void* const* d_in, const int* in_sizes, int n_in, void* d_out, int out_size, void* d_ws, size_t ws_size, hipStream_t stream) {
    static int grid_blocks = 0;
    if (grid_blocks == 0) {
        if (n_in != 15 || in_sizes[0] != M * DM || out_size != M * DM || ws_size < WS_END) { fprintf(stderr, "kernel_launch: unexpected shapes (n_in %d, in0 %d, out %d, ws %zu)\n", n_in, n_in > 0 ? in_sizes[0] : -1, out_size, ws_size); grid_blocks = -1; return; }
        int dev = 0, cus = 0, per_cu = 0;
        hipGetDevice(&dev); hipDeviceGetAttribute(&cus, hipDeviceAttributeMultiprocessorCount, dev);
        if (hipFuncSetAttribute((const void*)fwd_megakernel, hipFuncAttributeMaxDynamicSharedMemorySize, LDS_BYTES) != hipSuccess) { fprintf(stderr, "kernel_launch: hipFuncSetAttribute failed\n"); }
        if (hipOccupancyMaxActiveBlocksPerMultiprocessor(&per_cu, (const void*)fwd_megakernel, NTHR, LDS_BYTES) != hipSuccess || per_cu < 1) { fprintf(stderr, "kernel_launch: occupancy query says %d\n", per_cu); per_cu = 1; }
        (void)hipGetLastError();
        grid_blocks = cus * 1;
        if (grid_blocks <= 0) grid_blocks = 256;
    }
    if (grid_blocks < 0) return;
    Params p{};
    p.x = (const float*)d_in[0]; p.w_in = (const float*)d_in[1]; p.w_out = (const float*)d_in[2]; p.sgu_w = (const float*)d_in[3]; p.sgu_b = (const float*)d_in[4];
    p.pool_w = (const float*)d_in[5]; p.pool_scale = (const float*)d_in[6]; p.swa_sinks = (const float*)d_in[7]; p.rel_bias = (const float*)d_in[8]; p.mix_out_gain = (const float*)d_in[9];
    p.norm_mix = (const float*)d_in[10]; p.norm_ffn = (const float*)d_in[11]; p.w_gate_up = (const float*)d_in[12]; p.w_down = (const float*)d_in[13]; p.norm_final = (const float*)d_in[14];
    p.out = (float*)d_out; p.ws = (unsigned char*)d_ws;
    void* args[] = {&p};
    hipError_t e = hipLaunchCooperativeKernel((const void*)fwd_megakernel, dim3(grid_blocks), dim3(NTHR), args, LDS_BYTES, stream);
    if (e != hipSuccess) fprintf(stderr, "cooperative launch failed: %s (grid %d)\n", hipGetErrorString(e), grid_blocks);
}
```

```cpp
#include <hip/hip_runtime.h>
#include <hip/hip_cooperative_groups.h>
#include <cstdio>
#include <cstdint>
namespace cg = cooperative_groups;
namespace pg8 {
#define PG8_LAS __attribute__((address_space(3)))
typedef unsigned short bf16_t;
typedef short bf16x8 __attribute__((ext_vector_type(8)));
typedef float f32x4 __attribute__((ext_vector_type(4)));
typedef unsigned u32x4 __attribute__((ext_vector_type(4)));
constexpr int BM = 256, BK = 64, HALF = 128, HTB = HALF * BK * 2  , STAGE_BYTES = 8 * HTB, NXCD = 8, WGM = 8;

__host__ __device__ __forceinline__ int lds_byte(int r, int c) { const int st = (r >> 4) * 2 + (c >> 5), rr = r & 15, cc = c & 31, ob = rr * 64 + cc * 2; return st * 1024 + (ob ^ (((ob >> 9) & 1) << 5)); }
__host__ __device__ __forceinline__ void stage_rc(int b, int& R, int& C) { const int st = b / 1024, sb = b % 1024, swz = sb ^ (((sb >> 9) & 1) << 5); R = (st >> 1) * 16 + swz / 64; C = (st & 1) * 32 + (swz % 64) / 2; }
__host__ __device__ __forceinline__ int perm32(int rho) { const int n = rho >> 4, i = rho & 15; return 8 * (i >> 2) + 4 * n + (i & 3); }

struct Unit { int pm, pn; };
struct Gemm { const bf16_t* A; const bf16_t* Bt; int M, N, K; };

struct StaticOrder {
    int nM, nN, nwg, G, c;
    __host__ __device__ void init(int M, int N, int G_, int c_) { nM = M / BM; nN = N / BM; nwg = nM * nN; G = G_; c = c_; }
    __host__ __device__ bool next(int i, Unit& u) const {
        const long L = (long)i * G + c; if (L >= nwg) return false;
        int wgid = (int)L; { const int q = nwg / NXCD, r = nwg % NXCD, xcd = wgid % NXCD, off = wgid / NXCD; wgid = (xcd < r ? xcd * (q + 1) : r * (q + 1) + (xcd - r) * q) + off; }
        const int nig = WGM * nN, gid = wgid / nig, fm = gid * WGM, gsz = (nM - fm) < WGM ? (nM - fm) : WGM;
        u.pm = fm + ((wgid % nig) % gsz); u.pn = (wgid % nig) / gsz; return true;
    }
    __device__ __forceinline__ void a_ready(const Unit&) const {}
    __device__ __forceinline__ void done(const Unit&) const {}
};

__device__ __forceinline__ unsigned cvt_pk_bf16(float lo, float hi) { unsigned r; asm volatile("v_cvt_pk_bf16_f32 %0, %1, %2" : "=v"(r) : "v"(lo), "v"(hi)); return r; }
typedef float f32x2 __attribute__((ext_vector_type(2)));
template <class Epi, class Sched, bool ALIGN_EPI = false, bool SP2 = false>
__device__ __forceinline__ void gemm_phase(PG8_LAS unsigned char* lds, const Gemm g, const Sched& S, const Epi& E, const int opq) {
    const int tid = threadIdx.x + opq, wid = __builtin_amdgcn_readfirstlane(tid >> 6), lane = tid & 63, wr = wid >> 2, wc = wid & 3, fr = lane & 15, fq = lane >> 4;
    const int K = g.K, nt = K / BK;
    unsigned voffA[2], voffB[2];
#pragma unroll
    for (int i = 0; i < 2; ++i) { int R, C; stage_rc(tid * 16 + i * 8192, R, C); const int Rb = Epi::PERM ? ((R & ~31) + perm32(R & 31)) : R;
        voffA[i] = (unsigned)(R * K + C) * 2u; voffB[i] = (unsigned)(Rb * K + C) * 2u; }
    const size_t kstep = (size_t)(BK * 2);
    const size_t hstep = (size_t)HALF * K * 2;
    const size_t tstep = 2 * hstep;
    const unsigned ldsw = (unsigned)wid * 1024u;
    const int aoff = lds_byte(wr * 64 + fr, fq * 8), boff = lds_byte(wc * 32 + fr, fq * 8);
#define PG8_SA(b, h) (((b) * 2 + (h)) * HTB)
#define PG8_SB(b, h) ((4 + (b) * 2 + (h)) * HTB)
#define PG8_STAGE(bufoff, gbase, voff) do { _Pragma("unroll") for (int _i = 0; _i < 2; ++_i) \
        __builtin_amdgcn_global_load_lds((const unsigned*)((const char*)(gbase) + (voff)[_i]), (PG8_LAS unsigned*)(lds + (bufoff) + ldsw + _i * 8192), 16, 0, 0); } while (0)
#define PG8_LDA(dst, b, h) do { _Pragma("unroll") for (int m = 0; m < 4; ++m) _Pragma("unroll") for (int k = 0; k < 2; ++k) dst[m][k] = *(const PG8_LAS bf16x8*)(lds + PG8_SA(b, h) + aoff + m * 2048 + k * 1024); } while (0)
#define PG8_LDB(dst, b, h) do { _Pragma("unroll") for (int n = 0; n < 2; ++n) _Pragma("unroll") for (int k = 0; k < 2; ++k) dst[n][k] = *(const PG8_LAS bf16x8*)(lds + PG8_SB(b, h) + boff + n * 2048 + k * 1024); } while (0)
#define PG8_MMA(ai, bj, At, Bt) do { __builtin_amdgcn_s_setprio(1); _Pragma("unroll") for (int m = 0; m < 4; ++m) _Pragma("unroll") for (int n = 0; n < 2; ++n) _Pragma("unroll") for (int k = 0; k < 2; ++k) \
        acc[ai][bj][m][n] = __builtin_amdgcn_mfma_f32_16x16x32_bf16(Bt[n][k], At[m][k], acc[ai][bj][m][n], 0, 0, 0); __builtin_amdgcn_s_setprio(0); } while (0)
#define PG8_WAIT_V(n) asm volatile("s_waitcnt vmcnt(" #n ")" ::: "memory")
#define PG8_WAIT_L(n) asm volatile("s_waitcnt lgkmcnt(" #n ")" ::: "memory")
#define PG8_BAR __builtin_amdgcn_s_barrier()
#define PG8_SCHED __builtin_amdgcn_sched_barrier(0)
    Unit cur, nxt; int ui = 0;
    if (!S.next(0, cur)) return;
    f32x4 acc[2][2][4][2];
#pragma unroll
    for (int a = 0; a < 2; ++a)
#pragma unroll
        for (int b = 0; b < 2; ++b)
#pragma unroll
            for (int m = 0; m < 4; ++m)
#pragma unroll
                for (int n = 0; n < 2; ++n) acc[a][b][m][n] = (f32x4){0.f, 0.f, 0.f, 0.f};
    bf16x8 At[4][2], B0[2][2], B1[2][2];
    const char* cA = (const char*)g.A + (size_t)cur.pm * tstep; const char* cB = (const char*)g.Bt + (size_t)cur.pn * tstep;
    S.a_ready(cur);
    if constexpr (SP2) {
        PG8_STAGE(PG8_SB(0, 0), cB, voffB); PG8_STAGE(PG8_SB(0, 1), cB + hstep, voffB); PG8_STAGE(PG8_SA(0, 0), cA, voffA); PG8_STAGE(PG8_SA(0, 1), cA + hstep, voffA);
        if (wr == 1) PG8_BAR;
        PG8_WAIT_V(2); PG8_BAR;
        PG8_STAGE(PG8_SB(1, 0), cB + kstep, voffB); PG8_STAGE(PG8_SA(1, 0), cA + kstep, voffA); PG8_STAGE(PG8_SB(1, 1), cB + hstep + kstep, voffB);
        PG8_WAIT_V(6); PG8_BAR;
    } else {
        PG8_STAGE(PG8_SB(0, 0), cB, voffB); PG8_STAGE(PG8_SA(0, 0), cA, voffA); PG8_STAGE(PG8_SB(0, 1), cB + hstep, voffB); PG8_STAGE(PG8_SA(0, 1), cA + hstep, voffA);
        if (wr == 1) PG8_BAR;
        PG8_WAIT_V(4); PG8_BAR;
        PG8_STAGE(PG8_SB(1, 0), cB + kstep, voffB); PG8_STAGE(PG8_SA(1, 0), cA + kstep, voffA); PG8_STAGE(PG8_SB(1, 1), cB + hstep + kstep, voffB);
        PG8_WAIT_V(6); PG8_BAR;
    }
    for (;;) {
        const bool has_next = S.next(ui + 1, nxt);
        const char* nA = has_next ? (const char*)g.A + (size_t)nxt.pm * tstep : cA; const char* nB = has_next ? (const char*)g.Bt + (size_t)nxt.pn * tstep : cB;
        for (int t = 0; t < nt; t += 2) {
            const bool last = (t == nt - 2);
            const char* a1 = cA + (size_t)(t + 1) * kstep;
            const char* a2 = last ? nA : cA + (size_t)(t + 2) * kstep; const char* b2 = last ? nB : cB + (size_t)(t + 2) * kstep;
            const char* a3 = a2 + kstep; const char* b3 = b2 + kstep;
            if (last && has_next) S.a_ready(nxt);
            if constexpr (SP2) {
            PG8_LDB(B0, 0, 0); PG8_LDB(B1, 0, 1); PG8_SCHED; PG8_LDA(At, 0, 0); PG8_STAGE(PG8_SA(1, 1), a1 + hstep, voffA);
            PG8_WAIT_V(8); PG8_WAIT_L(0); PG8_BAR; PG8_MMA(0, 0, At, B0); PG8_MMA(0, 1, At, B1); PG8_BAR; PG8_SCHED;
            PG8_LDA(At, 0, 1); PG8_STAGE(PG8_SB(0, 0), b2, voffB); PG8_STAGE(PG8_SB(0, 1), b2 + hstep, voffB); PG8_STAGE(PG8_SA(0, 0), a2, voffA);
            PG8_WAIT_V(8); PG8_WAIT_L(0); PG8_BAR; PG8_MMA(1, 0, At, B0); PG8_MMA(1, 1, At, B1); PG8_BAR; PG8_SCHED;
            PG8_LDB(B0, 1, 0); PG8_LDB(B1, 1, 1); PG8_SCHED; PG8_LDA(At, 1, 0); PG8_STAGE(PG8_SA(0, 1), a2 + hstep, voffA);
            PG8_WAIT_V(8); PG8_WAIT_L(0); PG8_BAR; PG8_MMA(0, 0, At, B0); PG8_MMA(0, 1, At, B1); PG8_BAR; PG8_SCHED;
            PG8_LDA(At, 1, 1); PG8_STAGE(PG8_SB(1, 0), b3, voffB); PG8_STAGE(PG8_SB(1, 1), b3 + hstep, voffB); PG8_STAGE(PG8_SA(1, 0), a3, voffA);
            PG8_WAIT_V(8); PG8_WAIT_L(0); PG8_BAR; PG8_MMA(1, 0, At, B0); PG8_MMA(1, 1, At, B1); PG8_BAR; PG8_SCHED;
            } else {
            PG8_LDB(B0, 0, 0); PG8_SCHED; PG8_LDA(At, 0, 0); PG8_STAGE(PG8_SA(1, 1), a1 + hstep, voffA);
            PG8_WAIT_L(8); PG8_BAR; PG8_WAIT_L(0); PG8_MMA(0, 0, At, B0); PG8_BAR; PG8_SCHED;
            PG8_LDB(B1, 0, 1); PG8_STAGE(PG8_SB(0, 0), b2, voffB);
            PG8_BAR; PG8_WAIT_L(0); PG8_MMA(0, 1, At, B1); PG8_BAR;
            PG8_LDA(At, 0, 1); PG8_STAGE(PG8_SA(0, 0), a2, voffA);
            PG8_BAR; PG8_WAIT_L(0); PG8_MMA(1, 0, At, B0); PG8_BAR; PG8_SCHED;
            PG8_STAGE(PG8_SB(0, 1), b2 + hstep, voffB);
            PG8_WAIT_V(6); PG8_BAR; PG8_MMA(1, 1, At, B1); PG8_BAR;
            PG8_LDB(B0, 1, 0); PG8_SCHED; PG8_LDA(At, 1, 0); PG8_STAGE(PG8_SA(0, 1), a2 + hstep, voffA);
            PG8_WAIT_L(8); PG8_BAR; PG8_WAIT_L(0); PG8_MMA(0, 0, At, B0); PG8_BAR; PG8_SCHED;
            PG8_LDB(B1, 1, 1); PG8_STAGE(PG8_SB(1, 0), b3, voffB);
            PG8_BAR; PG8_WAIT_L(0); PG8_MMA(0, 1, At, B1); PG8_BAR;
            PG8_LDA(At, 1, 1); PG8_STAGE(PG8_SA(1, 0), a3, voffA);
            PG8_BAR; PG8_WAIT_L(0); PG8_MMA(1, 0, At, B0); PG8_BAR; PG8_SCHED;
            PG8_STAGE(PG8_SB(1, 1), b3 + hstep, voffB);
            PG8_WAIT_V(6); PG8_BAR; PG8_MMA(1, 1, At, B1); PG8_BAR;
            }
        }
        if constexpr (ALIGN_EPI) { if (wr == 0) PG8_BAR; }
        if constexpr (!Epi::AFTER_DRAIN) { E(acc, cur, wr, wc, fr, fq); S.done(cur); }
        if (!has_next) break;
#pragma unroll
        for (int a = 0; a < 2; ++a)
#pragma unroll
            for (int b = 0; b < 2; ++b)
#pragma unroll
                for (int m = 0; m < 4; ++m)
#pragma unroll
                    for (int n = 0; n < 2; ++n) acc[a][b][m][n] = (f32x4){0.f, 0.f, 0.f, 0.f};
        cur = nxt; cA = nA; cB = nB; ++ui;
        if constexpr (ALIGN_EPI) { if (wr == 1) PG8_BAR; }
    }
    PG8_WAIT_V(0);
    if constexpr (!ALIGN_EPI) { if (wr == 0) PG8_BAR; }
    PG8_BAR;
    if constexpr (Epi::AFTER_DRAIN) { E.fused(acc, cur, wr, wc, fr, fq, lds, wid, lane); S.done(cur); }
#undef PG8_SA
#undef PG8_SB
#undef PG8_STAGE
#undef PG8_LDA
#undef PG8_LDB
#undef PG8_MMA
#undef PG8_WAIT_V
#undef PG8_WAIT_L
#undef PG8_BAR
#undef PG8_SCHED
}
}

constexpr int NB = 16, SEQ = 2048, DM = 1024, DEPTH = 4, DIN = 2048, DFF = 2816, M = NB * SEQ;
constexpr float EPS = 1e-6f;
constexpr size_t MiB = 1u << 20;
constexpr size_t WS_WIN = 0, WS_WOUT = 16 * MiB, WS_WGU = 24 * MiB, WS_WDN = 68 * MiB, WS_SGUW = 90 * MiB, WS_PWT = 90 * MiB + 512 * 1024,
                 WS_SS = 91 * MiB, WS_BAR = 93 * MiB, WS_XB = 96 * MiB, WS_PROJ = 160 * MiB, WS_YCAT = 288 * MiB, WS_HID = 160 * MiB, WS_END = 352 * MiB;
constexpr int LDS_BYTES = 160 * 1024;
constexpr int NTHR = 512;

#define LAS __attribute__((address_space(3)))
typedef unsigned short bf16_t;
typedef short bf16x8 __attribute__((ext_vector_type(8)));
typedef float f32x4 __attribute__((ext_vector_type(4)));
typedef float f32x2 __attribute__((ext_vector_type(2)));
typedef unsigned u32x4 __attribute__((ext_vector_type(4)));
typedef unsigned u32x2 __attribute__((ext_vector_type(2)));
typedef __bf16 bf16x2_t __attribute__((ext_vector_type(2)));

__device__ __forceinline__ unsigned pk2(float lo, float hi) { f32x2 v = {lo, hi}; bf16x2_t b = __builtin_convertvector(v, bf16x2_t); return __builtin_bit_cast(unsigned, b); }
__device__ __forceinline__ bf16_t f2bf(float f) { return (bf16_t)(pk2(f, 0.f) & 0xffffu); }
__device__ __forceinline__ float bflo(unsigned w) { return __uint_as_float(w << 16); }
__device__ __forceinline__ float bfhi(unsigned w) { return __uint_as_float(w & 0xffff0000u); }
#define MFMA16(a, b, c) __builtin_amdgcn_mfma_f32_16x16x32_bf16((a), (b), (c), 0, 0, 0)
#define CFENCE() asm volatile("" ::: "memory")
#define LDSWAIT() asm volatile("s_waitcnt lgkmcnt(0)" ::: "memory")
__device__ __forceinline__ float fexp(float x) { return __builtin_amdgcn_exp2f(x * 1.4426950408889634f); }
__device__ __forceinline__ float gelu_tanh(float x) {
    const float u2 = 1.5957691216057308f * x * (1.0f + 0.044715f * x * x);
    return x * __builtin_amdgcn_rcpf(1.0f + fexp(-u2));
}
__device__ __forceinline__ float rstd_of1(const float* ss, int row) {
    const f32x4 s = *(const f32x4*)(ss + (size_t)row * 4); return rsqrtf(((s.x + s.y) + (s.z + s.w)) * (1.0f / 1024.0f) + EPS);
}

#ifdef USE_WT
__device__ __forceinline__ void st16(void* p, const u32x4 v) { asm volatile("global_store_dwordx4 %0, %1, off sc1\n\ts_nop 1" :: "v"(p), "v"(v) : "memory"); }
#else
__device__ __forceinline__ void st16(void* p, const u32x4 v) { *(u32x4*)p = v; }
#endif
__device__ __forceinline__ float ssq4(const f32x4 y) { return (y[0] * y[0] + y[1] * y[1]) + (y[2] * y[2] + y[3] * y[3]); }

#ifdef PROBE_RSTD2
__device__ __forceinline__ float rstd_of(const float* ss, int row) { const float a = rstd_of1(ss, row); int z; asm volatile("v_mov_b32 %0, 0" : "=v"(z) : "v"(a)); const float b = rstd_of1(ss, row + z); return (a + b) * 0.5f; }
#else
__device__ __forceinline__ float rstd_of(const float* ss, int row) { return rstd_of1(ss, row); }
#endif
namespace pg8 {
struct EpiIn {
    static constexpr bool PERM = true, AFTER_DRAIN = false;
    bf16_t* O; const float* ss; LAS float* T;
    __device__ __forceinline__ void operator()(const f32x4 (&acc)[2][2][4][2], const Unit& u, int wr, int wc, int fr, int fq) const {
        const int row0 = u.pm * BM + wr * 64 + fr, col0 = u.pn * BM + wc * 32 + 8 * fq; const bool act = u.pn < 2;
        float rsv[2][4];
        {
            volatile LAS int* TAG = (volatile LAS int*)(T + 256);
            if (TAG[0] != u.pm) {
                const int t = wr * 256 + wc * 64 + fq * 16 + fr;
                if (t < 256) T[t] = rstd_of(ss, u.pm * BM + t);
                asm volatile("s_waitcnt lgkmcnt(0)" ::: "memory"); __builtin_amdgcn_s_barrier(); asm volatile("" ::: "memory");
                if (t == 0) TAG[0] = u.pm; }
#pragma unroll
            for (int ai = 0; ai < 2; ++ai)
#pragma unroll
                for (int m = 0; m < 4; ++m) rsv[ai][m] = T[wr * 64 + fr + ai * HALF + m * 16]; }
#pragma unroll
        for (int ai = 0; ai < 2; ++ai)
#pragma unroll
            for (int m = 0; m < 4; ++m) { const int row = row0 + ai * HALF + m * 16; const float rs = rsv[ai][m]; bf16_t* rowp = O + (size_t)row * DIN + col0;
#pragma unroll
                for (int bj = 0; bj < 2; ++bj) { f32x4 v0 = acc[ai][bj][m][0] * rs, v1 = acc[ai][bj][m][1] * rs;
                    if (act) { v0 = (f32x4){gelu_tanh(v0[0]), gelu_tanh(v0[1]), gelu_tanh(v0[2]), gelu_tanh(v0[3])}; v1 = (f32x4){gelu_tanh(v1[0]), gelu_tanh(v1[1]), gelu_tanh(v1[2]), gelu_tanh(v1[3])}; }
                    u32x4 w; w.x = pk2(v0[0], v0[1]); w.y = pk2(v0[2], v0[3]); w.z = pk2(v1[0], v1[1]); w.w = pk2(v1[2], v1[3]);
                    st16(rowp + bj * HALF, w); }
                if (m & 1) CFENCE(); }
    }
};
struct EpiGU {
    static constexpr bool PERM = true, AFTER_DRAIN = false;
    bf16_t* O; const float* ss; LAS float* T;
    __device__ __forceinline__ void operator()(const f32x4 (&acc)[2][2][4][2], const Unit& u, int wr, int wc, int fr, int fq) const {
        const int row0 = u.pm * BM + wr * 64 + fr, col0 = u.pn * HALF + wc * 32 + 8 * fq;
        float rsv[2][4];
        {
            volatile LAS int* TAG = (volatile LAS int*)(T + 256);
            if (TAG[0] != u.pm) {
                const int t = wr * 256 + wc * 64 + fq * 16 + fr;
                if (t < 256) T[t] = rstd_of(ss, u.pm * BM + t);
                asm volatile("s_waitcnt lgkmcnt(0)" ::: "memory"); __builtin_amdgcn_s_barrier(); asm volatile("" ::: "memory");
                if (t == 0) TAG[0] = u.pm; }
#pragma unroll
            for (int ai = 0; ai < 2; ++ai)
#pragma unroll
                for (int m = 0; m < 4; ++m) rsv[ai][m] = T[wr * 64 + fr + ai * HALF + m * 16]; }
#pragma unroll
        for (int ai = 0; ai < 2; ++ai)
#pragma unroll
            for (int m = 0; m < 4; ++m) { const int row = row0 + ai * HALF + m * 16; const float rs = rsv[ai][m]; bf16_t* rowp = O + (size_t)row * DFF + col0;
                float h[8];
#pragma unroll
                for (int n = 0; n < 2; ++n)
#pragma unroll
                    for (int e = 0; e < 4; ++e) { const float g = acc[ai][0][m][n][e] * rs, up = acc[ai][1][m][n][e] * rs; h[n * 4 + e] = g * up * __builtin_amdgcn_rcpf(1.0f + fexp(-g)); }
                u32x4 w; w.x = pk2(h[0], h[1]); w.y = pk2(h[2], h[3]); w.z = pk2(h[4], h[5]); w.w = pk2(h[6], h[7]);
                st16(rowp, w);
                if (m & 1) CFENCE(); }
    }
};
struct EpiRes {
    static constexpr bool PERM = true, AFTER_DRAIN = false;
    const float* xin32; float* xout32; bf16_t* xb; float* ss; LAS float* P;
    __device__ __forceinline__ void operator()(const f32x4 (&acc)[2][2][4][2], const Unit& u, int wr, int wc, int fr, int fq) const {
        const int row0 = u.pm * BM + wr * 64 + fr, col0 = u.pn * BM + wc * 32 + 8 * fq;
#pragma unroll
        for (int ai = 0; ai < 2; ++ai)
#pragma unroll
            for (int m = 0; m < 4; ++m) { const int row = row0 + ai * HALF + m * 16; const size_t off = (size_t)row * DM + col0; float q = 0.f;
#pragma unroll
                for (int bj = 0; bj < 2; ++bj) { f32x4 r0, r1;
                    if (xin32) { r0 = *(const f32x4*)(xin32 + off + bj * HALF); r1 = *(const f32x4*)(xin32 + off + bj * HALF + 4); }
                    else { const u32x4 t = *(const u32x4*)(xb + off + bj * HALF); r0 = (f32x4){bflo(t.x), bfhi(t.x), bflo(t.y), bfhi(t.y)}; r1 = (f32x4){bflo(t.z), bfhi(t.z), bflo(t.w), bfhi(t.w)}; }
                    const f32x4 v0 = r0 + acc[ai][bj][m][0], v1 = r1 + acc[ai][bj][m][1];
                    q += ssq4(v0) + ssq4(v1);
                    if (xout32) { st16(xout32 + off + bj * HALF, __builtin_bit_cast(u32x4, v0)); st16(xout32 + off + bj * HALF + 4, __builtin_bit_cast(u32x4, v1)); }
                    else { u32x4 w; w.x = pk2(v0[0], v0[1]); w.y = pk2(v0[2], v0[3]); w.z = pk2(v1[0], v1[1]); w.w = pk2(v1[2], v1[3]); st16(xb + off + bj * HALF, w); } }
                q += __shfl_xor(q, 16); q += __shfl_xor(q, 32);
                if (fq == 0) P[(ai * HALF + wr * 64 + m * 16 + fr) * 4 + wc] = q;
                if (m & 1) CFENCE(); }
        asm volatile("s_waitcnt lgkmcnt(0)" ::: "memory"); __builtin_amdgcn_s_barrier(); asm volatile("" ::: "memory");
        const int t = wr * 256 + wc * 64 + fq * 16 + fr;
        if (t < 256) { const f32x4 pp = *(const LAS f32x4*)(P + t * 4); ss[(size_t)(u.pm * BM + t) * 4 + u.pn] = (pp.x + pp.y) + (pp.z + pp.w); }
    }
};
}

__device__ __forceinline__ void transpose_item(const float* W, int K, int N, bf16_t* WT, const float* gain, int mode, LAS float* scr, int item, int lane) {
    const int nblk = N / 32, kb = item / nblk, nb = item % nblk, k0 = 64 * kb, n0 = 32 * nb;
    const int c = lane & 7;
    f32x4 g0 = {1.f, 1.f, 1.f, 1.f}, g1 = {1.f, 1.f, 1.f, 1.f};
    if (gain) { g0 = *(const f32x4*)(gain + k0 + 8 * c); g1 = *(const f32x4*)(gain + k0 + 8 * c + 4); }
    const float* src = W + (size_t)(k0 + (lane >> 5)) * N + n0 + (lane & 31);
    float v[32];
#pragma unroll
    for (int i = 0; i < 32; ++i) v[i] = __builtin_nontemporal_load(src + (size_t)(2 * i) * N);
#pragma unroll
    for (int i = 0; i < 32; ++i) scr[(2 * i + (lane >> 5)) * 33 + (lane & 31)] = v[i];
    LDSWAIT();
#pragma unroll
    for (int j = 0; j < 4; ++j) { const int n = (lane >> 3) + 8 * j, gn = n0 + n; const LAS float* s = scr + (8 * c) * 33 + n;
        float cs = 1.0f; int row = gn;
        if (mode == 1) { if ((gn >= 768 && gn < 1024) || (gn >= 1280 && gn < 1536)) cs = 0.125f; }
        if (mode == 2) { const int jj = gn < DFF ? gn : gn - DFF; row = 256 * (jj >> 7) + (jj & 127) + (gn < DFF ? 0 : 128); }
        u32x4 o; o.x = pk2(s[0 * 33] * g0[0] * cs, s[1 * 33] * g0[1] * cs); o.y = pk2(s[2 * 33] * g0[2] * cs, s[3 * 33] * g0[3] * cs); o.z = pk2(s[4 * 33] * g1[0] * cs, s[5 * 33] * g1[1] * cs); o.w = pk2(s[6 * 33] * g1[2] * cs, s[7 * 33] * g1[3] * cs);
        *(u32x4*)(WT + (size_t)row * K + k0 + 8 * c) = o; }
    LDSWAIT();
}
__device__ __forceinline__ float wave_sum(float v) {
#pragma unroll
    for (int o = 1; o < 64; o <<= 1) v += __shfl_xor(v, o);
    return v;
}

struct Params {
    const float *x, *w_in, *w_out, *sgu_w, *sgu_b, *pool_w, *pool_scale, *swa_sinks, *rel_bias, *mix_out_gain, *norm_mix, *norm_ffn, *w_gate_up, *w_down, *norm_final;
    float* out; unsigned char* ws;
};


__device__ __forceinline__ void st4(bf16_t* p, const f32x4 y) { u32x2 o; o.x = pk2(y[0], y[1]); o.y = pk2(y[2], y[3]); *(u32x2*)p = o; }
#define VMWAIT() asm volatile("s_waitcnt vmcnt(0)" ::: "memory")
typedef short v4i16_t __attribute__((ext_vector_type(4)));
__device__ __forceinline__ bf16x8 tr_frag(const LAS bf16_t* p, int rows4) {
    const v4i16_t lo = __builtin_amdgcn_ds_read_tr16_b64_v4i16((LAS v4i16_t*)p);
    const v4i16_t hi = __builtin_amdgcn_ds_read_tr16_b64_v4i16((LAS v4i16_t*)(p + rows4));
    return (bf16x8){lo[0], lo[1], lo[2], lo[3], hi[0], hi[1], hi[2], hi[3]};
}

__device__ __forceinline__ void mixer_A(LAS unsigned char* L, const bf16_t* proj, const bf16_t* sguw, const float* sgub, bf16_t* ycat, int b, int ch, int tid, int lane, int w) {
    constexpr int VS = 264;
    LAS bf16_t* VL = (LAS bf16_t*)L;
    const size_t row0 = (size_t)b * SEQ + ch * 128;
    const int c = lane & 15, q = lane >> 4, wv = tid >> 6;
    const int nks = (w >> 1) + 1;
    const size_t trow = row0 + 16 * wv + c;
    const bf16_t* wbase = sguw + (size_t)(16 * wv + c) * 128 + 8 * q;
    const bf16_t* urow = proj + trow * DIN + 4 * q;
    bf16x8 bw[4][4]; u32x2 uu[4][4]; float bias[4];
#pragma unroll
    for (int h = 0; h < 4; ++h) { bias[h] = sgub[h * 128 + 16 * wv + c];
#pragma unroll
        for (int ks = 0; ks < 4; ++ks) if (ks < nks) bw[h][ks] = *(const bf16x8*)(wbase + h * 128 * 128 + 32 * ks);
#pragma unroll
        for (int n = 0; n < 4; ++n) uu[h][n] = *(const u32x2*)(urow + h * 64 + 16 * n); }
    {
        const int tok = tid >> 2, h = tid & 3;
        const bf16_t* src = proj + (row0 + tok) * DIN + 256 + h * 64;
        float v[64]; float s = 0.f;
#pragma unroll
        for (int i = 0; i < 8; ++i) { const u32x4 t = *(const u32x4*)(src + 8 * i);
            v[8 * i + 0] = bflo(t.x); v[8 * i + 1] = bfhi(t.x); v[8 * i + 2] = bflo(t.y); v[8 * i + 3] = bfhi(t.y); v[8 * i + 4] = bflo(t.z); v[8 * i + 5] = bfhi(t.z); v[8 * i + 6] = bflo(t.w); v[8 * i + 7] = bfhi(t.w); }
#pragma unroll
        for (int i = 0; i < 64; ++i) s += v[i];
        const float mean = s * (1.0f / 64.0f); float s2 = 0.f;
#pragma unroll
        for (int i = 0; i < 64; ++i) { v[i] -= mean; s2 += v[i] * v[i]; }
        const float rstd = rsqrtf(s2 * (1.0f / 64.0f) + EPS);
        LAS bf16_t* dst = VL + tok * VS + h * 64;
#pragma unroll
        for (int i = 0; i < 8; ++i) { u32x4 o; o.x = pk2(v[8 * i + 0] * rstd, v[8 * i + 1] * rstd); o.y = pk2(v[8 * i + 2] * rstd, v[8 * i + 3] * rstd); o.z = pk2(v[8 * i + 4] * rstd, v[8 * i + 5] * rstd); o.w = pk2(v[8 * i + 6] * rstd, v[8 * i + 7] * rstd);
            *(LAS u32x4*)(dst + 8 * i) = o; }
    }
    __syncthreads();
    const LAS bf16_t* vbase = VL + (8 * q + (c >> 2)) * VS + 4 * (c & 3);
    f32x4 yv[4][4]; float ssq = 0.f;
#pragma unroll
    for (int h = 0; h < 4; ++h) {
#pragma unroll
        for (int n = 0; n < 4; ++n) yv[h][n] = (f32x4){0.f, 0.f, 0.f, 0.f};
#pragma unroll
        for (int ks = 0; ks < 4; ++ks) if (ks < nks) {
#pragma unroll
            for (int n = 0; n < 4; ++n) { const bf16x8 a = tr_frag(vbase + 32 * ks * VS + h * 64 + 16 * n, 4 * VS); yv[h][n] = MFMA16(a, bw[h][ks], yv[h][n]); }
        }
#pragma unroll
        for (int n = 0; n < 4; ++n) { const u32x2 u2 = uu[h][n];
            f32x4 y; y[0] = bflo(u2.x) * (yv[h][n][0] + bias[h]); y[1] = bfhi(u2.x) * (yv[h][n][1] + bias[h]); y[2] = bflo(u2.y) * (yv[h][n][2] + bias[h]); y[3] = bfhi(u2.y) * (yv[h][n][3] + bias[h]);
            yv[h][n] = y; ssq += ssq4(y); }
    }
    ssq += __shfl_xor(ssq, 16); ssq += __shfl_xor(ssq, 32);
    const float rs = rsqrtf(ssq * (1.0f / 256.0f) + EPS);
    bf16_t* yrow = ycat + trow * DM + 0 + 4 * q;
#pragma unroll
    for (int h = 0; h < 4; ++h)
#pragma unroll
        for (int n = 0; n < 4; ++n) st4(yrow + h * 64 + 16 * n, yv[h][n] * rs);
}

__device__ __forceinline__ void mixer_B(LAS unsigned char* L, const bf16_t* proj, const bf16_t* pwt, const float* pscale, bf16_t* ycat, int b, int ch, int tid, int lane, int w) {
    constexpr int YS = 264;
    LAS bf16_t* PL = (LAS bf16_t*)L;
    LAS bf16_t* Y = (LAS bf16_t*)(L + 76032);
    const size_t row0 = (size_t)b * SEQ + ch * 128;
    const int c = lane & 15, q = lane >> 4, wv = tid >> 6;
    const bf16_t* pbase = pwt + (size_t)c * 64 + 8 * q;
    bf16x8 pw[4][4][2];
#pragma unroll
    for (int g = 0; g < 4; ++g)
#pragma unroll
        for (int n = 0; n < 4; ++n)
#pragma unroll
            for (int ks = 0; ks < 2; ++ks) pw[g][n][ks] = *(const bf16x8*)(pbase + (g * 64 + 16 * n) * 64 + 32 * ks);
    {
        u32x4 t[9];
#pragma unroll
        for (int i = 0; i < 9; ++i) { const int id = tid + 512 * i, r = id >> 5, cc = id & 31; t[i] = (u32x4){0u, 0u, 0u, 0u};
            if (id < 143 * 32 && (ch > 0 || r >= 15)) t[i] = *(const u32x4*)(proj + (row0 - 15 + r) * DIN + 512 + 8 * cc); }
#pragma unroll
        for (int i = 0; i < 9; ++i) { const int id = tid + 512 * i, r = id >> 5, cc = id & 31; if (id < 143 * 32) *(LAS u32x4*)(PL + r * YS + 8 * cc) = t[i]; }
    }
    __syncthreads();
    {
        const int cc = tid & 31, t0 = (tid >> 5) * 8; const int win = 2 << (cc >> 3);
        const LAS bf16_t* col = PL + 15 * YS + 8 * cc;
        float S[8];
#pragma unroll
        for (int e = 0; e < 8; ++e) S[e] = 0.f;
#pragma unroll 1
        for (int j = 0; j < win; ++j) { const u32x4 t = *(const LAS u32x4*)(col + (t0 - j) * YS);
            S[0] += bflo(t.x); S[1] += bfhi(t.x); S[2] += bflo(t.y); S[3] += bfhi(t.y); S[4] += bflo(t.z); S[5] += bfhi(t.z); S[6] += bflo(t.w); S[7] += bfhi(t.w); }
#pragma unroll
        for (int i = 0; i < 8; ++i) { const int t = t0 + i; const u32x4 pt = *(const LAS u32x4*)(col + t * YS);
            const float p0 = bflo(pt.x), p1 = bfhi(pt.x), p2 = bflo(pt.y), p3 = bfhi(pt.y), p4 = bflo(pt.z), p5 = bfhi(pt.z), p6 = bflo(pt.w), p7 = bfhi(pt.w);
            if (i > 0) { const u32x4 po = *(const LAS u32x4*)(col + (t - win) * YS);
                S[0] += p0 - bflo(po.x); S[1] += p1 - bfhi(po.x); S[2] += p2 - bflo(po.y); S[3] += p3 - bfhi(po.y); S[4] += p4 - bflo(po.z); S[5] += p5 - bfhi(po.z); S[6] += p6 - bflo(po.w); S[7] += p7 - bfhi(po.w); }
            const int tseq = ch * 128 + t; const int cnt = (tseq + 1 < win) ? (tseq + 1) : win; const float inv = 1.0f / (float)cnt;
            u32x4 o; o.x = pk2(S[0] * inv - p0, S[1] * inv - p1); o.y = pk2(S[2] * inv - p2, S[3] * inv - p3); o.z = pk2(S[4] * inv - p4, S[5] * inv - p5); o.w = pk2(S[6] * inv - p6, S[7] * inv - p7);
            *(LAS u32x4*)(Y + t * YS + 8 * cc) = o; }
    }
    __syncthreads();
    const size_t trow = row0 + 16 * wv + c; float ssq = 0.f;
    const LAS bf16_t* ybase = Y + (16 * wv + c) * YS + 8 * q;
    f32x4 yv[4][4];
#pragma unroll
    for (int g = 0; g < 4; ++g) {
#pragma unroll
        for (int n = 0; n < 4; ++n) yv[g][n] = (f32x4){0.f, 0.f, 0.f, 0.f};
#pragma unroll
        for (int ks = 0; ks < 2; ++ks) { const bf16x8 bfrag = *(const LAS bf16x8*)(ybase + g * 64 + 32 * ks);
#pragma unroll
            for (int n = 0; n < 4; ++n) yv[g][n] = MFMA16(pw[g][n][ks], bfrag, yv[g][n]); }
#pragma unroll
        for (int n = 0; n < 4; ++n) { const f32x4 sc = *(const f32x4*)(pscale + g * 64 + 16 * n + 4 * q); yv[g][n] = yv[g][n] * sc; ssq += ssq4(yv[g][n]); }
    }
    ssq += __shfl_xor(ssq, 16); ssq += __shfl_xor(ssq, 32);
    const float rs = rsqrtf(ssq * (1.0f / 256.0f) + EPS);
    bf16_t* yrow = ycat + trow * DM + 256 + 4 * q;
#pragma unroll
    for (int g = 0; g < 4; ++g)
#pragma unroll
        for (int n = 0; n < 4; ++n) st4(yrow + g * 64 + 16 * n, yv[g][n] * rs);
}

__device__ __forceinline__ bf16x8 tr_frag_perm(const LAS bf16_t* p, int rows16) {
    const v4i16_t lo = __builtin_amdgcn_ds_read_tr16_b64_v4i16((LAS v4i16_t*)p);
    const v4i16_t hi = __builtin_amdgcn_ds_read_tr16_b64_v4i16((LAS v4i16_t*)(p + rows16));
    return (bf16x8){lo[0], lo[1], lo[2], lo[3], hi[0], hi[1], hi[2], hi[3]};
}
__device__ __forceinline__ bf16x8 pack8(const f32x4 a, const f32x4 b) { u32x4 o; o.x = pk2(a[0], a[1]); o.y = pk2(a[2], a[3]); o.z = pk2(b[0], b[1]); o.w = pk2(b[2], b[3]); return __builtin_bit_cast(bf16x8, o); }

__device__ __forceinline__ void mixer_C(LAS unsigned char* L, const bf16_t* proj, const float* sinks, const float* rel_bias, bf16_t* ycat, int b, int qb, int tid, int lane, int w) {
    constexpr int KS = 144;
    const int wv = tid >> 6;
    LAS bf16_t* KL = (LAS bf16_t*)L;
    LAS bf16_t* VL = (LAS bf16_t*)(L + 73728);
    LAS float* BT = (LAS float*)(L + 152064);
    const size_t row0 = (size_t)b * SEQ + qb * 128;
    const int c = lane & 15, q = lane >> 4;
    const size_t trow = row0 + 16 * wv + c;
    {
        const int skey = tid >> 1, shalf = tid & 1; const bool okk = (qb > 0) || (skey >= 128);
        const bf16_t* ksrc = proj + (row0 - 128 + skey) * DIN + 1024 + shalf * 64;
        u32x4 kr[8], vr[8];
#pragma unroll
        for (int i = 0; i < 8; ++i) { kr[i] = (u32x4){0u, 0u, 0u, 0u}; vr[i] = (u32x4){0u, 0u, 0u, 0u}; if (okk) { kr[i] = *(const u32x4*)(ksrc + 8 * i); vr[i] = *(const u32x4*)(ksrc + 128 + 8 * i); } }
        { const int j = tid >> 7, dist = tid & 127; int bucket = dist;
          if (dist >= 16) { const int lg = 16 + (int)(__logf((float)dist * (1.0f / 16.0f)) / 2.0794415416798357f * 16.0f); bucket = lg < 31 ? lg : 31; }
          BT[j * 128 + dist] = rel_bias[bucket * 4 + j];
          if (tid < 288) *(LAS u32x4*)(VL + 256 * KS + 8 * tid) = (u32x4){0u, 0u, 0u, 0u}; }
#pragma unroll
        for (int i = 0; i < 8; ++i) { *(LAS u32x4*)(KL + skey * KS + shalf * 64 + 8 * i) = kr[i]; *(LAS u32x4*)(VL + skey * KS + shalf * 64 + 8 * i) = vr[i]; }
    }
    bf16x8 qf[4][2];
#pragma unroll
    for (int j = 0; j < 4; ++j)
#pragma unroll
        for (int ks = 0; ks < 2; ++ks) qf[j][ks] = *(const bf16x8*)(proj + trow * DIN + 768 + j * 64 + 32 * ks + 8 * q);
    __syncthreads();
    const LAS bf16_t* kbase = KL + (16 * wv + c) * KS + 8 * q;
    const LAS bf16_t* vbase = VL + (16 * wv + 4 * q + (c >> 2)) * KS + 4 * (c & 3);
    f32x4 yv[4][4]; float ssq = 0.f;
#pragma unroll
    for (int j = 0; j < 4; ++j) { const int kvh = j >> 1;
        f32x4 z[9];
#pragma unroll
        for (int kti = 0; kti < 9; ++kti) { z[kti] = (f32x4){0.f, 0.f, 0.f, 0.f};
#pragma unroll
            for (int ks = 0; ks < 2; ++ks) { const bf16x8 a = *(const LAS bf16x8*)(kbase + 16 * kti * KS + kvh * 64 + 32 * ks); z[kti] = MFMA16(a, qf[j][ks], z[kti]); } }
        const float sink = sinks[j]; const LAS float* bt = BT + j * 128;
        int zz; asm volatile("v_mov_b32 %0, 0" : "=v"(zz));
        const int cz = c + zz; const int klo = (qb > 0) ? (cz + 1) : max(cz + 1, 128 - 16 * w), khi = cz + 128;
        float mx = sink;
#pragma unroll
        for (int kti = 0; kti < 9; ++kti)
#pragma unroll
            for (int r = 0; r < 4; ++r) { const int kl = 16 * kti + 4 * q + r; const int dist = 128 + cz - kl; const bool valid = (unsigned)(kl - klo) <= (unsigned)(khi - klo);
                const float bb = bt[dist & 127]; const float v = valid ? (z[kti][r] + bb) : -1e30f; z[kti][r] = v; mx = fmaxf(mx, v); }
        mx = fmaxf(mx, __shfl_xor(mx, 16)); mx = fmaxf(mx, __shfl_xor(mx, 32));
        float sum = 0.f;
#pragma unroll
        for (int kti = 0; kti < 9; ++kti)
#pragma unroll
            for (int r = 0; r < 4; ++r) { const float p = (z[kti][r] > -1e29f) ? fexp(z[kti][r] - mx) : 0.f; z[kti][r] = p; sum += p; }
        sum += __shfl_xor(sum, 16); sum += __shfl_xor(sum, 32);
        const float inv = 1.0f / (sum + fexp(sink - mx));
#pragma unroll
        for (int n = 0; n < 4; ++n) yv[j][n] = (f32x4){0.f, 0.f, 0.f, 0.f};
#pragma unroll
        for (int ks = 0; ks < 5; ++ks) { const f32x4 zero4 = {0.f, 0.f, 0.f, 0.f};
            const bf16x8 bfrag = pack8(z[2 * ks] * inv, (ks < 4) ? (z[(ks < 4) ? 2 * ks + 1 : 0] * inv) : zero4);
#pragma unroll
            for (int n = 0; n < 4; ++n) { const bf16x8 a = tr_frag_perm(vbase + 32 * ks * KS + kvh * 64 + 16 * n, 16 * KS); yv[j][n] = MFMA16(a, bfrag, yv[j][n]); } }
#pragma unroll
        for (int n = 0; n < 4; ++n) ssq += ssq4(yv[j][n]);
    }
    ssq += __shfl_xor(ssq, 16); ssq += __shfl_xor(ssq, 32);
    const float rs = rsqrtf(ssq * (1.0f / 256.0f) + EPS);
    bf16_t* yrow = ycat + trow * DM + 512 + 4 * q;
#pragma unroll
    for (int j = 0; j < 4; ++j)
#pragma unroll
        for (int n = 0; n < 4; ++n) st4(yrow + j * 64 + 16 * n, yv[j][n] * rs);
}

#ifndef D_CUT
#define D_CUT 2.0e-9f
#endif
__device__ __forceinline__ void mixer_D(LAS unsigned char* L, const bf16_t* proj, bf16_t* ycat, int b, int qb64, int tid, int lane, int w) {
    constexpr int KS = 272;
    constexpr int TILE = 64 * KS;
    const int wv = tid >> 6;
    LAS bf16_t* KL = (LAS bf16_t*)L;
    LAS bf16_t* VL = (LAS bf16_t*)(L + 69632);
    LAS float* RED = (LAS float*)(L + 139264);
    volatile LAS unsigned* FLG = (volatile LAS unsigned*)(L + 139776);
    const int rg = wv & 3, hp = wv >> 2, c = lane & 15, q = lane >> 4;
    const size_t seq0 = (size_t)b * SEQ; const size_t trow = seq0 + qb64 * 64 + 16 * rg + c;
    const int skey = tid >> 3, spart = tid & 7;
    const bf16_t* ksrc0 = proj + (seq0 + skey) * DIN + 1536 + spart * 32;
    LAS bf16_t* kdst = KL + skey * KS + spart * 32;
    LAS bf16_t* vdst = VL + skey * KS + spart * 32;
    u32x4 kr[4], vr[4];
    { const bf16_t* ksrc = ksrc0 + (size_t)qb64 * 64 * DIN;
#pragma unroll
        for (int i = 0; i < 4; ++i) { kr[i] = *(const u32x4*)(ksrc + 8 * i); vr[i] = *(const u32x4*)(ksrc + 256 + 8 * i); } }
    bf16x8 qf[2][2];
#pragma unroll
    for (int hh = 0; hh < 2; ++hh)
#pragma unroll
        for (int ks = 0; ks < 2; ++ks) qf[hh][ks] = *(const bf16x8*)(proj + trow * DIN + 1280 + (2 * hp + hh) * 64 + 32 * ks + 8 * q);
    f32x4 acc[2][4];
#pragma unroll
    for (int hh = 0; hh < 2; ++hh)
#pragma unroll
        for (int n = 0; n < 4; ++n) acc[hh][n] = (f32x4){0.f, 0.f, 0.f, 0.f};
    float rem[2] = {1.f, 1.f};
    const int qloc = 16 * rg + c;
    const LAS bf16_t* kbase = KL + c * KS + hp * 128 + 8 * q;
    const LAS bf16_t* vbase = VL + (4 * q + (c >> 2)) * KS + hp * 128 + 4 * (c & 3);
    if (tid < 3) FLG[tid] = 0u;
#pragma unroll
    for (int i = 0; i < 4; ++i) { *(LAS u32x4*)(kdst + 8 * i) = kr[i]; *(LAS u32x4*)(vdst + 8 * i) = vr[i]; }
    u32x4 kr2[4], vr2[4];
    if (qb64 > 0) { const bf16_t* ksrc = ksrc0 + (size_t)(qb64 - 1) * 64 * DIN;
#pragma unroll
        for (int i = 0; i < 4; ++i) { kr[i] = *(const u32x4*)(ksrc + 8 * i); vr[i] = *(const u32x4*)(ksrc + 256 + 8 * i); } }
    if (qb64 > 1) { const bf16_t* ksrc = ksrc0 + (size_t)(qb64 - 2) * 64 * DIN;
#pragma unroll
        for (int i = 0; i < 4; ++i) { kr2[i] = *(const u32x4*)(ksrc + 8 * i); vr2[i] = *(const u32x4*)(ksrc + 256 + 8 * i); } }
    else {
#pragma unroll
        for (int i = 0; i < 4; ++i) { kr2[i] = (u32x4){0u, 0u, 0u, 0u}; vr2[i] = (u32x4){0u, 0u, 0u, 0u}; } }
#define D_STEP(KW, VW) \
        __syncthreads(); \
        if (it > 0 && FLG[fprev] == 0u) break; \
        const int bo = (it & 1) * TILE, bn = ((it + 1) & 1) * TILE; \
        if (kt > 0) { \
            _Pragma("unroll") \
            for (int i = 0; i < 4; ++i) { *(LAS u32x4*)(kdst + bn + 8 * i) = KW[i]; *(LAS u32x4*)(vdst + bn + 8 * i) = VW[i]; } \
            if (kt > 2) { const bf16_t* ksrc = ksrc0 + (size_t)(kt - 3) * 64 * DIN; \
                _Pragma("unroll") \
                for (int i = 0; i < 4; ++i) { KW[i] = *(const u32x4*)(ksrc + 8 * i); VW[i] = *(const u32x4*)(ksrc + 256 + 8 * i); } } \
        } \
        if (tid == 0) FLG[fnext] = 0u; \
        const bool diag = (kt == qb64); \
_Pragma("unroll") \
        for (int hh = 0; hh < 2; ++hh) { \
            f32x4 z[4]; \
_Pragma("unroll") \
            for (int kti = 0; kti < 4; ++kti) { z[kti] = (f32x4){0.f, 0.f, 0.f, 0.f}; \
_Pragma("unroll") \
                for (int ks = 0; ks < 2; ++ks) { const bf16x8 a = *(const LAS bf16x8*)(kbase + bo + 16 * kti * KS + hh * 64 + 32 * ks); z[kti] = MFMA16(a, qf[hh][ks], z[kti]); } } \
            f32x4 ex[4]; float G[4]; \
            if (diag) { \
_Pragma("unroll") \
                for (int kti = 0; kti < 4; ++kti) { float run = 1.f; \
_Pragma("unroll") \
                    for (int r = 3; r >= 0; --r) { const bool valid = (16 * kti + 4 * q + r < qloc); \
                        const float u = fexp(fminf(z[kti][r], 80.f)); const float om = __builtin_amdgcn_rcpf(1.0f + u); \
                        z[kti][r] = valid ? u * om : 0.f; ex[kti][r] = run; run *= valid ? om : 1.f; } \
                    G[kti] = run; } \
            } else { \
_Pragma("unroll") \
                for (int kti = 0; kti < 4; ++kti) { float run = 1.f; \
_Pragma("unroll") \
                    for (int r = 3; r >= 0; --r) { const float u = fexp(fminf(z[kti][r], 80.f)); const float om = __builtin_amdgcn_rcpf(1.0f + u); \
                        z[kti][r] = u * om; ex[kti][r] = run; run *= om; } \
                    G[kti] = run; } \
            } \
            float E[4], Tk[4]; \
_Pragma("unroll") \
            for (int kti = 0; kti < 4; ++kti) { const float bq = __shfl_xor(G[kti], 16); const float ps = G[kti] * bq; const float c2 = __shfl_xor(ps, 32); \
                E[kti] = ((q & 1) ? 1.f : bq) * ((q < 2) ? c2 : 1.f); Tk[kti] = ps * c2; } \
            const float U2 = Tk[3], U1 = U2 * Tk[2], U0 = U1 * Tk[1]; \
            const float cb = rem[hh]; \
            const float base[4] = {cb * U0 * E[0], cb * U1 * E[1], cb * U2 * E[2], cb * E[3]}; \
            rem[hh] = cb * U0 * Tk[0]; \
_Pragma("unroll") \
            for (int kti = 0; kti < 4; ++kti) \
_Pragma("unroll") \
                for (int r = 0; r < 4; ++r) z[kti][r] = z[kti][r] * (base[kti] * ex[kti][r]); \
_Pragma("unroll") \
            for (int ks = 0; ks < 2; ++ks) { const bf16x8 bfrag = pack8(z[2 * ks], z[2 * ks + 1]); \
_Pragma("unroll") \
                for (int n = 0; n < 4; ++n) { const bf16x8 a = tr_frag_perm(vbase + bo + 32 * ks * KS + hh * 64 + 16 * n, 16 * KS); acc[hh][n] = MFMA16(a, bfrag, acc[hh][n]); } } \
        } \
        if (__builtin_amdgcn_ballot_w64(fmaxf(rem[0], rem[1]) > D_CUT) != 0ull) { if (lane == 0) FLG[fcur] = 1u; } \
        { const int t = fprev; fprev = fcur; fcur = fnext; fnext = t; }
    int it = 0, fprev = 2, fcur = 0, fnext = 1;
#pragma unroll 1
    for (int kt = qb64; kt >= 0; --kt, ++it) {
        { D_STEP(kr, vr) }
        if (kt == 0) break;
        --kt; ++it;
        { D_STEP(kr2, vr2) }
    }
#undef D_STEP
    float ssq = 0.f;
#pragma unroll
    for (int hh = 0; hh < 2; ++hh)
#pragma unroll
        for (int n = 0; n < 4; ++n) ssq += ssq4(acc[hh][n]);
    ssq += __shfl_xor(ssq, 16); ssq += __shfl_xor(ssq, 32);
    __syncthreads();
    if (q == 0) RED[(16 * rg + c) * 2 + hp] = ssq;
    __syncthreads();
    const float tot = RED[(16 * rg + c) * 2 + 0] + RED[(16 * rg + c) * 2 + 1];
    const float rs = rsqrtf(tot * (1.0f / 256.0f) + EPS);
    bf16_t* yrow = ycat + trow * DM + 768 + hp * 128 + 4 * q;
#pragma unroll
    for (int hh = 0; hh < 2; ++hh)
#pragma unroll
        for (int n = 0; n < 4; ++n) st4(yrow + hh * 64 + 16 * n, acc[hh][n] * rs);
}

#define XB_TMO      128
#define XB_XCNT(j)  (256  + 64 * (j))
#define XB_XSUB(j)  (1280 + 64 * (j))
#define XB_XGEN(j)  (2304 + 64 * (j))
#define XB_TOP      3328
#define XB_TOPGEN   3392
#define XCD_BAR_WORDS 3456
#define XB_SPIN_CAP (1u << 18)

__device__ __forceinline__ unsigned xb_ld(unsigned* p)              { return __hip_atomic_load(p, __ATOMIC_RELAXED, __HIP_MEMORY_SCOPE_AGENT); }
__device__ __forceinline__ unsigned xb_add(unsigned* p, unsigned v) { return __hip_atomic_fetch_add(p, v, __ATOMIC_RELAXED, __HIP_MEMORY_SCOPE_AGENT); }
__device__ __forceinline__ unsigned xb_xcc_id() { return (unsigned)__builtin_amdgcn_s_getreg((3 << 11) | 20) & 0xFu; }
#define XB_SPIN(cond, bar) do { unsigned _sp = 0; while (cond) { __builtin_amdgcn_s_sleep(1); \
    if ((++_sp & 255u) == 0u) { if (xb_ld(&(bar)[XB_TMO])) break; if (_sp > XB_SPIN_CAP) { atomicAdd(&(bar)[XB_TMO], 1u); break; } } } } while (0)

struct XcdBarrier {
    unsigned* bar; unsigned x;
    volatile LAS unsigned* st;
};

__device__ __forceinline__ XcdBarrier xcd_barrier_post(unsigned* bar, volatile LAS unsigned* st) {
    XcdBarrier b; b.bar = bar; b.x = xb_xcc_id(); b.st = st;
    if (threadIdx.x == 0) (void)xb_add(&bar[XB_XCNT(b.x)], 1u);
    return b;
}
__device__ __forceinline__ void xcd_barrier_complete(unsigned* bar, unsigned x, unsigned& nloc, unsigned& nx) {
    const unsigned G = gridDim.x * gridDim.y * gridDim.z;
    unsigned sum, cnt, mine, sp = 0u;
    for (;;) {
        sum = 0u; cnt = 0u; mine = 0u;
#pragma unroll
        for (unsigned j = 0; j < 16; ++j) { const unsigned c = xb_ld(&bar[XB_XCNT(j)]); sum += c; cnt += (c > 0u) ? 1u : 0u; mine = (j == x) ? c : mine; }
        if (sum == G) break;
        __builtin_amdgcn_s_sleep(1);
        if ((++sp & 255u) == 0u) { if (xb_ld(&bar[XB_TMO])) break; if (sp > XB_SPIN_CAP) { atomicAdd(&bar[XB_TMO], 1u); break; } }
    }
    nloc = mine > 0u ? mine : 1u; nx = cnt > 0u ? cnt : 1u;
}

__device__ __forceinline__ void xcd_barrier(const XcdBarrier& b) {
    asm volatile("s_waitcnt vmcnt(0)" ::: "memory");
    __syncthreads();
    if (threadIdx.x == 0) {
        unsigned* bar = b.bar;
        __builtin_amdgcn_s_waitcnt(0);
        unsigned nloc = b.st[0], nx = b.st[1];
        if (nloc == 0u) { xcd_barrier_complete(bar, b.x, nloc, nx); b.st[0] = nloc; b.st[1] = nx; }
        const unsigned old = xb_add(&bar[XB_XSUB(b.x)], 1u);
        const unsigned gen = old / nloc;
        if (old + 1u == (gen + 1u) * nloc) {
            __builtin_amdgcn_fence(__ATOMIC_RELEASE, "agent");
            asm volatile("s_waitcnt vmcnt(0)" ::: "memory");
            const unsigned og = xb_add(&bar[XB_TOP], 1u);
            const unsigned tg = og / nx;
            if (og + 1u == (tg + 1u) * nx) xb_add(&bar[XB_TOPGEN], 1u);
            else XB_SPIN(xb_ld(&bar[XB_TOPGEN]) == tg, bar);
            __builtin_amdgcn_fence(__ATOMIC_ACQUIRE, "agent");
            xb_add(&bar[XB_XGEN(b.x)], 1u);
            asm volatile("s_waitcnt vmcnt(0)" ::: "memory");
        } else {
            XB_SPIN(xb_ld(&bar[XB_XGEN(b.x)]) == gen, bar);
            __builtin_amdgcn_fence(__ATOMIC_ACQUIRE, "agent");
            asm volatile("s_waitcnt vmcnt(0)" ::: "memory");
        }
    }
    __syncthreads();
}

#ifndef REP_SYNC
#define REP_SYNC 1
#endif
#define GSYNC() do { for (int _r = 0; _r < REP_SYNC; ++_r) xcd_barrier(xbar); } while (0)
__global__ void __launch_bounds__(NTHR, 2) fwd_megakernel(Params p) {
    extern __shared__ __attribute__((aligned(16))) unsigned char lds[];
    cg::grid_group grid = cg::this_grid();
    LAS unsigned char* L = (LAS unsigned char*)lds;
    const int tid = threadIdx.x, lane = tid & 63, wave = __builtin_amdgcn_readfirstlane(tid >> 6);
    const int G = gridDim.x, bx = blockIdx.x;
    unsigned char* ws = p.ws;
    bf16_t* Win_t = (bf16_t*)(ws + WS_WIN); bf16_t* Wout_t = (bf16_t*)(ws + WS_WOUT); bf16_t* Wgu_t = (bf16_t*)(ws + WS_WGU); bf16_t* Wdn_t = (bf16_t*)(ws + WS_WDN);
    bf16_t* SGUW = (bf16_t*)(ws + WS_SGUW); bf16_t* PWT = (bf16_t*)(ws + WS_PWT); float* SSQ = (float*)(ws + WS_SS);
    bf16_t* XB = (bf16_t*)(ws + WS_XB); bf16_t* PROJ = (bf16_t*)(ws + WS_PROJ); bf16_t* YCAT = (bf16_t*)(ws + WS_YCAT); bf16_t* HID = (bf16_t*)(ws + WS_HID);

    volatile LAS unsigned* xst = (volatile LAS unsigned*)(L + LDS_BYTES - 16);
    if (tid < 4) xst[tid] = 0u;
    unsigned* barw = (unsigned*)(ws + WS_BAR);
    if (bx == 0) for (int i = tid; i < XCD_BAR_WORDS; i += NTHR) __hip_atomic_store(barw + i, 0u, __ATOMIC_RELAXED, __HIP_MEMORY_SCOPE_AGENT);
#ifndef REP_P0
#define REP_P0 1
#endif
    for (int rep0 = 0; rep0 < REP_P0; ++rep0) {
        LAS float* scr = (LAS float*)(L + wave * 16384);
        const int gw = bx * 8 + wave, NGW = G * 8;
        constexpr int I_IN = (DM / 64) * (DIN / 32), I_OUT = (DM / 64) * (DM / 32), I_GU = (DM / 64) * (2 * DFF / 32), I_DN = (DFF / 64) * (DM / 32), I_L = I_IN + I_OUT + I_GU + I_DN;
        for (int it = gw; it < DEPTH * I_L; it += NGW) {
            const int l = it / I_L; int r = it % I_L;
            if (r < I_IN) { transpose_item(p.w_in + (size_t)l * DM * DIN, DM, DIN, Win_t + (size_t)l * DIN * DM, p.norm_mix + l * DM, 1, scr, r, lane); continue; } r -= I_IN;
            if (r < I_OUT) { transpose_item(p.w_out + (size_t)l * DM * DM, DM, DM, Wout_t + (size_t)l * DM * DM, p.mix_out_gain + l * DM, 0, scr, r, lane); continue; } r -= I_OUT;
            if (r < I_GU) { transpose_item(p.w_gate_up + (size_t)l * DM * 2 * DFF, DM, 2 * DFF, Wgu_t + (size_t)l * 2 * DFF * DM, p.norm_ffn + l * DM, 2, scr, r, lane); continue; } r -= I_GU;
            transpose_item(p.w_down + (size_t)l * DFF * DM, DFF, DM, Wdn_t + (size_t)l * DM * DFF, nullptr, 0, scr, r, lane);
        }
        for (int m = 2 * gw; m < M; m += 2 * NGW) {
            const f32x4* xr = (const f32x4*)(p.x + (size_t)m * DM) + lane; u32x2* o8 = (u32x2*)(XB + (size_t)m * DM) + lane; f32x4 v[2][4];
#pragma unroll
            for (int r = 0; r < 2; ++r)
#pragma unroll
                for (int j = 0; j < 4; ++j) v[r][j] = __builtin_nontemporal_load(xr + r * 256 + 64 * j);
#pragma unroll
            for (int r = 0; r < 2; ++r) { float s = 0.f;
#pragma unroll
                for (int j = 0; j < 4; ++j) { const f32x4 t = v[r][j]; s += ssq4(t); u32x2 o; o.x = pk2(t.x, t.y); o.y = pk2(t.z, t.w); o8[r * 256 + 64 * j] = o; }
                s = wave_sum(s);
                if (lane < 4) SSQ[(size_t)(m + r) * 4 + lane] = (lane == 0) ? s : 0.f; }
        }
        const int gt = bx * NTHR + tid, NGT = G * NTHR;
        for (int e = gt; e < DEPTH * 4 * 128 * 128 / 8; e += NGT) { const int s0 = (e & 15) * 8, t = (e >> 4) & 127; const float* src = p.sgu_w + (size_t)e * 8;
            const f32x4 a = *(const f32x4*)src, bq = *(const f32x4*)(src + 4); float v[8] = {a.x, a.y, a.z, a.w, bq.x, bq.y, bq.z, bq.w};
#pragma unroll
            for (int i = 0; i < 8; ++i) v[i] = (s0 + i <= t) ? v[i] : 0.f;
            u32x4 o; o.x = pk2(v[0], v[1]); o.y = pk2(v[2], v[3]); o.z = pk2(v[4], v[5]); o.w = pk2(v[6], v[7]); *(u32x4*)(SGUW + (size_t)e * 8) = o; }
        for (int e = gt; e < DEPTH * 4 * 64 * 64; e += NGT) { const int cc = e & 63, d = (e >> 6) & 63, lg = e >> 12; PWT[e] = f2bf(p.pool_w[((size_t)lg * 64 + cc) * 64 + d]); }
    }
    grid.sync();
    const XcdBarrier xbar = xcd_barrier_post(barw, xst);

    for (int l = 0; l < DEPTH; ++l) {
#ifndef REP_P1
#define REP_P1 1
#endif
#ifndef NO_P1
        for (int rep = 0; rep < REP_P1; ++rep) { int zk; asm volatile("s_mov_b32 %0, 0" : "=s"(zk)); pg8::Gemm g{XB, Win_t + (size_t)l * DIN * DM, M, DIN, DM + zk}; pg8::StaticOrder S; S.init(M, DIN, G + zk, bx); LAS float* RT = (LAS float*)(L + 135168); if (tid == 0) ((volatile LAS int*)(RT + 256))[0] = -1; __syncthreads(); pg8::EpiIn E{PROJ, SSQ, RT};
          pg8::gemm_phase<pg8::EpiIn, pg8::StaticOrder, true, true>(L, g, S, E, zk); }
#endif
        GSYNC();
#ifndef REP_MIX
#define REP_MIX 1
#endif
#ifndef REP_D
#define REP_D 1
#endif
        for (int rep = 0; rep < REP_MIX; ++rep)
        for (int u0 = bx; u0 < 256; u0 += G) {
            const int u = (G == 256) ? (((u0 & 7) << 5) | (u0 >> 3)) : u0; const int b = u >> 4, ch = u & 15;
            __syncthreads();
#ifndef REP_A
#define REP_A 1
#endif
#ifndef NO_A
            for (int rp = 0; rp < REP_A; ++rp) { __syncthreads(); int zt; asm volatile("v_mov_b32 %0, 0" : "=v"(zt)); const int t2 = tid + zt; mixer_A(L, PROJ, SGUW + (size_t)l * 4 * 128 * 128, p.sgu_b + l * 4 * 128, YCAT, b, ch, t2, t2 & 63, __builtin_amdgcn_readfirstlane(t2 >> 6)); }
#endif
            __syncthreads();
#ifndef REP_B
#define REP_B 1
#endif
#ifndef NO_B
            for (int rp = 0; rp < REP_B; ++rp) { __syncthreads(); int zt; asm volatile("v_mov_b32 %0, 0" : "=v"(zt)); const int t2 = tid + zt; mixer_B(L, PROJ, PWT + (size_t)l * 4 * 64 * 64, p.pool_scale + l * 256, YCAT, b, ch, t2, t2 & 63, __builtin_amdgcn_readfirstlane(t2 >> 6)); }
#endif
            __syncthreads();
#ifndef REP_C
#define REP_C 1
#endif
#ifndef NO_C
            for (int rp = 0; rp < REP_C; ++rp) { __syncthreads(); int zt; asm volatile("v_mov_b32 %0, 0" : "=v"(zt)); const int t2 = tid + zt; mixer_C(L, PROJ, p.swa_sinks + l * 4, p.rel_bias, YCAT, b, ch, t2, t2 & 63, __builtin_amdgcn_readfirstlane(t2 >> 6)); }
#endif
            __syncthreads();
#ifndef NO_D
#pragma unroll 1
            for (int hf = 0; hf < 2 * REP_D; ++hf) { int zt; asm volatile("v_mov_b32 %0, 0" : "=v"(zt)); const int t2 = tid + zt; mixer_D(L, PROJ, YCAT, b, (hf & 1) ? 31 - ch : ch, t2, t2 & 63, __builtin_amdgcn_readfirstlane(t2 >> 6)); __syncthreads(); }
#endif
        }
        GSYNC();
#ifndef NO_P3
        { int zk; asm volatile("s_mov_b32 %0, 0" : "=s"(zk)); pg8::Gemm g{YCAT, Wout_t + (size_t)l * DM * DM, M, DM, DM + zk}; pg8::StaticOrder S; S.init(M, DM, G + zk, bx); pg8::EpiRes E{l == 0 ? p.x : nullptr, nullptr, XB, SSQ, (LAS float*)(L + 131072)};
          pg8::gemm_phase<pg8::EpiRes, pg8::StaticOrder, true, true>(L, g, S, E, zk); }
#endif
        GSYNC();
#ifndef REP_P4
#define REP_P4 1
#endif
#ifndef NO_P4
        for (int rep = 0; rep < REP_P4; ++rep) { int zk; asm volatile("s_mov_b32 %0, 0" : "=s"(zk)); pg8::Gemm g{XB, Wgu_t + (size_t)l * 2 * DFF * DM, M, 2 * DFF, DM + zk}; pg8::StaticOrder S; S.init(M, 2 * DFF, G + zk, bx); LAS float* RT = (LAS float*)(L + 135168); if (tid == 0) ((volatile LAS int*)(RT + 256))[0] = -1; __syncthreads(); pg8::EpiGU E{HID, SSQ, RT};
          pg8::gemm_phase<pg8::EpiGU, pg8::StaticOrder, true, true>(L, g, S, E, zk); }
#endif
        GSYNC();
#ifndef NO_P5
        { int zk; asm volatile("s_mov_b32 %0, 0" : "=s"(zk)); pg8::Gemm g{HID, Wdn_t + (size_t)l * DM * DFF, M, DM, DFF + zk}; pg8::StaticOrder S; S.init(M, DM, G + zk, bx); pg8::EpiRes E{nullptr, l == DEPTH - 1 ? p.out : nullptr, XB, SSQ, (LAS float*)(L + 131072)};
          pg8::gemm_phase<pg8::EpiRes, pg8::StaticOrder, true, true>(L, g, S, E, zk); }
#endif
        GSYNC();
    }
    {
        const int gw = bx * 8 + wave, NGW = G * 8;
        for (int m = gw; m < M; m += NGW) { const float rs = rstd_of(SSQ, m); f32x4* xr = (f32x4*)(p.out + (size_t)m * DM) + lane; const f32x4* gr = (const f32x4*)p.norm_final + lane;
#pragma unroll
            for (int j = 0; j < 4; ++j) { const f32x4 v = xr[64 * j], gg = gr[64 * j]; xr[64 * j] = v * rs * gg; } }
    }
}

extern "C" void kernel_launch(void* const* d_in, const int* in_sizes, int n_in, void* d_out, int out_size, void* d_ws, size_t ws_size, hipStream_t stream) {
    static int grid_blocks = 0;
    if (grid_blocks == 0) {
        if (n_in != 15 || in_sizes[0] != M * DM || out_size != M * DM || ws_size < WS_END) { fprintf(stderr, "kernel_launch: unexpected shapes (n_in %d, in0 %d, out %d, ws %zu)\n", n_in, n_in > 0 ? in_sizes[0] : -1, out_size, ws_size); grid_blocks = -1; return; }
        int dev = 0, cus = 0, per_cu = 0;
        hipGetDevice(&dev); hipDeviceGetAttribute(&cus, hipDeviceAttributeMultiprocessorCount, dev);
        if (hipFuncSetAttribute((const void*)fwd_megakernel, hipFuncAttributeMaxDynamicSharedMemorySize, LDS_BYTES) != hipSuccess) { fprintf(stderr, "kernel_launch: hipFuncSetAttribute failed\n"); }
        if (hipOccupancyMaxActiveBlocksPerMultiprocessor(&per_cu, (const void*)fwd_megakernel, NTHR, LDS_BYTES) != hipSuccess || per_cu < 1) { fprintf(stderr, "kernel_launch: occupancy query says %d\n", per_cu); per_cu = 1; }
        (void)hipGetLastError();
        grid_blocks = cus * 1;
        if (grid_blocks <= 0) grid_blocks = 256;
    }
    if (grid_blocks < 0) return;
    Params p{};
    p.x = (const float*)d_in[0]; p.w_in = (const float*)d_in[1]; p.w_out = (const float*)d_in[2]; p.sgu_w = (const float*)d_in[3]; p.sgu_b = (const float*)d_in[4];
    p.pool_w = (const float*)d_in[5]; p.pool_scale = (const float*)d_in[6]; p.swa_sinks = (const float*)d_in[7]; p.rel_bias = (const float*)d_in[8]; p.mix_out_gain = (const float*)d_in[9];
    p.norm_mix = (const float*)d_in[10]; p.norm_ffn = (const float*)d_in[11]; p.w_gate_up = (const float*)d_in[12]; p.w_down = (const float*)d_in[13]; p.norm_final = (const float*)d_in[14];
    p.out = (float*)d_out; p.ws = (unsigned char*)d_ws;
    void* args[] = {&p};
    hipError_t e = hipLaunchCooperativeKernel((const void*)fwd_megakernel, dim3(grid_blocks), dim3(NTHR), args, LDS_BYTES, stream);
    if (e != hipSuccess) fprintf(stderr, "cooperative launch failed: %s (grid %d)\n", hipGetErrorString(e), grid_blocks);
}
```

```cpp
#include <hip/hip_runtime.h>
#include <hip/hip_cooperative_groups.h>
#include <cstdio>
#include <cstdint>
namespace cg = cooperative_groups;
namespace pg8 {
#define PG8_LAS __attribute__((address_space(3)))
typedef unsigned short bf16_t;
typedef short bf16x8 __attribute__((ext_vector_type(8)));
typedef float f32x4 __attribute__((ext_vector_type(4)));
typedef unsigned u32x4 __attribute__((ext_vector_type(4)));
constexpr int BM = 256, BK = 64, HALF = 128, HTB = HALF * BK * 2  , STAGE_BYTES = 8 * HTB, NXCD = 8, WGM = 8;

__host__ __device__ __forceinline__ int lds_byte(int r, int c) { const int st = (r >> 4) * 2 + (c >> 5), rr = r & 15, cc = c & 31, ob = rr * 64 + cc * 2; return st * 1024 + (ob ^ (((ob >> 9) & 1) << 5)); }
__host__ __device__ __forceinline__ void stage_rc(int b, int& R, int& C) { const int st = b / 1024, sb = b % 1024, swz = sb ^ (((sb >> 9) & 1) << 5); R = (st >> 1) * 16 + swz / 64; C = (st & 1) * 32 + (swz % 64) / 2; }
__host__ __device__ __forceinline__ int perm32(int rho) { const int n = rho >> 4, i = rho & 15; return 8 * (i >> 2) + 4 * n + (i & 3); }

struct Unit { int pm, pn; };
struct Gemm { const bf16_t* A; const bf16_t* Bt; int M, N, K; };

struct StaticOrder {
    int nM, nN, nwg, G, c;
    __host__ __device__ void init(int M, int N, int G_, int c_) { nM = M / BM; nN = N / BM; nwg = nM * nN; G = G_; c = c_; }
    __host__ __device__ bool next(int i, Unit& u) const {
        const long L = (long)i * G + c; if (L >= nwg) return false;
        int wgid = (int)L; { const int q = nwg / NXCD, r = nwg % NXCD, xcd = wgid % NXCD, off = wgid / NXCD; wgid = (xcd < r ? xcd * (q + 1) : r * (q + 1) + (xcd - r) * q) + off; }
        const int nig = WGM * nN, gid = wgid / nig, fm = gid * WGM, gsz = (nM - fm) < WGM ? (nM - fm) : WGM;
        u.pm = fm + ((wgid % nig) % gsz); u.pn = (wgid % nig) / gsz; return true;
    }
    __device__ __forceinline__ void a_ready(const Unit&) const {}
    __device__ __forceinline__ void done(const Unit&) const {}
};

__device__ __forceinline__ unsigned cvt_pk_bf16(float lo, float hi) { unsigned r; asm volatile("v_cvt_pk_bf16_f32 %0, %1, %2" : "=v"(r) : "v"(lo), "v"(hi)); return r; }
typedef float f32x2 __attribute__((ext_vector_type(2)));
template <class Epi, class Sched, bool ALIGN_EPI = false, bool SP2 = false>
__device__ __forceinline__ void gemm_phase(PG8_LAS unsigned char* lds, const Gemm g, const Sched& S, const Epi& E, const int opq) {
    const int tid = threadIdx.x + opq, wid = __builtin_amdgcn_readfirstlane(tid >> 6), lane = tid & 63, wr = wid >> 2, wc = wid & 3, fr = lane & 15, fq = lane >> 4;
    const int K = g.K, nt = K / BK;
    unsigned voffA[2], voffB[2];
#pragma unroll
    for (int i = 0; i < 2; ++i) { int R, C; stage_rc(tid * 16 + i * 8192, R, C); const int Rb = Epi::PERM ? ((R & ~31) + perm32(R & 31)) : R;
        voffA[i] = (unsigned)(R * K + C) * 2u; voffB[i] = (unsigned)(Rb * K + C) * 2u; }
    const size_t kstep = (size_t)(BK * 2);
    const size_t hstep = (size_t)HALF * K * 2;
    const size_t tstep = 2 * hstep;
    const unsigned ldsw = (unsigned)wid * 1024u;
    const int aoff = lds_byte(wr * 64 + fr, fq * 8), boff = lds_byte(wc * 32 + fr, fq * 8);
#define PG8_SA(b, h) (((b) * 2 + (h)) * HTB)
#define PG8_SB(b, h) ((4 + (b) * 2 + (h)) * HTB)
#define PG8_STAGE(bufoff, gbase, voff) do { _Pragma("unroll") for (int _i = 0; _i < 2; ++_i) \
        __builtin_amdgcn_global_load_lds((const unsigned*)((const char*)(gbase) + (voff)[_i]), (PG8_LAS unsigned*)(lds + (bufoff) + ldsw + _i * 8192), 16, 0, 0); } while (0)
#define PG8_LDA(dst, b, h) do { _Pragma("unroll") for (int m = 0; m < 4; ++m) _Pragma("unroll") for (int k = 0; k < 2; ++k) dst[m][k] = *(const PG8_LAS bf16x8*)(lds + PG8_SA(b, h) + aoff + m * 2048 + k * 1024); } while (0)
#define PG8_LDB(dst, b, h) do { _Pragma("unroll") for (int n = 0; n < 2; ++n) _Pragma("unroll") for (int k = 0; k < 2; ++k) dst[n][k] = *(const PG8_LAS bf16x8*)(lds + PG8_SB(b, h) + boff + n * 2048 + k * 1024); } while (0)
#define PG8_MMA(ai, bj, At, Bt) do { __builtin_amdgcn_s_setprio(1); _Pragma("unroll") for (int m = 0; m < 4; ++m) _Pragma("unroll") for (int n = 0; n < 2; ++n) _Pragma("unroll") for (int k = 0; k < 2; ++k) \
        acc[ai][bj][m][n] = __builtin_amdgcn_mfma_f32_16x16x32_bf16(Bt[n][k], At[m][k], acc[ai][bj][m][n], 0, 0, 0); __builtin_amdgcn_s_setprio(0); } while (0)
#define PG8_WAIT_V(n) asm volatile("s_waitcnt vmcnt(" #n ")" ::: "memory")
#define PG8_WAIT_L(n) asm volatile("s_waitcnt lgkmcnt(" #n ")" ::: "memory")
#define PG8_BAR __builtin_amdgcn_s_barrier()
#define PG8_SCHED __builtin_amdgcn_sched_barrier(0)
    Unit cur, nxt; int ui = 0;
    if (!S.next(0, cur)) return;
    f32x4 acc[2][2][4][2];
#pragma unroll
    for (int a = 0; a < 2; ++a)
#pragma unroll
        for (int b = 0; b < 2; ++b)
#pragma unroll
            for (int m = 0; m < 4; ++m)
#pragma unroll
                for (int n = 0; n < 2; ++n) acc[a][b][m][n] = (f32x4){0.f, 0.f, 0.f, 0.f};
    bf16x8 At[4][2], B0[2][2], B1[2][2];
    const char* cA = (const char*)g.A + (size_t)cur.pm * tstep; const char* cB = (const char*)g.Bt + (size_t)cur.pn * tstep;
    S.a_ready(cur);
    if constexpr (SP2) {
        PG8_STAGE(PG8_SB(0, 0), cB, voffB); PG8_STAGE(PG8_SB(0, 1), cB + hstep, voffB); PG8_STAGE(PG8_SA(0, 0), cA, voffA); PG8_STAGE(PG8_SA(0, 1), cA + hstep, voffA);
        if (wr == 1) PG8_BAR;
        PG8_WAIT_V(2); PG8_BAR;
        PG8_STAGE(PG8_SB(1, 0), cB + kstep, voffB); PG8_STAGE(PG8_SA(1, 0), cA + kstep, voffA); PG8_STAGE(PG8_SB(1, 1), cB + hstep + kstep, voffB);
        PG8_WAIT_V(6); PG8_BAR;
    } else {
        PG8_STAGE(PG8_SB(0, 0), cB, voffB); PG8_STAGE(PG8_SA(0, 0), cA, voffA); PG8_STAGE(PG8_SB(0, 1), cB + hstep, voffB); PG8_STAGE(PG8_SA(0, 1), cA + hstep, voffA);
        if (wr == 1) PG8_BAR;
        PG8_WAIT_V(4); PG8_BAR;
        PG8_STAGE(PG8_SB(1, 0), cB + kstep, voffB); PG8_STAGE(PG8_SA(1, 0), cA + kstep, voffA); PG8_STAGE(PG8_SB(1, 1), cB + hstep + kstep, voffB);
        PG8_WAIT_V(6); PG8_BAR;
    }
    for (;;) {
        const bool has_next = S.next(ui + 1, nxt);
        const char* nA = has_next ? (const char*)g.A + (size_t)nxt.pm * tstep : cA; const char* nB = has_next ? (const char*)g.Bt + (size_t)nxt.pn * tstep : cB;
        for (int t = 0; t < nt; t += 2) {
            const bool last = (t == nt - 2);
            const char* a1 = cA + (size_t)(t + 1) * kstep;
            const char* a2 = last ? nA : cA + (size_t)(t + 2) * kstep; const char* b2 = last ? nB : cB + (size_t)(t + 2) * kstep;
            const char* a3 = a2 + kstep; const char* b3 = b2 + kstep;
            if (last && has_next) S.a_ready(nxt);
            if constexpr (SP2) {
            PG8_LDB(B0, 0, 0); PG8_LDB(B1, 0, 1); PG8_SCHED; PG8_LDA(At, 0, 0); PG8_STAGE(PG8_SA(1, 1), a1 + hstep, voffA);
            PG8_WAIT_V(8); PG8_WAIT_L(0); PG8_BAR; PG8_MMA(0, 0, At, B0); PG8_MMA(0, 1, At, B1); PG8_BAR; PG8_SCHED;
            PG8_LDA(At, 0, 1); PG8_STAGE(PG8_SB(0, 0), b2, voffB); PG8_STAGE(PG8_SB(0, 1), b2 + hstep, voffB); PG8_STAGE(PG8_SA(0, 0), a2, voffA);
            PG8_WAIT_V(8); PG8_WAIT_L(0); PG8_BAR; PG8_MMA(1, 0, At, B0); PG8_MMA(1, 1, At, B1); PG8_BAR; PG8_SCHED;
            PG8_LDB(B0, 1, 0); PG8_LDB(B1, 1, 1); PG8_SCHED; PG8_LDA(At, 1, 0); PG8_STAGE(PG8_SA(0, 1), a2 + hstep, voffA);
            PG8_WAIT_V(8); PG8_WAIT_L(0); PG8_BAR; PG8_MMA(0, 0, At, B0); PG8_MMA(0, 1, At, B1); PG8_BAR; PG8_SCHED;
            PG8_LDA(At, 1, 1); PG8_STAGE(PG8_SB(1, 0), b3, voffB); PG8_STAGE(PG8_SB(1, 1), b3 + hstep, voffB); PG8_STAGE(PG8_SA(1, 0), a3, voffA);
            PG8_WAIT_V(8); PG8_WAIT_L(0); PG8_BAR; PG8_MMA(1, 0, At, B0); PG8_MMA(1, 1, At, B1); PG8_BAR; PG8_SCHED;
            } else {
            PG8_LDB(B0, 0, 0); PG8_SCHED; PG8_LDA(At, 0, 0); PG8_STAGE(PG8_SA(1, 1), a1 + hstep, voffA);
            PG8_WAIT_L(8); PG8_BAR; PG8_WAIT_L(0); PG8_MMA(0, 0, At, B0); PG8_BAR; PG8_SCHED;
            PG8_LDB(B1, 0, 1); PG8_STAGE(PG8_SB(0, 0), b2, voffB);
            PG8_BAR; PG8_WAIT_L(0); PG8_MMA(0, 1, At, B1); PG8_BAR;
            PG8_LDA(At, 0, 1); PG8_STAGE(PG8_SA(0, 0), a2, voffA);
            PG8_BAR; PG8_WAIT_L(0); PG8_MMA(1, 0, At, B0); PG8_BAR; PG8_SCHED;
            PG8_STAGE(PG8_SB(0, 1), b2 + hstep, voffB);
            PG8_WAIT_V(6); PG8_BAR; PG8_MMA(1, 1, At, B1); PG8_BAR;
            PG8_LDB(B0, 1, 0); PG8_SCHED; PG8_LDA(At, 1, 0); PG8_STAGE(PG8_SA(0, 1), a2 + hstep, voffA);
            PG8_WAIT_L(8); PG8_BAR; PG8_WAIT_L(0); PG8_MMA(0, 0, At, B0); PG8_BAR; PG8_SCHED;
            PG8_LDB(B1, 1, 1); PG8_STAGE(PG8_SB(1, 0), b3, voffB);
            PG8_BAR; PG8_WAIT_L(0); PG8_MMA(0, 1, At, B1); PG8_BAR;
            PG8_LDA(At, 1, 1); PG8_STAGE(PG8_SA(1, 0), a3, voffA);
            PG8_BAR; PG8_WAIT_L(0); PG8_MMA(1, 0, At, B0); PG8_BAR; PG8_SCHED;
            PG8_STAGE(PG8_SB(1, 1), b3 + hstep, voffB);
            PG8_WAIT_V(6); PG8_BAR; PG8_MMA(1, 1, At, B1); PG8_BAR;
            }
        }
        if constexpr (ALIGN_EPI) { if (wr == 0) PG8_BAR; }
        if constexpr (!Epi::AFTER_DRAIN) { E(acc, cur, wr, wc, fr, fq); S.done(cur); }
        if (!has_next) break;
#pragma unroll
        for (int a = 0; a < 2; ++a)
#pragma unroll
            for (int b = 0; b < 2; ++b)
#pragma unroll
                for (int m = 0; m < 4; ++m)
#pragma unroll
                    for (int n = 0; n < 2; ++n) acc[a][b][m][n] = (f32x4){0.f, 0.f, 0.f, 0.f};
        cur = nxt; cA = nA; cB = nB; ++ui;
        if constexpr (ALIGN_EPI) { if (wr == 1) PG8_BAR; }
    }
    PG8_WAIT_V(0);
    if constexpr (!ALIGN_EPI) { if (wr == 0) PG8_BAR; }
    PG8_BAR;
    if constexpr (Epi::AFTER_DRAIN) { E.fused(acc, cur, wr, wc, fr, fq, lds, wid, lane); S.done(cur); }
#undef PG8_SA
#undef PG8_SB
#undef PG8_STAGE
#undef PG8_LDA
#undef PG8_LDB
#undef PG8_MMA
#undef PG8_WAIT_V
#undef PG8_WAIT_L
#undef PG8_BAR
#undef PG8_SCHED
}
}

constexpr int NB = 16, SEQ = 2048, DM = 1024, DEPTH = 4, DIN = 2048, DFF = 2816, M = NB * SEQ;
constexpr float EPS = 1e-6f;
constexpr size_t MiB = 1u << 20;
constexpr size_t WS_WIN = 0, WS_WOUT = 16 * MiB, WS_WGU = 24 * MiB, WS_WDN = 68 * MiB, WS_SGUW = 90 * MiB, WS_PWT = 90 * MiB + 512 * 1024,
                 WS_SS = 91 * MiB, WS_BAR = 93 * MiB, WS_XB = 96 * MiB, WS_PROJ = 160 * MiB, WS_YCAT = 288 * MiB, WS_HID = 160 * MiB, WS_END = 352 * MiB;
constexpr int LDS_BYTES = 160 * 1024;
constexpr int NTHR = 512;

#define LAS __attribute__((address_space(3)))
typedef unsigned short bf16_t;
typedef short bf16x8 __attribute__((ext_vector_type(8)));
typedef float f32x4 __attribute__((ext_vector_type(4)));
typedef float f32x2 __attribute__((ext_vector_type(2)));
typedef unsigned u32x4 __attribute__((ext_vector_type(4)));
typedef unsigned u32x2 __attribute__((ext_vector_type(2)));
typedef __bf16 bf16x2_t __attribute__((ext_vector_type(2)));

__device__ __forceinline__ unsigned pk2(float lo, float hi) { f32x2 v = {lo, hi}; bf16x2_t b = __builtin_convertvector(v, bf16x2_t); return __builtin_bit_cast(unsigned, b); }
__device__ __forceinline__ bf16_t f2bf(float f) { return (bf16_t)(pk2(f, 0.f) & 0xffffu); }
__device__ __forceinline__ float bflo(unsigned w) { return __uint_as_float(w << 16); }
__device__ __forceinline__ float bfhi(unsigned w) { return __uint_as_float(w & 0xffff0000u); }
#define MFMA16(a, b, c) __builtin_amdgcn_mfma_f32_16x16x32_bf16((a), (b), (c), 0, 0, 0)
#define CFENCE() asm volatile("" ::: "memory")
#define LDSWAIT() asm volatile("s_waitcnt lgkmcnt(0)" ::: "memory")
__device__ __forceinline__ float fexp(float x) { return __builtin_amdgcn_exp2f(x * 1.4426950408889634f); }
__device__ __forceinline__ float gelu_tanh(float x) {
    const float u2 = 1.5957691216057308f * x * (1.0f + 0.044715f * x * x);
    return x * __builtin_amdgcn_rcpf(1.0f + fexp(-u2));
}
__device__ __forceinline__ float rstd_of1(const float* ss, int row) {
    const f32x4 s = *(const f32x4*)(ss + (size_t)row * 4); return rsqrtf(((s.x + s.y) + (s.z + s.w)) * (1.0f / 1024.0f) + EPS);
}

#ifdef USE_WT
__device__ __forceinline__ void st16(void* p, const u32x4 v) { asm volatile("global_store_dwordx4 %0, %1, off sc1\n\ts_nop 1" :: "v"(p), "v"(v) : "memory"); }
#else
__device__ __forceinline__ void st16(void* p, const u32x4 v) { *(u32x4*)p = v; }
#endif
__device__ __forceinline__ float ssq4(const f32x4 y) { return (y[0] * y[0] + y[1] * y[1]) + (y[2] * y[2] + y[3] * y[3]); }

#ifdef PROBE_RSTD2
__device__ __forceinline__ float rstd_of(const float* ss, int row) { const float a = rstd_of1(ss, row); int z; asm volatile("v_mov_b32 %0, 0" : "=v"(z) : "v"(a)); const float b = rstd_of1(ss, row + z); return (a + b) * 0.5f; }
#else
__device__ __forceinline__ float rstd_of(const float* ss, int row) { return rstd_of1(ss, row); }
#endif
namespace pg8 {
struct EpiIn {
    static constexpr bool PERM = true, AFTER_DRAIN = false;
    bf16_t* O; const float* ss; LAS float* T;
    __device__ __forceinline__ void operator()(const f32x4 (&acc)[2][2][4][2], const Unit& u, int wr, int wc, int fr, int fq) const {
        const int row0 = u.pm * BM + wr * 64 + fr, col0 = u.pn * BM + wc * 32 + 8 * fq; const bool act = u.pn < 2;
        float rsv[2][4];
        {
            volatile LAS int* TAG = (volatile LAS int*)(T + 256);
            if (TAG[0] != u.pm) {
                const int t = wr * 256 + wc * 64 + fq * 16 + fr;
                if (t < 256) T[t] = rstd_of(ss, u.pm * BM + t);
                asm volatile("s_waitcnt lgkmcnt(0)" ::: "memory"); __builtin_amdgcn_s_barrier(); asm volatile("" ::: "memory");
                if (t == 0) TAG[0] = u.pm; }
#pragma unroll
            for (int ai = 0; ai < 2; ++ai)
#pragma unroll
                for (int m = 0; m < 4; ++m) rsv[ai][m] = T[wr * 64 + fr + ai * HALF + m * 16]; }
#pragma unroll
        for (int ai = 0; ai < 2; ++ai)
#pragma unroll
            for (int m = 0; m < 4; ++m) { const int row = row0 + ai * HALF + m * 16; const float rs = rsv[ai][m]; bf16_t* rowp = O + (size_t)row * DIN + col0;
#pragma unroll
                for (int bj = 0; bj < 2; ++bj) { f32x4 v0 = acc[ai][bj][m][0] * rs, v1 = acc[ai][bj][m][1] * rs;
                    if (act) { v0 = (f32x4){gelu_tanh(v0[0]), gelu_tanh(v0[1]), gelu_tanh(v0[2]), gelu_tanh(v0[3])}; v1 = (f32x4){gelu_tanh(v1[0]), gelu_tanh(v1[1]), gelu_tanh(v1[2]), gelu_tanh(v1[3])}; }
                    u32x4 w; w.x = pk2(v0[0], v0[1]); w.y = pk2(v0[2], v0[3]); w.z = pk2(v1[0], v1[1]); w.w = pk2(v1[2], v1[3]);
                    st16(rowp + bj * HALF, w); }
                if (m & 1) CFENCE(); }
    }
};
struct EpiGU {
    static constexpr bool PERM = true, AFTER_DRAIN = false;
    bf16_t* O; const float* ss; LAS float* T;
    __device__ __forceinline__ void operator()(const f32x4 (&acc)[2][2][4][2], const Unit& u, int wr, int wc, int fr, int fq) const {
        const int row0 = u.pm * BM + wr * 64 + fr, col0 = u.pn * HALF + wc * 32 + 8 * fq;
        float rsv[2][4];
        {
            volatile LAS int* TAG = (volatile LAS int*)(T + 256);
            if (TAG[0] != u.pm) {
                const int t = wr * 256 + wc * 64 + fq * 16 + fr;
                if (t < 256) T[t] = rstd_of(ss, u.pm * BM + t);
                asm volatile("s_waitcnt lgkmcnt(0)" ::: "memory"); __builtin_amdgcn_s_barrier(); asm volatile("" ::: "memory");
                if (t == 0) TAG[0] = u.pm; }
#pragma unroll
            for (int ai = 0; ai < 2; ++ai)
#pragma unroll
                for (int m = 0; m < 4; ++m) rsv[ai][m] = T[wr * 64 + fr + ai * HALF + m * 16]; }
#pragma unroll
        for (int ai = 0; ai < 2; ++ai)
#pragma unroll
            for (int m = 0; m < 4; ++m) { const int row = row0 + ai * HALF + m * 16; const float rs = rsv[ai][m]; bf16_t* rowp = O + (size_t)row * DFF + col0;
                float h[8];
#pragma unroll
                for (int n = 0; n < 2; ++n)
#pragma unroll
                    for (int e = 0; e < 4; ++e) { const float g = acc[ai][0][m][n][e] * rs, up = acc[ai][1][m][n][e] * rs; h[n * 4 + e] = g * up * __builtin_amdgcn_rcpf(1.0f + fexp(-g)); }
                u32x4 w; w.x = pk2(h[0], h[1]); w.y = pk2(h[2], h[3]); w.z = pk2(h[4], h[5]); w.w = pk2(h[6], h[7]);
                st16(rowp, w);
                if (m & 1) CFENCE(); }
    }
};
struct EpiRes {
    static constexpr bool PERM = true, AFTER_DRAIN = false;
    const float* xin32; float* xout32; bf16_t* xb; float* ss; LAS float* P;
    __device__ __forceinline__ void operator()(const f32x4 (&acc)[2][2][4][2], const Unit& u, int wr, int wc, int fr, int fq) const {
        const int row0 = u.pm * BM + wr * 64 + fr, col0 = u.pn * BM + wc * 32 + 8 * fq;
#pragma unroll
        for (int ai = 0; ai < 2; ++ai)
#pragma unroll
            for (int m = 0; m < 4; ++m) { const int row = row0 + ai * HALF + m * 16; const size_t off = (size_t)row * DM + col0; float q = 0.f;
#pragma unroll
                for (int bj = 0; bj < 2; ++bj) { f32x4 r0, r1;
                    if (xin32) { r0 = *(const f32x4*)(xin32 + off + bj * HALF); r1 = *(const f32x4*)(xin32 + off + bj * HALF + 4); }
                    else { const u32x4 t = *(const u32x4*)(xb + off + bj * HALF); r0 = (f32x4){bflo(t.x), bfhi(t.x), bflo(t.y), bfhi(t.y)}; r1 = (f32x4){bflo(t.z), bfhi(t.z), bflo(t.w), bfhi(t.w)}; }
                    const f32x4 v0 = r0 + acc[ai][bj][m][0], v1 = r1 + acc[ai][bj][m][1];
                    q += ssq4(v0) + ssq4(v1);
                    if (xout32) { st16(xout32 + off + bj * HALF, __builtin_bit_cast(u32x4, v0)); st16(xout32 + off + bj * HALF + 4, __builtin_bit_cast(u32x4, v1)); }
                    else { u32x4 w; w.x = pk2(v0[0], v0[1]); w.y = pk2(v0[2], v0[3]); w.z = pk2(v1[0], v1[1]); w.w = pk2(v1[2], v1[3]); st16(xb + off + bj * HALF, w); } }
                q += __shfl_xor(q, 16); q += __shfl_xor(q, 32);
                if (fq == 0) P[(ai * HALF + wr * 64 + m * 16 + fr) * 4 + wc] = q;
                if (m & 1) CFENCE(); }
        asm volatile("s_waitcnt lgkmcnt(0)" ::: "memory"); __builtin_amdgcn_s_barrier(); asm volatile("" ::: "memory");
        const int t = wr * 256 + wc * 64 + fq * 16 + fr;
        if (t < 256) { const f32x4 pp = *(const LAS f32x4*)(P + t * 4); ss[(size_t)(u.pm * BM + t) * 4 + u.pn] = (pp.x + pp.y) + (pp.z + pp.w); }
    }
};
}

__device__ __forceinline__ void transpose_item(const float* W, int K, int N, bf16_t* WT, const float* gain, int mode, LAS float* scr, int item, int lane) {
    const int nblk = N / 32, kb = item / nblk, nb = item % nblk, k0 = 64 * kb, n0 = 32 * nb;
    const int c = lane & 7;
    f32x4 g0 = {1.f, 1.f, 1.f, 1.f}, g1 = {1.f, 1.f, 1.f, 1.f};
    if (gain) { g0 = *(const f32x4*)(gain + k0 + 8 * c); g1 = *(const f32x4*)(gain + k0 + 8 * c + 4); }
    const float* src = W + (size_t)(k0 + (lane >> 5)) * N + n0 + (lane & 31);
    float v[32];
#pragma unroll
    for (int i = 0; i < 32; ++i) v[i] = __builtin_nontemporal_load(src + (size_t)(2 * i) * N);
#pragma unroll
    for (int i = 0; i < 32; ++i) scr[(2 * i + (lane >> 5)) * 33 + (lane & 31)] = v[i];
    LDSWAIT();
#pragma unroll
    for (int j = 0; j < 4; ++j) { const int n = (lane >> 3) + 8 * j, gn = n0 + n; const LAS float* s = scr + (8 * c) * 33 + n;
        float cs = 1.0f; int row = gn;
        if (mode == 1) { if ((gn >= 768 && gn < 1024) || (gn >= 1280 && gn < 1536)) cs = 0.125f; }
        if (mode == 2) { const int jj = gn < DFF ? gn : gn - DFF; row = 256 * (jj >> 7) + (jj & 127) + (gn < DFF ? 0 : 128); }
        u32x4 o; o.x = pk2(s[0 * 33] * g0[0] * cs, s[1 * 33] * g0[1] * cs); o.y = pk2(s[2 * 33] * g0[2] * cs, s[3 * 33] * g0[3] * cs); o.z = pk2(s[4 * 33] * g1[0] * cs, s[5 * 33] * g1[1] * cs); o.w = pk2(s[6 * 33] * g1[2] * cs, s[7 * 33] * g1[3] * cs);
        *(u32x4*)(WT + (size_t)row * K + k0 + 8 * c) = o; }
    LDSWAIT();
}
__device__ __forceinline__ float wave_sum(float v) {
#pragma unroll
    for (int o = 1; o < 64; o <<= 1) v += __shfl_xor(v, o);
    return v;
}

struct Params {
    const float *x, *w_in, *w_out, *sgu_w, *sgu_b, *pool_w, *pool_scale, *swa_sinks, *rel_bias, *mix_out_gain, *norm_mix, *norm_ffn, *w_gate_up, *w_down, *norm_final;
    float* out; unsigned char* ws;
};


__device__ __forceinline__ void st4(bf16_t* p, const f32x4 y) { u32x2 o; o.x = pk2(y[0], y[1]); o.y = pk2(y[2], y[3]); *(u32x2*)p = o; }
#define VMWAIT() asm volatile("s_waitcnt vmcnt(0)" ::: "memory")
typedef short v4i16_t __attribute__((ext_vector_type(4)));
__device__ __forceinline__ bf16x8 tr_frag(const LAS bf16_t* p, int rows4) {
    const v4i16_t lo = __builtin_amdgcn_ds_read_tr16_b64_v4i16((LAS v4i16_t*)p);
    const v4i16_t hi = __builtin_amdgcn_ds_read_tr16_b64_v4i16((LAS v4i16_t*)(p + rows4));
    return (bf16x8){lo[0], lo[1], lo[2], lo[3], hi[0], hi[1], hi[2], hi[3]};
}

__device__ __forceinline__ void mixer_A(LAS unsigned char* L, const bf16_t* proj, const bf16_t* sguw, const float* sgub, bf16_t* ycat, int b, int ch, int tid, int lane, int w) {
    constexpr int VS = 264;
    LAS bf16_t* VL = (LAS bf16_t*)L;
    const size_t row0 = (size_t)b * SEQ + ch * 128;
    const int c = lane & 15, q = lane >> 4, wv = tid >> 6;
    const int nks = (w >> 1) + 1;
    const size_t trow = row0 + 16 * wv + c;
    const bf16_t* wbase = sguw + (size_t)(16 * wv + c) * 128 + 8 * q;
    const bf16_t* urow = proj + trow * DIN + 4 * q;
    bf16x8 bw[4][4]; u32x2 uu[4][4]; float bias[4];
#pragma unroll
    for (int h = 0; h < 4; ++h) { bias[h] = sgub[h * 128 + 16 * wv + c];
#pragma unroll
        for (int ks = 0; ks < 4; ++ks) if (ks < nks) bw[h][ks] = *(const bf16x8*)(wbase + h * 128 * 128 + 32 * ks);
#pragma unroll
        for (int n = 0; n < 4; ++n) uu[h][n] = *(const u32x2*)(urow + h * 64 + 16 * n); }
    {
        const int tok = tid >> 2, h = tid & 3;
        const bf16_t* src = proj + (row0 + tok) * DIN + 256 + h * 64;
        float v[64]; float s = 0.f;
#pragma unroll
        for (int i = 0; i < 8; ++i) { const u32x4 t = *(const u32x4*)(src + 8 * i);
            v[8 * i + 0] = bflo(t.x); v[8 * i + 1] = bfhi(t.x); v[8 * i + 2] = bflo(t.y); v[8 * i + 3] = bfhi(t.y); v[8 * i + 4] = bflo(t.z); v[8 * i + 5] = bfhi(t.z); v[8 * i + 6] = bflo(t.w); v[8 * i + 7] = bfhi(t.w); }
#pragma unroll
        for (int i = 0; i < 64; ++i) s += v[i];
        const float mean = s * (1.0f / 64.0f); float s2 = 0.f;
#pragma unroll
        for (int i = 0; i < 64; ++i) { v[i] -= mean; s2 += v[i] * v[i]; }
        const float rstd = rsqrtf(s2 * (1.0f / 64.0f) + EPS);
        LAS bf16_t* dst = VL + tok * VS + h * 64;
#pragma unroll
        for (int i = 0; i < 8; ++i) { u32x4 o; o.x = pk2(v[8 * i + 0] * rstd, v[8 * i + 1] * rstd); o.y = pk2(v[8 * i + 2] * rstd, v[8 * i + 3] * rstd); o.z = pk2(v[8 * i + 4] * rstd, v[8 * i + 5] * rstd); o.w = pk2(v[8 * i + 6] * rstd, v[8 * i + 7] * rstd);
            *(LAS u32x4*)(dst + 8 * i) = o; }
    }
    __syncthreads();
    const LAS bf16_t* vbase = VL + (8 * q + (c >> 2)) * VS + 4 * (c & 3);
    f32x4 yv[4][4]; float ssq = 0.f;
#pragma unroll
    for (int h = 0; h < 4; ++h) {
#pragma unroll
        for (int n = 0; n < 4; ++n) yv[h][n] = (f32x4){0.f, 0.f, 0.f, 0.f};
#pragma unroll
        for (int ks = 0; ks < 4; ++ks) if (ks < nks) {
#pragma unroll
            for (int n = 0; n < 4; ++n) { const bf16x8 a = tr_frag(vbase + 32 * ks * VS + h * 64 + 16 * n, 4 * VS); yv[h][n] = MFMA16(a, bw[h][ks], yv[h][n]); }
        }
#pragma unroll
        for (int n = 0; n < 4; ++n) { const u32x2 u2 = uu[h][n];
            f32x4 y; y[0] = bflo(u2.x) * (yv[h][n][0] + bias[h]); y[1] = bfhi(u2.x) * (yv[h][n][1] + bias[h]); y[2] = bflo(u2.y) * (yv[h][n][2] + bias[h]); y[3] = bfhi(u2.y) * (yv[h][n][3] + bias[h]);
            yv[h][n] = y; ssq += ssq4(y); }
    }
    ssq += __shfl_xor(ssq, 16); ssq += __shfl_xor(ssq, 32);
    const float rs = rsqrtf(ssq * (1.0f / 256.0f) + EPS);
    bf16_t* yrow = ycat + trow * DM + 0 + 4 * q;
#pragma unroll
    for (int h = 0; h < 4; ++h)
#pragma unroll
        for (int n = 0; n < 4; ++n) st4(yrow + h * 64 + 16 * n, yv[h][n] * rs);
}

__device__ __forceinline__ void mixer_B(LAS unsigned char* L, const bf16_t* proj, const bf16_t* pwt, const float* pscale, bf16_t* ycat, int b, int ch, int tid, int lane, int w) {
    constexpr int YS = 264;
    LAS bf16_t* PL = (LAS bf16_t*)L;
    LAS bf16_t* Y = (LAS bf16_t*)(L + 76032);
    const size_t row0 = (size_t)b * SEQ + ch * 128;
    const int c = lane & 15, q = lane >> 4, wv = tid >> 6;
    const bf16_t* pbase = pwt + (size_t)c * 64 + 8 * q;
    bf16x8 pw[4][4][2];
#pragma unroll
    for (int g = 0; g < 4; ++g)
#pragma unroll
        for (int n = 0; n < 4; ++n)
#pragma unroll
            for (int ks = 0; ks < 2; ++ks) pw[g][n][ks] = *(const bf16x8*)(pbase + (g * 64 + 16 * n) * 64 + 32 * ks);
    {
        u32x4 t[9];
#pragma unroll
        for (int i = 0; i < 9; ++i) { const int id = tid + 512 * i, r = id >> 5, cc = id & 31; t[i] = (u32x4){0u, 0u, 0u, 0u};
            if (id < 143 * 32 && (ch > 0 || r >= 15)) t[i] = *(const u32x4*)(proj + (row0 - 15 + r) * DIN + 512 + 8 * cc); }
#pragma unroll
        for (int i = 0; i < 9; ++i) { const int id = tid + 512 * i, r = id >> 5, cc = id & 31; if (id < 143 * 32) *(LAS u32x4*)(PL + r * YS + 8 * cc) = t[i]; }
    }
    __syncthreads();
    {
        const int cc = tid & 31, t0 = (tid >> 5) * 8; const int win = 2 << (cc >> 3);
        const LAS bf16_t* col = PL + 15 * YS + 8 * cc;
        float S[8];
#pragma unroll
        for (int e = 0; e < 8; ++e) S[e] = 0.f;
#pragma unroll 1
        for (int j = 0; j < win; ++j) { const u32x4 t = *(const LAS u32x4*)(col + (t0 - j) * YS);
            S[0] += bflo(t.x); S[1] += bfhi(t.x); S[2] += bflo(t.y); S[3] += bfhi(t.y); S[4] += bflo(t.z); S[5] += bfhi(t.z); S[6] += bflo(t.w); S[7] += bfhi(t.w); }
#pragma unroll
        for (int i = 0; i < 8; ++i) { const int t = t0 + i; const u32x4 pt = *(const LAS u32x4*)(col + t * YS);
            const float p0 = bflo(pt.x), p1 = bfhi(pt.x), p2 = bflo(pt.y), p3 = bfhi(pt.y), p4 = bflo(pt.z), p5 = bfhi(pt.z), p6 = bflo(pt.w), p7 = bfhi(pt.w);
            if (i > 0) { const u32x4 po = *(const LAS u32x4*)(col + (t - win) * YS);
                S[0] += p0 - bflo(po.x); S[1] += p1 - bfhi(po.x); S[2] += p2 - bflo(po.y); S[3] += p3 - bfhi(po.y); S[4] += p4 - bflo(po.z); S[5] += p5 - bfhi(po.z); S[6] += p6 - bflo(po.w); S[7] += p7 - bfhi(po.w); }
            const int tseq = ch * 128 + t; const int cnt = (tseq + 1 < win) ? (tseq + 1) : win; const float inv = 1.0f / (float)cnt;
            u32x4 o; o.x = pk2(S[0] * inv - p0, S[1] * inv - p1); o.y = pk2(S[2] * inv - p2, S[3] * inv - p3); o.z = pk2(S[4] * inv - p4, S[5] * inv - p5); o.w = pk2(S[6] * inv - p6, S[7] * inv - p7);
            *(LAS u32x4*)(Y + t * YS + 8 * cc) = o; }
    }
    __syncthreads();
    const size_t trow = row0 + 16 * wv + c; float ssq = 0.f;
    const LAS bf16_t* ybase = Y + (16 * wv + c) * YS + 8 * q;
    f32x4 yv[4][4];
#pragma unroll
    for (int g = 0; g < 4; ++g) {
#pragma unroll
        for (int n = 0; n < 4; ++n) yv[g][n] = (f32x4){0.f, 0.f, 0.f, 0.f};
#pragma unroll
        for (int ks = 0; ks < 2; ++ks) { const bf16x8 bfrag = *(const LAS bf16x8*)(ybase + g * 64 + 32 * ks);
#pragma unroll
            for (int n = 0; n < 4; ++n) yv[g][n] = MFMA16(pw[g][n][ks], bfrag, yv[g][n]); }
#pragma unroll
        for (int n = 0; n < 4; ++n) { const f32x4 sc = *(const f32x4*)(pscale + g * 64 + 16 * n + 4 * q); yv[g][n] = yv[g][n] * sc; ssq += ssq4(yv[g][n]); }
    }
    ssq += __shfl_xor(ssq, 16); ssq += __shfl_xor(ssq, 32);
    const float rs = rsqrtf(ssq * (1.0f / 256.0f) + EPS);
    bf16_t* yrow = ycat + trow * DM + 256 + 4 * q;
#pragma unroll
    for (int g = 0; g < 4; ++g)
#pragma unroll
        for (int n = 0; n < 4; ++n) st4(yrow + g * 64 + 16 * n, yv[g][n] * rs);
}

__device__ __forceinline__ bf16x8 tr_frag_perm(const LAS bf16_t* p, int rows16) {
    const v4i16_t lo = __builtin_amdgcn_ds_read_tr16_b64_v4i16((LAS v4i16_t*)p);
    const v4i16_t hi = __builtin_amdgcn_ds_read_tr16_b64_v4i16((LAS v4i16_t*)(p + rows16));
    return (bf16x8){lo[0], lo[1], lo[2], lo[3], hi[0], hi[1], hi[2], hi[3]};
}
__device__ __forceinline__ bf16x8 pack8(const f32x4 a, const f32x4 b) { u32x4 o; o.x = pk2(a[0], a[1]); o.y = pk2(a[2], a[3]); o.z = pk2(b[0], b[1]); o.w = pk2(b[2], b[3]); return __builtin_bit_cast(bf16x8, o); }

__device__ __forceinline__ void mixer_C(LAS unsigned char* L, const bf16_t* proj, const float* sinks, const float* rel_bias, bf16_t* ycat, int b, int qb, int tid, int lane, int w) {
    constexpr int KS = 144;
    const int wv = tid >> 6;
    LAS bf16_t* KL = (LAS bf16_t*)L;
    LAS bf16_t* VL = (LAS bf16_t*)(L + 73728);
    LAS float* BT = (LAS float*)(L + 152064);
    const size_t row0 = (size_t)b * SEQ + qb * 128;
    const int c = lane & 15, q = lane >> 4;
    const size_t trow = row0 + 16 * wv + c;
    {
        const int skey = tid >> 1, shalf = tid & 1; const bool okk = (qb > 0) || (skey >= 128);
        const bf16_t* ksrc = proj + (row0 - 128 + skey) * DIN + 1024 + shalf * 64;
        u32x4 kr[8], vr[8];
#pragma unroll
        for (int i = 0; i < 8; ++i) { kr[i] = (u32x4){0u, 0u, 0u, 0u}; vr[i] = (u32x4){0u, 0u, 0u, 0u}; if (okk) { kr[i] = *(const u32x4*)(ksrc + 8 * i); vr[i] = *(const u32x4*)(ksrc + 128 + 8 * i); } }
        { const int j = tid >> 7, dist = tid & 127; int bucket = dist;
          if (dist >= 16) { const int lg = 16 + (int)(__logf((float)dist * (1.0f / 16.0f)) / 2.0794415416798357f * 16.0f); bucket = lg < 31 ? lg : 31; }
          BT[j * 128 + dist] = rel_bias[bucket * 4 + j];
          if (tid < 288) *(LAS u32x4*)(VL + 256 * KS + 8 * tid) = (u32x4){0u, 0u, 0u, 0u}; }
#pragma unroll
        for (int i = 0; i < 8; ++i) { *(LAS u32x4*)(KL + skey * KS + shalf * 64 + 8 * i) = kr[i]; *(LAS u32x4*)(VL + skey * KS + shalf * 64 + 8 * i) = vr[i]; }
    }
    bf16x8 qf[4][2];
#pragma unroll
    for (int j = 0; j < 4; ++j)
#pragma unroll
        for (int ks = 0; ks < 2; ++ks) qf[j][ks] = *(const bf16x8*)(proj + trow * DIN + 768 + j * 64 + 32 * ks + 8 * q);
    __syncthreads();
    const LAS bf16_t* kbase = KL + (16 * wv + c) * KS + 8 * q;
    const LAS bf16_t* vbase = VL + (16 * wv + 4 * q + (c >> 2)) * KS + 4 * (c & 3);
    f32x4 yv[4][4]; float ssq = 0.f;
#pragma unroll
    for (int j = 0; j < 4; ++j) { const int kvh = j >> 1;
        f32x4 z[9];
#pragma unroll
        for (int kti = 0; kti < 9; ++kti) { z[kti] = (f32x4){0.f, 0.f, 0.f, 0.f};
#pragma unroll
            for (int ks = 0; ks < 2; ++ks) { const bf16x8 a = *(const LAS bf16x8*)(kbase + 16 * kti * KS + kvh * 64 + 32 * ks); z[kti] = MFMA16(a, qf[j][ks], z[kti]); } }
        const float sink = sinks[j]; const LAS float* bt = BT + j * 128;
        int zz; asm volatile("v_mov_b32 %0, 0" : "=v"(zz));
        const int cz = c + zz; const int klo = (qb > 0) ? (cz + 1) : max(cz + 1, 128 - 16 * w), khi = cz + 128;
        float mx = sink;
#pragma unroll
        for (int kti = 0; kti < 9; ++kti)
#pragma unroll
            for (int r = 0; r < 4; ++r) { const int kl = 16 * kti + 4 * q + r; const int dist = 128 + cz - kl; const bool valid = (unsigned)(kl - klo) <= (unsigned)(khi - klo);
                const float bb = bt[dist & 127]; const float v = valid ? (z[kti][r] + bb) : -1e30f; z[kti][r] = v; mx = fmaxf(mx, v); }
        mx = fmaxf(mx, __shfl_xor(mx, 16)); mx = fmaxf(mx, __shfl_xor(mx, 32));
        float sum = 0.f;
#pragma unroll
        for (int kti = 0; kti < 9; ++kti)
#pragma unroll
            for (int r = 0; r < 4; ++r) { const float p = (z[kti][r] > -1e29f) ? fexp(z[kti][r] - mx) : 0.f; z[kti][r] = p; sum += p; }
        sum += __shfl_xor(sum, 16); sum += __shfl_xor(sum, 32);
        const float inv = 1.0f / (sum + fexp(sink - mx));
#pragma unroll
        for (int n = 0; n < 4; ++n) yv[j][n] = (f32x4){0.f, 0.f, 0.f, 0.f};
#pragma unroll
        for (int ks = 0; ks < 5; ++ks) { const f32x4 zero4 = {0.f, 0.f, 0.f, 0.f};
            const bf16x8 bfrag = pack8(z[2 * ks] * inv, (ks < 4) ? (z[(ks < 4) ? 2 * ks + 1 : 0] * inv) : zero4);
#pragma unroll
            for (int n = 0; n < 4; ++n) { const bf16x8 a = tr_frag_perm(vbase + 32 * ks * KS + kvh * 64 + 16 * n, 16 * KS); yv[j][n] = MFMA16(a, bfrag, yv[j][n]); } }
#pragma unroll
        for (int n = 0; n < 4; ++n) ssq += ssq4(yv[j][n]);
    }
    ssq += __shfl_xor(ssq, 16); ssq += __shfl_xor(ssq, 32);
    const float rs = rsqrtf(ssq * (1.0f / 256.0f) + EPS);
    bf16_t* yrow = ycat + trow * DM + 512 + 4 * q;
#pragma unroll
    for (int j = 0; j < 4; ++j)
#pragma unroll
        for (int n = 0; n < 4; ++n) st4(yrow + j * 64 + 16 * n, yv[j][n] * rs);
}

#ifndef D_CUT
#define D_CUT 2.0e-9f
#endif
__device__ __forceinline__ void mixer_D(LAS unsigned char* L, const bf16_t* proj, bf16_t* ycat, int b, int qb64, int tid, int lane, int w) {
    constexpr int KS = 272;
    constexpr int TILE = 64 * KS;
    const int wv = tid >> 6;
    LAS bf16_t* KL = (LAS bf16_t*)L;
    LAS bf16_t* VL = (LAS bf16_t*)(L + 69632);
    LAS float* RED = (LAS float*)(L + 139264);
    volatile LAS unsigned* FLG = (volatile LAS unsigned*)(L + 139776);
    const int rg = wv & 3, hp = wv >> 2, c = lane & 15, q = lane >> 4;
    const size_t seq0 = (size_t)b * SEQ; const size_t trow = seq0 + qb64 * 64 + 16 * rg + c;
    const int skey = tid >> 3, spart = tid & 7;
    const bf16_t* ksrc0 = proj + (seq0 + skey) * DIN + 1536 + spart * 32;
    LAS bf16_t* kdst = KL + skey * KS + spart * 32;
    LAS bf16_t* vdst = VL + skey * KS + spart * 32;
    u32x4 kr[4], vr[4];
    { const bf16_t* ksrc = ksrc0 + (size_t)qb64 * 64 * DIN;
#pragma unroll
        for (int i = 0; i < 4; ++i) { kr[i] = *(const u32x4*)(ksrc + 8 * i); vr[i] = *(const u32x4*)(ksrc + 256 + 8 * i); } }
    bf16x8 qf[2][2];
#pragma unroll
    for (int hh = 0; hh < 2; ++hh)
#pragma unroll
        for (int ks = 0; ks < 2; ++ks) qf[hh][ks] = *(const bf16x8*)(proj + trow * DIN + 1280 + (2 * hp + hh) * 64 + 32 * ks + 8 * q);
    f32x4 acc[2][4];
#pragma unroll
    for (int hh = 0; hh < 2; ++hh)
#pragma unroll
        for (int n = 0; n < 4; ++n) acc[hh][n] = (f32x4){0.f, 0.f, 0.f, 0.f};
    float rem[2] = {1.f, 1.f};
    const int qloc = 16 * rg + c;
    const LAS bf16_t* kbase = KL + c * KS + hp * 128 + 8 * q;
    const LAS bf16_t* vbase = VL + (4 * q + (c >> 2)) * KS + hp * 128 + 4 * (c & 3);
    if (tid < 3) FLG[tid] = 0u;
#pragma unroll
    for (int i = 0; i < 4; ++i) { *(LAS u32x4*)(kdst + 8 * i) = kr[i]; *(LAS u32x4*)(vdst + 8 * i) = vr[i]; }
    u32x4 kr2[4], vr2[4];
    if (qb64 > 0) { const bf16_t* ksrc = ksrc0 + (size_t)(qb64 - 1) * 64 * DIN;
#pragma unroll
        for (int i = 0; i < 4; ++i) { kr[i] = *(const u32x4*)(ksrc + 8 * i); vr[i] = *(const u32x4*)(ksrc + 256 + 8 * i); } }
    if (qb64 > 1) { const bf16_t* ksrc = ksrc0 + (size_t)(qb64 - 2) * 64 * DIN;
#pragma unroll
        for (int i = 0; i < 4; ++i) { kr2[i] = *(const u32x4*)(ksrc + 8 * i); vr2[i] = *(const u32x4*)(ksrc + 256 + 8 * i); } }
    else {
#pragma unroll
        for (int i = 0; i < 4; ++i) { kr2[i] = (u32x4){0u, 0u, 0u, 0u}; vr2[i] = (u32x4){0u, 0u, 0u, 0u}; } }
#define D_STEP(KW, VW) \
        __syncthreads(); \
        if (it > 0 && FLG[fprev] == 0u) break; \
        const int bo = (it & 1) * TILE, bn = ((it + 1) & 1) * TILE; \
        if (kt > 0) { \
            _Pragma("unroll") \
            for (int i = 0; i < 4; ++i) { *(LAS u32x4*)(kdst + bn + 8 * i) = KW[i]; *(LAS u32x4*)(vdst + bn + 8 * i) = VW[i]; } \
            if (kt > 2) { const bf16_t* ksrc = ksrc0 + (size_t)(kt - 3) * 64 * DIN; \
                _Pragma("unroll") \
                for (int i = 0; i < 4; ++i) { KW[i] = *(const u32x4*)(ksrc + 8 * i); VW[i] = *(const u32x4*)(ksrc + 256 + 8 * i); } } \
        } \
        if (tid == 0) FLG[fnext] = 0u; \
        const bool diag = (kt == qb64); \
_Pragma("unroll") \
        for (int hh = 0; hh < 2; ++hh) { \
            f32x4 z[4]; \
_Pragma("unroll") \
            for (int kti = 0; kti < 4; ++kti) { z[kti] = (f32x4){0.f, 0.f, 0.f, 0.f}; \
_Pragma("unroll") \
                for (int ks = 0; ks < 2; ++ks) { const bf16x8 a = *(const LAS bf16x8*)(kbase + bo + 16 * kti * KS + hh * 64 + 32 * ks); z[kti] = MFMA16(a, qf[hh][ks], z[kti]); } } \
            f32x4 ex[4]; float G[4]; \
            if (diag) { \
_Pragma("unroll") \
                for (int kti = 0; kti < 4; ++kti) { float run = 1.f; \
_Pragma("unroll") \
                    for (int r = 3; r >= 0; --r) { const bool valid = (16 * kti + 4 * q + r < qloc); \
                        const float u = fexp(fminf(z[kti][r], 80.f)); const float om = __builtin_amdgcn_rcpf(1.0f + u); \
                        z[kti][r] = valid ? u * om : 0.f; ex[kti][r] = run; run *= valid ? om : 1.f; } \
                    G[kti] = run; } \
            } else { \
_Pragma("unroll") \
                for (int kti = 0; kti < 4; ++kti) { float run = 1.f; \
_Pragma("unroll") \
                    for (int r = 3; r >= 0; --r) { const float u = fexp(fminf(z[kti][r], 80.f)); const float om = __builtin_amdgcn_rcpf(1.0f + u); \
                        z[kti][r] = u * om; ex[kti][r] = run; run *= om; } \
                    G[kti] = run; } \
            } \
            float E[4], Tk[4]; \
_Pragma("unroll") \
            for (int kti = 0; kti < 4; ++kti) { const float bq = __shfl_xor(G[kti], 16); const float ps = G[kti] * bq; const float c2 = __shfl_xor(ps, 32); \
                E[kti] = ((q & 1) ? 1.f : bq) * ((q < 2) ? c2 : 1.f); Tk[kti] = ps * c2; } \
            const float U2 = Tk[3], U1 = U2 * Tk[2], U0 = U1 * Tk[1]; \
            const float cb = rem[hh]; \
            const float base[4] = {cb * U0 * E[0], cb * U1 * E[1], cb * U2 * E[2], cb * E[3]}; \
            rem[hh] = cb * U0 * Tk[0]; \
_Pragma("unroll") \
            for (int kti = 0; kti < 4; ++kti) \
_Pragma("unroll") \
                for (int r = 0; r < 4; ++r) z[kti][r] = z[kti][r] * (base[kti] * ex[kti][r]); \
_Pragma("unroll") \
            for (int ks = 0; ks < 2; ++ks) { const bf16x8 bfrag = pack8(z[2 * ks], z[2 * ks + 1]); \
_Pragma("unroll") \
                for (int n = 0; n < 4; ++n) { const bf16x8 a = tr_frag_perm(vbase + bo + 32 * ks * KS + hh * 64 + 16 * n, 16 * KS); acc[hh][n] = MFMA16(a, bfrag, acc[hh][n]); } } \
        } \
        if (__builtin_amdgcn_ballot_w64(fmaxf(rem[0], rem[1]) > D_CUT) != 0ull) { if (lane == 0) FLG[fcur] = 1u; } \
        { const int t = fprev; fprev = fcur; fcur = fnext; fnext = t; }
    int it = 0, fprev = 2, fcur = 0, fnext = 1;
#pragma unroll 1
    for (int kt = qb64; kt >= 0; --kt, ++it) {
        { D_STEP(kr, vr) }
        if (kt == 0) break;
        --kt; ++it;
        { D_STEP(kr2, vr2) }
    }
#undef D_STEP
    float ssq = 0.f;
#pragma unroll
    for (int hh = 0; hh < 2; ++hh)
#pragma unroll
        for (int n = 0; n < 4; ++n) ssq += ssq4(acc[hh][n]);
    ssq += __shfl_xor(ssq, 16); ssq += __shfl_xor(ssq, 32);
    __syncthreads();
    if (q == 0) RED[(16 * rg + c) * 2 + hp] = ssq;
    __syncthreads();
    const float tot = RED[(16 * rg + c) * 2 + 0] + RED[(16 * rg + c) * 2 + 1];
    const float rs = rsqrtf(tot * (1.0f / 256.0f) + EPS);
    bf16_t* yrow = ycat + trow * DM + 768 + hp * 128 + 4 * q;
#pragma unroll
    for (int hh = 0; hh < 2; ++hh)
#pragma unroll
        for (int n = 0; n < 4; ++n) st4(yrow + hh * 64 + 16 * n, acc[hh][n] * rs);
}

#define XB_TMO      128
#define XB_XCNT(j)  (256  + 64 * (j))
#define XB_XSUB(j)  (1280 + 64 * (j))
#define XB_XGEN(j)  (2304 + 64 * (j))
#define XB_TOP      3328
#define XB_TOPGEN   3392
#define XCD_BAR_WORDS 3456
#define XB_SPIN_CAP (1u << 18)

__device__ __forceinline__ unsigned xb_ld(unsigned* p)              { return __hip_atomic_load(p, __ATOMIC_RELAXED, __HIP_MEMORY_SCOPE_AGENT); }
__device__ __forceinline__ unsigned xb_add(unsigned* p, unsigned v) { return __hip_atomic_fetch_add(p, v, __ATOMIC_RELAXED, __HIP_MEMORY_SCOPE_AGENT); }
__device__ __forceinline__ unsigned xb_xcc_id() { return (unsigned)__builtin_amdgcn_s_getreg((3 << 11) | 20) & 0xFu; }
#define XB_SPIN(cond, bar) do { unsigned _sp = 0; while (cond) { __builtin_amdgcn_s_sleep(1); \
    if ((++_sp & 255u) == 0u) { if (xb_ld(&(bar)[XB_TMO])) break; if (_sp > XB_SPIN_CAP) { atomicAdd(&(bar)[XB_TMO], 1u); break; } } } } while (0)

struct XcdBarrier {
    unsigned* bar; unsigned x;
    volatile LAS unsigned* st;
};

__device__ __forceinline__ XcdBarrier xcd_barrier_post(unsigned* bar, volatile LAS unsigned* st) {
    XcdBarrier b; b.bar = bar; b.x = xb_xcc_id(); b.st = st;
    if (threadIdx.x == 0) (void)xb_add(&bar[XB_XCNT(b.x)], 1u);
    return b;
}
__device__ __forceinline__ void xcd_barrier_complete(unsigned* bar, unsigned x, unsigned& nloc, unsigned& nx) {
    const unsigned G = gridDim.x * gridDim.y * gridDim.z;
    unsigned sum, cnt, mine, sp = 0u;
    for (;;) {
        sum = 0u; cnt = 0u; mine = 0u;
#pragma unroll
        for (unsigned j = 0; j < 16; ++j) { const unsigned c = xb_ld(&bar[XB_XCNT(j)]); sum += c; cnt += (c > 0u) ? 1u : 0u; mine = (j == x) ? c : mine; }
        if (sum == G) break;
        __builtin_amdgcn_s_sleep(1);
        if ((++sp & 255u) == 0u) { if (xb_ld(&bar[XB_TMO])) break; if (sp > XB_SPIN_CAP) { atomicAdd(&bar[XB_TMO], 1u); break; } }
    }
    nloc = mine > 0u ? mine : 1u; nx = cnt > 0u ? cnt : 1u;
}

__device__ __forceinline__ void xcd_barrier(const XcdBarrier& b) {
    asm volatile("s_waitcnt vmcnt(0)" ::: "memory");
    __syncthreads();
    if (threadIdx.x == 0) {
        unsigned* bar = b.bar;
        __builtin_amdgcn_s_waitcnt(0);
        unsigned nloc = b.st[0], nx = b.st[1];
        if (nloc == 0u) { xcd_barrier_complete(bar, b.x, nloc, nx); b.st[0] = nloc; b.st[1] = nx; }
        const unsigned old = xb_add(&bar[XB_XSUB(b.x)], 1u);
        const unsigned gen = old / nloc;
        if (old + 1u == (gen + 1u) * nloc) {
            __builtin_amdgcn_fence(__ATOMIC_RELEASE, "agent");
            asm volatile("s_waitcnt vmcnt(0)" ::: "memory");
            const unsigned og = xb_add(&bar[XB_TOP], 1u);
            const unsigned tg = og / nx;
            if (og + 1u == (tg + 1u) * nx) xb_add(&bar[XB_TOPGEN], 1u);
            else XB_SPIN(xb_ld(&bar[XB_TOPGEN]) == tg, bar);
            __builtin_amdgcn_fence(__ATOMIC_ACQUIRE, "agent");
            xb_add(&bar[XB_XGEN(b.x)], 1u);
            asm volatile("s_waitcnt vmcnt(0)" ::: "memory");
        } else {
            XB_SPIN(xb_ld(&bar[XB_XGEN(b.x)]) == gen, bar);
            __builtin_amdgcn_fence(__ATOMIC_ACQUIRE, "agent");
            asm volatile("s_waitcnt vmcnt(0)" ::: "memory");
        }
    }
    __syncthreads();
}

#ifndef REP_SYNC
#define REP_SYNC 1
#endif
#define GSYNC() do { for (int _r = 0; _r < REP_SYNC; ++_r) xcd_barrier(xbar); } while (0)
__global__ void __launch_bounds__(NTHR, 2) fwd_megakernel(Params p) {
    extern __shared__ __attribute__((aligned(16))) unsigned char lds[];
    cg::grid_group grid = cg::this_grid();
    LAS unsigned char* L = (LAS unsigned char*)lds;
    const int tid = threadIdx.x, lane = tid & 63, wave = __builtin_amdgcn_readfirstlane(tid >> 6);
    const int G = gridDim.x, bx = blockIdx.x;
    unsigned char* ws = p.ws;
    bf16_t* Win_t = (bf16_t*)(ws + WS_WIN); bf16_t* Wout_t = (bf16_t*)(ws + WS_WOUT); bf16_t* Wgu_t = (bf16_t*)(ws + WS_WGU); bf16_t* Wdn_t = (bf16_t*)(ws + WS_WDN);
    bf16_t* SGUW = (bf16_t*)(ws + WS_SGUW); bf16_t* PWT = (bf16_t*)(ws + WS_PWT); float* SSQ = (float*)(ws + WS_SS);
    bf16_t* XB = (bf16_t*)(ws + WS_XB); bf16_t* PROJ = (bf16_t*)(ws + WS_PROJ); bf16_t* YCAT = (bf16_t*)(ws + WS_YCAT); bf16_t* HID = (bf16_t*)(ws + WS_HID);

    volatile LAS unsigned* xst = (volatile LAS unsigned*)(L + LDS_BYTES - 16);
    if (tid < 4) xst[tid] = 0u;
    unsigned* barw = (unsigned*)(ws + WS_BAR);
    if (bx == 0) for (int i = tid; i < XCD_BAR_WORDS; i += NTHR) __hip_atomic_store(barw + i, 0u, __ATOMIC_RELAXED, __HIP_MEMORY_SCOPE_AGENT);
#ifndef REP_P0
#define REP_P0 1
#endif
    for (int rep0 = 0; rep0 < REP_P0; ++rep0) {
        LAS float* scr = (LAS float*)(L + wave * 16384);
        const int gw = bx * 8 + wave, NGW = G * 8;
        constexpr int I_IN = (DM / 64) * (DIN / 32), I_OUT = (DM / 64) * (DM / 32), I_GU = (DM / 64) * (2 * DFF / 32), I_DN = (DFF / 64) * (DM / 32), I_L = I_IN + I_OUT + I_GU + I_DN;
        for (int it = gw; it < DEPTH * I_L; it += NGW) {
            const int l = it / I_L; int r = it % I_L;
            if (r < I_IN) { transpose_item(p.w_in + (size_t)l * DM * DIN, DM, DIN, Win_t + (size_t)l * DIN * DM, p.norm_mix + l * DM, 1, scr, r, lane); continue; } r -= I_IN;
            if (r < I_OUT) { transpose_item(p.w_out + (size_t)l * DM * DM, DM, DM, Wout_t + (size_t)l * DM * DM, p.mix_out_gain + l * DM, 0, scr, r, lane); continue; } r -= I_OUT;
            if (r < I_GU) { transpose_item(p.w_gate_up + (size_t)l * DM * 2 * DFF, DM, 2 * DFF, Wgu_t + (size_t)l * 2 * DFF * DM, p.norm_ffn + l * DM, 2, scr, r, lane); continue; } r -= I_GU;
            transpose_item(p.w_down + (size_t)l * DFF * DM, DFF, DM, Wdn_t + (size_t)l * DM * DFF, nullptr, 0, scr, r, lane);
        }
        for (int m = 2 * gw; m < M; m += 2 * NGW) {
            const f32x4* xr = (const f32x4*)(p.x + (size_t)m * DM) + lane; u32x2* o8 = (u32x2*)(XB + (size_t)m * DM) + lane; f32x4 v[2][4];
#pragma unroll
            for (int r = 0; r < 2; ++r)
#pragma unroll
                for (int j = 0; j < 4; ++j) v[r][j] = __builtin_nontemporal_load(xr + r * 256 + 64 * j);
#pragma unroll
            for (int r = 0; r < 2; ++r) { float s = 0.f;
#pragma unroll
                for (int j = 0; j < 4; ++j) { const f32x4 t = v[r][j]; s += ssq4(t); u32x2 o; o.x = pk2(t.x, t.y); o.y = pk2(t.z, t.w); o8[r * 256 + 64 * j] = o; }
                s = wave_sum(s);
                if (lane < 4) SSQ[(size_t)(m + r) * 4 + lane] = (lane == 0) ? s : 0.f; }
        }
        const int gt = bx * NTHR + tid, NGT = G * NTHR;
        for (int e = gt; e < DEPTH * 4 * 128 * 128 / 8; e += NGT) { const int s0 = (e & 15) * 8, t = (e >> 4) & 127; const float* src = p.sgu_w + (size_t)e * 8;
            const f32x4 a = *(const f32x4*)src, bq = *(const f32x4*)(src + 4); float v[8] = {a.x, a.y, a.z, a.w, bq.x, bq.y, bq.z, bq.w};
#pragma unroll
            for (int i = 0; i < 8; ++i) v[i] = (s0 + i <= t) ? v[i] : 0.f;
            u32x4 o; o.x = pk2(v[0], v[1]); o.y = pk2(v[2], v[3]); o.z = pk2(v[4], v[5]); o.w = pk2(v[6], v[7]); *(u32x4*)(SGUW + (size_t)e * 8) = o; }
        for (int e = gt; e < DEPTH * 4 * 64 * 64; e += NGT) { const int cc = e & 63, d = (e >> 6) & 63, lg = e >> 12; PWT[e] = f2bf(p.pool_w[((size_t)lg * 64 + cc) * 64 + d]); }
    }
    grid.sync();
    const XcdBarrier xbar = xcd_barrier_post(barw, xst);

    for (int l = 0; l < DEPTH; ++l) {
#ifndef REP_P1
#define REP_P1 1
#endif
#ifndef NO_P1
        for (int rep = 0; rep < REP_P1; ++rep) { int zk; asm volatile("s_mov_b32 %0, 0" : "=s"(zk)); pg8::Gemm g{XB, Win_t + (size_t)l * DIN * DM, M, DIN, DM + zk}; pg8::StaticOrder S; S.init(M, DIN, G + zk, bx); LAS float* RT = (LAS float*)(L + 135168); if (tid == 0) ((volatile LAS int*)(RT + 256))[0] = -1; __syncthreads(); pg8::EpiIn E{PROJ, SSQ, RT};
          pg8::gemm_phase<pg8::EpiIn, pg8::StaticOrder, true, true>(L, g, S, E, zk); }
#endif
        GSYNC();
#ifndef REP_MIX
#define REP_MIX 1
#endif
#ifndef REP_D
#define REP_D 1
#endif
        for (int rep = 0; rep < REP_MIX; ++rep)
        for (int u0 = bx; u0 < 256; u0 += G) {
            const int u = (G == 256) ? (((u0 & 7) << 5) | (u0 >> 3)) : u0; const int b = u >> 4, ch = u & 15;
            __syncthreads();
#ifndef REP_A
#define REP_A 1
#endif
#ifndef NO_A
            for (int rp = 0; rp < REP_A; ++rp) { __syncthreads(); int zt; asm volatile("v_mov_b32 %0, 0" : "=v"(zt)); const int t2 = tid + zt; mixer_A(L, PROJ, SGUW + (size_t)l * 4 * 128 * 128, p.sgu_b + l * 4 * 128, YCAT, b, ch, t2, t2 & 63, __builtin_amdgcn_readfirstlane(t2 >> 6)); }
#endif
            __syncthreads();
#ifndef REP_B
#define REP_B 1
#endif
#ifndef NO_B
            for (int rp = 0; rp < REP_B; ++rp) { __syncthreads(); int zt; asm volatile("v_mov_b32 %0, 0" : "=v"(zt)); const int t2 = tid + zt; mixer_B(L, PROJ, PWT + (size_t)l * 4 * 64 * 64, p.pool_scale + l * 256, YCAT, b, ch, t2, t2 & 63, __builtin_amdgcn_readfirstlane(t2 >> 6)); }
#endif
            __syncthreads();
#ifndef REP_C
#define REP_C 1
#endif
#ifndef NO_C
            for (int rp = 0; rp < REP_C; ++rp) { __syncthreads(); int zt; asm volatile("v_mov_b32 %0, 0" : "=v"(zt)); const int t2 = tid + zt; mixer_C(L, PROJ, p.swa_sinks + l * 4, p.rel_bias, YCAT, b, ch, t2, t2 & 63, __builtin_amdgcn_readfirstlane(t2 >> 6)); }
#endif
            __syncthreads();
#ifndef NO_D
#pragma unroll 1
            for (int hf = 0; hf < 2 * REP_D; ++hf) { int zt; asm volatile("v_mov_b32 %0, 0" : "=v"(zt)); const int t2 = tid + zt; mixer_D(L, PROJ, YCAT, b, (hf & 1) ? 31 - ch : ch, t2, t2 & 63, __builtin_amdgcn_readfirstlane(t2 >> 6)); __syncthreads(); }
#endif
        }
        GSYNC();
#ifndef NO_P3
        { int zk; asm volatile("s_mov_b32 %0, 0" : "=s"(zk)); pg8::Gemm g{YCAT, Wout_t + (size_t)l * DM * DM, M, DM, DM + zk}; pg8::StaticOrder S; S.init(M, DM, G + zk, bx); pg8::EpiRes E{l == 0 ? p.x : nullptr, nullptr, XB, SSQ, (LAS float*)(L + 131072)};
          pg8::gemm_phase<pg8::EpiRes, pg8::StaticOrder, true, true>(L, g, S, E, zk); }
#endif
        GSYNC();
#ifndef REP_P4
#define REP_P4 1
#endif
#ifndef NO_P4
        for (int rep = 0; rep < REP_P4; ++rep) { int zk; asm volatile("s_mov_b32 %0, 0" : "=s"(zk)); pg8::Gemm g{XB, Wgu_t + (size_t)l * 2 * DFF * DM, M, 2 * DFF, DM + zk}; pg8::StaticOrder S; S.init(M, 2 * DFF, G + zk, bx); LAS float* RT = (LAS float*)(L + 135168); if (tid == 0) ((volatile LAS int*)(RT + 256))[0] = -1; __syncthreads(); pg8::EpiGU E{HID, SSQ, RT};
          pg8::gemm_phase<pg8::EpiGU, pg8::StaticOrder, true, true>(L, g, S, E, zk); }
#endif
        GSYNC();
#ifndef NO_P5
        { int zk; asm volatile("s_mov_b32 %0, 0" : "=s"(zk)); pg8::Gemm g{HID, Wdn_t + (size_t)l * DM * DFF, M, DM, DFF + zk}; pg8::StaticOrder S; S.init(M, DM, G + zk, bx); pg8::EpiRes E{nullptr, l == DEPTH - 1 ? p.out : nullptr, XB, SSQ, (LAS float*)(L + 131072)};
          pg8::gemm_phase<pg8::EpiRes, pg8::StaticOrder, true, true>(L, g, S, E, zk); }
#endif
        GSYNC();
    }
    {
        const int gw = bx * 8 + wave, NGW = G * 8;
        const f32x4* gr = (const f32x4*)p.norm_final + lane; f32x4 gg[4];
#pragma unroll
        for (int j = 0; j < 4; ++j) gg[j] = gr[64 * j];
        for (int m = 2 * gw; m < M; m += 2 * NGW) {
            f32x4* xr = (f32x4*)(p.out + (size_t)m * DM) + lane; f32x4 v[2][4]; float rs[2];
#pragma unroll
            for (int r = 0; r < 2; ++r) { rs[r] = rstd_of(SSQ, m + r);
#pragma unroll
                for (int j = 0; j < 4; ++j) v[r][j] = xr[r * 256 + 64 * j]; }
#pragma unroll
            for (int r = 0; r < 2; ++r)
#pragma unroll
                for (int j = 0; j < 4; ++j) __builtin_nontemporal_store(v[r][j] * rs[r] * gg[j], xr + r * 256 + 64 * j); }
    }
}

extern "C" void kernel_launch(void* const* d_in, const int* in_sizes, int n_in, void* d_out, int out_size, void* d_ws, size_t ws_size, hipStream_t stream) {
    static int grid_blocks = 0;
    if (grid_blocks == 0) {
        if (n_in != 15 || in_sizes[0] != M * DM || out_size != M * DM || ws_size < WS_END) { fprintf(stderr, "kernel_launch: unexpected shapes (n_in %d, in0 %d, out %d, ws %zu)\n", n_in, n_in > 0 ? in_sizes[0] : -1, out_size, ws_size); grid_blocks = -1; return; }
        int dev = 0, cus = 0, per_cu = 0;
        hipGetDevice(&dev); hipDeviceGetAttribute(&cus, hipDeviceAttributeMultiprocessorCount, dev);
        if (hipFuncSetAttribute((const void*)fwd_megakernel, hipFuncAttributeMaxDynamicSharedMemorySize, LDS_BYTES) != hipSuccess) { fprintf(stderr, "kernel_launch: hipFuncSetAttribute failed\n"); }
        if (hipOccupancyMaxActiveBlocksPerMultiprocessor(&per_cu, (const void*)fwd_megakernel, NTHR, LDS_BYTES) != hipSuccess || per_cu < 1) { fprintf(stderr, "kernel_launch: occupancy query says %d\n", per_cu); per_cu = 1; }
        (void)hipGetLastError();
        grid_blocks = cus * 1;
        if (grid_blocks <= 0) grid_blocks = 256;
    }
    if (grid_blocks < 0) return;
    Params p{};
    p.x = (const float*)d_in[0]; p.w_in = (const float*)d_in[1]; p.w_out = (const float*)d_in[2]; p.sgu_w = (const float*)d_in[3]; p.sgu_b = (const float*)d_in[4];
    p.pool_w = (const float*)d_in[5]; p.pool_scale = (const float*)d_in[6]; p.swa_sinks = (const float*)d_in[7]; p.rel_bias = (const float*)d_in[8]; p.mix_out_gain = (const float*)d_in[9];
    p.norm_mix = (const float*)d_in[10]; p.norm_ffn = (const float*)d_in[11]; p.w_gate_up = (const float*)d_in[12]; p.w_down = (const float*)d_in[13]; p.norm_final = (const float*)d_in[14];
    p.out = (float*)d_out; p.ws = (unsigned char*)d_ws;
    void* args[] = {&p};
    hipError_t e = hipLaunchCooperativeKernel((const void*)fwd_megakernel, dim3(grid_blocks), dim3(NTHR), args, LDS_BYTES, stream);
    if (e != hipSuccess) fprintf(stderr, "cooperative launch failed: %s (grid %d)\n", hipGetErrorString(e), grid_blocks);
}
```

```cpp
#include <hip/hip_runtime.h>
#include <hip/hip_cooperative_groups.h>
#include <cstdio>
#include <cstdint>
namespace cg = cooperative_groups;
namespace pg8 {
#define PG8_LAS __attribute__((address_space(3)))
typedef unsigned short bf16_t;
typedef short bf16x8 __attribute__((ext_vector_type(8)));
typedef float f32x4 __attribute__((ext_vector_type(4)));
typedef unsigned u32x4 __attribute__((ext_vector_type(4)));
constexpr int BM = 256, BK = 64, HALF = 128, HTB = HALF * BK * 2  , STAGE_BYTES = 8 * HTB, NXCD = 8, WGM = 8;

__host__ __device__ __forceinline__ int lds_byte(int r, int c) { const int st = (r >> 4) * 2 + (c >> 5), rr = r & 15, cc = c & 31, ob = rr * 64 + cc * 2; return st * 1024 + (ob ^ (((ob >> 9) & 1) << 5)); }
__host__ __device__ __forceinline__ void stage_rc(int b, int& R, int& C) { const int st = b / 1024, sb = b % 1024, swz = sb ^ (((sb >> 9) & 1) << 5); R = (st >> 1) * 16 + swz / 64; C = (st & 1) * 32 + (swz % 64) / 2; }
__host__ __device__ __forceinline__ int perm32(int rho) { const int n = rho >> 4, i = rho & 15; return 8 * (i >> 2) + 4 * n + (i & 3); }

struct Unit { int pm, pn; };
struct Gemm { const bf16_t* A; const bf16_t* Bt; int M, N, K; };

struct StaticOrder {
    int nM, nN, nwg, G, c;
    __host__ __device__ void init(int M, int N, int G_, int c_) { nM = M / BM; nN = N / BM; nwg = nM * nN; G = G_; c = c_; }
    __host__ __device__ bool next(int i, Unit& u) const {
        const long L = (long)i * G + c; if (L >= nwg) return false;
        int wgid = (int)L; { const int q = nwg / NXCD, r = nwg % NXCD, xcd = wgid % NXCD, off = wgid / NXCD; wgid = (xcd < r ? xcd * (q + 1) : r * (q + 1) + (xcd - r) * q) + off; }
        const int nig = WGM * nN, gid = wgid / nig, fm = gid * WGM, gsz = (nM - fm) < WGM ? (nM - fm) : WGM;
        u.pm = fm + ((wgid % nig) % gsz); u.pn = (wgid % nig) / gsz; return true;
    }
    __device__ __forceinline__ void a_ready(const Unit&) const {}
    __device__ __forceinline__ void done(const Unit&) const {}
};

__device__ __forceinline__ unsigned cvt_pk_bf16(float lo, float hi) { unsigned r; asm volatile("v_cvt_pk_bf16_f32 %0, %1, %2" : "=v"(r) : "v"(lo), "v"(hi)); return r; }
typedef float f32x2 __attribute__((ext_vector_type(2)));
template <class Epi, class Sched, bool ALIGN_EPI = false, bool SP2 = false>
__device__ __forceinline__ void gemm_phase(PG8_LAS unsigned char* lds, const Gemm g, const Sched& S, const Epi& E, const int opq) {
    const int tid = threadIdx.x + opq, wid = __builtin_amdgcn_readfirstlane(tid >> 6), lane = tid & 63, wr = wid >> 2, wc = wid & 3, fr = lane & 15, fq = lane >> 4;
    const int K = g.K, nt = K / BK;
    unsigned voffA[2], voffB[2];
#pragma unroll
    for (int i = 0; i < 2; ++i) { int R, C; stage_rc(tid * 16 + i * 8192, R, C); const int Rb = Epi::PERM ? ((R & ~31) + perm32(R & 31)) : R;
        voffA[i] = (unsigned)(R * K + C) * 2u; voffB[i] = (unsigned)(Rb * K + C) * 2u; }
    const size_t kstep = (size_t)(BK * 2);
    const size_t hstep = (size_t)HALF * K * 2;
    const size_t tstep = 2 * hstep;
    const unsigned ldsw = (unsigned)wid * 1024u;
    const int aoff = lds_byte(wr * 64 + fr, fq * 8), boff = lds_byte(wc * 32 + fr, fq * 8);
#define PG8_SA(b, h) (((b) * 2 + (h)) * HTB)
#define PG8_SB(b, h) ((4 + (b) * 2 + (h)) * HTB)
#define PG8_STAGE(bufoff, gbase, voff) do { _Pragma("unroll") for (int _i = 0; _i < 2; ++_i) \
        __builtin_amdgcn_global_load_lds((const unsigned*)((const char*)(gbase) + (voff)[_i]), (PG8_LAS unsigned*)(lds + (bufoff) + ldsw + _i * 8192), 16, 0, 0); } while (0)
#define PG8_LDA(dst, b, h) do { _Pragma("unroll") for (int m = 0; m < 4; ++m) _Pragma("unroll") for (int k = 0; k < 2; ++k) dst[m][k] = *(const PG8_LAS bf16x8*)(lds + PG8_SA(b, h) + aoff + m * 2048 + k * 1024); } while (0)
#define PG8_LDB(dst, b, h) do { _Pragma("unroll") for (int n = 0; n < 2; ++n) _Pragma("unroll") for (int k = 0; k < 2; ++k) dst[n][k] = *(const PG8_LAS bf16x8*)(lds + PG8_SB(b, h) + boff + n * 2048 + k * 1024); } while (0)
#define PG8_MMA(ai, bj, At, Bt) do { __builtin_amdgcn_s_setprio(1); _Pragma("unroll") for (int m = 0; m < 4; ++m) _Pragma("unroll") for (int n = 0; n < 2; ++n) _Pragma("unroll") for (int k = 0; k < 2; ++k) \
        acc[ai][bj][m][n] = __builtin_amdgcn_mfma_f32_16x16x32_bf16(Bt[n][k], At[m][k], acc[ai][bj][m][n], 0, 0, 0); __builtin_amdgcn_s_setprio(0); } while (0)
#define PG8_WAIT_V(n) asm volatile("s_waitcnt vmcnt(" #n ")" ::: "memory")
#define PG8_WAIT_L(n) asm volatile("s_waitcnt lgkmcnt(" #n ")" ::: "memory")
#define PG8_BAR __builtin_amdgcn_s_barrier()
#define PG8_SCHED __builtin_amdgcn_sched_barrier(0)
    Unit cur, nxt; int ui = 0;
    if (!S.next(0, cur)) return;
    f32x4 acc[2][2][4][2];
#pragma unroll
    for (int a = 0; a < 2; ++a)
#pragma unroll
        for (int b = 0; b < 2; ++b)
#pragma unroll
            for (int m = 0; m < 4; ++m)
#pragma unroll
                for (int n = 0; n < 2; ++n) acc[a][b][m][n] = (f32x4){0.f, 0.f, 0.f, 0.f};
    bf16x8 At[4][2], B0[2][2], B1[2][2];
    const char* cA = (const char*)g.A + (size_t)cur.pm * tstep; const char* cB = (const char*)g.Bt + (size_t)cur.pn * tstep;
    S.a_ready(cur);
    if constexpr (SP2) {
        PG8_STAGE(PG8_SB(0, 0), cB, voffB); PG8_STAGE(PG8_SB(0, 1), cB + hstep, voffB); PG8_STAGE(PG8_SA(0, 0), cA, voffA); PG8_STAGE(PG8_SA(0, 1), cA + hstep, voffA);
        if (wr == 1) PG8_BAR;
        PG8_WAIT_V(2); PG8_BAR;
        PG8_STAGE(PG8_SB(1, 0), cB + kstep, voffB); PG8_STAGE(PG8_SA(1, 0), cA + kstep, voffA); PG8_STAGE(PG8_SB(1, 1), cB + hstep + kstep, voffB);
        PG8_WAIT_V(6); PG8_BAR;
    } else {
        PG8_STAGE(PG8_SB(0, 0), cB, voffB); PG8_STAGE(PG8_SA(0, 0), cA, voffA); PG8_STAGE(PG8_SB(0, 1), cB + hstep, voffB); PG8_STAGE(PG8_SA(0, 1), cA + hstep, voffA);
        if (wr == 1) PG8_BAR;
        PG8_WAIT_V(4); PG8_BAR;
        PG8_STAGE(PG8_SB(1, 0), cB + kstep, voffB); PG8_STAGE(PG8_SA(1, 0), cA + kstep, voffA); PG8_STAGE(PG8_SB(1, 1), cB + hstep + kstep, voffB);
        PG8_WAIT_V(6); PG8_BAR;
    }
    for (;;) {
        const bool has_next = S.next(ui + 1, nxt);
        const char* nA = has_next ? (const char*)g.A + (size_t)nxt.pm * tstep : cA; const char* nB = has_next ? (const char*)g.Bt + (size_t)nxt.pn * tstep : cB;
        for (int t = 0; t < nt; t += 2) {
            const bool last = (t == nt - 2);
            const char* a1 = cA + (size_t)(t + 1) * kstep;
            const char* a2 = last ? nA : cA + (size_t)(t + 2) * kstep; const char* b2 = last ? nB : cB + (size_t)(t + 2) * kstep;
            const char* a3 = a2 + kstep; const char* b3 = b2 + kstep;
            if (last && has_next) S.a_ready(nxt);
            if constexpr (SP2) {
            PG8_LDB(B0, 0, 0); PG8_LDB(B1, 0, 1); PG8_SCHED; PG8_LDA(At, 0, 0); PG8_STAGE(PG8_SA(1, 1), a1 + hstep, voffA);
            PG8_WAIT_V(8); PG8_WAIT_L(0); PG8_BAR; PG8_MMA(0, 0, At, B0); PG8_MMA(0, 1, At, B1); PG8_BAR; PG8_SCHED;
            PG8_LDA(At, 0, 1); PG8_STAGE(PG8_SB(0, 0), b2, voffB); PG8_STAGE(PG8_SB(0, 1), b2 + hstep, voffB); PG8_STAGE(PG8_SA(0, 0), a2, voffA);
            PG8_WAIT_V(8); PG8_WAIT_L(0); PG8_BAR; PG8_MMA(1, 0, At, B0); PG8_MMA(1, 1, At, B1); PG8_BAR; PG8_SCHED;
            PG8_LDB(B0, 1, 0); PG8_LDB(B1, 1, 1); PG8_SCHED; PG8_LDA(At, 1, 0); PG8_STAGE(PG8_SA(0, 1), a2 + hstep, voffA);
            PG8_WAIT_V(8); PG8_WAIT_L(0); PG8_BAR; PG8_MMA(0, 0, At, B0); PG8_MMA(0, 1, At, B1); PG8_BAR; PG8_SCHED;
            PG8_LDA(At, 1, 1); PG8_STAGE(PG8_SB(1, 0), b3, voffB); PG8_STAGE(PG8_SB(1, 1), b3 + hstep, voffB); PG8_STAGE(PG8_SA(1, 0), a3, voffA);
            PG8_WAIT_V(8); PG8_WAIT_L(0); PG8_BAR; PG8_MMA(1, 0, At, B0); PG8_MMA(1, 1, At, B1); PG8_BAR; PG8_SCHED;
            } else {
            PG8_LDB(B0, 0, 0); PG8_SCHED; PG8_LDA(At, 0, 0); PG8_STAGE(PG8_SA(1, 1), a1 + hstep, voffA);
            PG8_WAIT_L(8); PG8_BAR; PG8_WAIT_L(0); PG8_MMA(0, 0, At, B0); PG8_BAR; PG8_SCHED;
            PG8_LDB(B1, 0, 1); PG8_STAGE(PG8_SB(0, 0), b2, voffB);
            PG8_BAR; PG8_WAIT_L(0); PG8_MMA(0, 1, At, B1); PG8_BAR;
            PG8_LDA(At, 0, 1); PG8_STAGE(PG8_SA(0, 0), a2, voffA);
            PG8_BAR; PG8_WAIT_L(0); PG8_MMA(1, 0, At, B0); PG8_BAR; PG8_SCHED;
            PG8_STAGE(PG8_SB(0, 1), b2 + hstep, voffB);
            PG8_WAIT_V(6); PG8_BAR; PG8_MMA(1, 1, At, B1); PG8_BAR;
            PG8_LDB(B0, 1, 0); PG8_SCHED; PG8_LDA(At, 1, 0); PG8_STAGE(PG8_SA(0, 1), a2 + hstep, voffA);
            PG8_WAIT_L(8); PG8_BAR; PG8_WAIT_L(0); PG8_MMA(0, 0, At, B0); PG8_BAR; PG8_SCHED;
            PG8_LDB(B1, 1, 1); PG8_STAGE(PG8_SB(1, 0), b3, voffB);
            PG8_BAR; PG8_WAIT_L(0); PG8_MMA(0, 1, At, B1); PG8_BAR;
            PG8_LDA(At, 1, 1); PG8_STAGE(PG8_SA(1, 0), a3, voffA);
            PG8_BAR; PG8_WAIT_L(0); PG8_MMA(1, 0, At, B0); PG8_BAR; PG8_SCHED;
            PG8_STAGE(PG8_SB(1, 1), b3 + hstep, voffB);
            PG8_WAIT_V(6); PG8_BAR; PG8_MMA(1, 1, At, B1); PG8_BAR;
            }
        }
        if constexpr (ALIGN_EPI) { if (wr == 0) PG8_BAR; }
        if constexpr (!Epi::AFTER_DRAIN) { E(acc, cur, wr, wc, fr, fq); S.done(cur); }
        if (!has_next) break;
#pragma unroll
        for (int a = 0; a < 2; ++a)
#pragma unroll
            for (int b = 0; b < 2; ++b)
#pragma unroll
                for (int m = 0; m < 4; ++m)
#pragma unroll
                    for (int n = 0; n < 2; ++n) acc[a][b][m][n] = (f32x4){0.f, 0.f, 0.f, 0.f};
        cur = nxt; cA = nA; cB = nB; ++ui;
        if constexpr (ALIGN_EPI) { if (wr == 1) PG8_BAR; }
    }
    PG8_WAIT_V(0);
    if constexpr (!ALIGN_EPI) { if (wr == 0) PG8_BAR; }
    PG8_BAR;
    if constexpr (Epi::AFTER_DRAIN) { E.fused(acc, cur, wr, wc, fr, fq, lds, wid, lane); S.done(cur); }
#undef PG8_SA
#undef PG8_SB
#undef PG8_STAGE
#undef PG8_LDA
#undef PG8_LDB
#undef PG8_MMA
#undef PG8_WAIT_V
#undef PG8_WAIT_L
#undef PG8_BAR
#undef PG8_SCHED
}
}

constexpr int NB = 16, SEQ = 2048, DM = 1024, DEPTH = 4, DIN = 2048, DFF = 2816, M = NB * SEQ;
constexpr float EPS = 1e-6f;
constexpr size_t MiB = 1u << 20;
constexpr size_t WS_WIN = 0, WS_WOUT = 16 * MiB, WS_WGU = 24 * MiB, WS_WDN = 68 * MiB, WS_SGUW = 90 * MiB, WS_PWT = 90 * MiB + 512 * 1024,
                 WS_SS = 91 * MiB, WS_BAR = 93 * MiB, WS_XB = 96 * MiB, WS_PROJ = 160 * MiB, WS_YCAT = 288 * MiB, WS_HID = 160 * MiB, WS_END = 352 * MiB;
constexpr int LDS_BYTES = 160 * 1024;
constexpr int NTHR = 512;

#define LAS __attribute__((address_space(3)))
typedef unsigned short bf16_t;
typedef short bf16x8 __attribute__((ext_vector_type(8)));
typedef float f32x4 __attribute__((ext_vector_type(4)));
typedef float f32x2 __attribute__((ext_vector_type(2)));
typedef unsigned u32x4 __attribute__((ext_vector_type(4)));
typedef unsigned u32x2 __attribute__((ext_vector_type(2)));
typedef __bf16 bf16x2_t __attribute__((ext_vector_type(2)));

__device__ __forceinline__ unsigned pk2(float lo, float hi) { f32x2 v = {lo, hi}; bf16x2_t b = __builtin_convertvector(v, bf16x2_t); return __builtin_bit_cast(unsigned, b); }
__device__ __forceinline__ bf16_t f2bf(float f) { return (bf16_t)(pk2(f, 0.f) & 0xffffu); }
__device__ __forceinline__ float bflo(unsigned w) { return __uint_as_float(w << 16); }
__device__ __forceinline__ float bfhi(unsigned w) { return __uint_as_float(w & 0xffff0000u); }
#define MFMA16(a, b, c) __builtin_amdgcn_mfma_f32_16x16x32_bf16((a), (b), (c), 0, 0, 0)
#define CFENCE() asm volatile("" ::: "memory")
#define LDSWAIT() asm volatile("s_waitcnt lgkmcnt(0)" ::: "memory")
__device__ __forceinline__ float fexp(float x) { return __builtin_amdgcn_exp2f(x * 1.4426950408889634f); }
__device__ __forceinline__ float gelu_tanh(float x) {
    const float u2 = 1.5957691216057308f * x * (1.0f + 0.044715f * x * x);
    return x * __builtin_amdgcn_rcpf(1.0f + fexp(-u2));
}
__device__ __forceinline__ float rstd_of1(const float* ss, int row) {
    const f32x4 s = *(const f32x4*)(ss + (size_t)row * 4); return rsqrtf(((s.x + s.y) + (s.z + s.w)) * (1.0f / 1024.0f) + EPS);
}

#ifdef USE_WT
__device__ __forceinline__ void st16(void* p, const u32x4 v) { asm volatile("global_store_dwordx4 %0, %1, off sc1\n\ts_nop 1" :: "v"(p), "v"(v) : "memory"); }
#else
__device__ __forceinline__ void st16(void* p, const u32x4 v) { *(u32x4*)p = v; }
#endif
__device__ __forceinline__ float ssq4(const f32x4 y) { return (y[0] * y[0] + y[1] * y[1]) + (y[2] * y[2] + y[3] * y[3]); }

#ifdef PROBE_RSTD2
__device__ __forceinline__ float rstd_of(const float* ss, int row) { const float a = rstd_of1(ss, row); int z; asm volatile("v_mov_b32 %0, 0" : "=v"(z) : "v"(a)); const float b = rstd_of1(ss, row + z); return (a + b) * 0.5f; }
#else
__device__ __forceinline__ float rstd_of(const float* ss, int row) { return rstd_of1(ss, row); }
#endif
namespace pg8 {
struct EpiIn {
    static constexpr bool PERM = true, AFTER_DRAIN = false;
    bf16_t* O; const float* ss; LAS float* T;
    __device__ __forceinline__ void operator()(const f32x4 (&acc)[2][2][4][2], const Unit& u, int wr, int wc, int fr, int fq) const {
        const int row0 = u.pm * BM + wr * 64 + fr, col0 = u.pn * BM + wc * 32 + 8 * fq; const bool act = u.pn < 2;
        float rsv[2][4];
        {
            volatile LAS int* TAG = (volatile LAS int*)(T + 256);
            if (TAG[0] != u.pm) {
                const int t = wr * 256 + wc * 64 + fq * 16 + fr;
                if (t < 256) T[t] = rstd_of(ss, u.pm * BM + t);
                asm volatile("s_waitcnt lgkmcnt(0)" ::: "memory"); __builtin_amdgcn_s_barrier(); asm volatile("" ::: "memory");
                if (t == 0) TAG[0] = u.pm; }
#pragma unroll
            for (int ai = 0; ai < 2; ++ai)
#pragma unroll
                for (int m = 0; m < 4; ++m) rsv[ai][m] = T[wr * 64 + fr + ai * HALF + m * 16]; }
#pragma unroll
        for (int ai = 0; ai < 2; ++ai)
#pragma unroll
            for (int m = 0; m < 4; ++m) { const int row = row0 + ai * HALF + m * 16; const float rs = rsv[ai][m]; bf16_t* rowp = O + (size_t)row * DIN + col0;
#pragma unroll
                for (int bj = 0; bj < 2; ++bj) { f32x4 v0 = acc[ai][bj][m][0] * rs, v1 = acc[ai][bj][m][1] * rs;
                    if (act) { v0 = (f32x4){gelu_tanh(v0[0]), gelu_tanh(v0[1]), gelu_tanh(v0[2]), gelu_tanh(v0[3])}; v1 = (f32x4){gelu_tanh(v1[0]), gelu_tanh(v1[1]), gelu_tanh(v1[2]), gelu_tanh(v1[3])}; }
                    u32x4 w; w.x = pk2(v0[0], v0[1]); w.y = pk2(v0[2], v0[3]); w.z = pk2(v1[0], v1[1]); w.w = pk2(v1[2], v1[3]);
                    st16(rowp + bj * HALF, w); }
                if (m & 1) CFENCE(); }
    }
};
struct EpiGU {
    static constexpr bool PERM = true, AFTER_DRAIN = false;
    bf16_t* O; const float* ss; LAS float* T;
    __device__ __forceinline__ void operator()(const f32x4 (&acc)[2][2][4][2], const Unit& u, int wr, int wc, int fr, int fq) const {
        const int row0 = u.pm * BM + wr * 64 + fr, col0 = u.pn * HALF + wc * 32 + 8 * fq;
        float rsv[2][4];
        {
            volatile LAS int* TAG = (volatile LAS int*)(T + 256);
            if (TAG[0] != u.pm) {
                const int t = wr * 256 + wc * 64 + fq * 16 + fr;
                if (t < 256) T[t] = rstd_of(ss, u.pm * BM + t);
                asm volatile("s_waitcnt lgkmcnt(0)" ::: "memory"); __builtin_amdgcn_s_barrier(); asm volatile("" ::: "memory");
                if (t == 0) TAG[0] = u.pm; }
#pragma unroll
            for (int ai = 0; ai < 2; ++ai)
#pragma unroll
                for (int m = 0; m < 4; ++m) rsv[ai][m] = T[wr * 64 + fr + ai * HALF + m * 16]; }
#pragma unroll
        for (int ai = 0; ai < 2; ++ai)
#pragma unroll
            for (int m = 0; m < 4; ++m) { const int row = row0 + ai * HALF + m * 16; const float rs = rsv[ai][m]; bf16_t* rowp = O + (size_t)row * DFF + col0;
                float h[8];
#pragma unroll
                for (int n = 0; n < 2; ++n)
#pragma unroll
                    for (int e = 0; e < 4; ++e) { const float g = acc[ai][0][m][n][e] * rs, up = acc[ai][1][m][n][e] * rs; h[n * 4 + e] = g * up * __builtin_amdgcn_rcpf(1.0f + fexp(-g)); }
                u32x4 w; w.x = pk2(h[0], h[1]); w.y = pk2(h[2], h[3]); w.z = pk2(h[4], h[5]); w.w = pk2(h[6], h[7]);
                st16(rowp, w);
                if (m & 1) CFENCE(); }
    }
};
struct EpiRes {
    static constexpr bool PERM = true, AFTER_DRAIN = false;
    const float* xin32; float* xout32; bf16_t* xb; float* ss; LAS float* P;
    __device__ __forceinline__ void operator()(const f32x4 (&acc)[2][2][4][2], const Unit& u, int wr, int wc, int fr, int fq) const {
        const int row0 = u.pm * BM + wr * 64 + fr, col0 = u.pn * BM + wc * 32 + 8 * fq;
        if (xin32) {
#pragma unroll
            for (int ai = 0; ai < 2; ++ai)
#pragma unroll
                for (int m = 0; m < 4; ++m) { const int row = row0 + ai * HALF + m * 16; const size_t off = (size_t)row * DM + col0; float q = 0.f;
#pragma unroll
                    for (int bj = 0; bj < 2; ++bj) { const f32x4 r0 = *(const f32x4*)(xin32 + off + bj * HALF), r1 = *(const f32x4*)(xin32 + off + bj * HALF + 4);
                        const f32x4 v0 = r0 + acc[ai][bj][m][0], v1 = r1 + acc[ai][bj][m][1];
                        q += ssq4(v0) + ssq4(v1);
                        u32x4 w; w.x = pk2(v0[0], v0[1]); w.y = pk2(v0[2], v0[3]); w.z = pk2(v1[0], v1[1]); w.w = pk2(v1[2], v1[3]); st16(xb + off + bj * HALF, w); }
                    q += __shfl_xor(q, 16); q += __shfl_xor(q, 32);
                    if (fq == 0) P[(ai * HALF + wr * 64 + m * 16 + fr) * 4 + wc] = q;
                    if (m & 1) CFENCE(); }
        } else {
#pragma unroll
            for (int ai = 0; ai < 2; ++ai) {
                u32x4 rr[4][2];
#pragma unroll
                for (int m = 0; m < 4; ++m)
#pragma unroll
                    for (int bj = 0; bj < 2; ++bj) rr[m][bj] = *(const u32x4*)(xb + (size_t)(row0 + ai * HALF + m * 16) * DM + col0 + bj * HALF);
#pragma unroll
                for (int m = 0; m < 4; ++m) { const int row = row0 + ai * HALF + m * 16; const size_t off = (size_t)row * DM + col0; float q = 0.f;
#pragma unroll
                    for (int bj = 0; bj < 2; ++bj) { const u32x4 t = rr[m][bj];
                        const f32x4 r0 = (f32x4){bflo(t.x), bfhi(t.x), bflo(t.y), bfhi(t.y)}, r1 = (f32x4){bflo(t.z), bfhi(t.z), bflo(t.w), bfhi(t.w)};
                        const f32x4 v0 = r0 + acc[ai][bj][m][0], v1 = r1 + acc[ai][bj][m][1];
                        q += ssq4(v0) + ssq4(v1);
                        if (xout32) { st16(xout32 + off + bj * HALF, __builtin_bit_cast(u32x4, v0)); st16(xout32 + off + bj * HALF + 4, __builtin_bit_cast(u32x4, v1)); }
                        else { u32x4 w; w.x = pk2(v0[0], v0[1]); w.y = pk2(v0[2], v0[3]); w.z = pk2(v1[0], v1[1]); w.w = pk2(v1[2], v1[3]); st16(xb + off + bj * HALF, w); } }
                    q += __shfl_xor(q, 16); q += __shfl_xor(q, 32);
                    if (fq == 0) P[(ai * HALF + wr * 64 + m * 16 + fr) * 4 + wc] = q; }
                CFENCE(); }
        }
        asm volatile("s_waitcnt lgkmcnt(0)" ::: "memory"); __builtin_amdgcn_s_barrier(); asm volatile("" ::: "memory");
        const int t = wr * 256 + wc * 64 + fq * 16 + fr;
        if (t < 256) { const f32x4 pp = *(const LAS f32x4*)(P + t * 4); ss[(size_t)(u.pm * BM + t) * 4 + u.pn] = (pp.x + pp.y) + (pp.z + pp.w); }
    }
};
}

__device__ __forceinline__ void transpose_item(const float* W, int K, int N, bf16_t* WT, const float* gain, int mode, LAS float* scr, int item, int lane) {
    const int nblk = N / 32, kb = item / nblk, nb = item % nblk, k0 = 64 * kb, n0 = 32 * nb;
    const int c = lane & 7;
    f32x4 g0 = {1.f, 1.f, 1.f, 1.f}, g1 = {1.f, 1.f, 1.f, 1.f};
    if (gain) { g0 = *(const f32x4*)(gain + k0 + 8 * c); g1 = *(const f32x4*)(gain + k0 + 8 * c + 4); }
    const float* src = W + (size_t)(k0 + (lane >> 5)) * N + n0 + (lane & 31);
    float v[32];
#pragma unroll
    for (int i = 0; i < 32; ++i) v[i] = __builtin_nontemporal_load(src + (size_t)(2 * i) * N);
#pragma unroll
    for (int i = 0; i < 32; ++i) scr[(2 * i + (lane >> 5)) * 33 + (lane & 31)] = v[i];
    LDSWAIT();
#pragma unroll
    for (int j = 0; j < 4; ++j) { const int n = (lane >> 3) + 8 * j, gn = n0 + n; const LAS float* s = scr + (8 * c) * 33 + n;
        float cs = 1.0f; int row = gn;
        if (mode == 1) { if ((gn >= 768 && gn < 1024) || (gn >= 1280 && gn < 1536)) cs = 0.125f; }
        if (mode == 2) { const int jj = gn < DFF ? gn : gn - DFF; row = 256 * (jj >> 7) + (jj & 127) + (gn < DFF ? 0 : 128); }
        u32x4 o; o.x = pk2(s[0 * 33] * g0[0] * cs, s[1 * 33] * g0[1] * cs); o.y = pk2(s[2 * 33] * g0[2] * cs, s[3 * 33] * g0[3] * cs); o.z = pk2(s[4 * 33] * g1[0] * cs, s[5 * 33] * g1[1] * cs); o.w = pk2(s[6 * 33] * g1[2] * cs, s[7 * 33] * g1[3] * cs);
        *(u32x4*)(WT + (size_t)row * K + k0 + 8 * c) = o; }
    LDSWAIT();
}
__device__ __forceinline__ float wave_sum(float v) {
#pragma unroll
    for (int o = 1; o < 64; o <<= 1) v += __shfl_xor(v, o);
    return v;
}

struct Params {
    const float *x, *w_in, *w_out, *sgu_w, *sgu_b, *pool_w, *pool_scale, *swa_sinks, *rel_bias, *mix_out_gain, *norm_mix, *norm_ffn, *w_gate_up, *w_down, *norm_final;
    float* out; unsigned char* ws;
};


__device__ __forceinline__ void st4(bf16_t* p, const f32x4 y) { u32x2 o; o.x = pk2(y[0], y[1]); o.y = pk2(y[2], y[3]); *(u32x2*)p = o; }
#define VMWAIT() asm volatile("s_waitcnt vmcnt(0)" ::: "memory")
typedef short v4i16_t __attribute__((ext_vector_type(4)));
__device__ __forceinline__ bf16x8 tr_frag(const LAS bf16_t* p, int rows4) {
    const v4i16_t lo = __builtin_amdgcn_ds_read_tr16_b64_v4i16((LAS v4i16_t*)p);
    const v4i16_t hi = __builtin_amdgcn_ds_read_tr16_b64_v4i16((LAS v4i16_t*)(p + rows4));
    return (bf16x8){lo[0], lo[1], lo[2], lo[3], hi[0], hi[1], hi[2], hi[3]};
}

__device__ __forceinline__ void mixer_A(LAS unsigned char* L, const bf16_t* proj, const bf16_t* sguw, const float* sgub, bf16_t* ycat, int b, int ch, int tid, int lane, int w) {
    constexpr int VS = 264;
    LAS bf16_t* VL = (LAS bf16_t*)L;
    const size_t row0 = (size_t)b * SEQ + ch * 128;
    const int c = lane & 15, q = lane >> 4, wv = tid >> 6;
    const int nks = (w >> 1) + 1;
    const size_t trow = row0 + 16 * wv + c;
    const bf16_t* wbase = sguw + (size_t)(16 * wv + c) * 128 + 8 * q;
    const bf16_t* urow = proj + trow * DIN + 4 * q;
    bf16x8 bw[4][4]; u32x2 uu[4][4]; float bias[4];
#pragma unroll
    for (int h = 0; h < 4; ++h) { bias[h] = sgub[h * 128 + 16 * wv + c];
#pragma unroll
        for (int ks = 0; ks < 4; ++ks) if (ks < nks) bw[h][ks] = *(const bf16x8*)(wbase + h * 128 * 128 + 32 * ks);
#pragma unroll
        for (int n = 0; n < 4; ++n) uu[h][n] = *(const u32x2*)(urow + h * 64 + 16 * n); }
    {
        const int tok = tid >> 2, h = tid & 3;
        const bf16_t* src = proj + (row0 + tok) * DIN + 256 + h * 64;
        float v[64]; float s = 0.f;
#pragma unroll
        for (int i = 0; i < 8; ++i) { const u32x4 t = *(const u32x4*)(src + 8 * i);
            v[8 * i + 0] = bflo(t.x); v[8 * i + 1] = bfhi(t.x); v[8 * i + 2] = bflo(t.y); v[8 * i + 3] = bfhi(t.y); v[8 * i + 4] = bflo(t.z); v[8 * i + 5] = bfhi(t.z); v[8 * i + 6] = bflo(t.w); v[8 * i + 7] = bfhi(t.w); }
#pragma unroll
        for (int i = 0; i < 64; ++i) s += v[i];
        const float mean = s * (1.0f / 64.0f); float s2 = 0.f;
#pragma unroll
        for (int i = 0; i < 64; ++i) { v[i] -= mean; s2 += v[i] * v[i]; }
        const float rstd = rsqrtf(s2 * (1.0f / 64.0f) + EPS);
        LAS bf16_t* dst = VL + tok * VS + h * 64;
#pragma unroll
        for (int i = 0; i < 8; ++i) { u32x4 o; o.x = pk2(v[8 * i + 0] * rstd, v[8 * i + 1] * rstd); o.y = pk2(v[8 * i + 2] * rstd, v[8 * i + 3] * rstd); o.z = pk2(v[8 * i + 4] * rstd, v[8 * i + 5] * rstd); o.w = pk2(v[8 * i + 6] * rstd, v[8 * i + 7] * rstd);
            *(LAS u32x4*)(dst + 8 * i) = o; }
    }
    __syncthreads();
    const LAS bf16_t* vbase = VL + (8 * q + (c >> 2)) * VS + 4 * (c & 3);
    f32x4 yv[4][4]; float ssq = 0.f;
#pragma unroll
    for (int h = 0; h < 4; ++h) {
#pragma unroll
        for (int n = 0; n < 4; ++n) yv[h][n] = (f32x4){0.f, 0.f, 0.f, 0.f};
#pragma unroll
        for (int ks = 0; ks < 4; ++ks) if (ks < nks) {
#pragma unroll
            for (int n = 0; n < 4; ++n) { const bf16x8 a = tr_frag(vbase + 32 * ks * VS + h * 64 + 16 * n, 4 * VS); yv[h][n] = MFMA16(a, bw[h][ks], yv[h][n]); }
        }
#pragma unroll
        for (int n = 0; n < 4; ++n) { const u32x2 u2 = uu[h][n];
            f32x4 y; y[0] = bflo(u2.x) * (yv[h][n][0] + bias[h]); y[1] = bfhi(u2.x) * (yv[h][n][1] + bias[h]); y[2] = bflo(u2.y) * (yv[h][n][2] + bias[h]); y[3] = bfhi(u2.y) * (yv[h][n][3] + bias[h]);
            yv[h][n] = y; ssq += ssq4(y); }
    }
    ssq += __shfl_xor(ssq, 16); ssq += __shfl_xor(ssq, 32);
    const float rs = rsqrtf(ssq * (1.0f / 256.0f) + EPS);
    bf16_t* yrow = ycat + trow * DM + 0 + 4 * q;
#pragma unroll
    for (int h = 0; h < 4; ++h)
#pragma unroll
        for (int n = 0; n < 4; ++n) st4(yrow + h * 64 + 16 * n, yv[h][n] * rs);
}

__device__ __forceinline__ void mixer_B(LAS unsigned char* L, const bf16_t* proj, const bf16_t* pwt, const float* pscale, bf16_t* ycat, int b, int ch, int tid, int lane, int w) {
    constexpr int YS = 264;
    LAS bf16_t* PL = (LAS bf16_t*)L;
    LAS bf16_t* Y = (LAS bf16_t*)(L + 76032);
    const size_t row0 = (size_t)b * SEQ + ch * 128;
    const int c = lane & 15, q = lane >> 4, wv = tid >> 6;
    const bf16_t* pbase = pwt + (size_t)c * 64 + 8 * q;
    bf16x8 pw[4][4][2];
#pragma unroll
    for (int g = 0; g < 4; ++g)
#pragma unroll
        for (int n = 0; n < 4; ++n)
#pragma unroll
            for (int ks = 0; ks < 2; ++ks) pw[g][n][ks] = *(const bf16x8*)(pbase + (g * 64 + 16 * n) * 64 + 32 * ks);
    {
        u32x4 t[9];
#pragma unroll
        for (int i = 0; i < 9; ++i) { const int id = tid + 512 * i, r = id >> 5, cc = id & 31; t[i] = (u32x4){0u, 0u, 0u, 0u};
            if (id < 143 * 32 && (ch > 0 || r >= 15)) t[i] = *(const u32x4*)(proj + (row0 - 15 + r) * DIN + 512 + 8 * cc); }
#pragma unroll
        for (int i = 0; i < 9; ++i) { const int id = tid + 512 * i, r = id >> 5, cc = id & 31; if (id < 143 * 32) *(LAS u32x4*)(PL + r * YS + 8 * cc) = t[i]; }
    }
    __syncthreads();
    {
        const int cc = tid & 31, t0 = (tid >> 5) * 8; const int win = 2 << (cc >> 3);
        const LAS bf16_t* col = PL + 15 * YS + 8 * cc;
        float S[8];
#pragma unroll
        for (int e = 0; e < 8; ++e) S[e] = 0.f;
#pragma unroll 1
        for (int j = 0; j < win; ++j) { const u32x4 t = *(const LAS u32x4*)(col + (t0 - j) * YS);
            S[0] += bflo(t.x); S[1] += bfhi(t.x); S[2] += bflo(t.y); S[3] += bfhi(t.y); S[4] += bflo(t.z); S[5] += bfhi(t.z); S[6] += bflo(t.w); S[7] += bfhi(t.w); }
#pragma unroll
        for (int i = 0; i < 8; ++i) { const int t = t0 + i; const u32x4 pt = *(const LAS u32x4*)(col + t * YS);
            const float p0 = bflo(pt.x), p1 = bfhi(pt.x), p2 = bflo(pt.y), p3 = bfhi(pt.y), p4 = bflo(pt.z), p5 = bfhi(pt.z), p6 = bflo(pt.w), p7 = bfhi(pt.w);
            if (i > 0) { const u32x4 po = *(const LAS u32x4*)(col + (t - win) * YS);
                S[0] += p0 - bflo(po.x); S[1] += p1 - bfhi(po.x); S[2] += p2 - bflo(po.y); S[3] += p3 - bfhi(po.y); S[4] += p4 - bflo(po.z); S[5] += p5 - bfhi(po.z); S[6] += p6 - bflo(po.w); S[7] += p7 - bfhi(po.w); }
            const int tseq = ch * 128 + t; const int cnt = (tseq + 1 < win) ? (tseq + 1) : win; const float inv = 1.0f / (float)cnt;
            u32x4 o; o.x = pk2(S[0] * inv - p0, S[1] * inv - p1); o.y = pk2(S[2] * inv - p2, S[3] * inv - p3); o.z = pk2(S[4] * inv - p4, S[5] * inv - p5); o.w = pk2(S[6] * inv - p6, S[7] * inv - p7);
            *(LAS u32x4*)(Y + t * YS + 8 * cc) = o; }
    }
    __syncthreads();
    const size_t trow = row0 + 16 * wv + c; float ssq = 0.f;
    const LAS bf16_t* ybase = Y + (16 * wv + c) * YS + 8 * q;
    f32x4 yv[4][4];
#pragma unroll
    for (int g = 0; g < 4; ++g) {
#pragma unroll
        for (int n = 0; n < 4; ++n) yv[g][n] = (f32x4){0.f, 0.f, 0.f, 0.f};
#pragma unroll
        for (int ks = 0; ks < 2; ++ks) { const bf16x8 bfrag = *(const LAS bf16x8*)(ybase + g * 64 + 32 * ks);
#pragma unroll
            for (int n = 0; n < 4; ++n) yv[g][n] = MFMA16(pw[g][n][ks], bfrag, yv[g][n]); }
#pragma unroll
        for (int n = 0; n < 4; ++n) { const f32x4 sc = *(const f32x4*)(pscale + g * 64 + 16 * n + 4 * q); yv[g][n] = yv[g][n] * sc; ssq += ssq4(yv[g][n]); }
    }
    ssq += __shfl_xor(ssq, 16); ssq += __shfl_xor(ssq, 32);
    const float rs = rsqrtf(ssq * (1.0f / 256.0f) + EPS);
    bf16_t* yrow = ycat + trow * DM + 256 + 4 * q;
#pragma unroll
    for (int g = 0; g < 4; ++g)
#pragma unroll
        for (int n = 0; n < 4; ++n) st4(yrow + g * 64 + 16 * n, yv[g][n] * rs);
}

__device__ __forceinline__ bf16x8 tr_frag_perm(const LAS bf16_t* p, int rows16) {
    const v4i16_t lo = __builtin_amdgcn_ds_read_tr16_b64_v4i16((LAS v4i16_t*)p);
    const v4i16_t hi = __builtin_amdgcn_ds_read_tr16_b64_v4i16((LAS v4i16_t*)(p + rows16));
    return (bf16x8){lo[0], lo[1], lo[2], lo[3], hi[0], hi[1], hi[2], hi[3]};
}
__device__ __forceinline__ bf16x8 pack8(const f32x4 a, const f32x4 b) { u32x4 o; o.x = pk2(a[0], a[1]); o.y = pk2(a[2], a[3]); o.z = pk2(b[0], b[1]); o.w = pk2(b[2], b[3]); return __builtin_bit_cast(bf16x8, o); }

__device__ __forceinline__ void mixer_C(LAS unsigned char* L, const bf16_t* proj, const float* sinks, const float* rel_bias, bf16_t* ycat, int b, int qb, int tid, int lane, int w) {
    constexpr int KS = 144;
    const int wv = tid >> 6;
    LAS bf16_t* KL = (LAS bf16_t*)L;
    LAS bf16_t* VL = (LAS bf16_t*)(L + 73728);
    LAS float* BT = (LAS float*)(L + 152064);
    const size_t row0 = (size_t)b * SEQ + qb * 128;
    const int c = lane & 15, q = lane >> 4;
    const size_t trow = row0 + 16 * wv + c;
    {
        const int skey = tid >> 1, shalf = tid & 1; const bool okk = (qb > 0) || (skey >= 128);
        const bf16_t* ksrc = proj + (row0 - 128 + skey) * DIN + 1024 + shalf * 64;
        u32x4 kr[8], vr[8];
#pragma unroll
        for (int i = 0; i < 8; ++i) { kr[i] = (u32x4){0u, 0u, 0u, 0u}; vr[i] = (u32x4){0u, 0u, 0u, 0u}; if (okk) { kr[i] = *(const u32x4*)(ksrc + 8 * i); vr[i] = *(const u32x4*)(ksrc + 128 + 8 * i); } }
        { const int j = tid >> 7, dist = tid & 127; int bucket = dist;
          if (dist >= 16) { const int lg = 16 + (int)(__logf((float)dist * (1.0f / 16.0f)) / 2.0794415416798357f * 16.0f); bucket = lg < 31 ? lg : 31; }
          BT[j * 128 + dist] = rel_bias[bucket * 4 + j];
          if (tid < 288) *(LAS u32x4*)(VL + 256 * KS + 8 * tid) = (u32x4){0u, 0u, 0u, 0u}; }
#pragma unroll
        for (int i = 0; i < 8; ++i) { *(LAS u32x4*)(KL + skey * KS + shalf * 64 + 8 * i) = kr[i]; *(LAS u32x4*)(VL + skey * KS + shalf * 64 + 8 * i) = vr[i]; }
    }
    bf16x8 qf[4][2];
#pragma unroll
    for (int j = 0; j < 4; ++j)
#pragma unroll
        for (int ks = 0; ks < 2; ++ks) qf[j][ks] = *(const bf16x8*)(proj + trow * DIN + 768 + j * 64 + 32 * ks + 8 * q);
    __syncthreads();
    const LAS bf16_t* kbase = KL + (16 * wv + c) * KS + 8 * q;
    const LAS bf16_t* vbase = VL + (16 * wv + 4 * q + (c >> 2)) * KS + 4 * (c & 3);
    f32x4 yv[4][4]; float ssq = 0.f;
#pragma unroll
    for (int j = 0; j < 4; ++j) { const int kvh = j >> 1;
        f32x4 z[9];
#pragma unroll
        for (int kti = 0; kti < 9; ++kti) { z[kti] = (f32x4){0.f, 0.f, 0.f, 0.f};
#pragma unroll
            for (int ks = 0; ks < 2; ++ks) { const bf16x8 a = *(const LAS bf16x8*)(kbase + 16 * kti * KS + kvh * 64 + 32 * ks); z[kti] = MFMA16(a, qf[j][ks], z[kti]); } }
        const float sink = sinks[j]; const LAS float* bt = BT + j * 128;
        int zz; asm volatile("v_mov_b32 %0, 0" : "=v"(zz));
        const int cz = c + zz; const int klo = (qb > 0) ? (cz + 1) : max(cz + 1, 128 - 16 * w), khi = cz + 128;
        float mx = sink;
#pragma unroll
        for (int kti = 0; kti < 9; ++kti)
#pragma unroll
            for (int r = 0; r < 4; ++r) { const int kl = 16 * kti + 4 * q + r; const int dist = 128 + cz - kl; const bool valid = (unsigned)(kl - klo) <= (unsigned)(khi - klo);
                const float bb = bt[dist & 127]; const float v = valid ? (z[kti][r] + bb) : -1e30f; z[kti][r] = v; mx = fmaxf(mx, v); }
        mx = fmaxf(mx, __shfl_xor(mx, 16)); mx = fmaxf(mx, __shfl_xor(mx, 32));
        float sum = 0.f;
#pragma unroll
        for (int kti = 0; kti < 9; ++kti)
#pragma unroll
            for (int r = 0; r < 4; ++r) { const float p = (z[kti][r] > -1e29f) ? fexp(z[kti][r] - mx) : 0.f; z[kti][r] = p; sum += p; }
        sum += __shfl_xor(sum, 16); sum += __shfl_xor(sum, 32);
        const float inv = 1.0f / (sum + fexp(sink - mx));
#pragma unroll
        for (int n = 0; n < 4; ++n) yv[j][n] = (f32x4){0.f, 0.f, 0.f, 0.f};
#pragma unroll
        for (int ks = 0; ks < 5; ++ks) { const f32x4 zero4 = {0.f, 0.f, 0.f, 0.f};
            const bf16x8 bfrag = pack8(z[2 * ks] * inv, (ks < 4) ? (z[(ks < 4) ? 2 * ks + 1 : 0] * inv) : zero4);
#pragma unroll
            for (int n = 0; n < 4; ++n) { const bf16x8 a = tr_frag_perm(vbase + 32 * ks * KS + kvh * 64 + 16 * n, 16 * KS); yv[j][n] = MFMA16(a, bfrag, yv[j][n]); } }
#pragma unroll
        for (int n = 0; n < 4; ++n) ssq += ssq4(yv[j][n]);
    }
    ssq += __shfl_xor(ssq, 16); ssq += __shfl_xor(ssq, 32);
    const float rs = rsqrtf(ssq * (1.0f / 256.0f) + EPS);
    bf16_t* yrow = ycat + trow * DM + 512 + 4 * q;
#pragma unroll
    for (int j = 0; j < 4; ++j)
#pragma unroll
        for (int n = 0; n < 4; ++n) st4(yrow + j * 64 + 16 * n, yv[j][n] * rs);
}

#ifndef D_CUT
#define D_CUT 2.0e-9f
#endif
__device__ __forceinline__ void mixer_D(LAS unsigned char* L, const bf16_t* proj, bf16_t* ycat, int b, int qb64, int tid, int lane, int w) {
    constexpr int KS = 272;
    constexpr int TILE = 64 * KS;
    const int wv = tid >> 6;
    LAS bf16_t* KL = (LAS bf16_t*)L;
    LAS bf16_t* VL = (LAS bf16_t*)(L + 69632);
    LAS float* RED = (LAS float*)(L + 139264);
    volatile LAS unsigned* FLG = (volatile LAS unsigned*)(L + 139776);
    const int rg = wv & 3, hp = wv >> 2, c = lane & 15, q = lane >> 4;
    const size_t seq0 = (size_t)b * SEQ; const size_t trow = seq0 + qb64 * 64 + 16 * rg + c;
    const int skey = tid >> 3, spart = tid & 7;
    const bf16_t* ksrc0 = proj + (seq0 + skey) * DIN + 1536 + spart * 32;
    LAS bf16_t* kdst = KL + skey * KS + spart * 32;
    LAS bf16_t* vdst = VL + skey * KS + spart * 32;
    u32x4 kr[4], vr[4];
    { const bf16_t* ksrc = ksrc0 + (size_t)qb64 * 64 * DIN;
#pragma unroll
        for (int i = 0; i < 4; ++i) { kr[i] = *(const u32x4*)(ksrc + 8 * i); vr[i] = *(const u32x4*)(ksrc + 256 + 8 * i); } }
    bf16x8 qf[2][2];
#pragma unroll
    for (int hh = 0; hh < 2; ++hh)
#pragma unroll
        for (int ks = 0; ks < 2; ++ks) qf[hh][ks] = *(const bf16x8*)(proj + trow * DIN + 1280 + (2 * hp + hh) * 64 + 32 * ks + 8 * q);
    f32x4 acc[2][4];
#pragma unroll
    for (int hh = 0; hh < 2; ++hh)
#pragma unroll
        for (int n = 0; n < 4; ++n) acc[hh][n] = (f32x4){0.f, 0.f, 0.f, 0.f};
    float rem[2] = {1.f, 1.f};
    const int qloc = 16 * rg + c;
    const LAS bf16_t* kbase = KL + c * KS + hp * 128 + 8 * q;
    const LAS bf16_t* vbase = VL + (4 * q + (c >> 2)) * KS + hp * 128 + 4 * (c & 3);
    if (tid < 3) FLG[tid] = 0u;
#pragma unroll
    for (int i = 0; i < 4; ++i) { *(LAS u32x4*)(kdst + 8 * i) = kr[i]; *(LAS u32x4*)(vdst + 8 * i) = vr[i]; }
    u32x4 kr2[4], vr2[4];
    if (qb64 > 0) { const bf16_t* ksrc = ksrc0 + (size_t)(qb64 - 1) * 64 * DIN;
#pragma unroll
        for (int i = 0; i < 4; ++i) { kr[i] = *(const u32x4*)(ksrc + 8 * i); vr[i] = *(const u32x4*)(ksrc + 256 + 8 * i); } }
    if (qb64 > 1) { const bf16_t* ksrc = ksrc0 + (size_t)(qb64 - 2) * 64 * DIN;
#pragma unroll
        for (int i = 0; i < 4; ++i) { kr2[i] = *(const u32x4*)(ksrc + 8 * i); vr2[i] = *(const u32x4*)(ksrc + 256 + 8 * i); } }
    else {
#pragma unroll
        for (int i = 0; i < 4; ++i) { kr2[i] = (u32x4){0u, 0u, 0u, 0u}; vr2[i] = (u32x4){0u, 0u, 0u, 0u}; } }
#define D_STEP(KW, VW) \
        __syncthreads(); \
        if (it > 0 && FLG[fprev] == 0u) break; \
        const int bo = (it & 1) * TILE, bn = ((it + 1) & 1) * TILE; \
        if (kt > 0) { \
            _Pragma("unroll") \
            for (int i = 0; i < 4; ++i) { *(LAS u32x4*)(kdst + bn + 8 * i) = KW[i]; *(LAS u32x4*)(vdst + bn + 8 * i) = VW[i]; } \
            if (kt > 2) { const bf16_t* ksrc = ksrc0 + (size_t)(kt - 3) * 64 * DIN; \
                _Pragma("unroll") \
                for (int i = 0; i < 4; ++i) { KW[i] = *(const u32x4*)(ksrc + 8 * i); VW[i] = *(const u32x4*)(ksrc + 256 + 8 * i); } } \
        } \
        if (tid == 0) FLG[fnext] = 0u; \
        const bool diag = (kt == qb64); \
_Pragma("unroll") \
        for (int hh = 0; hh < 2; ++hh) { \
            f32x4 z[4]; \
_Pragma("unroll") \
            for (int kti = 0; kti < 4; ++kti) { z[kti] = (f32x4){0.f, 0.f, 0.f, 0.f}; \
_Pragma("unroll") \
                for (int ks = 0; ks < 2; ++ks) { const bf16x8 a = *(const LAS bf16x8*)(kbase + bo + 16 * kti * KS + hh * 64 + 32 * ks); z[kti] = MFMA16(a, qf[hh][ks], z[kti]); } } \
            f32x4 ex[4]; float G[4]; \
            if (diag) { \
_Pragma("unroll") \
                for (int kti = 0; kti < 4; ++kti) { float run = 1.f; \
_Pragma("unroll") \
                    for (int r = 3; r >= 0; --r) { const bool valid = (16 * kti + 4 * q + r < qloc); \
                        const float u = fexp(fminf(z[kti][r], 80.f)); const float om = __builtin_amdgcn_rcpf(1.0f + u); \
                        z[kti][r] = valid ? u * om : 0.f; ex[kti][r] = run; run *= valid ? om : 1.f; } \
                    G[kti] = run; } \
            } else { \
_Pragma("unroll") \
                for (int kti = 0; kti < 4; ++kti) { float run = 1.f; \
_Pragma("unroll") \
                    for (int r = 3; r >= 0; --r) { const float u = fexp(fminf(z[kti][r], 80.f)); const float om = __builtin_amdgcn_rcpf(1.0f + u); \
                        z[kti][r] = u * om; ex[kti][r] = run; run *= om; } \
                    G[kti] = run; } \
            } \
            float E[4], Tk[4]; \
_Pragma("unroll") \
            for (int kti = 0; kti < 4; ++kti) { const float bq = __shfl_xor(G[kti], 16); const float ps = G[kti] * bq; const float c2 = __shfl_xor(ps, 32); \
                E[kti] = ((q & 1) ? 1.f : bq) * ((q < 2) ? c2 : 1.f); Tk[kti] = ps * c2; } \
            const float U2 = Tk[3], U1 = U2 * Tk[2], U0 = U1 * Tk[1]; \
            const float cb = rem[hh]; \
            const float base[4] = {cb * U0 * E[0], cb * U1 * E[1], cb * U2 * E[2], cb * E[3]}; \
            rem[hh] = cb * U0 * Tk[0]; \
_Pragma("unroll") \
            for (int kti = 0; kti < 4; ++kti) \
_Pragma("unroll") \
                for (int r = 0; r < 4; ++r) z[kti][r] = z[kti][r] * (base[kti] * ex[kti][r]); \
_Pragma("unroll") \
            for (int ks = 0; ks < 2; ++ks) { const bf16x8 bfrag = pack8(z[2 * ks], z[2 * ks + 1]); \
_Pragma("unroll") \
                for (int n = 0; n < 4; ++n) { const bf16x8 a = tr_frag_perm(vbase + bo + 32 * ks * KS + hh * 64 + 16 * n, 16 * KS); acc[hh][n] = MFMA16(a, bfrag, acc[hh][n]); } } \
        } \
        if (__builtin_amdgcn_ballot_w64(fmaxf(rem[0], rem[1]) > D_CUT) != 0ull) { if (lane == 0) FLG[fcur] = 1u; } \
        { const int t = fprev; fprev = fcur; fcur = fnext; fnext = t; }
    int it = 0, fprev = 2, fcur = 0, fnext = 1;
#pragma unroll 1
    for (int kt = qb64; kt >= 0; --kt, ++it) {
        { D_STEP(kr, vr) }
        if (kt == 0) break;
        --kt; ++it;
        { D_STEP(kr2, vr2) }
    }
#undef D_STEP
    float ssq = 0.f;
#pragma unroll
    for (int hh = 0; hh < 2; ++hh)
#pragma unroll
        for (int n = 0; n < 4; ++n) ssq += ssq4(acc[hh][n]);
    ssq += __shfl_xor(ssq, 16); ssq += __shfl_xor(ssq, 32);
    __syncthreads();
    if (q == 0) RED[(16 * rg + c) * 2 + hp] = ssq;
    __syncthreads();
    const float tot = RED[(16 * rg + c) * 2 + 0] + RED[(16 * rg + c) * 2 + 1];
    const float rs = rsqrtf(tot * (1.0f / 256.0f) + EPS);
    bf16_t* yrow = ycat + trow * DM + 768 + hp * 128 + 4 * q;
#pragma unroll
    for (int hh = 0; hh < 2; ++hh)
#pragma unroll
        for (int n = 0; n < 4; ++n) st4(yrow + hh * 64 + 16 * n, acc[hh][n] * rs);
}

#define XB_TMO      128
#define XB_XCNT(j)  (256  + 64 * (j))
#define XB_XSUB(j)  (1280 + 64 * (j))
#define XB_XGEN(j)  (2304 + 64 * (j))
#define XB_TOP      3328
#define XB_TOPGEN   3392
#define XCD_BAR_WORDS 3456
#define XB_SPIN_CAP (1u << 18)

__device__ __forceinline__ unsigned xb_ld(unsigned* p)              { return __hip_atomic_load(p, __ATOMIC_RELAXED, __HIP_MEMORY_SCOPE_AGENT); }
__device__ __forceinline__ unsigned xb_add(unsigned* p, unsigned v) { return __hip_atomic_fetch_add(p, v, __ATOMIC_RELAXED, __HIP_MEMORY_SCOPE_AGENT); }
__device__ __forceinline__ unsigned xb_xcc_id() { return (unsigned)__builtin_amdgcn_s_getreg((3 << 11) | 20) & 0xFu; }
#define XB_SPIN(cond, bar) do { unsigned _sp = 0; while (cond) { __builtin_amdgcn_s_sleep(1); \
    if ((++_sp & 255u) == 0u) { if (xb_ld(&(bar)[XB_TMO])) break; if (_sp > XB_SPIN_CAP) { atomicAdd(&(bar)[XB_TMO], 1u); break; } } } } while (0)

struct XcdBarrier {
    unsigned* bar; unsigned x;
    volatile LAS unsigned* st;
};

__device__ __forceinline__ XcdBarrier xcd_barrier_post(unsigned* bar, volatile LAS unsigned* st) {
    XcdBarrier b; b.bar = bar; b.x = xb_xcc_id(); b.st = st;
    if (threadIdx.x == 0) (void)xb_add(&bar[XB_XCNT(b.x)], 1u);
    return b;
}
__device__ __forceinline__ void xcd_barrier_complete(unsigned* bar, unsigned x, unsigned& nloc, unsigned& nx) {
    const unsigned G = gridDim.x * gridDim.y * gridDim.z;
    unsigned sum, cnt, mine, sp = 0u;
    for (;;) {
        sum = 0u; cnt = 0u; mine = 0u;
#pragma unroll
        for (unsigned j = 0; j < 16; ++j) { const unsigned c = xb_ld(&bar[XB_XCNT(j)]); sum += c; cnt += (c > 0u) ? 1u : 0u; mine = (j == x) ? c : mine; }
        if (sum == G) break;
        __builtin_amdgcn_s_sleep(1);
        if ((++sp & 255u) == 0u) { if (xb_ld(&bar[XB_TMO])) break; if (sp > XB_SPIN_CAP) { atomicAdd(&bar[XB_TMO], 1u); break; } }
    }
    nloc = mine > 0u ? mine : 1u; nx = cnt > 0u ? cnt : 1u;
}

__device__ __forceinline__ void xcd_barrier(const XcdBarrier& b) {
    asm volatile("s_waitcnt vmcnt(0)" ::: "memory");
    __syncthreads();
    if (threadIdx.x == 0) {
        unsigned* bar = b.bar;
        __builtin_amdgcn_s_waitcnt(0);
        unsigned nloc = b.st[0], nx = b.st[1];
        if (nloc == 0u) { xcd_barrier_complete(bar, b.x, nloc, nx); b.st[0] = nloc; b.st[1] = nx; }
        const unsigned old = xb_add(&bar[XB_XSUB(b.x)], 1u);
        const unsigned gen = old / nloc;
        if (old + 1u == (gen + 1u) * nloc) {
            __builtin_amdgcn_fence(__ATOMIC_RELEASE, "agent");
            asm volatile("s_waitcnt vmcnt(0)" ::: "memory");
            const unsigned og = xb_add(&bar[XB_TOP], 1u);
            const unsigned tg = og / nx;
            if (og + 1u == (tg + 1u) * nx) xb_add(&bar[XB_TOPGEN], 1u);
            else XB_SPIN(xb_ld(&bar[XB_TOPGEN]) == tg, bar);
            __builtin_amdgcn_fence(__ATOMIC_ACQUIRE, "agent");
            xb_add(&bar[XB_XGEN(b.x)], 1u);
            asm volatile("s_waitcnt vmcnt(0)" ::: "memory");
        } else {
            XB_SPIN(xb_ld(&bar[XB_XGEN(b.x)]) == gen, bar);
            __builtin_amdgcn_fence(__ATOMIC_ACQUIRE, "agent");
            asm volatile("s_waitcnt vmcnt(0)" ::: "memory");
        }
    }
    __syncthreads();
}

#ifndef REP_SYNC
#define REP_SYNC 1
#endif
#define GSYNC() do { for (int _r = 0; _r < REP_SYNC; ++_r) xcd_barrier(xbar); } while (0)
__global__ void __launch_bounds__(NTHR, 2) fwd_megakernel(Params p) {
    extern __shared__ __attribute__((aligned(16))) unsigned char lds[];
    cg::grid_group grid = cg::this_grid();
    LAS unsigned char* L = (LAS unsigned char*)lds;
    const int tid = threadIdx.x, lane = tid & 63, wave = __builtin_amdgcn_readfirstlane(tid >> 6);
    const int G = gridDim.x, bx = blockIdx.x;
    unsigned char* ws = p.ws;
    bf16_t* Win_t = (bf16_t*)(ws + WS_WIN); bf16_t* Wout_t = (bf16_t*)(ws + WS_WOUT); bf16_t* Wgu_t = (bf16_t*)(ws + WS_WGU); bf16_t* Wdn_t = (bf16_t*)(ws + WS_WDN);
    bf16_t* SGUW = (bf16_t*)(ws + WS_SGUW); bf16_t* PWT = (bf16_t*)(ws + WS_PWT); float* SSQ = (float*)(ws + WS_SS);
    bf16_t* XB = (bf16_t*)(ws + WS_XB); bf16_t* PROJ = (bf16_t*)(ws + WS_PROJ); bf16_t* YCAT = (bf16_t*)(ws + WS_YCAT); bf16_t* HID = (bf16_t*)(ws + WS_HID);

    volatile LAS unsigned* xst = (volatile LAS unsigned*)(L + LDS_BYTES - 16);
    if (tid < 4) xst[tid] = 0u;
    unsigned* barw = (unsigned*)(ws + WS_BAR);
    if (bx == 0) for (int i = tid; i < XCD_BAR_WORDS; i += NTHR) __hip_atomic_store(barw + i, 0u, __ATOMIC_RELAXED, __HIP_MEMORY_SCOPE_AGENT);
#ifndef REP_P0
#define REP_P0 1
#endif
    for (int rep0 = 0; rep0 < REP_P0; ++rep0) {
        LAS float* scr = (LAS float*)(L + wave * 16384);
        const int gw = bx * 8 + wave, NGW = G * 8;
        constexpr int I_IN = (DM / 64) * (DIN / 32), I_OUT = (DM / 64) * (DM / 32), I_GU = (DM / 64) * (2 * DFF / 32), I_DN = (DFF / 64) * (DM / 32), I_L = I_IN + I_OUT + I_GU + I_DN;
        for (int it = gw; it < DEPTH * I_L; it += NGW) {
            const int l = it / I_L; int r = it % I_L;
            if (r < I_IN) { transpose_item(p.w_in + (size_t)l * DM * DIN, DM, DIN, Win_t + (size_t)l * DIN * DM, p.norm_mix + l * DM, 1, scr, r, lane); continue; } r -= I_IN;
            if (r < I_OUT) { transpose_item(p.w_out + (size_t)l * DM * DM, DM, DM, Wout_t + (size_t)l * DM * DM, p.mix_out_gain + l * DM, 0, scr, r, lane); continue; } r -= I_OUT;
            if (r < I_GU) { transpose_item(p.w_gate_up + (size_t)l * DM * 2 * DFF, DM, 2 * DFF, Wgu_t + (size_t)l * 2 * DFF * DM, p.norm_ffn + l * DM, 2, scr, r, lane); continue; } r -= I_GU;
            transpose_item(p.w_down + (size_t)l * DFF * DM, DFF, DM, Wdn_t + (size_t)l * DM * DFF, nullptr, 0, scr, r, lane);
        }
        for (int m = 2 * gw; m < M; m += 2 * NGW) {
            const f32x4* xr = (const f32x4*)(p.x + (size_t)m * DM) + lane; u32x2* o8 = (u32x2*)(XB + (size_t)m * DM) + lane; f32x4 v[2][4];
#pragma unroll
            for (int r = 0; r < 2; ++r)
#pragma unroll
                for (int j = 0; j < 4; ++j) v[r][j] = __builtin_nontemporal_load(xr + r * 256 + 64 * j);
#pragma unroll
            for (int r = 0; r < 2; ++r) { float s = 0.f;
#pragma unroll
                for (int j = 0; j < 4; ++j) { const f32x4 t = v[r][j]; s += ssq4(t); u32x2 o; o.x = pk2(t.x, t.y); o.y = pk2(t.z, t.w); o8[r * 256 + 64 * j] = o; }
                s = wave_sum(s);
                if (lane < 4) SSQ[(size_t)(m + r) * 4 + lane] = (lane == 0) ? s : 0.f; }
        }
        const int gt = bx * NTHR + tid, NGT = G * NTHR;
        for (int e = gt; e < DEPTH * 4 * 128 * 128 / 8; e += NGT) { const int s0 = (e & 15) * 8, t = (e >> 4) & 127; const float* src = p.sgu_w + (size_t)e * 8;
            const f32x4 a = *(const f32x4*)src, bq = *(const f32x4*)(src + 4); float v[8] = {a.x, a.y, a.z, a.w, bq.x, bq.y, bq.z, bq.w};
#pragma unroll
            for (int i = 0; i < 8; ++i) v[i] = (s0 + i <= t) ? v[i] : 0.f;
            u32x4 o; o.x = pk2(v[0], v[1]); o.y = pk2(v[2], v[3]); o.z = pk2(v[4], v[5]); o.w = pk2(v[6], v[7]); *(u32x4*)(SGUW + (size_t)e * 8) = o; }
        for (int e = gt; e < DEPTH * 4 * 64 * 64; e += NGT) { const int cc = e & 63, d = (e >> 6) & 63, lg = e >> 12; PWT[e] = f2bf(p.pool_w[((size_t)lg * 64 + cc) * 64 + d]); }
    }
    grid.sync();
    const XcdBarrier xbar = xcd_barrier_post(barw, xst);

    for (int l = 0; l < DEPTH; ++l) {
#ifndef REP_P1
#define REP_P1 1
#endif
#ifndef NO_P1
        for (int rep = 0; rep < REP_P1; ++rep) { int zk; asm volatile("s_mov_b32 %0, 0" : "=s"(zk)); pg8::Gemm g{XB, Win_t + (size_t)l * DIN * DM, M, DIN, DM + zk}; pg8::StaticOrder S; S.init(M, DIN, G + zk, bx); LAS float* RT = (LAS float*)(L + 135168); if (tid == 0) ((volatile LAS int*)(RT + 256))[0] = -1; __syncthreads(); pg8::EpiIn E{PROJ, SSQ, RT};
          pg8::gemm_phase<pg8::EpiIn, pg8::StaticOrder, true, true>(L, g, S, E, zk); }
#endif
        GSYNC();
#ifndef REP_MIX
#define REP_MIX 1
#endif
#ifndef REP_D
#define REP_D 1
#endif
        for (int rep = 0; rep < REP_MIX; ++rep)
        for (int u0 = bx; u0 < 256; u0 += G) {
            const int u = (G == 256) ? (((u0 & 7) << 5) | (u0 >> 3)) : u0; const int b = u >> 4, ch = u & 15;
            __syncthreads();
#ifndef REP_A
#define REP_A 1
#endif
#ifndef NO_A
            for (int rp = 0; rp < REP_A; ++rp) { __syncthreads(); int zt; asm volatile("v_mov_b32 %0, 0" : "=v"(zt)); const int t2 = tid + zt; mixer_A(L, PROJ, SGUW + (size_t)l * 4 * 128 * 128, p.sgu_b + l * 4 * 128, YCAT, b, ch, t2, t2 & 63, __builtin_amdgcn_readfirstlane(t2 >> 6)); }
#endif
            __syncthreads();
#ifndef REP_B
#define REP_B 1
#endif
#ifndef NO_B
            for (int rp = 0; rp < REP_B; ++rp) { __syncthreads(); int zt; asm volatile("v_mov_b32 %0, 0" : "=v"(zt)); const int t2 = tid + zt; mixer_B(L, PROJ, PWT + (size_t)l * 4 * 64 * 64, p.pool_scale + l * 256, YCAT, b, ch, t2, t2 & 63, __builtin_amdgcn_readfirstlane(t2 >> 6)); }
#endif
            __syncthreads();
#ifndef REP_C
#define REP_C 1
#endif
#ifndef NO_C
            for (int rp = 0; rp < REP_C; ++rp) { __syncthreads(); int zt; asm volatile("v_mov_b32 %0, 0" : "=v"(zt)); const int t2 = tid + zt; mixer_C(L, PROJ, p.swa_sinks + l * 4, p.rel_bias, YCAT, b, ch, t2, t2 & 63, __builtin_amdgcn_readfirstlane(t2 >> 6)); }
#endif
            __syncthreads();
#ifndef NO_D
#pragma unroll 1
            for (int hf = 0; hf < 2 * REP_D; ++hf) { int zt; asm volatile("v_mov_b32 %0, 0" : "=v"(zt)); const int t2 = tid + zt; mixer_D(L, PROJ, YCAT, b, (hf & 1) ? 31 - ch : ch, t2, t2 & 63, __builtin_amdgcn_readfirstlane(t2 >> 6)); __syncthreads(); }
#endif
        }
        GSYNC();
#ifndef NO_P3
        { int zk; asm volatile("s_mov_b32 %0, 0" : "=s"(zk)); pg8::Gemm g{YCAT, Wout_t + (size_t)l * DM * DM, M, DM, DM + zk}; pg8::StaticOrder S; S.init(M, DM, G + zk, bx); pg8::EpiRes E{l == 0 ? p.x : nullptr, nullptr, XB, SSQ, (LAS float*)(L + 131072)};
          pg8::gemm_phase<pg8::EpiRes, pg8::StaticOrder, true, true>(L, g, S, E, zk); }
#endif
        GSYNC();
#ifndef REP_P4
#define REP_P4 1
#endif
#ifndef NO_P4
        for (int rep = 0; rep < REP_P4; ++rep) { int zk; asm volatile("s_mov_b32 %0, 0" : "=s"(zk)); pg8::Gemm g{XB, Wgu_t + (size_t)l * 2 * DFF * DM, M, 2 * DFF, DM + zk}; pg8::StaticOrder S; S.init(M, 2 * DFF, G + zk, bx); LAS float* RT = (LAS float*)(L + 135168); if (tid == 0) ((volatile LAS int*)(RT + 256))[0] = -1; __syncthreads(); pg8::EpiGU E{HID, SSQ, RT};
          pg8::gemm_phase<pg8::EpiGU, pg8::StaticOrder, true, true>(L, g, S, E, zk); }
#endif
        GSYNC();
#ifndef NO_P5
        { int zk; asm volatile("s_mov_b32 %0, 0" : "=s"(zk)); pg8::Gemm g{HID, Wdn_t + (size_t)l * DM * DFF, M, DM, DFF + zk}; pg8::StaticOrder S; S.init(M, DM, G + zk, bx); pg8::EpiRes E{nullptr, l == DEPTH - 1 ? p.out : nullptr, XB, SSQ, (LAS float*)(L + 131072)};
          pg8::gemm_phase<pg8::EpiRes, pg8::StaticOrder, true, true>(L, g, S, E, zk); }
#endif
        GSYNC();
    }
    {
        const int gw = bx * 8 + wave, NGW = G * 8;
        const f32x4* gr = (const f32x4*)p.norm_final + lane; f32x4 gg[4];
#pragma unroll
        for (int j = 0; j < 4; ++j) gg[j] = gr[64 * j];
        for (int m = 2 * gw; m < M; m += 2 * NGW) {
            f32x4* xr = (f32x4*)(p.out + (size_t)m * DM) + lane; f32x4 v[2][4]; float rs[2];
#pragma unroll
            for (int r = 0; r < 2; ++r) { rs[r] = rstd_of(SSQ, m + r);
#pragma unroll
                for (int j = 0; j < 4; ++j) v[r][j] = xr[r * 256 + 64 * j]; }
#pragma unroll
            for (int r = 0; r < 2; ++r)
#pragma unroll
                for (int j = 0; j < 4; ++j) __builtin_nontemporal_store(v[r][j] * rs[r] * gg[j], xr + r * 256 + 64 * j); }
    }
}

extern "C" void kernel_launch(void* const* d_in, const int* in_sizes, int n_in, void* d_out, int out_size, void* d_ws, size_t ws_size, hipStream_t stream) {
    static int grid_blocks = 0;
    if (grid_blocks == 0) {
        if (n_in != 15 || in_sizes[0] != M * DM || out_size != M * DM || ws_size < WS_END) { fprintf(stderr, "kernel_launch: unexpected shapes (n_in %d, in0 %d, out %d, ws %zu)\n", n_in, n_in > 0 ? in_sizes[0] : -1, out_size, ws_size); grid_blocks = -1; return; }
        int dev = 0, cus = 0, per_cu = 0;
        hipGetDevice(&dev); hipDeviceGetAttribute(&cus, hipDeviceAttributeMultiprocessorCount, dev);
        if (hipFuncSetAttribute((const void*)fwd_megakernel, hipFuncAttributeMaxDynamicSharedMemorySize, LDS_BYTES) != hipSuccess) { fprintf(stderr, "kernel_launch: hipFuncSetAttribute failed\n"); }
        if (hipOccupancyMaxActiveBlocksPerMultiprocessor(&per_cu, (const void*)fwd_megakernel, NTHR, LDS_BYTES) != hipSuccess || per_cu < 1) { fprintf(stderr, "kernel_launch: occupancy query says %d\n", per_cu); per_cu = 1; }
        (void)hipGetLastError();
        grid_blocks = cus * 1;
        if (grid_blocks <= 0) grid_blocks = 256;
    }
    if (grid_blocks < 0) return;
    Params p{};
    p.x = (const float*)d_in[0]; p.w_in = (const float*)d_in[1]; p.w_out = (const float*)d_in[2]; p.sgu_w = (const float*)d_in[3]; p.sgu_b = (const float*)d_in[4];
    p.pool_w = (const float*)d_in[5]; p.pool_scale = (const float*)d_in[6]; p.swa_sinks = (const float*)d_in[7]; p.rel_bias = (const float*)d_in[8]; p.mix_out_gain = (const float*)d_in[9];
    p.norm_mix = (const float*)d_in[10]; p.norm_ffn = (const float*)d_in[11]; p.w_gate_up = (const float*)d_in[12]; p.w_down = (const float*)d_in[13]; p.norm_final = (const float*)d_in[14];
    p.out = (float*)d_out; p.ws = (unsigned char*)d_ws;
    void* args[] = {&p};
    hipError_t e = hipLaunchCooperativeKernel((const void*)fwd_megakernel, dim3(grid_blocks), dim3(NTHR), args, LDS_BYTES, stream);
    if (e != hipSuccess) fprintf(stderr, "cooperative launch failed: %s (grid %d)\n", hipGetErrorString(e), grid_blocks);
}
```

```cpp
#include <hip/hip_runtime.h>
#include <hip/hip_cooperative_groups.h>
#include <cstdio>
#include <cstdint>
namespace cg = cooperative_groups;
namespace pg8 {
#define PG8_LAS __attribute__((address_space(3)))
typedef unsigned short bf16_t;
typedef short bf16x8 __attribute__((ext_vector_type(8)));
typedef float f32x4 __attribute__((ext_vector_type(4)));
typedef unsigned u32x4 __attribute__((ext_vector_type(4)));
constexpr int BM = 256, BK = 64, HALF = 128, HTB = HALF * BK * 2  , STAGE_BYTES = 8 * HTB, NXCD = 8, WGM = 8;

__host__ __device__ __forceinline__ int lds_byte(int r, int c) { const int st = (r >> 4) * 2 + (c >> 5), rr = r & 15, cc = c & 31, ob = rr * 64 + cc * 2; return st * 1024 + (ob ^ (((ob >> 9) & 1) << 5)); }
__host__ __device__ __forceinline__ void stage_rc(int b, int& R, int& C) { const int st = b / 1024, sb = b % 1024, swz = sb ^ (((sb >> 9) & 1) << 5); R = (st >> 1) * 16 + swz / 64; C = (st & 1) * 32 + (swz % 64) / 2; }
__host__ __device__ __forceinline__ int perm32(int rho) { const int n = rho >> 4, i = rho & 15; return 8 * (i >> 2) + 4 * n + (i & 3); }

struct Unit { int pm, pn; };
struct Gemm { const bf16_t* A; const bf16_t* Bt; int M, N, K; };

struct StaticOrder {
    int nM, nN, nwg, G, c;
    __host__ __device__ void init(int M, int N, int G_, int c_) { nM = M / BM; nN = N / BM; nwg = nM * nN; G = G_; c = c_; }
    __host__ __device__ bool next(int i, Unit& u) const {
        const long L = (long)i * G + c; if (L >= nwg) return false;
        int wgid = (int)L; { const int q = nwg / NXCD, r = nwg % NXCD, xcd = wgid % NXCD, off = wgid / NXCD; wgid = (xcd < r ? xcd * (q + 1) : r * (q + 1) + (xcd - r) * q) + off; }
        const int nig = WGM * nN, gid = wgid / nig, fm = gid * WGM, gsz = (nM - fm) < WGM ? (nM - fm) : WGM;
        u.pm = fm + ((wgid % nig) % gsz); u.pn = (wgid % nig) / gsz; return true;
    }
    __device__ __forceinline__ void a_ready(const Unit&) const {}
    __device__ __forceinline__ void done(const Unit&) const {}
};

__device__ __forceinline__ unsigned cvt_pk_bf16(float lo, float hi) { unsigned r; asm volatile("v_cvt_pk_bf16_f32 %0, %1, %2" : "=v"(r) : "v"(lo), "v"(hi)); return r; }
typedef float f32x2 __attribute__((ext_vector_type(2)));
template <class Epi, class Sched, bool ALIGN_EPI = false, bool SP2 = false>
__device__ __forceinline__ void gemm_phase(PG8_LAS unsigned char* lds, const Gemm g, const Sched& S, const Epi& E, const int opq) {
    const int tid = threadIdx.x + opq, wid = __builtin_amdgcn_readfirstlane(tid >> 6), lane = tid & 63, wr = wid >> 2, wc = wid & 3, fr = lane & 15, fq = lane >> 4;
    const int K = g.K, nt = K / BK;
    unsigned voffA[2], voffB[2];
#pragma unroll
    for (int i = 0; i < 2; ++i) { int R, C; stage_rc(tid * 16 + i * 8192, R, C); const int Rb = Epi::PERM ? ((R & ~31) + perm32(R & 31)) : R;
        voffA[i] = (unsigned)(R * K + C) * 2u; voffB[i] = (unsigned)(Rb * K + C) * 2u; }
    const size_t kstep = (size_t)(BK * 2);
    const size_t hstep = (size_t)HALF * K * 2;
    const size_t tstep = 2 * hstep;
    const unsigned ldsw = (unsigned)wid * 1024u;
    const int aoff = lds_byte(wr * 64 + fr, fq * 8), boff = lds_byte(wc * 32 + fr, fq * 8);
#define PG8_SA(b, h) (((b) * 2 + (h)) * HTB)
#define PG8_SB(b, h) ((4 + (b) * 2 + (h)) * HTB)
#define PG8_STAGE(bufoff, gbase, voff) do { _Pragma("unroll") for (int _i = 0; _i < 2; ++_i) \
        __builtin_amdgcn_global_load_lds((const unsigned*)((const char*)(gbase) + (voff)[_i]), (PG8_LAS unsigned*)(lds + (bufoff) + ldsw + _i * 8192), 16, 0, 0); } while (0)
#define PG8_LDA(dst, b, h) do { _Pragma("unroll") for (int m = 0; m < 4; ++m) _Pragma("unroll") for (int k = 0; k < 2; ++k) dst[m][k] = *(const PG8_LAS bf16x8*)(lds + PG8_SA(b, h) + aoff + m * 2048 + k * 1024); } while (0)
#define PG8_LDB(dst, b, h) do { _Pragma("unroll") for (int n = 0; n < 2; ++n) _Pragma("unroll") for (int k = 0; k < 2; ++k) dst[n][k] = *(const PG8_LAS bf16x8*)(lds + PG8_SB(b, h) + boff + n * 2048 + k * 1024); } while (0)
#define PG8_MMA(ai, bj, At, Bt) do { __builtin_amdgcn_s_setprio(1); _Pragma("unroll") for (int m = 0; m < 4; ++m) _Pragma("unroll") for (int n = 0; n < 2; ++n) _Pragma("unroll") for (int k = 0; k < 2; ++k) \
        acc[ai][bj][m][n] = __builtin_amdgcn_mfma_f32_16x16x32_bf16(Bt[n][k], At[m][k], acc[ai][bj][m][n], 0, 0, 0); __builtin_amdgcn_s_setprio(0); } while (0)
#define PG8_WAIT_V(n) asm volatile("s_waitcnt vmcnt(" #n ")" ::: "memory")
#define PG8_WAIT_L(n) asm volatile("s_waitcnt lgkmcnt(" #n ")" ::: "memory")
#define PG8_BAR __builtin_amdgcn_s_barrier()
#define PG8_SCHED __builtin_amdgcn_sched_barrier(0)
    Unit cur, nxt; int ui = 0;
    if (!S.next(0, cur)) return;
    f32x4 acc[2][2][4][2];
#pragma unroll
    for (int a = 0; a < 2; ++a)
#pragma unroll
        for (int b = 0; b < 2; ++b)
#pragma unroll
            for (int m = 0; m < 4; ++m)
#pragma unroll
                for (int n = 0; n < 2; ++n) acc[a][b][m][n] = (f32x4){0.f, 0.f, 0.f, 0.f};
    bf16x8 At[4][2], B0[2][2], B1[2][2];
    const char* cA = (const char*)g.A + (size_t)cur.pm * tstep; const char* cB = (const char*)g.Bt + (size_t)cur.pn * tstep;
    S.a_ready(cur);
    if constexpr (SP2) {
        PG8_STAGE(PG8_SB(0, 0), cB, voffB); PG8_STAGE(PG8_SB(0, 1), cB + hstep, voffB); PG8_STAGE(PG8_SA(0, 0), cA, voffA); PG8_STAGE(PG8_SA(0, 1), cA + hstep, voffA);
        if (wr == 1) PG8_BAR;
        PG8_WAIT_V(2); PG8_BAR;
        PG8_STAGE(PG8_SB(1, 0), cB + kstep, voffB); PG8_STAGE(PG8_SA(1, 0), cA + kstep, voffA); PG8_STAGE(PG8_SB(1, 1), cB + hstep + kstep, voffB);
        PG8_WAIT_V(6); PG8_BAR;
    } else {
        PG8_STAGE(PG8_SB(0, 0), cB, voffB); PG8_STAGE(PG8_SA(0, 0), cA, voffA); PG8_STAGE(PG8_SB(0, 1), cB + hstep, voffB); PG8_STAGE(PG8_SA(0, 1), cA + hstep, voffA);
        if (wr == 1) PG8_BAR;
        PG8_WAIT_V(4); PG8_BAR;
        PG8_STAGE(PG8_SB(1, 0), cB + kstep, voffB); PG8_STAGE(PG8_SA(1, 0), cA + kstep, voffA); PG8_STAGE(PG8_SB(1, 1), cB + hstep + kstep, voffB);
        PG8_WAIT_V(6); PG8_BAR;
    }
    for (;;) {
        const bool has_next = S.next(ui + 1, nxt);
        const char* nA = has_next ? (const char*)g.A + (size_t)nxt.pm * tstep : cA; const char* nB = has_next ? (const char*)g.Bt + (size_t)nxt.pn * tstep : cB;
        for (int t = 0; t < nt; t += 2) {
            const bool last = (t == nt - 2);
            const char* a1 = cA + (size_t)(t + 1) * kstep;
            const char* a2 = last ? nA : cA + (size_t)(t + 2) * kstep; const char* b2 = last ? nB : cB + (size_t)(t + 2) * kstep;
            const char* a3 = a2 + kstep; const char* b3 = b2 + kstep;
            if (last && has_next) S.a_ready(nxt);
            if constexpr (SP2) {
            PG8_LDB(B0, 0, 0); PG8_LDB(B1, 0, 1); PG8_SCHED; PG8_LDA(At, 0, 0); PG8_STAGE(PG8_SA(1, 1), a1 + hstep, voffA);
            PG8_WAIT_V(8); PG8_WAIT_L(0); PG8_BAR; PG8_MMA(0, 0, At, B0); PG8_MMA(0, 1, At, B1); PG8_BAR; PG8_SCHED;
            PG8_LDA(At, 0, 1); PG8_STAGE(PG8_SB(0, 0), b2, voffB); PG8_STAGE(PG8_SB(0, 1), b2 + hstep, voffB); PG8_STAGE(PG8_SA(0, 0), a2, voffA);
            PG8_WAIT_V(8); PG8_WAIT_L(0); PG8_BAR; PG8_MMA(1, 0, At, B0); PG8_MMA(1, 1, At, B1); PG8_BAR; PG8_SCHED;
            PG8_LDB(B0, 1, 0); PG8_LDB(B1, 1, 1); PG8_SCHED; PG8_LDA(At, 1, 0); PG8_STAGE(PG8_SA(0, 1), a2 + hstep, voffA);
            PG8_WAIT_V(8); PG8_WAIT_L(0); PG8_BAR; PG8_MMA(0, 0, At, B0); PG8_MMA(0, 1, At, B1); PG8_BAR; PG8_SCHED;
            PG8_LDA(At, 1, 1); PG8_STAGE(PG8_SB(1, 0), b3, voffB); PG8_STAGE(PG8_SB(1, 1), b3 + hstep, voffB); PG8_STAGE(PG8_SA(1, 0), a3, voffA);
            PG8_WAIT_V(8); PG8_WAIT_L(0); PG8_BAR; PG8_MMA(1, 0, At, B0); PG8_MMA(1, 1, At, B1); PG8_BAR; PG8_SCHED;
            } else {
            PG8_LDB(B0, 0, 0); PG8_SCHED; PG8_LDA(At, 0, 0); PG8_STAGE(PG8_SA(1, 1), a1 + hstep, voffA);
            PG8_WAIT_L(8); PG8_BAR; PG8_WAIT_L(0); PG8_MMA(0, 0, At, B0); PG8_BAR; PG8_SCHED;
            PG8_LDB(B1, 0, 1); PG8_STAGE(PG8_SB(0, 0), b2, voffB);
            PG8_BAR; PG8_WAIT_L(0); PG8_MMA(0, 1, At, B1); PG8_BAR;
            PG8_LDA(At, 0, 1); PG8_STAGE(PG8_SA(0, 0), a2, voffA);
            PG8_BAR; PG8_WAIT_L(0); PG8_MMA(1, 0, At, B0); PG8_BAR; PG8_SCHED;
            PG8_STAGE(PG8_SB(0, 1), b2 + hstep, voffB);
            PG8_WAIT_V(6); PG8_BAR; PG8_MMA(1, 1, At, B1); PG8_BAR;
            PG8_LDB(B0, 1, 0); PG8_SCHED; PG8_LDA(At, 1, 0); PG8_STAGE(PG8_SA(0, 1), a2 + hstep, voffA);
            PG8_WAIT_L(8); PG8_BAR; PG8_WAIT_L(0); PG8_MMA(0, 0, At, B0); PG8_BAR; PG8_SCHED;
            PG8_LDB(B1, 1, 1); PG8_STAGE(PG8_SB(1, 0), b3, voffB);
            PG8_BAR; PG8_WAIT_L(0); PG8_MMA(0, 1, At, B1); PG8_BAR;
            PG8_LDA(At, 1, 1); PG8_STAGE(PG8_SA(1, 0), a3, voffA);
            PG8_BAR; PG8_WAIT_L(0); PG8_MMA(1, 0, At, B0); PG8_BAR; PG8_SCHED;
            PG8_STAGE(PG8_SB(1, 1), b3 + hstep, voffB);
            PG8_WAIT_V(6); PG8_BAR; PG8_MMA(1, 1, At, B1); PG8_BAR;
            }
        }
        if constexpr (ALIGN_EPI) { if (wr == 0) PG8_BAR; }
        if constexpr (!Epi::AFTER_DRAIN) { E(acc, cur, wr, wc, fr, fq); S.done(cur); }
        if (!has_next) break;
#pragma unroll
        for (int a = 0; a < 2; ++a)
#pragma unroll
            for (int b = 0; b < 2; ++b)
#pragma unroll
                for (int m = 0; m < 4; ++m)
#pragma unroll
                    for (int n = 0; n < 2; ++n) acc[a][b][m][n] = (f32x4){0.f, 0.f, 0.f, 0.f};
        cur = nxt; cA = nA; cB = nB; ++ui;
        if constexpr (ALIGN_EPI) { if (wr == 1) PG8_BAR; }
    }
    PG8_WAIT_V(0);
    if constexpr (!ALIGN_EPI) { if (wr == 0) PG8_BAR; }
    PG8_BAR;
    if constexpr (Epi::AFTER_DRAIN) { E.fused(acc, cur, wr, wc, fr, fq, lds, wid, lane); S.done(cur); }
#undef PG8_SA
#undef PG8_SB
#undef PG8_STAGE
#undef PG8_LDA
#undef PG8_LDB
#undef PG8_MMA
#undef PG8_WAIT_V
#undef PG8_WAIT_L
#undef PG8_BAR
#undef PG8_SCHED
}
}

constexpr int NB = 16, SEQ = 2048, DM = 1024, DEPTH = 4, DIN = 2048, DFF = 2816, M = NB * SEQ;
constexpr float EPS = 1e-6f;
constexpr size_t MiB = 1u << 20;
constexpr size_t WS_WIN = 0, WS_WOUT = 16 * MiB, WS_WGU = 24 * MiB, WS_WDN = 68 * MiB, WS_SGUW = 90 * MiB, WS_PWT = 90 * MiB + 512 * 1024,
                 WS_SS = 91 * MiB, WS_BAR = 93 * MiB, WS_XB = 96 * MiB, WS_PROJ = 160 * MiB, WS_YCAT = 288 * MiB, WS_HID = 160 * MiB, WS_END = 352 * MiB;
constexpr int LDS_BYTES = 160 * 1024;
constexpr int NTHR = 512;

#define LAS __attribute__((address_space(3)))
typedef unsigned short bf16_t;
typedef short bf16x8 __attribute__((ext_vector_type(8)));
typedef float f32x4 __attribute__((ext_vector_type(4)));
typedef float f32x2 __attribute__((ext_vector_type(2)));
typedef unsigned u32x4 __attribute__((ext_vector_type(4)));
typedef unsigned u32x2 __attribute__((ext_vector_type(2)));
typedef __bf16 bf16x2_t __attribute__((ext_vector_type(2)));

__device__ __forceinline__ unsigned pk2(float lo, float hi) { f32x2 v = {lo, hi}; bf16x2_t b = __builtin_convertvector(v, bf16x2_t); return __builtin_bit_cast(unsigned, b); }
__device__ __forceinline__ bf16_t f2bf(float f) { return (bf16_t)(pk2(f, 0.f) & 0xffffu); }
__device__ __forceinline__ float bflo(unsigned w) { return __uint_as_float(w << 16); }
__device__ __forceinline__ float bfhi(unsigned w) { return __uint_as_float(w & 0xffff0000u); }
#define MFMA16(a, b, c) __builtin_amdgcn_mfma_f32_16x16x32_bf16((a), (b), (c), 0, 0, 0)
#define CFENCE() asm volatile("" ::: "memory")
#define LDSWAIT() asm volatile("s_waitcnt lgkmcnt(0)" ::: "memory")
__device__ __forceinline__ float fexp(float x) { return __builtin_amdgcn_exp2f(x * 1.4426950408889634f); }
__device__ __forceinline__ float gelu_tanh(float x) {
    const float u2 = 1.5957691216057308f * x * (1.0f + 0.044715f * x * x);
    return x * __builtin_amdgcn_rcpf(1.0f + fexp(-u2));
}
__device__ __forceinline__ float rstd_of1(const float* ss, int row) {
    const f32x4 s = *(const f32x4*)(ss + (size_t)row * 4); return rsqrtf(((s.x + s.y) + (s.z + s.w)) * (1.0f / 1024.0f) + EPS);
}

#ifdef USE_WT
__device__ __forceinline__ void st16(void* p, const u32x4 v) { asm volatile("global_store_dwordx4 %0, %1, off sc1\n\ts_nop 1" :: "v"(p), "v"(v) : "memory"); }
#else
__device__ __forceinline__ void st16(void* p, const u32x4 v) { *(u32x4*)p = v; }
#endif
__device__ __forceinline__ float ssq4(const f32x4 y) { return (y[0] * y[0] + y[1] * y[1]) + (y[2] * y[2] + y[3] * y[3]); }

#ifdef PROBE_RSTD2
__device__ __forceinline__ float rstd_of(const float* ss, int row) { const float a = rstd_of1(ss, row); int z; asm volatile("v_mov_b32 %0, 0" : "=v"(z) : "v"(a)); const float b = rstd_of1(ss, row + z); return (a + b) * 0.5f; }
#else
__device__ __forceinline__ float rstd_of(const float* ss, int row) { return rstd_of1(ss, row); }
#endif
namespace pg8 {
struct EpiIn {
    static constexpr bool PERM = true, AFTER_DRAIN = false;
    bf16_t* O; const float* ss; LAS float* T;
    __device__ __forceinline__ void operator()(const f32x4 (&acc)[2][2][4][2], const Unit& u, int wr, int wc, int fr, int fq) const {
        const int row0 = u.pm * BM + wr * 64 + fr, col0 = u.pn * BM + wc * 32 + 8 * fq; const bool act = u.pn < 2;
        float rsv[2][4];
        {
            volatile LAS int* TAG = (volatile LAS int*)(T + 256);
            if (TAG[0] != u.pm) {
                const int t = wr * 256 + wc * 64 + fq * 16 + fr;
                if (t < 256) T[t] = rstd_of(ss, u.pm * BM + t);
                asm volatile("s_waitcnt lgkmcnt(0)" ::: "memory"); __builtin_amdgcn_s_barrier(); asm volatile("" ::: "memory");
                if (t == 0) TAG[0] = u.pm; }
#pragma unroll
            for (int ai = 0; ai < 2; ++ai)
#pragma unroll
                for (int m = 0; m < 4; ++m) rsv[ai][m] = T[wr * 64 + fr + ai * HALF + m * 16]; }
#pragma unroll
        for (int ai = 0; ai < 2; ++ai)
#pragma unroll
            for (int m = 0; m < 4; ++m) { const int row = row0 + ai * HALF + m * 16; const float rs = rsv[ai][m]; bf16_t* rowp = O + (size_t)row * DIN + col0;
#pragma unroll
                for (int bj = 0; bj < 2; ++bj) { f32x4 v0 = acc[ai][bj][m][0] * rs, v1 = acc[ai][bj][m][1] * rs;
                    if (act) { v0 = (f32x4){gelu_tanh(v0[0]), gelu_tanh(v0[1]), gelu_tanh(v0[2]), gelu_tanh(v0[3])}; v1 = (f32x4){gelu_tanh(v1[0]), gelu_tanh(v1[1]), gelu_tanh(v1[2]), gelu_tanh(v1[3])}; }
                    u32x4 w; w.x = pk2(v0[0], v0[1]); w.y = pk2(v0[2], v0[3]); w.z = pk2(v1[0], v1[1]); w.w = pk2(v1[2], v1[3]);
                    st16(rowp + bj * HALF, w); }
                if (m & 1) CFENCE(); }
    }
};
struct EpiGU {
    static constexpr bool PERM = true, AFTER_DRAIN = false;
    bf16_t* O; const float* ss; LAS float* T;
    __device__ __forceinline__ void operator()(const f32x4 (&acc)[2][2][4][2], const Unit& u, int wr, int wc, int fr, int fq) const {
        const int row0 = u.pm * BM + wr * 64 + fr, col0 = u.pn * HALF + wc * 32 + 8 * fq;
        float rsv[2][4];
        {
            volatile LAS int* TAG = (volatile LAS int*)(T + 256);
            if (TAG[0] != u.pm) {
                const int t = wr * 256 + wc * 64 + fq * 16 + fr;
                if (t < 256) T[t] = rstd_of(ss, u.pm * BM + t);
                asm volatile("s_waitcnt lgkmcnt(0)" ::: "memory"); __builtin_amdgcn_s_barrier(); asm volatile("" ::: "memory");
                if (t == 0) TAG[0] = u.pm; }
#pragma unroll
            for (int ai = 0; ai < 2; ++ai)
#pragma unroll
                for (int m = 0; m < 4; ++m) rsv[ai][m] = T[wr * 64 + fr + ai * HALF + m * 16]; }
#pragma unroll
        for (int ai = 0; ai < 2; ++ai)
#pragma unroll
            for (int m = 0; m < 4; ++m) { const int row = row0 + ai * HALF + m * 16; const float rs = rsv[ai][m]; bf16_t* rowp = O + (size_t)row * DFF + col0;
                float h[8];
#pragma unroll
                for (int n = 0; n < 2; ++n)
#pragma unroll
                    for (int e = 0; e < 4; ++e) { const float g = acc[ai][0][m][n][e] * rs, up = acc[ai][1][m][n][e] * rs; h[n * 4 + e] = g * up * __builtin_amdgcn_rcpf(1.0f + fexp(-g)); }
                u32x4 w; w.x = pk2(h[0], h[1]); w.y = pk2(h[2], h[3]); w.z = pk2(h[4], h[5]); w.w = pk2(h[6], h[7]);
                st16(rowp, w);
                if (m & 1) CFENCE(); }
    }
};
struct EpiRes {
    static constexpr bool PERM = true, AFTER_DRAIN = false;
    const float* xin32; float* xout32; bf16_t* xb; float* ss; LAS float* P;
    __device__ __forceinline__ void operator()(const f32x4 (&acc)[2][2][4][2], const Unit& u, int wr, int wc, int fr, int fq) const {
        const int row0 = u.pm * BM + wr * 64 + fr, col0 = u.pn * BM + wc * 32 + 8 * fq;
        if (xin32) {
#pragma unroll
            for (int ai = 0; ai < 2; ++ai)
#pragma unroll
                for (int m = 0; m < 4; ++m) { const int row = row0 + ai * HALF + m * 16; const size_t off = (size_t)row * DM + col0; float q = 0.f;
#pragma unroll
                    for (int bj = 0; bj < 2; ++bj) { const f32x4 r0 = *(const f32x4*)(xin32 + off + bj * HALF), r1 = *(const f32x4*)(xin32 + off + bj * HALF + 4);
                        const f32x4 v0 = r0 + acc[ai][bj][m][0], v1 = r1 + acc[ai][bj][m][1];
                        q += ssq4(v0) + ssq4(v1);
                        u32x4 w; w.x = pk2(v0[0], v0[1]); w.y = pk2(v0[2], v0[3]); w.z = pk2(v1[0], v1[1]); w.w = pk2(v1[2], v1[3]); st16(xb + off + bj * HALF, w); }
                    q += __shfl_xor(q, 16); q += __shfl_xor(q, 32);
                    if (fq == 0) P[(ai * HALF + wr * 64 + m * 16 + fr) * 4 + wc] = q;
                    if (m & 1) CFENCE(); }
        } else {
#pragma unroll
            for (int ai = 0; ai < 2; ++ai) {
                u32x4 rr[4][2];
#pragma unroll
                for (int m = 0; m < 4; ++m)
#pragma unroll
                    for (int bj = 0; bj < 2; ++bj) rr[m][bj] = *(const u32x4*)(xb + (size_t)(row0 + ai * HALF + m * 16) * DM + col0 + bj * HALF);
#pragma unroll
                for (int m = 0; m < 4; ++m) { const int row = row0 + ai * HALF + m * 16; const size_t off = (size_t)row * DM + col0; float q = 0.f;
#pragma unroll
                    for (int bj = 0; bj < 2; ++bj) { const u32x4 t = rr[m][bj];
                        const f32x4 r0 = (f32x4){bflo(t.x), bfhi(t.x), bflo(t.y), bfhi(t.y)}, r1 = (f32x4){bflo(t.z), bfhi(t.z), bflo(t.w), bfhi(t.w)};
                        const f32x4 v0 = r0 + acc[ai][bj][m][0], v1 = r1 + acc[ai][bj][m][1];
                        q += ssq4(v0) + ssq4(v1);
                        if (xout32) { st16(xout32 + off + bj * HALF, __builtin_bit_cast(u32x4, v0)); st16(xout32 + off + bj * HALF + 4, __builtin_bit_cast(u32x4, v1)); }
                        else { u32x4 w; w.x = pk2(v0[0], v0[1]); w.y = pk2(v0[2], v0[3]); w.z = pk2(v1[0], v1[1]); w.w = pk2(v1[2], v1[3]); st16(xb + off + bj * HALF, w); } }
                    q += __shfl_xor(q, 16); q += __shfl_xor(q, 32);
                    if (fq == 0) P[(ai * HALF + wr * 64 + m * 16 + fr) * 4 + wc] = q; }
                CFENCE(); }
        }
        asm volatile("s_waitcnt lgkmcnt(0)" ::: "memory"); __builtin_amdgcn_s_barrier(); asm volatile("" ::: "memory");
        const int t = wr * 256 + wc * 64 + fq * 16 + fr;
        if (t < 256) { const f32x4 pp = *(const LAS f32x4*)(P + t * 4); ss[(size_t)(u.pm * BM + t) * 4 + u.pn] = (pp.x + pp.y) + (pp.z + pp.w); }
    }
};
}

__device__ __forceinline__ void transpose_item(const float* W, int K, int N, bf16_t* WT, const float* gain, int mode, LAS float* scr, int item, int lane) {
    const int nblk = N / 32, kb = item / nblk, nb = item % nblk, k0 = 64 * kb, n0 = 32 * nb;
    const int c = lane & 7;
    f32x4 g0 = {1.f, 1.f, 1.f, 1.f}, g1 = {1.f, 1.f, 1.f, 1.f};
    if (gain) { g0 = *(const f32x4*)(gain + k0 + 8 * c); g1 = *(const f32x4*)(gain + k0 + 8 * c + 4); }
    const float* src = W + (size_t)(k0 + (lane >> 5)) * N + n0 + (lane & 31);
    float v[32];
#pragma unroll
    for (int i = 0; i < 32; ++i) v[i] = __builtin_nontemporal_load(src + (size_t)(2 * i) * N);
#pragma unroll
    for (int i = 0; i < 32; ++i) scr[(2 * i + (lane >> 5)) * 33 + (lane & 31)] = v[i];
    LDSWAIT();
#pragma unroll
    for (int j = 0; j < 4; ++j) { const int n = (lane >> 3) + 8 * j, gn = n0 + n; const LAS float* s = scr + (8 * c) * 33 + n;
        float cs = 1.0f; int row = gn;
        if (mode == 1) { if ((gn >= 768 && gn < 1024) || (gn >= 1280 && gn < 1536)) cs = 0.125f; }
        if (mode == 2) { const int jj = gn < DFF ? gn : gn - DFF; row = 256 * (jj >> 7) + (jj & 127) + (gn < DFF ? 0 : 128); }
        u32x4 o; o.x = pk2(s[0 * 33] * g0[0] * cs, s[1 * 33] * g0[1] * cs); o.y = pk2(s[2 * 33] * g0[2] * cs, s[3 * 33] * g0[3] * cs); o.z = pk2(s[4 * 33] * g1[0] * cs, s[5 * 33] * g1[1] * cs); o.w = pk2(s[6 * 33] * g1[2] * cs, s[7 * 33] * g1[3] * cs);
        *(u32x4*)(WT + (size_t)row * K + k0 + 8 * c) = o; }
    LDSWAIT();
}
__device__ __forceinline__ float wave_sum(float v) {
#pragma unroll
    for (int o = 1; o < 64; o <<= 1) v += __shfl_xor(v, o);
    return v;
}

struct Params {
    const float *x, *w_in, *w_out, *sgu_w, *sgu_b, *pool_w, *pool_scale, *swa_sinks, *rel_bias, *mix_out_gain, *norm_mix, *norm_ffn, *w_gate_up, *w_down, *norm_final;
    float* out; unsigned char* ws;
};


__device__ __forceinline__ void st4(bf16_t* p, const f32x4 y) { u32x2 o; o.x = pk2(y[0], y[1]); o.y = pk2(y[2], y[3]); *(u32x2*)p = o; }
#define VMWAIT() asm volatile("s_waitcnt vmcnt(0)" ::: "memory")
typedef short v4i16_t __attribute__((ext_vector_type(4)));
__device__ __forceinline__ bf16x8 tr_frag(const LAS bf16_t* p, int rows4) {
    const v4i16_t lo = __builtin_amdgcn_ds_read_tr16_b64_v4i16((LAS v4i16_t*)p);
    const v4i16_t hi = __builtin_amdgcn_ds_read_tr16_b64_v4i16((LAS v4i16_t*)(p + rows4));
    return (bf16x8){lo[0], lo[1], lo[2], lo[3], hi[0], hi[1], hi[2], hi[3]};
}

__device__ __forceinline__ void b_issue(const bf16_t* proj, int b, int ch, int tid, u32x4 (&t)[9]) {
    const size_t row0 = (size_t)b * SEQ + ch * 128;
#pragma unroll
    for (int i = 0; i < 9; ++i) { const int id = tid + 512 * i, r = id >> 5, cc = id & 31; t[i] = (u32x4){0u, 0u, 0u, 0u};
        if (id < 143 * 32 && (ch > 0 || r >= 15)) t[i] = *(const u32x4*)(proj + (row0 - 15 + r) * DIN + 512 + 8 * cc); }
}
__device__ __forceinline__ void c_issue(const bf16_t* proj, int b, int qb, int tid, u32x4 (&kr)[8], u32x4 (&vr)[8]) {
    const size_t row0 = (size_t)b * SEQ + qb * 128;
    const int skey = tid >> 1, shalf = tid & 1; const bool okk = (qb > 0) || (skey >= 128);
    const bf16_t* ksrc = proj + (row0 - 128 + skey) * DIN + 1024 + shalf * 64;
#pragma unroll
    for (int i = 0; i < 8; ++i) { kr[i] = (u32x4){0u, 0u, 0u, 0u}; vr[i] = (u32x4){0u, 0u, 0u, 0u}; if (okk) { kr[i] = *(const u32x4*)(ksrc + 8 * i); vr[i] = *(const u32x4*)(ksrc + 128 + 8 * i); } }
}

__device__ __forceinline__ void mixer_A(LAS unsigned char* L, const bf16_t* proj, const bf16_t* sguw, const float* sgub, bf16_t* ycat, int b, int ch, int tid, int lane, int w, u32x4 (&bt)[9]) {
    constexpr int VS = 264;
    LAS bf16_t* VL = (LAS bf16_t*)L;
    const size_t row0 = (size_t)b * SEQ + ch * 128;
    const int c = lane & 15, q = lane >> 4, wv = tid >> 6;
    const int nks = (w >> 1) + 1;
    const size_t trow = row0 + 16 * wv + c;
    const bf16_t* wbase = sguw + (size_t)(16 * wv + c) * 128 + 8 * q;
    const bf16_t* urow = proj + trow * DIN + 4 * q;
    bf16x8 bw[4][4]; u32x2 uu[4][4]; float bias[4];
#pragma unroll
    for (int h = 0; h < 4; ++h) { bias[h] = sgub[h * 128 + 16 * wv + c];
#pragma unroll
        for (int ks = 0; ks < 4; ++ks) if (ks < nks) bw[h][ks] = *(const bf16x8*)(wbase + h * 128 * 128 + 32 * ks);
#pragma unroll
        for (int n = 0; n < 4; ++n) uu[h][n] = *(const u32x2*)(urow + h * 64 + 16 * n); }
    {
        const int tok = tid >> 2, h = tid & 3;
        const bf16_t* src = proj + (row0 + tok) * DIN + 256 + h * 64;
        float v[64]; float s = 0.f;
#pragma unroll
        for (int i = 0; i < 8; ++i) { const u32x4 t = *(const u32x4*)(src + 8 * i);
            v[8 * i + 0] = bflo(t.x); v[8 * i + 1] = bfhi(t.x); v[8 * i + 2] = bflo(t.y); v[8 * i + 3] = bfhi(t.y); v[8 * i + 4] = bflo(t.z); v[8 * i + 5] = bfhi(t.z); v[8 * i + 6] = bflo(t.w); v[8 * i + 7] = bfhi(t.w); }
#pragma unroll
        for (int i = 0; i < 64; ++i) s += v[i];
        const float mean = s * (1.0f / 64.0f); float s2 = 0.f;
#pragma unroll
        for (int i = 0; i < 64; ++i) { v[i] -= mean; s2 += v[i] * v[i]; }
        const float rstd = rsqrtf(s2 * (1.0f / 64.0f) + EPS);
        LAS bf16_t* dst = VL + tok * VS + h * 64;
#pragma unroll
        for (int i = 0; i < 8; ++i) { u32x4 o; o.x = pk2(v[8 * i + 0] * rstd, v[8 * i + 1] * rstd); o.y = pk2(v[8 * i + 2] * rstd, v[8 * i + 3] * rstd); o.z = pk2(v[8 * i + 4] * rstd, v[8 * i + 5] * rstd); o.w = pk2(v[8 * i + 6] * rstd, v[8 * i + 7] * rstd);
            *(LAS u32x4*)(dst + 8 * i) = o; }
    }
    __syncthreads();
    b_issue(proj, b, ch, tid, bt);
    const LAS bf16_t* vbase = VL + (8 * q + (c >> 2)) * VS + 4 * (c & 3);
    f32x4 yv[4][4]; float ssq = 0.f;
#pragma unroll
    for (int h = 0; h < 4; ++h) {
#pragma unroll
        for (int n = 0; n < 4; ++n) yv[h][n] = (f32x4){0.f, 0.f, 0.f, 0.f};
#pragma unroll
        for (int ks = 0; ks < 4; ++ks) if (ks < nks) {
#pragma unroll
            for (int n = 0; n < 4; ++n) { const bf16x8 a = tr_frag(vbase + 32 * ks * VS + h * 64 + 16 * n, 4 * VS); yv[h][n] = MFMA16(a, bw[h][ks], yv[h][n]); }
        }
#pragma unroll
        for (int n = 0; n < 4; ++n) { const u32x2 u2 = uu[h][n];
            f32x4 y; y[0] = bflo(u2.x) * (yv[h][n][0] + bias[h]); y[1] = bfhi(u2.x) * (yv[h][n][1] + bias[h]); y[2] = bflo(u2.y) * (yv[h][n][2] + bias[h]); y[3] = bfhi(u2.y) * (yv[h][n][3] + bias[h]);
            yv[h][n] = y; ssq += ssq4(y); }
    }
    ssq += __shfl_xor(ssq, 16); ssq += __shfl_xor(ssq, 32);
    const float rs = rsqrtf(ssq * (1.0f / 256.0f) + EPS);
    bf16_t* yrow = ycat + trow * DM + 0 + 4 * q;
#pragma unroll
    for (int h = 0; h < 4; ++h)
#pragma unroll
        for (int n = 0; n < 4; ++n) st4(yrow + h * 64 + 16 * n, yv[h][n] * rs);
}

__device__ __forceinline__ void mixer_B(LAS unsigned char* L, const bf16_t* proj, const bf16_t* pwt, const float* pscale, bf16_t* ycat, int b, int ch, int tid, int lane, int w, u32x4 (&t)[9], u32x4 (&ckr)[8], u32x4 (&cvr)[8]) {
    constexpr int YS = 264;
    LAS bf16_t* PL = (LAS bf16_t*)L;
    LAS bf16_t* Y = (LAS bf16_t*)(L + 76032);
    const size_t row0 = (size_t)b * SEQ + ch * 128;
    const int c = lane & 15, q = lane >> 4, wv = tid >> 6;
    const bf16_t* pbase = pwt + (size_t)c * 64 + 8 * q;
    {
#pragma unroll
        for (int i = 0; i < 9; ++i) { const int id = tid + 512 * i, r = id >> 5, cc = id & 31; if (id < 143 * 32) *(LAS u32x4*)(PL + r * YS + 8 * cc) = t[i]; }
    }
    c_issue(proj, b, ch, tid, ckr, cvr);
    __syncthreads();
    {
        const int cc = tid & 31, t0 = (tid >> 5) * 8; const int win = 2 << (cc >> 3);
        const LAS bf16_t* col = PL + 15 * YS + 8 * cc;
        float S[8];
#pragma unroll
        for (int e = 0; e < 8; ++e) S[e] = 0.f;
#pragma unroll 1
        for (int j = 0; j < win; ++j) { const u32x4 t = *(const LAS u32x4*)(col + (t0 - j) * YS);
            S[0] += bflo(t.x); S[1] += bfhi(t.x); S[2] += bflo(t.y); S[3] += bfhi(t.y); S[4] += bflo(t.z); S[5] += bfhi(t.z); S[6] += bflo(t.w); S[7] += bfhi(t.w); }
#pragma unroll
        for (int i = 0; i < 8; ++i) { const int t = t0 + i; const u32x4 pt = *(const LAS u32x4*)(col + t * YS);
            const float p0 = bflo(pt.x), p1 = bfhi(pt.x), p2 = bflo(pt.y), p3 = bfhi(pt.y), p4 = bflo(pt.z), p5 = bfhi(pt.z), p6 = bflo(pt.w), p7 = bfhi(pt.w);
            if (i > 0) { const u32x4 po = *(const LAS u32x4*)(col + (t - win) * YS);
                S[0] += p0 - bflo(po.x); S[1] += p1 - bfhi(po.x); S[2] += p2 - bflo(po.y); S[3] += p3 - bfhi(po.y); S[4] += p4 - bflo(po.z); S[5] += p5 - bfhi(po.z); S[6] += p6 - bflo(po.w); S[7] += p7 - bfhi(po.w); }
            const int tseq = ch * 128 + t; const int cnt = (tseq + 1 < win) ? (tseq + 1) : win; const float inv = 1.0f / (float)cnt;
            u32x4 o; o.x = pk2(S[0] * inv - p0, S[1] * inv - p1); o.y = pk2(S[2] * inv - p2, S[3] * inv - p3); o.z = pk2(S[4] * inv - p4, S[5] * inv - p5); o.w = pk2(S[6] * inv - p6, S[7] * inv - p7);
            *(LAS u32x4*)(Y + t * YS + 8 * cc) = o; }
    }
    __syncthreads();
    const size_t trow = row0 + 16 * wv + c; float ssq = 0.f;
    const LAS bf16_t* ybase = Y + (16 * wv + c) * YS + 8 * q;
    f32x4 yv[4][4];
#pragma unroll
    for (int g = 0; g < 4; ++g) {
#pragma unroll
        for (int n = 0; n < 4; ++n) yv[g][n] = (f32x4){0.f, 0.f, 0.f, 0.f};
#pragma unroll
        for (int ks = 0; ks < 2; ++ks) { const bf16x8 bfrag = *(const LAS bf16x8*)(ybase + g * 64 + 32 * ks);
#pragma unroll
            for (int n = 0; n < 4; ++n) { const bf16x8 a = *(const bf16x8*)(pbase + (g * 64 + 16 * n) * 64 + 32 * ks); yv[g][n] = MFMA16(a, bfrag, yv[g][n]); } }
        CFENCE();
#pragma unroll
        for (int n = 0; n < 4; ++n) { const f32x4 sc = *(const f32x4*)(pscale + g * 64 + 16 * n + 4 * q); yv[g][n] = yv[g][n] * sc; ssq += ssq4(yv[g][n]); }
    }
    ssq += __shfl_xor(ssq, 16); ssq += __shfl_xor(ssq, 32);
    const float rs = rsqrtf(ssq * (1.0f / 256.0f) + EPS);
    bf16_t* yrow = ycat + trow * DM + 256 + 4 * q;
#pragma unroll
    for (int g = 0; g < 4; ++g)
#pragma unroll
        for (int n = 0; n < 4; ++n) st4(yrow + g * 64 + 16 * n, yv[g][n] * rs);
}

__device__ __forceinline__ bf16x8 tr_frag_perm(const LAS bf16_t* p, int rows16) {
    const v4i16_t lo = __builtin_amdgcn_ds_read_tr16_b64_v4i16((LAS v4i16_t*)p);
    const v4i16_t hi = __builtin_amdgcn_ds_read_tr16_b64_v4i16((LAS v4i16_t*)(p + rows16));
    return (bf16x8){lo[0], lo[1], lo[2], lo[3], hi[0], hi[1], hi[2], hi[3]};
}
__device__ __forceinline__ bf16x8 pack8(const f32x4 a, const f32x4 b) { u32x4 o; o.x = pk2(a[0], a[1]); o.y = pk2(a[2], a[3]); o.z = pk2(b[0], b[1]); o.w = pk2(b[2], b[3]); return __builtin_bit_cast(bf16x8, o); }

__device__ __forceinline__ void mixer_C(LAS unsigned char* L, const bf16_t* proj, const float* sinks, const float* rel_bias, bf16_t* ycat, int b, int qb, int tid, int lane, int w, u32x4 (&kr)[8], u32x4 (&vr)[8]) {
    constexpr int KS = 144;
    const int wv = tid >> 6;
    LAS bf16_t* KL = (LAS bf16_t*)L;
    LAS bf16_t* VL = (LAS bf16_t*)(L + 73728);
    LAS float* BT = (LAS float*)(L + 152064);
    const size_t row0 = (size_t)b * SEQ + qb * 128;
    const int c = lane & 15, q = lane >> 4;
    const size_t trow = row0 + 16 * wv + c;
    {
        const int skey = tid >> 1, shalf = tid & 1;
        { const int j = tid >> 7, dist = tid & 127; int bucket = dist;
          if (dist >= 16) { const int lg = 16 + (int)(__logf((float)dist * (1.0f / 16.0f)) / 2.0794415416798357f * 16.0f); bucket = lg < 31 ? lg : 31; }
          BT[j * 128 + dist] = rel_bias[bucket * 4 + j];
          if (tid < 288) *(LAS u32x4*)(VL + 256 * KS + 8 * tid) = (u32x4){0u, 0u, 0u, 0u}; }
#pragma unroll
        for (int i = 0; i < 8; ++i) { *(LAS u32x4*)(KL + skey * KS + shalf * 64 + 8 * i) = kr[i]; *(LAS u32x4*)(VL + skey * KS + shalf * 64 + 8 * i) = vr[i]; }
    }
    bf16x8 qf[4][2];
#pragma unroll
    for (int j = 0; j < 4; ++j)
#pragma unroll
        for (int ks = 0; ks < 2; ++ks) qf[j][ks] = *(const bf16x8*)(proj + trow * DIN + 768 + j * 64 + 32 * ks + 8 * q);
    __syncthreads();
    const LAS bf16_t* kbase = KL + (16 * wv + c) * KS + 8 * q;
    const LAS bf16_t* vbase = VL + (16 * wv + 4 * q + (c >> 2)) * KS + 4 * (c & 3);
    f32x4 yv[4][4]; float ssq = 0.f;
#pragma unroll
    for (int j = 0; j < 4; ++j) { const int kvh = j >> 1;
        f32x4 z[9];
#pragma unroll
        for (int kti = 0; kti < 9; ++kti) { z[kti] = (f32x4){0.f, 0.f, 0.f, 0.f};
#pragma unroll
            for (int ks = 0; ks < 2; ++ks) { const bf16x8 a = *(const LAS bf16x8*)(kbase + 16 * kti * KS + kvh * 64 + 32 * ks); z[kti] = MFMA16(a, qf[j][ks], z[kti]); } }
        const float sink = sinks[j]; const LAS float* bt = BT + j * 128;
        int zz; asm volatile("v_mov_b32 %0, 0" : "=v"(zz));
        const int cz = c + zz; const int klo = (qb > 0) ? (cz + 1) : max(cz + 1, 128 - 16 * w), khi = cz + 128;
        float mx = sink;
#pragma unroll
        for (int kti = 0; kti < 9; ++kti)
#pragma unroll
            for (int r = 0; r < 4; ++r) { const int kl = 16 * kti + 4 * q + r; const int dist = 128 + cz - kl; const bool valid = (unsigned)(kl - klo) <= (unsigned)(khi - klo);
                const float bb = bt[dist & 127]; const float v = valid ? (z[kti][r] + bb) : -1e30f; z[kti][r] = v; mx = fmaxf(mx, v); }
        mx = fmaxf(mx, __shfl_xor(mx, 16)); mx = fmaxf(mx, __shfl_xor(mx, 32));
        float sum = 0.f;
#pragma unroll
        for (int kti = 0; kti < 9; ++kti)
#pragma unroll
            for (int r = 0; r < 4; ++r) { const float p = (z[kti][r] > -1e29f) ? fexp(z[kti][r] - mx) : 0.f; z[kti][r] = p; sum += p; }
        sum += __shfl_xor(sum, 16); sum += __shfl_xor(sum, 32);
        const float inv = 1.0f / (sum + fexp(sink - mx));
#pragma unroll
        for (int n = 0; n < 4; ++n) yv[j][n] = (f32x4){0.f, 0.f, 0.f, 0.f};
#pragma unroll
        for (int ks = 0; ks < 5; ++ks) { const f32x4 zero4 = {0.f, 0.f, 0.f, 0.f};
            const bf16x8 bfrag = pack8(z[2 * ks] * inv, (ks < 4) ? (z[(ks < 4) ? 2 * ks + 1 : 0] * inv) : zero4);
#pragma unroll
            for (int n = 0; n < 4; ++n) { const bf16x8 a = tr_frag_perm(vbase + 32 * ks * KS + kvh * 64 + 16 * n, 16 * KS); yv[j][n] = MFMA16(a, bfrag, yv[j][n]); } }
#pragma unroll
        for (int n = 0; n < 4; ++n) ssq += ssq4(yv[j][n]);
    }
    ssq += __shfl_xor(ssq, 16); ssq += __shfl_xor(ssq, 32);
    const float rs = rsqrtf(ssq * (1.0f / 256.0f) + EPS);
    bf16_t* yrow = ycat + trow * DM + 512 + 4 * q;
#pragma unroll
    for (int j = 0; j < 4; ++j)
#pragma unroll
        for (int n = 0; n < 4; ++n) st4(yrow + j * 64 + 16 * n, yv[j][n] * rs);
}

#ifndef D_CUT
#define D_CUT 2.0e-9f
#endif
__device__ __forceinline__ void mixer_D(LAS unsigned char* L, const bf16_t* proj, bf16_t* ycat, int b, int qb64, int tid, int lane, int w) {
    constexpr int KS = 272;
    constexpr int TILE = 64 * KS;
    const int wv = tid >> 6;
    LAS bf16_t* KL = (LAS bf16_t*)L;
    LAS bf16_t* VL = (LAS bf16_t*)(L + 69632);
    LAS float* RED = (LAS float*)(L + 139264);
    volatile LAS unsigned* FLG = (volatile LAS unsigned*)(L + 139776);
    const int rg = wv & 3, hp = wv >> 2, c = lane & 15, q = lane >> 4;
    const size_t seq0 = (size_t)b * SEQ; const size_t trow = seq0 + qb64 * 64 + 16 * rg + c;
    const int skey = tid >> 3, spart = tid & 7;
    const bf16_t* ksrc0 = proj + (seq0 + skey) * DIN + 1536 + spart * 32;
    LAS bf16_t* kdst = KL + skey * KS + spart * 32;
    LAS bf16_t* vdst = VL + skey * KS + spart * 32;
    u32x4 kr[4], vr[4];
    { const bf16_t* ksrc = ksrc0 + (size_t)qb64 * 64 * DIN;
#pragma unroll
        for (int i = 0; i < 4; ++i) { kr[i] = *(const u32x4*)(ksrc + 8 * i); vr[i] = *(const u32x4*)(ksrc + 256 + 8 * i); } }
    bf16x8 qf[2][2];
#pragma unroll
    for (int hh = 0; hh < 2; ++hh)
#pragma unroll
        for (int ks = 0; ks < 2; ++ks) qf[hh][ks] = *(const bf16x8*)(proj + trow * DIN + 1280 + (2 * hp + hh) * 64 + 32 * ks + 8 * q);
    f32x4 acc[2][4];
#pragma unroll
    for (int hh = 0; hh < 2; ++hh)
#pragma unroll
        for (int n = 0; n < 4; ++n) acc[hh][n] = (f32x4){0.f, 0.f, 0.f, 0.f};
    float rem[2] = {1.f, 1.f};
    const int qloc = 16 * rg + c;
    const LAS bf16_t* kbase = KL + c * KS + hp * 128 + 8 * q;
    const LAS bf16_t* vbase = VL + (4 * q + (c >> 2)) * KS + hp * 128 + 4 * (c & 3);
    if (tid < 3) FLG[tid] = 0u;
#pragma unroll
    for (int i = 0; i < 4; ++i) { *(LAS u32x4*)(kdst + 8 * i) = kr[i]; *(LAS u32x4*)(vdst + 8 * i) = vr[i]; }
    u32x4 kr2[4], vr2[4];
    if (qb64 > 0) { const bf16_t* ksrc = ksrc0 + (size_t)(qb64 - 1) * 64 * DIN;
#pragma unroll
        for (int i = 0; i < 4; ++i) { kr[i] = *(const u32x4*)(ksrc + 8 * i); vr[i] = *(const u32x4*)(ksrc + 256 + 8 * i); } }
    if (qb64 > 1) { const bf16_t* ksrc = ksrc0 + (size_t)(qb64 - 2) * 64 * DIN;
#pragma unroll
        for (int i = 0; i < 4; ++i) { kr2[i] = *(const u32x4*)(ksrc + 8 * i); vr2[i] = *(const u32x4*)(ksrc + 256 + 8 * i); } }
    else {
#pragma unroll
        for (int i = 0; i < 4; ++i) { kr2[i] = (u32x4){0u, 0u, 0u, 0u}; vr2[i] = (u32x4){0u, 0u, 0u, 0u}; } }
#define D_STEP(KW, VW) \
        __syncthreads(); \
        if (it > 0 && FLG[fprev] == 0u) break; \
        const int bo = (it & 1) * TILE, bn = ((it + 1) & 1) * TILE; \
        if (kt > 0) { \
            _Pragma("unroll") \
            for (int i = 0; i < 4; ++i) { *(LAS u32x4*)(kdst + bn + 8 * i) = KW[i]; *(LAS u32x4*)(vdst + bn + 8 * i) = VW[i]; } \
            if (kt > 2) { const bf16_t* ksrc = ksrc0 + (size_t)(kt - 3) * 64 * DIN; \
                _Pragma("unroll") \
                for (int i = 0; i < 4; ++i) { KW[i] = *(const u32x4*)(ksrc + 8 * i); VW[i] = *(const u32x4*)(ksrc + 256 + 8 * i); } } \
        } \
        if (tid == 0) FLG[fnext] = 0u; \
        const bool diag = (kt == qb64); \
_Pragma("unroll") \
        for (int hh = 0; hh < 2; ++hh) { \
            f32x4 z[4]; \
_Pragma("unroll") \
            for (int kti = 0; kti < 4; ++kti) { z[kti] = (f32x4){0.f, 0.f, 0.f, 0.f}; \
_Pragma("unroll") \
                for (int ks = 0; ks < 2; ++ks) { const bf16x8 a = *(const LAS bf16x8*)(kbase + bo + 16 * kti * KS + hh * 64 + 32 * ks); z[kti] = MFMA16(a, qf[hh][ks], z[kti]); } } \
            f32x4 ex[4]; float G[4]; \
            if (diag) { \
_Pragma("unroll") \
                for (int kti = 0; kti < 4; ++kti) { float run = 1.f; \
_Pragma("unroll") \
                    for (int r = 3; r >= 0; --r) { const bool valid = (16 * kti + 4 * q + r < qloc); \
                        const float u = fexp(fminf(z[kti][r], 80.f)); const float om = __builtin_amdgcn_rcpf(1.0f + u); \
                        z[kti][r] = valid ? u * om : 0.f; ex[kti][r] = run; run *= valid ? om : 1.f; } \
                    G[kti] = run; } \
            } else { \
_Pragma("unroll") \
                for (int kti = 0; kti < 4; ++kti) { float run = 1.f; \
_Pragma("unroll") \
                    for (int r = 3; r >= 0; --r) { const float u = fexp(fminf(z[kti][r], 80.f)); const float om = __builtin_amdgcn_rcpf(1.0f + u); \
                        z[kti][r] = u * om; ex[kti][r] = run; run *= om; } \
                    G[kti] = run; } \
            } \
            float E[4], Tk[4]; \
_Pragma("unroll") \
            for (int kti = 0; kti < 4; ++kti) { const float bq = __shfl_xor(G[kti], 16); const float ps = G[kti] * bq; const float c2 = __shfl_xor(ps, 32); \
                E[kti] = ((q & 1) ? 1.f : bq) * ((q < 2) ? c2 : 1.f); Tk[kti] = ps * c2; } \
            const float U2 = Tk[3], U1 = U2 * Tk[2], U0 = U1 * Tk[1]; \
            const float cb = rem[hh]; \
            const float base[4] = {cb * U0 * E[0], cb * U1 * E[1], cb * U2 * E[2], cb * E[3]}; \
            rem[hh] = cb * U0 * Tk[0]; \
_Pragma("unroll") \
            for (int kti = 0; kti < 4; ++kti) \
_Pragma("unroll") \
                for (int r = 0; r < 4; ++r) z[kti][r] = z[kti][r] * (base[kti] * ex[kti][r]); \
_Pragma("unroll") \
            for (int ks = 0; ks < 2; ++ks) { const bf16x8 bfrag = pack8(z[2 * ks], z[2 * ks + 1]); \
_Pragma("unroll") \
                for (int n = 0; n < 4; ++n) { const bf16x8 a = tr_frag_perm(vbase + bo + 32 * ks * KS + hh * 64 + 16 * n, 16 * KS); acc[hh][n] = MFMA16(a, bfrag, acc[hh][n]); } } \
        } \
        if (__builtin_amdgcn_ballot_w64(fmaxf(rem[0], rem[1]) > D_CUT) != 0ull) { if (lane == 0) FLG[fcur] = 1u; } \
        { const int t = fprev; fprev = fcur; fcur = fnext; fnext = t; }
    int it = 0, fprev = 2, fcur = 0, fnext = 1;
#pragma unroll 1
    for (int kt = qb64; kt >= 0; --kt, ++it) {
        { D_STEP(kr, vr) }
        if (kt == 0) break;
        --kt; ++it;
        { D_STEP(kr2, vr2) }
    }
#undef D_STEP
    float ssq = 0.f;
#pragma unroll
    for (int hh = 0; hh < 2; ++hh)
#pragma unroll
        for (int n = 0; n < 4; ++n) ssq += ssq4(acc[hh][n]);
    ssq += __shfl_xor(ssq, 16); ssq += __shfl_xor(ssq, 32);
    __syncthreads();
    if (q == 0) RED[(16 * rg + c) * 2 + hp] = ssq;
    __syncthreads();
    const float tot = RED[(16 * rg + c) * 2 + 0] + RED[(16 * rg + c) * 2 + 1];
    const float rs = rsqrtf(tot * (1.0f / 256.0f) + EPS);
    bf16_t* yrow = ycat + trow * DM + 768 + hp * 128 + 4 * q;
#pragma unroll
    for (int hh = 0; hh < 2; ++hh)
#pragma unroll
        for (int n = 0; n < 4; ++n) st4(yrow + hh * 64 + 16 * n, acc[hh][n] * rs);
}

#define XB_TMO      128
#define XB_XCNT(j)  (256  + 64 * (j))
#define XB_XSUB(j)  (1280 + 64 * (j))
#define XB_XGEN(j)  (2304 + 64 * (j))
#define XB_TOP      3328
#define XB_TOPGEN   3392
#define XCD_BAR_WORDS 3456
#define XB_SPIN_CAP (1u << 18)

__device__ __forceinline__ unsigned xb_ld(unsigned* p)              { return __hip_atomic_load(p, __ATOMIC_RELAXED, __HIP_MEMORY_SCOPE_AGENT); }
__device__ __forceinline__ unsigned xb_add(unsigned* p, unsigned v) { return __hip_atomic_fetch_add(p, v, __ATOMIC_RELAXED, __HIP_MEMORY_SCOPE_AGENT); }
__device__ __forceinline__ unsigned xb_xcc_id() { return (unsigned)__builtin_amdgcn_s_getreg((3 << 11) | 20) & 0xFu; }
#define XB_SPIN(cond, bar) do { unsigned _sp = 0; while (cond) { __builtin_amdgcn_s_sleep(1); \
    if ((++_sp & 255u) == 0u) { if (xb_ld(&(bar)[XB_TMO])) break; if (_sp > XB_SPIN_CAP) { atomicAdd(&(bar)[XB_TMO], 1u); break; } } } } while (0)

struct XcdBarrier {
    unsigned* bar; unsigned x;
    volatile LAS unsigned* st;
};

__device__ __forceinline__ XcdBarrier xcd_barrier_post(unsigned* bar, volatile LAS unsigned* st) {
    XcdBarrier b; b.bar = bar; b.x = xb_xcc_id(); b.st = st;
    if (threadIdx.x == 0) (void)xb_add(&bar[XB_XCNT(b.x)], 1u);
    return b;
}
__device__ __forceinline__ void xcd_barrier_complete(unsigned* bar, unsigned x, unsigned& nloc, unsigned& nx) {
    const unsigned G = gridDim.x * gridDim.y * gridDim.z;
    unsigned sum, cnt, mine, sp = 0u;
    for (;;) {
        sum = 0u; cnt = 0u; mine = 0u;
#pragma unroll
        for (unsigned j = 0; j < 16; ++j) { const unsigned c = xb_ld(&bar[XB_XCNT(j)]); sum += c; cnt += (c > 0u) ? 1u : 0u; mine = (j == x) ? c : mine; }
        if (sum == G) break;
        __builtin_amdgcn_s_sleep(1);
        if ((++sp & 255u) == 0u) { if (xb_ld(&bar[XB_TMO])) break; if (sp > XB_SPIN_CAP) { atomicAdd(&bar[XB_TMO], 1u); break; } }
    }
    nloc = mine > 0u ? mine : 1u; nx = cnt > 0u ? cnt : 1u;
}

__device__ __forceinline__ void xcd_barrier(const XcdBarrier& b) {
    asm volatile("s_waitcnt vmcnt(0)" ::: "memory");
    __syncthreads();
    if (threadIdx.x == 0) {
        unsigned* bar = b.bar;
        __builtin_amdgcn_s_waitcnt(0);
        unsigned nloc = b.st[0], nx = b.st[1];
        if (nloc == 0u) { xcd_barrier_complete(bar, b.x, nloc, nx); b.st[0] = nloc; b.st[1] = nx; }
        const unsigned old = xb_add(&bar[XB_XSUB(b.x)], 1u);
        const unsigned gen = old / nloc;
        if (old + 1u == (gen + 1u) * nloc) {
            __builtin_amdgcn_fence(__ATOMIC_RELEASE, "agent");
            asm volatile("s_waitcnt vmcnt(0)" ::: "memory");
            const unsigned og = xb_add(&bar[XB_TOP], 1u);
            const unsigned tg = og / nx;
            if (og + 1u == (tg + 1u) * nx) xb_add(&bar[XB_TOPGEN], 1u);
            else XB_SPIN(xb_ld(&bar[XB_TOPGEN]) == tg, bar);
            __builtin_amdgcn_fence(__ATOMIC_ACQUIRE, "agent");
            xb_add(&bar[XB_XGEN(b.x)], 1u);
            asm volatile("s_waitcnt vmcnt(0)" ::: "memory");
        } else {
            XB_SPIN(xb_ld(&bar[XB_XGEN(b.x)]) == gen, bar);
            __builtin_amdgcn_fence(__ATOMIC_ACQUIRE, "agent");
            asm volatile("s_waitcnt vmcnt(0)" ::: "memory");
        }
    }
    __syncthreads();
}

#ifndef REP_SYNC
#define REP_SYNC 1
#endif
#define GSYNC() do { for (int _r = 0; _r < REP_SYNC; ++_r) xcd_barrier(xbar); } while (0)
__global__ void __launch_bounds__(NTHR, 2) fwd_megakernel(Params p) {
    extern __shared__ __attribute__((aligned(16))) unsigned char lds[];
    cg::grid_group grid = cg::this_grid();
    LAS unsigned char* L = (LAS unsigned char*)lds;
    const int tid = threadIdx.x, lane = tid & 63, wave = __builtin_amdgcn_readfirstlane(tid >> 6);
    const int G = gridDim.x, bx = blockIdx.x;
    unsigned char* ws = p.ws;
    bf16_t* Win_t = (bf16_t*)(ws + WS_WIN); bf16_t* Wout_t = (bf16_t*)(ws + WS_WOUT); bf16_t* Wgu_t = (bf16_t*)(ws + WS_WGU); bf16_t* Wdn_t = (bf16_t*)(ws + WS_WDN);
    bf16_t* SGUW = (bf16_t*)(ws + WS_SGUW); bf16_t* PWT = (bf16_t*)(ws + WS_PWT); float* SSQ = (float*)(ws + WS_SS);
    bf16_t* XB = (bf16_t*)(ws + WS_XB); bf16_t* PROJ = (bf16_t*)(ws + WS_PROJ); bf16_t* YCAT = (bf16_t*)(ws + WS_YCAT); bf16_t* HID = (bf16_t*)(ws + WS_HID);

    volatile LAS unsigned* xst = (volatile LAS unsigned*)(L + LDS_BYTES - 16);
    if (tid < 4) xst[tid] = 0u;
    unsigned* barw = (unsigned*)(ws + WS_BAR);
    if (bx == 0) for (int i = tid; i < XCD_BAR_WORDS; i += NTHR) __hip_atomic_store(barw + i, 0u, __ATOMIC_RELAXED, __HIP_MEMORY_SCOPE_AGENT);
#ifndef REP_P0
#define REP_P0 1
#endif
    for (int rep0 = 0; rep0 < REP_P0; ++rep0) {
        LAS float* scr = (LAS float*)(L + wave * 16384);
        const int gw = bx * 8 + wave, NGW = G * 8;
        constexpr int I_IN = (DM / 64) * (DIN / 32), I_OUT = (DM / 64) * (DM / 32), I_GU = (DM / 64) * (2 * DFF / 32), I_DN = (DFF / 64) * (DM / 32), I_L = I_IN + I_OUT + I_GU + I_DN;
        for (int it = gw; it < DEPTH * I_L; it += NGW) {
            const int l = it / I_L; int r = it % I_L;
            if (r < I_IN) { transpose_item(p.w_in + (size_t)l * DM * DIN, DM, DIN, Win_t + (size_t)l * DIN * DM, p.norm_mix + l * DM, 1, scr, r, lane); continue; } r -= I_IN;
            if (r < I_OUT) { transpose_item(p.w_out + (size_t)l * DM * DM, DM, DM, Wout_t + (size_t)l * DM * DM, p.mix_out_gain + l * DM, 0, scr, r, lane); continue; } r -= I_OUT;
            if (r < I_GU) { transpose_item(p.w_gate_up + (size_t)l * DM * 2 * DFF, DM, 2 * DFF, Wgu_t + (size_t)l * 2 * DFF * DM, p.norm_ffn + l * DM, 2, scr, r, lane); continue; } r -= I_GU;
            transpose_item(p.w_down + (size_t)l * DFF * DM, DFF, DM, Wdn_t + (size_t)l * DM * DFF, nullptr, 0, scr, r, lane);
        }
        for (int m = 2 * gw; m < M; m += 2 * NGW) {
            const f32x4* xr = (const f32x4*)(p.x + (size_t)m * DM) + lane; u32x2* o8 = (u32x2*)(XB + (size_t)m * DM) + lane; f32x4 v[2][4];
#pragma unroll
            for (int r = 0; r < 2; ++r)
#pragma unroll
                for (int j = 0; j < 4; ++j) v[r][j] = __builtin_nontemporal_load(xr + r * 256 + 64 * j);
#pragma unroll
            for (int r = 0; r < 2; ++r) { float s = 0.f;
#pragma unroll
                for (int j = 0; j < 4; ++j) { const f32x4 t = v[r][j]; s += ssq4(t); u32x2 o; o.x = pk2(t.x, t.y); o.y = pk2(t.z, t.w); o8[r * 256 + 64 * j] = o; }
                s = wave_sum(s);
                if (lane < 4) SSQ[(size_t)(m + r) * 4 + lane] = (lane == 0) ? s : 0.f; }
        }
        const int gt = bx * NTHR + tid, NGT = G * NTHR;
        for (int e = gt; e < DEPTH * 4 * 128 * 128 / 8; e += NGT) { const int s0 = (e & 15) * 8, t = (e >> 4) & 127; const float* src = p.sgu_w + (size_t)e * 8;
            const f32x4 a = *(const f32x4*)src, bq = *(const f32x4*)(src + 4); float v[8] = {a.x, a.y, a.z, a.w, bq.x, bq.y, bq.z, bq.w};
#pragma unroll
            for (int i = 0; i < 8; ++i) v[i] = (s0 + i <= t) ? v[i] : 0.f;
            u32x4 o; o.x = pk2(v[0], v[1]); o.y = pk2(v[2], v[3]); o.z = pk2(v[4], v[5]); o.w = pk2(v[6], v[7]); *(u32x4*)(SGUW + (size_t)e * 8) = o; }
        for (int e = gt; e < DEPTH * 4 * 64 * 64; e += NGT) { const int cc = e & 63, d = (e >> 6) & 63, lg = e >> 12; PWT[e] = f2bf(p.pool_w[((size_t)lg * 64 + cc) * 64 + d]); }
    }
    grid.sync();
    const XcdBarrier xbar = xcd_barrier_post(barw, xst);

    for (int l = 0; l < DEPTH; ++l) {
#ifndef REP_P1
#define REP_P1 1
#endif
#ifndef NO_P1
        for (int rep = 0; rep < REP_P1; ++rep) { int zk; asm volatile("s_mov_b32 %0, 0" : "=s"(zk)); pg8::Gemm g{XB, Win_t + (size_t)l * DIN * DM, M, DIN, DM + zk}; pg8::StaticOrder S; S.init(M, DIN, G + zk, bx); LAS float* RT = (LAS float*)(L + 135168); if (tid == 0) ((volatile LAS int*)(RT + 256))[0] = -1; __syncthreads(); pg8::EpiIn E{PROJ, SSQ, RT};
          pg8::gemm_phase<pg8::EpiIn, pg8::StaticOrder, true, true>(L, g, S, E, zk); }
#endif
        GSYNC();
#ifndef REP_MIX
#define REP_MIX 1
#endif
#ifndef REP_D
#define REP_D 1
#endif
        for (int rep = 0; rep < REP_MIX; ++rep)
        for (int u0 = bx; u0 < 256; u0 += G) {
            const int u = (G == 256) ? (((u0 & 7) << 5) | (u0 >> 3)) : u0; const int b = u >> 4, ch = u & 15;
            __syncthreads();
#ifndef REP_A
#define REP_A 1
#endif
#ifndef NO_A
            u32x4 bt[9], ckr[8], cvr[8];
            for (int rp = 0; rp < REP_A; ++rp) { __syncthreads(); int zt; asm volatile("v_mov_b32 %0, 0" : "=v"(zt)); const int t2 = tid + zt; mixer_A(L, PROJ, SGUW + (size_t)l * 4 * 128 * 128, p.sgu_b + l * 4 * 128, YCAT, b, ch, t2, t2 & 63, __builtin_amdgcn_readfirstlane(t2 >> 6), bt); }
#endif
            __syncthreads();
#ifndef REP_B
#define REP_B 1
#endif
#ifndef NO_B
            for (int rp = 0; rp < REP_B; ++rp) { __syncthreads(); int zt; asm volatile("v_mov_b32 %0, 0" : "=v"(zt)); const int t2 = tid + zt; mixer_B(L, PROJ, PWT + (size_t)l * 4 * 64 * 64, p.pool_scale + l * 256, YCAT, b, ch, t2, t2 & 63, __builtin_amdgcn_readfirstlane(t2 >> 6), bt, ckr, cvr); }
#endif
            __syncthreads();
#ifndef REP_C
#define REP_C 1
#endif
#ifndef NO_C
            for (int rp = 0; rp < REP_C; ++rp) { __syncthreads(); int zt; asm volatile("v_mov_b32 %0, 0" : "=v"(zt)); const int t2 = tid + zt; mixer_C(L, PROJ, p.swa_sinks + l * 4, p.rel_bias, YCAT, b, ch, t2, t2 & 63, __builtin_amdgcn_readfirstlane(t2 >> 6), ckr, cvr); }
#endif
            __syncthreads();
#ifndef NO_D
#pragma unroll 1
            for (int hf = 0; hf < 2 * REP_D; ++hf) { int zt; asm volatile("v_mov_b32 %0, 0" : "=v"(zt)); const int t2 = tid + zt; mixer_D(L, PROJ, YCAT, b, (hf & 1) ? 31 - ch : ch, t2, t2 & 63, __builtin_amdgcn_readfirstlane(t2 >> 6)); __syncthreads(); }
#endif
        }
        GSYNC();
#ifndef NO_P3
        { int zk; asm volatile("s_mov_b32 %0, 0" : "=s"(zk)); pg8::Gemm g{YCAT, Wout_t + (size_t)l * DM * DM, M, DM, DM + zk}; pg8::StaticOrder S; S.init(M, DM, G + zk, bx); pg8::EpiRes E{l == 0 ? p.x : nullptr, nullptr, XB, SSQ, (LAS float*)(L + 131072)};
          pg8::gemm_phase<pg8::EpiRes, pg8::StaticOrder, true, true>(L, g, S, E, zk); }
#endif
        GSYNC();
#ifndef REP_P4
#define REP_P4 1
#endif
#ifndef NO_P4
        for (int rep = 0; rep < REP_P4; ++rep) { int zk; asm volatile("s_mov_b32 %0, 0" : "=s"(zk)); pg8::Gemm g{XB, Wgu_t + (size_t)l * 2 * DFF * DM, M, 2 * DFF, DM + zk}; pg8::StaticOrder S; S.init(M, 2 * DFF, G + zk, bx); LAS float* RT = (LAS float*)(L + 135168); if (tid == 0) ((volatile LAS int*)(RT + 256))[0] = -1; __syncthreads(); pg8::EpiGU E{HID, SSQ, RT};
          pg8::gemm_phase<pg8::EpiGU, pg8::StaticOrder, true, true>(L, g, S, E, zk); }
#endif
        GSYNC();
#ifndef NO_P5
        { int zk; asm volatile("s_mov_b32 %0, 0" : "=s"(zk)); pg8::Gemm g{HID, Wdn_t + (size_t)l * DM * DFF, M, DM, DFF + zk}; pg8::StaticOrder S; S.init(M, DM, G + zk, bx); pg8::EpiRes E{nullptr, l == DEPTH - 1 ? p.out : nullptr, XB, SSQ, (LAS float*)(L + 131072)};
          pg8::gemm_phase<pg8::EpiRes, pg8::StaticOrder, true, true>(L, g, S, E, zk); }
#endif
        GSYNC();
    }
    {
        const int gw = bx * 8 + wave, NGW = G * 8;
        const f32x4* gr = (const f32x4*)p.norm_final + lane; f32x4 gg[4];
#pragma unroll
        for (int j = 0; j < 4; ++j) gg[j] = gr[64 * j];
        for (int m = 2 * gw; m < M; m += 2 * NGW) {
            f32x4* xr = (f32x4*)(p.out + (size_t)m * DM) + lane; f32x4 v[2][4]; float rs[2];
#pragma unroll
            for (int r = 0; r < 2; ++r) { rs[r] = rstd_of(SSQ, m + r);
#pragma unroll
                for (int j = 0; j < 4; ++j) v[r][j] = xr[r * 256 + 64 * j]; }
#pragma unroll
            for (int r = 0; r < 2; ++r)
#pragma unroll
                for (int j = 0; j < 4; ++j) __builtin_nontemporal_store(v[r][j] * rs[r] * gg[j], xr + r * 256 + 64 * j); }
    }
}

extern "C" void kernel_launch(void* const* d_in, const int* in_sizes, int n_in, void* d_out, int out_size, void* d_ws, size_t ws_size, hipStream_t stream) {
    static int grid_blocks = 0;
    if (grid_blocks == 0) {
        if (n_in != 15 || in_sizes[0] != M * DM || out_size != M * DM || ws_size < WS_END) { fprintf(stderr, "kernel_launch: unexpected shapes (n_in %d, in0 %d, out %d, ws %zu)\n", n_in, n_in > 0 ? in_sizes[0] : -1, out_size, ws_size); grid_blocks = -1; return; }
        int dev = 0, cus = 0, per_cu = 0;
        hipGetDevice(&dev); hipDeviceGetAttribute(&cus, hipDeviceAttributeMultiprocessorCount, dev);
        if (hipFuncSetAttribute((const void*)fwd_megakernel, hipFuncAttributeMaxDynamicSharedMemorySize, LDS_BYTES) != hipSuccess) { fprintf(stderr, "kernel_launch: hipFuncSetAttribute failed\n"); }
        if (hipOccupancyMaxActiveBlocksPerMultiprocessor(&per_cu, (const void*)fwd_megakernel, NTHR, LDS_BYTES) != hipSuccess || per_cu < 1) { fprintf(stderr, "kernel_launch: occupancy query says %d\n", per_cu); per_cu = 1; }
        (void)hipGetLastError();
        grid_blocks = cus * 1;
        if (grid_blocks <= 0) grid_blocks = 256;
    }
    if (grid_blocks < 0) return;
    Params p{};
    p.x = (const float*)d_in[0]; p.w_in = (const float*)d_in[1]; p.w_out = (const float*)d_in[2]; p.sgu_w = (const float*)d_in[3]; p.sgu_b = (const float*)d_in[4];
    p.pool_w = (const float*)d_in[5]; p.pool_scale = (const float*)d_in[6]; p.swa_sinks = (const float*)d_in[7]; p.rel_bias = (const float*)d_in[8]; p.mix_out_gain = (const float*)d_in[9];
    p.norm_mix = (const float*)d_in[10]; p.norm_ffn = (const float*)d_in[11]; p.w_gate_up = (const float*)d_in[12]; p.w_down = (const float*)d_in[13]; p.norm_final = (const float*)d_in[14];
    p.out = (float*)d_out; p.ws = (unsigned char*)d_ws;
    void* args[] = {&p};
    hipError_t e = hipLaunchCooperativeKernel((const void*)fwd_megakernel, dim3(grid_blocks), dim3(NTHR), args, LDS_BYTES, stream);
    if (e != hipSuccess) fprintf(stderr, "cooperative launch failed: %s (grid %d)\n", hipGetErrorString(e), grid_blocks);
}
```
